# Optimizing an MI355X kernel written in HIP

```python
import math
import jax, jax.numpy as jnp
from jax import lax
import numpy as np

D_MODEL = 1024
BATCH = 2
SEQ = 8192
DEPTH = 1
DEC_BATCH = 128
DEC_SEQ = 8
PAST_LEN = 16384
PAGE_SIZE = 128

HEAD_DIM = 64
RWKV_HEADS = 8
RWKV_WIDTH = RWKV_HEADS * HEAD_DIM
ATT_HEADS = 8
ATT_KV_HEADS = 2
ATT_GROUPS = ATT_HEADS // ATT_KV_HEADS
ATT_WIDTH = ATT_HEADS * HEAD_DIM
ATT_KV_WIDTH = ATT_KV_HEADS * HEAD_DIM
MIX_WIDTH = RWKV_WIDTH + ATT_WIDTH
DECAY_LORA = 64
ICLR_LORA = 64
GATE_LORA = 128
RWKV_PROJ = 3 * RWKV_WIDTH + DECAY_LORA + ICLR_LORA + GATE_LORA
IN_PROJ = RWKV_PROJ + ATT_WIDTH + 2 * ATT_KV_WIDTH
WINDOW = 128
N_BUCKETS = 32
MAX_DISTANCE = 128
D_FF = 2816
N_MOD = 9
ALPHA = (2 * DEPTH) ** 0.25
BETA = (8 * DEPTH) ** -0.25
LN_EPS = 1e-5
GN_EPS = 64e-5
NEG_INF = -1e30

kernel_name = 'hymba_rwkv7_swa_sink_macaron_deepnorm_step'


def post_ln(h, g, b):
    hf = h.astype(jnp.float32)
    mu = jnp.mean(hf, axis=-1, keepdims=True)
    var = jnp.mean(jnp.square(hf - mu), axis=-1, keepdims=True)
    return ((hf - mu) * lax.rsqrt(var + LN_EPS) * g + b).astype(h.dtype)


def modulate(x, shift, scale):
    return x * (1 + scale) + shift


def swiglu(u, w_in, w_out):
    gt, up = jnp.split(u @ w_in, 2, axis=-1)
    return (jax.nn.silu(gt) * up) @ w_out


def rel_bucket(dist):
    max_exact = N_BUCKETS // 2
    n = jnp.maximum(dist, 0)
    n_f = jnp.maximum(n, max_exact).astype(jnp.float32)
    large = max_exact + (jnp.log(n_f / max_exact) / math.log(MAX_DISTANCE / max_exact)
                         * (N_BUCKETS - max_exact)).astype(jnp.int32)
    return jnp.where(n < max_exact, n, jnp.minimum(large, N_BUCKETS - 1))


def band_bias(n_q, n_prefix, n_keys, rel_bias):
    dist = jnp.arange(n_q)[:, None] + n_prefix - jnp.arange(n_keys)[None, :]
    mask = (dist >= 0) & (dist < WINDOW)
    bias = jnp.take(rel_bias, rel_bucket(dist), axis=0)
    bias = jnp.transpose(bias, (2, 0, 1)).reshape(ATT_KV_HEADS, ATT_GROUPS, n_q, n_keys)
    return bias.astype(jnp.float32), mask


def sink_attention(q, k, v, bias, mask, sinks):
    s = jnp.einsum('...qhgd,...shd->...hgqs', q, k).astype(jnp.float32) * (HEAD_DIM ** -0.5) + bias
    s = jnp.where(mask, s, NEG_INF)
    sink = jnp.broadcast_to(sinks.astype(jnp.float32).reshape(ATT_KV_HEADS, ATT_GROUPS, 1, 1), s.shape[:-1] + (1,))
    p = jax.nn.softmax(jnp.concatenate([s, sink], axis=-1), axis=-1)[..., :-1]
    return jnp.einsum('...hgqs,...shd->...qhgd', p.astype(v.dtype), v)


def swa_prompt(q, k, v, rel_bias, sinks):
    bsz, t = q.shape[:2]
    nb = t // WINDOW
    qb = q.reshape(bsz, nb, WINDOW, ATT_KV_HEADS, ATT_GROUPS, HEAD_DIM)

    def band(a):
        ap = jnp.pad(a, ((0, 0), (WINDOW, 0), (0, 0), (0, 0))).reshape(bsz, nb + 1, WINDOW, ATT_KV_HEADS, HEAD_DIM)
        return jnp.concatenate([ap[:, :-1], ap[:, 1:]], axis=2)

    bias, mask = band_bias(WINDOW, WINDOW, 2 * WINDOW, rel_bias)
    valid = (jnp.arange(nb)[:, None, None] > 0) | (jnp.arange(2 * WINDOW)[None, None, :] >= WINDOW)
    mask = mask[None] & valid
    o = sink_attention(qb, band(k), band(v), bias, mask[None, :, None, None], sinks)
    return o.reshape(bsz, t, ATT_WIDTH)


def swa_sample(q, k, v, kbuf, vbuf, rel_bias, sinks):
    bsz, t = q.shape[:2]
    wb = kbuf.shape[1]
    kc = jnp.concatenate([kbuf.astype(k.dtype), k], axis=1)
    vc = jnp.concatenate([vbuf.astype(v.dtype), v], axis=1)
    bias, mask = band_bias(t, wb, wb + t, rel_bias)
    o = sink_attention(q, kc, vc, bias, mask[None, None, None], sinks)
    return o.reshape(bsz, t, ATT_WIDTH), kc[:, -wb:], vc[:, -wb:]


def wkv7_scan(r, w, k, v, kk, a, s0):
    def step(s, inp):
        r_t, w_t, k_t, v_t, kk_t, a_t = inp
        sa = jnp.einsum('bhvk,bhk->bhv', s, kk_t)
        s = s * w_t[:, :, None, :] - sa[..., None] * (kk_t * a_t)[:, :, None, :] + v_t[..., None] * k_t[:, :, None, :]
        return s, jnp.einsum('bhvk,bhk->bhv', s, r_t)
    xs = tuple(jnp.moveaxis(z.astype(jnp.float32), 1, 0) for z in (r, w, k, v, kk, a))
    s_fin, ys = lax.scan(step, s0.astype(jnp.float32), xs)
    return jnp.moveaxis(ys, 0, 1), s_fin


def rwkv_mix(p, shift0, s0, lp):
    bsz, t = p.shape[:2]
    prev = jnp.concatenate([shift0[:, None].astype(p.dtype), p[:, :-1]], axis=1)
    xs = p + (prev - p) * lp['mu_shift']
    r, k, v, wl, al, gl = jnp.split(xs, [RWKV_WIDTH, 2 * RWKV_WIDTH, 3 * RWKV_WIDTH,
                                         3 * RWKV_WIDTH + DECAY_LORA,
                                         3 * RWKV_WIDTH + DECAY_LORA + ICLR_LORA], axis=-1)
    w = -jax.nn.softplus(-(lp['w0'] + jnp.tanh(wl) @ lp['w_decay']).astype(jnp.float32)) - 0.5
    decay = jnp.exp(-jnp.exp(w))
    a = jax.nn.sigmoid(lp['a0'] + al @ lp['w_iclr'])
    g = jax.nn.sigmoid(gl) @ lp['w_gate']
    heads = lambda z: z.reshape(bsz, t, RWKV_HEADS, HEAD_DIM)
    kk = heads(k * lp['k_k']).astype(jnp.float32)
    kk = kk / jnp.maximum(jnp.sqrt(jnp.sum(kk * kk, axis=-1, keepdims=True)), 1e-12)
    k = k * (1 + (a - 1) * lp['k_a'])
    rh, kh, vh = heads(r), heads(k), heads(v)
    y, s_fin = wkv7_scan(rh, heads(decay), kh, vh, kk, heads(a), s0)
    mu = jnp.mean(y, axis=-1, keepdims=True)
    var = jnp.mean(jnp.square(y - mu), axis=-1, keepdims=True)
    yn = ((y - mu) * lax.rsqrt(var + GN_EPS)).reshape(bsz, t, RWKV_WIDTH) * lp['gn_w'] + lp['gn_b']
    bonus = (jnp.sum(rh * kh * lp['r_k'], axis=-1, keepdims=True) * vh).reshape(bsz, t, RWKV_WIDTH)
    out = (yn + bonus.astype(jnp.float32)) * g
    return out.astype(p.dtype), p[:, -1], s_fin


def block(x, c, wkv0, shift0, kbuf, vbuf, w_buf, lp, rel_bias):
    bsz, t = x.shape[:2]
    mod = (jax.nn.silu(c) @ lp['w_ada'] + lp['b_ada'])[:, None, :]
    sh1, sc1, gt1, sh2, sc2, gt2, sh3, sc3, gt3 = jnp.split(mod, N_MOD, axis=-1)
    f1 = swiglu(modulate(x, sh1, sc1), lp['w_ffn1_in'], lp['w_ffn1_out'])
    x = post_ln(ALPHA * x + 0.5 * (1 + gt1) * f1, lp['ln_g'][0], lp['ln_b'][0])
    u = modulate(x, sh2, sc2)
    p = u @ lp['w_in']
    p_rwkv, q, k, v = jnp.split(p, [RWKV_PROJ, RWKV_PROJ + ATT_WIDTH, RWKV_PROJ + ATT_WIDTH + ATT_KV_WIDTH], axis=-1)
    y_rwkv, shift_new, wkv_new = rwkv_mix(p_rwkv, shift0, wkv0, lp)
    q = q.reshape(bsz, t, ATT_KV_HEADS, ATT_GROUPS, HEAD_DIM)
    k = k.reshape(bsz, t, ATT_KV_HEADS, HEAD_DIM)
    v = v.reshape(bsz, t, ATT_KV_HEADS, HEAD_DIM)
    if kbuf is None:
        y_att = swa_prompt(q, k, v, rel_bias, lp['sinks'])
        kb_new, vb_new = k[:, t - w_buf:], v[:, t - w_buf:]
    else:
        y_att, kb_new, vb_new = swa_sample(q, k, v, kbuf, vbuf, rel_bias, lp['sinks'])
    mix = jnp.concatenate([y_rwkv, y_att.astype(y_rwkv.dtype)], axis=-1) @ lp['w_out']
    x = post_ln(ALPHA * x + (1 + gt2) * mix, lp['ln_g'][1], lp['ln_b'][1])
    f2 = swiglu(modulate(x, sh3, sc3), lp['w_ffn2_in'], lp['w_ffn2_out'])
    x = post_ln(ALPHA * x + 0.5 * (1 + gt3) * f2, lp['ln_g'][2], lp['ln_b'][2])
    return x, wkv_new, shift_new, kb_new, vb_new


def setup_inputs(seed: int = 0) -> dict:
    key = jax.random.key(seed)
    ks = jax.random.split(key, 32)
    f32 = jnp.float32

    def nrm(i, shape, scale):
        return jax.random.normal(ks[i], shape, f32) * scale

    w_buf = min(WINDOW, PAST_LEN)
    L, D, F = DEPTH, D_MODEL, D_FF
    return {
        'x_prompt': nrm(0, (BATCH, SEQ, D), 1.0),
        'x_sample': nrm(1, (DEC_BATCH, DEC_SEQ, D), 1.0),
        'state_wkv': nrm(2, (L, DEC_BATCH, RWKV_HEADS, HEAD_DIM, HEAD_DIM), 0.1),
        'state_shift': nrm(3, (L, DEC_BATCH, RWKV_PROJ), 1.0),
        'cache_win_k': nrm(4, (L, DEC_BATCH, w_buf, ATT_KV_HEADS, HEAD_DIM), 1.0),
        'cache_win_v': nrm(5, (L, DEC_BATCH, w_buf, ATT_KV_HEADS, HEAD_DIM), 1.0),
        'c_prompt': nrm(6, (BATCH, D), 1.0),
        'c_sample': nrm(7, (DEC_BATCH, D), 1.0),
        'rel_bias': nrm(8, (N_BUCKETS, ATT_HEADS), 0.5),
        'w_ada': nrm(9, (L, D, N_MOD * D), 0.1 * D ** -0.5),
        'b_ada': nrm(10, (L, N_MOD * D), 0.01),
        'ln_g': 1.0 + nrm(11, (L, 3, D), 0.01),
        'ln_b': nrm(12, (L, 3, D), 0.01),
        'w_ffn1_in': nrm(13, (L, D, 2 * F), D ** -0.5),
        'w_ffn1_out': nrm(14, (L, F, D), BETA * F ** -0.5),
        'w_in': nrm(15, (L, D, IN_PROJ), D ** -0.5),
        'mu_shift': jax.random.uniform(ks[16], (L, RWKV_PROJ), f32),
        'w0': jax.random.uniform(ks[17], (L, RWKV_WIDTH), f32, -5.0, 0.5),
        'w_decay': nrm(18, (L, DECAY_LORA, RWKV_WIDTH), 0.1),
        'a0': nrm(19, (L, RWKV_WIDTH), 0.1),
        'w_iclr': nrm(20, (L, ICLR_LORA, RWKV_WIDTH), ICLR_LORA ** -0.5),
        'w_gate': nrm(21, (L, GATE_LORA, RWKV_WIDTH), GATE_LORA ** -0.5),
        'k_k': 0.85 + nrm(22, (L, RWKV_WIDTH), 0.02),
        'k_a': 1.0 + nrm(23, (L, RWKV_WIDTH), 0.02),
        'r_k': nrm(24, (L, RWKV_HEADS, HEAD_DIM), 0.1),
        'gn_w': 1.0 + nrm(25, (L, RWKV_WIDTH), 0.01),
        'gn_b': nrm(26, (L, RWKV_WIDTH), 0.01),
        'sinks': nrm(27, (L, ATT_HEADS), 0.5),
        'w_out': nrm(28, (L, MIX_WIDTH, D), BETA * MIX_WIDTH ** -0.5),
        'w_ffn2_in': nrm(29, (L, D, 2 * F), D ** -0.5),
        'w_ffn2_out': nrm(30, (L, F, D), BETA * F ** -0.5),
    }


def reference(x_prompt, x_sample, state_wkv, state_shift, cache_win_k, cache_win_v,
              c_prompt, c_sample, rel_bias, w_ada, b_ada, ln_g, ln_b,
              w_ffn1_in, w_ffn1_out, w_in, mu_shift, w0, w_decay, a0, w_iclr, w_gate,
              k_k, k_a, r_k, gn_w, gn_b, sinks, w_out, w_ffn2_in, w_ffn2_out):
    w_buf = cache_win_k.shape[2]
    y_prompt, y_sample = x_prompt, x_sample
    p_wkv, p_shift, p_k, p_v = [], [], [], []
    s_wkv, s_shift, s_k, s_v = [], [], [], []
    nbp = x_prompt.shape[0]
    for l in range(DEPTH):
        lp = {'w_ada': w_ada[l], 'b_ada': b_ada[l], 'ln_g': ln_g[l], 'ln_b': ln_b[l],
              'w_ffn1_in': w_ffn1_in[l], 'w_ffn1_out': w_ffn1_out[l], 'w_in': w_in[l],
              'mu_shift': mu_shift[l], 'w0': w0[l], 'w_decay': w_decay[l], 'a0': a0[l],
              'w_iclr': w_iclr[l], 'w_gate': w_gate[l], 'k_k': k_k[l], 'k_a': k_a[l],
              'r_k': r_k[l], 'gn_w': gn_w[l], 'gn_b': gn_b[l], 'sinks': sinks[l],
              'w_out': w_out[l], 'w_ffn2_in': w_ffn2_in[l], 'w_ffn2_out': w_ffn2_out[l]}
        wkv0 = jnp.zeros((nbp, RWKV_HEADS, HEAD_DIM, HEAD_DIM), jnp.float32)
        shift0 = jnp.zeros((nbp, RWKV_PROJ), x_prompt.dtype)
        y_prompt, wkv_p, sh_p, k_p, v_p = block(y_prompt, c_prompt, wkv0, shift0, None, None, w_buf, lp, rel_bias)
        y_sample, wkv_s, sh_s, k_s, v_s = block(y_sample, c_sample, state_wkv[l], state_shift[l],
                                                cache_win_k[l], cache_win_v[l], w_buf, lp, rel_bias)
        p_wkv.append(wkv_p); p_shift.append(sh_p); p_k.append(k_p); p_v.append(v_p)
        s_wkv.append(wkv_s); s_shift.append(sh_s); s_k.append(k_s); s_v.append(v_s)
    return (y_prompt, y_sample,
            jnp.stack(p_wkv).astype(state_wkv.dtype), jnp.stack(p_shift).astype(state_shift.dtype),
            jnp.stack(p_k).astype(cache_win_k.dtype), jnp.stack(p_v).astype(cache_win_v.dtype),
            jnp.stack(s_wkv).astype(state_wkv.dtype), jnp.stack(s_shift).astype(state_shift.dtype),
            jnp.stack(s_k).astype(cache_win_k.dtype), jnp.stack(s_v).astype(cache_win_v.dtype))
```

```cpp
#define MK_PER_PHASE 1
#include <hip/hip_runtime.h>
#include <cstdio>
#include <cstdint>
#include <cmath>
namespace pg8 {
#define PG8_LAS __attribute__((address_space(3)))
typedef unsigned short bf16_t;
typedef short bf16x8 __attribute__((ext_vector_type(8)));
typedef float f32x4 __attribute__((ext_vector_type(4)));
typedef unsigned u32x4 __attribute__((ext_vector_type(4)));
constexpr int BM = 256, BK = 64, HALF = 128, HTB = HALF * BK * 2  , STAGE_BYTES = 8 * HTB, NXCD = 8, WGM = 8;

__host__ __device__ __forceinline__ int lds_byte(int r, int c) { const int st = (r >> 4) * 2 + (c >> 5), rr = r & 15, cc = c & 31, ob = rr * 64 + cc * 2; return st * 1024 + (ob ^ (((ob >> 9) & 1) << 5)); }
__host__ __device__ __forceinline__ void stage_rc(int b, int& R, int& C) { const int st = b / 1024, sb = b % 1024, swz = sb ^ (((sb >> 9) & 1) << 5); R = (st >> 1) * 16 + swz / 64; C = (st & 1) * 32 + (swz % 64) / 2; }
__host__ __device__ __forceinline__ int perm32(int rho) { const int n = rho >> 4, i = rho & 15; return 8 * (i >> 2) + 4 * n + (i & 3); }

struct Unit { int pm, pn; };
struct Gemm { const bf16_t* A; const bf16_t* Bt; int M, N, K; };

struct StaticOrder {
    int nM, nN, nwg, G, c;
    __host__ __device__ void init(int M, int N, int G_, int c_) { nM = M / BM; nN = N / BM; nwg = nM * nN; G = G_; c = c_; }
    __host__ __device__ bool next(int i, Unit& u) const {
        const long L = (long)i * G + c; if (L >= nwg) return false;
        int wgid = (int)L; { const int q = nwg / NXCD, r = nwg % NXCD, xcd = wgid % NXCD, off = wgid / NXCD; wgid = (xcd < r ? xcd * (q + 1) : r * (q + 1) + (xcd - r) * q) + off; }
        const int nig = WGM * nN, gid = wgid / nig, fm = gid * WGM, gsz = (nM - fm) < WGM ? (nM - fm) : WGM;
        u.pm = fm + ((wgid % nig) % gsz); u.pn = (wgid % nig) / gsz; return true;
    }
    __device__ __forceinline__ void a_ready(const Unit&) const {}
    __device__ __forceinline__ void done(const Unit&) const {}
};

__device__ __forceinline__ unsigned cvt_pk_bf16(float lo, float hi) { unsigned r; asm volatile("v_cvt_pk_bf16_f32 %0, %1, %2" : "=v"(r) : "v"(lo), "v"(hi)); return r; }
template <int ACT  > struct EpiBf16 {
    static constexpr bool PERM = true, AFTER_DRAIN = false; static_assert(ACT == 0, "EpiBf16: ACT is 0 (none)");
    bf16_t* O; int ldc; const float* bias; int split_cols; size_t split_stride; float scale0;
    __device__ __forceinline__ void operator()(const f32x4 (&acc)[2][2][4][2], const Unit& u, int wr, int wc, int fr, int fq) const {
        const int row0 = u.pm * BM + wr * 64 + fr; int colt = u.pn * BM; bf16_t* base = O;
        float sc = 1.f; if (split_cols) { const int t = colt / split_cols; base += (size_t)t * split_stride; colt -= t * split_cols; if (t == 0) sc = scale0; }
        const int col0 = colt + wc * 32 + 8 * fq, bcol0 = u.pn * BM + wc * 32 + 8 * fq;
        f32x4 bv[2][2];
#pragma unroll
        for (int bj = 0; bj < 2; ++bj)
#pragma unroll
            for (int n = 0; n < 2; ++n) bv[bj][n] = bias ? *(const f32x4*)(bias + bcol0 + bj * HALF + 4 * n) : (f32x4){0.f, 0.f, 0.f, 0.f};
#pragma unroll
        for (int ai = 0; ai < 2; ++ai)
#pragma unroll
            for (int m = 0; m < 4; ++m) { bf16_t* rowp = base + (size_t)(row0 + ai * HALF + m * 16) * ldc + col0;
#pragma unroll
                for (int bj = 0; bj < 2; ++bj) { f32x4 v0 = acc[ai][bj][m][0] + bv[bj][0], v1 = acc[ai][bj][m][1] + bv[bj][1];
                    v0 = v0 * sc; v1 = v1 * sc; u32x4 w; w.x = cvt_pk_bf16(v0[0], v0[1]); w.y = cvt_pk_bf16(v0[2], v0[3]); w.z = cvt_pk_bf16(v1[0], v1[1]); w.w = cvt_pk_bf16(v1[2], v1[3]);
                    *(u32x4*)(rowp + bj * HALF) = w; } }
    }
};

template <class Epi, class Sched, bool ALIGN_EPI = false, bool SP2 = false>
__device__ __forceinline__ void gemm_phase(PG8_LAS unsigned char* lds, const Gemm g, const Sched& S, const Epi& E) {
    const int tid = threadIdx.x, wid = __builtin_amdgcn_readfirstlane(tid >> 6), lane = tid & 63, wr = wid >> 2, wc = wid & 3, fr = lane & 15, fq = lane >> 4;
    const int K = g.K, nt = K / BK;
    unsigned voffA[2], voffB[2];
#pragma unroll
    for (int i = 0; i < 2; ++i) { int R, C; stage_rc(tid * 16 + i * 8192, R, C); const int Rb = Epi::PERM ? ((R & ~31) + perm32(R & 31)) : R;
        voffA[i] = (unsigned)(R * K + C) * 2u; voffB[i] = (unsigned)(Rb * K + C) * 2u; }
    const size_t kstep = (size_t)(BK * 2);
    const size_t hstep = (size_t)HALF * K * 2;
    const size_t tstep = 2 * hstep;
    const unsigned ldsw = (unsigned)wid * 1024u;
    const int aoff = lds_byte(wr * 64 + fr, fq * 8), boff = lds_byte(wc * 32 + fr, fq * 8);
#define PG8_SA(b, h) (((b) * 2 + (h)) * HTB)
#define PG8_SB(b, h) ((4 + (b) * 2 + (h)) * HTB)
#define PG8_STAGE(bufoff, gbase, voff) do { _Pragma("unroll") for (int _i = 0; _i < 2; ++_i) \
        __builtin_amdgcn_global_load_lds((const unsigned*)((const char*)(gbase) + (voff)[_i]), (PG8_LAS unsigned*)(lds + (bufoff) + ldsw + _i * 8192), 16, 0, 0); } while (0)
#define PG8_LDA(dst, b, h) do { _Pragma("unroll") for (int m = 0; m < 4; ++m) _Pragma("unroll") for (int k = 0; k < 2; ++k) dst[m][k] = *(const PG8_LAS bf16x8*)(lds + PG8_SA(b, h) + aoff + m * 2048 + k * 1024); } while (0)
#define PG8_LDB(dst, b, h) do { _Pragma("unroll") for (int n = 0; n < 2; ++n) _Pragma("unroll") for (int k = 0; k < 2; ++k) dst[n][k] = *(const PG8_LAS bf16x8*)(lds + PG8_SB(b, h) + boff + n * 2048 + k * 1024); } while (0)
#define PG8_MMA(ai, bj, At, Bt) do { __builtin_amdgcn_s_setprio(1); _Pragma("unroll") for (int m = 0; m < 4; ++m) _Pragma("unroll") for (int n = 0; n < 2; ++n) _Pragma("unroll") for (int k = 0; k < 2; ++k) \
        acc[ai][bj][m][n] = __builtin_amdgcn_mfma_f32_16x16x32_bf16(Bt[n][k], At[m][k], acc[ai][bj][m][n], 0, 0, 0); __builtin_amdgcn_s_setprio(0); } while (0)
#define PG8_WAIT_V(n) asm volatile("s_waitcnt vmcnt(" #n ")" ::: "memory")
#define PG8_WAIT_L(n) asm volatile("s_waitcnt lgkmcnt(" #n ")" ::: "memory")
#define PG8_BAR __builtin_amdgcn_s_barrier()
#define PG8_SCHED __builtin_amdgcn_sched_barrier(0)
    Unit cur, nxt; int ui = 0;
    if (!S.next(0, cur)) return;
    f32x4 acc[2][2][4][2];
#pragma unroll
    for (int a = 0; a < 2; ++a)
#pragma unroll
        for (int b = 0; b < 2; ++b)
#pragma unroll
            for (int m = 0; m < 4; ++m)
#pragma unroll
                for (int n = 0; n < 2; ++n) acc[a][b][m][n] = (f32x4){0.f, 0.f, 0.f, 0.f};
    bf16x8 At[4][2], B0[2][2], B1[2][2];
    const char* cA = (const char*)g.A + (size_t)cur.pm * tstep; const char* cB = (const char*)g.Bt + (size_t)cur.pn * tstep;
    S.a_ready(cur);
    if constexpr (SP2) {
        PG8_STAGE(PG8_SB(0, 0), cB, voffB); PG8_STAGE(PG8_SB(0, 1), cB + hstep, voffB); PG8_STAGE(PG8_SA(0, 0), cA, voffA); PG8_STAGE(PG8_SA(0, 1), cA + hstep, voffA);
        if (wr == 1) PG8_BAR;
        PG8_WAIT_V(2); PG8_BAR;
        PG8_STAGE(PG8_SB(1, 0), cB + kstep, voffB); PG8_STAGE(PG8_SA(1, 0), cA + kstep, voffA); PG8_STAGE(PG8_SB(1, 1), cB + hstep + kstep, voffB);
        PG8_WAIT_V(6); PG8_BAR;
    } else {
        PG8_STAGE(PG8_SB(0, 0), cB, voffB); PG8_STAGE(PG8_SA(0, 0), cA, voffA); PG8_STAGE(PG8_SB(0, 1), cB + hstep, voffB); PG8_STAGE(PG8_SA(0, 1), cA + hstep, voffA);
        if (wr == 1) PG8_BAR;
        PG8_WAIT_V(4); PG8_BAR;
        PG8_STAGE(PG8_SB(1, 0), cB + kstep, voffB); PG8_STAGE(PG8_SA(1, 0), cA + kstep, voffA); PG8_STAGE(PG8_SB(1, 1), cB + hstep + kstep, voffB);
        PG8_WAIT_V(6); PG8_BAR;
    }
    for (;;) {
        const bool has_next = S.next(ui + 1, nxt);
        const char* nA = has_next ? (const char*)g.A + (size_t)nxt.pm * tstep : cA; const char* nB = has_next ? (const char*)g.Bt + (size_t)nxt.pn * tstep : cB;
        for (int t = 0; t < nt; t += 2) {
            const bool last = (t == nt - 2);
            const char* a1 = cA + (size_t)(t + 1) * kstep;
            const char* a2 = last ? nA : cA + (size_t)(t + 2) * kstep; const char* b2 = last ? nB : cB + (size_t)(t + 2) * kstep;
            const char* a3 = a2 + kstep; const char* b3 = b2 + kstep;
            if (last && has_next) S.a_ready(nxt);
            if constexpr (SP2) {
            PG8_LDB(B0, 0, 0); PG8_LDB(B1, 0, 1); PG8_SCHED; PG8_LDA(At, 0, 0); PG8_STAGE(PG8_SA(1, 1), a1 + hstep, voffA);
            PG8_WAIT_V(8); PG8_WAIT_L(0); PG8_BAR; PG8_MMA(0, 0, At, B0); PG8_MMA(0, 1, At, B1); PG8_BAR; PG8_SCHED;
            PG8_LDA(At, 0, 1); PG8_STAGE(PG8_SB(0, 0), b2, voffB); PG8_STAGE(PG8_SB(0, 1), b2 + hstep, voffB); PG8_STAGE(PG8_SA(0, 0), a2, voffA);
            PG8_WAIT_V(8); PG8_WAIT_L(0); PG8_BAR; PG8_MMA(1, 0, At, B0); PG8_MMA(1, 1, At, B1); PG8_BAR; PG8_SCHED;
            PG8_LDB(B0, 1, 0); PG8_LDB(B1, 1, 1); PG8_SCHED; PG8_LDA(At, 1, 0); PG8_STAGE(PG8_SA(0, 1), a2 + hstep, voffA);
            PG8_WAIT_V(8); PG8_WAIT_L(0); PG8_BAR; PG8_MMA(0, 0, At, B0); PG8_MMA(0, 1, At, B1); PG8_BAR; PG8_SCHED;
            PG8_LDA(At, 1, 1); PG8_STAGE(PG8_SB(1, 0), b3, voffB); PG8_STAGE(PG8_SB(1, 1), b3 + hstep, voffB); PG8_STAGE(PG8_SA(1, 0), a3, voffA);
            PG8_WAIT_V(8); PG8_WAIT_L(0); PG8_BAR; PG8_MMA(1, 0, At, B0); PG8_MMA(1, 1, At, B1); PG8_BAR; PG8_SCHED;
            } else {
            PG8_LDB(B0, 0, 0); PG8_SCHED; PG8_LDA(At, 0, 0); PG8_STAGE(PG8_SA(1, 1), a1 + hstep, voffA);
            PG8_WAIT_L(8); PG8_BAR; PG8_WAIT_L(0); PG8_MMA(0, 0, At, B0); PG8_BAR; PG8_SCHED;
            PG8_LDB(B1, 0, 1); PG8_STAGE(PG8_SB(0, 0), b2, voffB);
            PG8_BAR; PG8_WAIT_L(0); PG8_MMA(0, 1, At, B1); PG8_BAR;
            PG8_LDA(At, 0, 1); PG8_STAGE(PG8_SA(0, 0), a2, voffA);
            PG8_BAR; PG8_WAIT_L(0); PG8_MMA(1, 0, At, B0); PG8_BAR; PG8_SCHED;
            PG8_STAGE(PG8_SB(0, 1), b2 + hstep, voffB);
            PG8_WAIT_V(6); PG8_BAR; PG8_MMA(1, 1, At, B1); PG8_BAR;
            PG8_LDB(B0, 1, 0); PG8_SCHED; PG8_LDA(At, 1, 0); PG8_STAGE(PG8_SA(0, 1), a2 + hstep, voffA);
            PG8_WAIT_L(8); PG8_BAR; PG8_WAIT_L(0); PG8_MMA(0, 0, At, B0); PG8_BAR; PG8_SCHED;
            PG8_LDB(B1, 1, 1); PG8_STAGE(PG8_SB(1, 0), b3, voffB);
            PG8_BAR; PG8_WAIT_L(0); PG8_MMA(0, 1, At, B1); PG8_BAR;
            PG8_LDA(At, 1, 1); PG8_STAGE(PG8_SA(1, 0), a3, voffA);
            PG8_BAR; PG8_WAIT_L(0); PG8_MMA(1, 0, At, B0); PG8_BAR; PG8_SCHED;
            PG8_STAGE(PG8_SB(1, 1), b3 + hstep, voffB);
            PG8_WAIT_V(6); PG8_BAR; PG8_MMA(1, 1, At, B1); PG8_BAR;
            }
        }
        if constexpr (ALIGN_EPI) { if (wr == 0) PG8_BAR; }
        if constexpr (!Epi::AFTER_DRAIN) { E(acc, cur, wr, wc, fr, fq); S.done(cur); }
        if (!has_next) break;
#pragma unroll
        for (int a = 0; a < 2; ++a)
#pragma unroll
            for (int b = 0; b < 2; ++b)
#pragma unroll
                for (int m = 0; m < 4; ++m)
#pragma unroll
                    for (int n = 0; n < 2; ++n) acc[a][b][m][n] = (f32x4){0.f, 0.f, 0.f, 0.f};
        cur = nxt; cA = nA; cB = nB; ++ui;
        if constexpr (ALIGN_EPI) { if (wr == 1) PG8_BAR; }
    }
    PG8_WAIT_V(0);
    if constexpr (!ALIGN_EPI) { if (wr == 0) PG8_BAR; }
    PG8_BAR;
    if constexpr (Epi::AFTER_DRAIN) { E.fused(acc, cur, wr, wc, fr, fq, lds, wid, lane); S.done(cur); }
#undef PG8_SA
#undef PG8_SB
#undef PG8_STAGE
#undef PG8_LDA
#undef PG8_LDB
#undef PG8_MMA
#undef PG8_WAIT_V
#undef PG8_WAIT_L
#undef PG8_BAR
#undef PG8_SCHED
}
struct EpiSwiglu {
    static constexpr bool PERM = true, AFTER_DRAIN = false;
    bf16_t* H; int ldh;
    __device__ __forceinline__ void operator()(const f32x4 (&acc)[2][2][4][2], const Unit& u, int wr, int wc, int fr, int fq) const {
        const int row0 = u.pm * BM + wr * 64 + fr, col0 = u.pn * HALF + wc * 32 + 8 * fq;
#pragma unroll
        for (int ai = 0; ai < 2; ++ai)
#pragma unroll
            for (int m = 0; m < 4; ++m) {
                bf16_t* p = H + (size_t)(row0 + ai * HALF + m * 16) * ldh + col0;
                float h[8];
#pragma unroll
                for (int n = 0; n < 2; ++n)
#pragma unroll
                    for (int i = 0; i < 4; ++i) { const float g = acc[ai][0][m][n][i], up = acc[ai][1][m][n][i];
                        h[n * 4 + i] = g * __builtin_amdgcn_rcpf(1.0f + __expf(-g)) * up; }
                u32x4 w; w.x = cvt_pk_bf16(h[0], h[1]); w.y = cvt_pk_bf16(h[2], h[3]); w.z = cvt_pk_bf16(h[4], h[5]); w.w = cvt_pk_bf16(h[6], h[7]);
                *(u32x4*)p = w;
            }
    }
};
struct EpiResid {
    static constexpr bool PERM = false, AFTER_DRAIN = false;
    const float* xp; const float* xs; float* X; const float* gt; float alpha, gs;
    __device__ __forceinline__ void operator()(const f32x4 (&acc)[2][2][4][2], const Unit& u, int wr, int wc, int fr, int fq) const {
        const int col0 = u.pn * BM + wc * 32 + 4 * fq;
#pragma unroll
        for (int ai = 0; ai < 2; ++ai)
#pragma unroll
            for (int m = 0; m < 4; ++m) {
                const int row = u.pm * BM + ai * HALF + wr * 64 + m * 16 + fr;
                const bool smp = row >= 16384;
                const float* xr = smp ? xs + (size_t)(row - 16384) * 1024 : xp + (size_t)row * 1024;
                const int b = smp ? 2 + ((row - 16384) >> 3) : (row >> 13);
                const float* gr = gt + (size_t)b * 9216;
                float* xo = X + (size_t)row * 1024;
#pragma unroll
                for (int bj = 0; bj < 2; ++bj)
#pragma unroll
                    for (int n = 0; n < 2; ++n) { const int c = col0 + bj * HALF + n * 16;
                        const f32x4 xv = *(const f32x4*)(xr + c), gv = *(const f32x4*)(gr + c);
                        const f32x4 z = xv * alpha + (gv + 1.0f) * gs * acc[ai][bj][m][n];
                        *(f32x4*)(xo + c) = z; }
            }
    }
};
}
#define GAS __attribute__((address_space(1)))
#define LAS __attribute__((address_space(3)))
typedef unsigned short bf16;
typedef unsigned v4u __attribute__((ext_vector_type(4)));
typedef float f32x4 __attribute__((ext_vector_type(4)));
typedef short bf16x8 __attribute__((ext_vector_type(8)));
typedef GAS unsigned gu32;
typedef GAS unsigned long long gu64;
#define RLX_AGENT __ATOMIC_RELAXED, __HIP_MEMORY_SCOPE_AGENT
#define LDS_WAIT() asm volatile("s_waitcnt lgkmcnt(0)" ::: "memory")
#define VM_WAIT() asm volatile("s_waitcnt vmcnt(0)" ::: "memory")
__device__ __forceinline__ unsigned long long rt() { return __builtin_amdgcn_s_memrealtime(); }
__device__ __forceinline__ unsigned f2bf(float f) { unsigned u = __builtin_bit_cast(unsigned, f); return (u + 0x7fffu + ((u >> 16) & 1u)) >> 16; }
__device__ __forceinline__ unsigned pk2(float lo, float hi) { return f2bf(lo) | (f2bf(hi) << 16); }

#define XB_TMO      128
#define XB_XCNT(j)  (256  + 64 * (j))
#define XB_XSUB(j)  (1280 + 64 * (j))
#define XB_XGEN(j)  (2304 + 64 * (j))
#define XB_TOP      3328
#define XB_TOPGEN   3392
#define XCD_BAR_WORDS 3456
#define XB_SPIN_CAP (1u << 18)

__device__ __forceinline__ unsigned xb_ld(unsigned* p)              { return __hip_atomic_load(p, __ATOMIC_RELAXED, __HIP_MEMORY_SCOPE_AGENT); }
__device__ __forceinline__ unsigned xb_add(unsigned* p, unsigned v) { return __hip_atomic_fetch_add(p, v, __ATOMIC_RELAXED, __HIP_MEMORY_SCOPE_AGENT); }
__device__ __forceinline__ unsigned xb_xcc_id() { return (unsigned)__builtin_amdgcn_s_getreg((3 << 11) | 20) & 0xFu; }
#define XB_SPIN(cond, bar) do { unsigned _sp = 0; while (cond) { __builtin_amdgcn_s_sleep(1); \
    if ((++_sp & 255u) == 0u) { if (xb_ld(&(bar)[XB_TMO])) break; if (_sp > XB_SPIN_CAP) { atomicAdd(&(bar)[XB_TMO], 1u); break; } } } } while (0)

struct XcdBarrier {
    unsigned* bar; unsigned x;
    volatile LAS unsigned* st;
};

__device__ __forceinline__ XcdBarrier xcd_barrier_post(unsigned* bar, volatile LAS unsigned* st) {
    XcdBarrier b; b.bar = bar; b.x = xb_xcc_id(); b.st = st;
    if (threadIdx.x == 0) (void)xb_add(&bar[XB_XCNT(b.x)], 1u);
    return b;
}
__device__ __forceinline__ void xcd_barrier_complete(unsigned* bar, unsigned x, unsigned& nloc, unsigned& nx) {
    const unsigned G = gridDim.x * gridDim.y * gridDim.z;
    unsigned sum, cnt, mine, sp = 0u;
    for (;;) {
        sum = 0u; cnt = 0u; mine = 0u;
#pragma unroll
        for (unsigned j = 0; j < 16; ++j) { const unsigned c = xb_ld(&bar[XB_XCNT(j)]); sum += c; cnt += (c > 0u) ? 1u : 0u; mine = (j == x) ? c : mine; }
        if (sum == G) break;
        __builtin_amdgcn_s_sleep(1);
        if ((++sp & 255u) == 0u) { if (xb_ld(&bar[XB_TMO])) break; if (sp > XB_SPIN_CAP) { atomicAdd(&bar[XB_TMO], 1u); break; } }
    }
    nloc = mine > 0u ? mine : 1u; nx = cnt > 0u ? cnt : 1u;
}

__device__ __forceinline__ void xcd_barrier(const XcdBarrier& b) {
    asm volatile("s_waitcnt vmcnt(0)" ::: "memory");
    __syncthreads();
    if (threadIdx.x == 0) {
        unsigned* bar = b.bar;
        __builtin_amdgcn_s_waitcnt(0);
        unsigned nloc = b.st[0], nx = b.st[1];
        if (nloc == 0u) { xcd_barrier_complete(bar, b.x, nloc, nx); b.st[0] = nloc; b.st[1] = nx; }
        const unsigned old = xb_add(&bar[XB_XSUB(b.x)], 1u);
        const unsigned gen = old / nloc;
        if (old + 1u == (gen + 1u) * nloc) {
            __builtin_amdgcn_fence(__ATOMIC_RELEASE, "agent");
            asm volatile("s_waitcnt vmcnt(0)" ::: "memory");
            const unsigned og = xb_add(&bar[XB_TOP], 1u);
            const unsigned tg = og / nx;
            if (og + 1u == (tg + 1u) * nx) xb_add(&bar[XB_TOPGEN], 1u);
            else XB_SPIN(xb_ld(&bar[XB_TOPGEN]) == tg, bar);
            __builtin_amdgcn_fence(__ATOMIC_ACQUIRE, "agent");
            xb_add(&bar[XB_XGEN(b.x)], 1u);
            asm volatile("s_waitcnt vmcnt(0)" ::: "memory");
        } else {
            XB_SPIN(xb_ld(&bar[XB_XGEN(b.x)]) == gen, bar);
            __builtin_amdgcn_fence(__ATOMIC_ACQUIRE, "agent");
            asm volatile("s_waitcnt vmcnt(0)" ::: "memory");
        }
    }
    __syncthreads();
}

constexpr int D = 1024, FF = 2816, NFF = 2 * FF, NIN = 2560, RW = 512, RWP = 1792;
constexpr int MP = 16384, MS = 1024, M = MP + MS, TP = 8192, TS = 8, NBS = 128;
constexpr int MODW = 9216, NMOD = 130;
constexpr float ALPHA = 1.189207115002721f;
constexpr float LN_EPS = 1e-5f, GN_EPS = 64e-5f;
constexpr int NWAVES = 8;
enum { I_XP = 0, I_XS, I_SWKV, I_SSHIFT, I_CK, I_CV, I_CP, I_CS, I_RELB, I_WADA, I_BADA, I_LNG, I_LNB, I_W1IN, I_W1OUT, I_WIN, I_MU, I_W0, I_WDEC, I_A0, I_WICLR, I_WGATE,
       I_KK, I_KA, I_RK, I_GNW, I_GNB, I_SINKS, I_WOUT, I_W2IN, I_W2OUT, N_IN };
constexpr size_t O_Y = 0, O_WKV_P = (size_t)M * D, O_SHIFT_P = O_WKV_P + 65536, O_WINK_P = O_SHIFT_P + 3584, O_WINV_P = O_WINK_P + 32768,
                 O_WKV_S = O_WINV_P + 32768, O_SHIFT_S = O_WKV_S + 4194304, O_WINK_S = O_SHIFT_S + 229376, O_WINV_S = O_WINK_S + 2097152, O_END = O_WINV_S + 2097152;
static_assert(O_END == 26578432, "d_out size");
constexpr size_t MiB = 1u << 20;
constexpr size_t WS_CTL = 0, CTL_ZERO_BYTES = 1 * MiB;
constexpr size_t WS_W1IN = 2 * MiB, WS_W1OUT = 13 * MiB, WS_WIN = 19 * MiB, WS_WOUT = 24 * MiB, WS_W2IN = 26 * MiB, WS_W2OUT = 37 * MiB;
constexpr size_t WS_MOD = 43 * MiB;
constexpr size_t WS_U = 48 * MiB;
constexpr size_t WS_H = 82 * MiB;
constexpr size_t WS_WLOG = 176 * MiB, WS_A = 210 * MiB, WS_G = 227 * MiB, WS_INV = 244 * MiB, WS_END = 245 * MiB;
static_assert(WS_W1IN + (size_t)NFF * D * 2 <= WS_W1OUT && WS_W1OUT + (size_t)D * FF * 2 <= WS_WIN && WS_WIN + (size_t)NIN * D * 2 <= WS_WOUT && WS_WOUT + (size_t)D * D * 2 <= WS_W2IN &&
              WS_W2IN + (size_t)NFF * D * 2 <= WS_W2OUT && WS_W2OUT + (size_t)D * FF * 2 <= WS_MOD && WS_MOD + (size_t)NMOD * MODW * 4 <= WS_U && WS_U + (size_t)M * D * 2 <= WS_H &&
              WS_H + (size_t)M * FF * 2 <= WS_WLOG && WS_WLOG + (size_t)M * RW * 4 <= WS_A && WS_A + (size_t)M * RW * 2 <= WS_G && WS_G + (size_t)M * RW * 2 <= WS_INV &&
              WS_INV + (size_t)M * 8 * 4 <= WS_END && WS_END <= 256 * MiB, "d_ws map");
constexpr int CW_BAR = 4096;
constexpr int RING_OFF = 0, RING_BYTES = 131072;
constexpr int LDSCTL_OFF = RING_BYTES, MISC_OFF = LDSCTL_OFF + 320;
constexpr int LDS_BYTES = 147456;
static_assert(MISC_OFF + 128 <= LDS_BYTES, "LDS map");

__device__ __forceinline__ float bf2f(unsigned short h) { return __uint_as_float((unsigned)h << 16); }
__device__ __forceinline__ float bflo(unsigned u) { return __uint_as_float(u << 16); }
__device__ __forceinline__ float bfhi(unsigned u) { return __uint_as_float(u & 0xffff0000u); }
__device__ __forceinline__ float wave_sum(float v) {
#pragma unroll
    for (int o = 1; o < 64; o <<= 1) v += __shfl_xor(v, o);
    return v;
}
template <int CTRL> __device__ __forceinline__ float dppf(float x) { return __builtin_bit_cast(float, __builtin_amdgcn_update_dpp(0, __builtin_bit_cast(int, x), CTRL, 0xf, 0xf, true)); }
__device__ __forceinline__ float sum8(float x) {
    x += dppf<0xB1>(x);
    x += dppf<0x4E>(x);
    x += dppf<0x141>(x);
    return x;
}
__device__ __forceinline__ float sigmoidf_(float x) { return 1.0f / (1.0f + expf(-x)); }

struct Frame {
    LAS unsigned char* lds;
    volatile LAS unsigned* MISC;
    gu32* ctl;
    int tid, lane, wave, vcu, G;
    const float* in[N_IN];
    float* out; unsigned char* ws;
};
#define WSP(T, off) ((T*)(F.ws + (off)))

__device__ __forceinline__ void p0_transpose_item(const float* W, int K, int N, bf16* WT, int dst_row0, int k0, int n0, LAS float* scr, int lane) {
#pragma unroll 8
    for (int i = 0; i < 32; ++i) { const int kk = 2 * i + (lane >> 5); scr[kk * 33 + (lane & 31)] = W[(size_t)(k0 + kk) * N + n0 + (lane & 31)]; }
    LDS_WAIT(); asm volatile("" ::: "memory");
    const int c = lane & 7;
#pragma unroll
    for (int j = 0; j < 4; ++j) { const int n = (lane >> 3) + 8 * j; const LAS float* s = scr + (8 * c) * 33 + n;
        v4u o; o.x = pk2(s[0 * 33], s[1 * 33]); o.y = pk2(s[2 * 33], s[3 * 33]); o.z = pk2(s[4 * 33], s[5 * 33]); o.w = pk2(s[6 * 33], s[7 * 33]);
        *(GAS v4u*)(WT + (size_t)(dst_row0 + n) * K + k0 + 8 * c) = o; }
    LDS_WAIT(); asm volatile("" ::: "memory");
}
__device__ __forceinline__ void p0_ffin_item(const float* W, bf16* WT, int r, LAS float* scr, int lane) {
    const int kb = r / 176, nb = r % 176, n0 = 32 * nb; const bool up = n0 >= FF; const int j = up ? n0 - FF : n0;
    p0_transpose_item(W, D, NFF, WT, (j >> 7) * 256 + (up ? 128 : 0) + (j & 127), 64 * kb, n0, scr, lane);
}
__device__ __forceinline__ void p0_plain_item(const float* W, int K, int N, bf16* WT, int r, LAS float* scr, int lane) {
    const int nblk = N / 32, kb = r / nblk, nb = r % nblk;
    p0_transpose_item(W, K, N, WT, 32 * nb, 64 * kb, 32 * nb, scr, lane);
}
__device__ __forceinline__ void p0_weights(Frame& F) {
    LAS float* scr = (LAS float*)(F.lds + RING_OFF + F.wave * 16384);
    const int gw = F.vcu * NWAVES + F.wave, NGW = F.G * NWAVES;
    constexpr int I_FI = 16 * 176, I_FO = 44 * 32, I_IN = 16 * 80, I_O = 16 * 32, NITEMS = 2 * I_FI + 2 * I_FO + I_IN + I_O;
    for (int it = gw; it < NITEMS; it += NGW) {
        int r = it;
        if (r < I_FI) { p0_ffin_item(F.in[I_W1IN], WSP(bf16, WS_W1IN), r, scr, F.lane); continue; } r -= I_FI;
        if (r < I_FI) { p0_ffin_item(F.in[I_W2IN], WSP(bf16, WS_W2IN), r, scr, F.lane); continue; } r -= I_FI;
        if (r < I_FO) { p0_plain_item(F.in[I_W1OUT], FF, D, WSP(bf16, WS_W1OUT), r, scr, F.lane); continue; } r -= I_FO;
        if (r < I_FO) { p0_plain_item(F.in[I_W2OUT], FF, D, WSP(bf16, WS_W2OUT), r, scr, F.lane); continue; } r -= I_FO;
        if (r < I_IN) { p0_plain_item(F.in[I_WIN], D, NIN, WSP(bf16, WS_WIN), r, scr, F.lane); continue; } r -= I_IN;
        p0_plain_item(F.in[I_WOUT], D, D, WSP(bf16, WS_WOUT), r, scr, F.lane);
    }
}
__device__ __forceinline__ void p0_mod(Frame& F) {
    constexpr int SCP = 172;
    LAS float* sc = (LAS float*)(F.lds);
    LAS float* red = (LAS float*)(F.lds + 64 * SCP * 4);
    const float* wada = F.in[I_WADA]; const float* bada = F.in[I_BADA]; const float* cp = F.in[I_CP]; const float* cs = F.in[I_CS];
    float* mod = WSP(float, WS_MOD);
    const int tid = F.tid; const bool act = tid < 504; const int q = act ? tid / 126 : 3, r = act ? tid % 126 : 125, g = r / 9, cg = r % 9;
    for (int task = blockIdx.x; task < MODW / 36; task += F.G) {
        const int j0 = 36 * task + 4 * cg;
        float acc[10][4];
#pragma unroll
        for (int s = 0; s < 10; ++s)
#pragma unroll
            for (int jj = 0; jj < 4; ++jj) acc[s][jj] = 0.f;
        for (int ch = 0; ch < 16; ++ch) {
            __syncthreads();
            for (int idx = tid; idx < 64 * NMOD; idx += 512) {
                const int b = idx >> 6, e = idx & 63, i = 256 * (e >> 4) + 16 * ch + (e & 15);
                const float c = b < 2 ? cp[b * D + i] : cs[(b - 2) * D + i];
                sc[e * SCP + (b % 14) * 12 + b / 14] = c / (1.0f + expf(-c));
            }
            __syncthreads();
            if (act) {
#pragma unroll 4
                for (int ii = 0; ii < 16; ++ii) {
                    const int i = 256 * q + 16 * ch + ii;
                    const f32x4 w = *(const f32x4*)(wada + (size_t)i * MODW + j0);
                    const LAS f32x4* sp = (const LAS f32x4*)(sc + (q * 16 + ii) * SCP + g * 12);
                    const f32x4 s0 = sp[0], s1 = sp[1], s2 = sp[2];
                    const float sv[10] = {s0[0], s0[1], s0[2], s0[3], s1[0], s1[1], s1[2], s1[3], s2[0], s2[1]};
#pragma unroll
                    for (int s = 0; s < 10; ++s)
#pragma unroll
                        for (int jj = 0; jj < 4; ++jj) acc[s][jj] += sv[s] * w[jj];
                }
            }
        }
        __syncthreads();
        if (act && q > 0) {
#pragma unroll
            for (int s = 0; s < 10; ++s)
#pragma unroll
                for (int jj = 0; jj < 4; ++jj) red[((q - 1) * 40 + s * 4 + jj) * 126 + r] = acc[s][jj];
        }
        __syncthreads();
        if (act && q == 0) {
            const f32x4 bb = *(const f32x4*)(bada + j0);
#pragma unroll
            for (int s = 0; s < 10; ++s) { const int b = g + 14 * s;
                if (b < NMOD) { f32x4 o;
#pragma unroll
                    for (int jj = 0; jj < 4; ++jj) { const int k = s * 4 + jj; o[jj] = acc[s][jj] + red[(0 * 40 + k) * 126 + r] + red[(1 * 40 + k) * 126 + r] + red[(2 * 40 + k) * 126 + r] + bb[jj]; }
                    *(f32x4*)(mod + (size_t)b * MODW + j0) = o; } }
        }
    }
    __syncthreads();
}

__device__ __forceinline__ int mod_row_of(int m) { return m < MP ? (m >> 13) : 2 + ((m - MP) >> 3); }
__device__ __forceinline__ void p_modulate0(Frame& F) {
    const int gw = F.vcu * NWAVES + F.wave, NGW = F.G * NWAVES;
    const float* mod = WSP(float, WS_MOD); bf16* U = WSP(bf16, WS_U);
    for (int m = gw; m < M; m += NGW) {
        const float* xr = m < MP ? F.in[I_XP] + (size_t)m * D : F.in[I_XS] + (size_t)(m - MP) * D;
        const float* mr = mod + (size_t)mod_row_of(m) * MODW;
        unsigned long long* o8 = (unsigned long long*)(U + (size_t)m * D) + F.lane;
#pragma unroll
        for (int j = 0; j < 4; ++j) { const int c = 4 * F.lane + 256 * j;
            const f32x4 x = *(const f32x4*)(xr + c), sh = *(const f32x4*)(mr + c), sc = *(const f32x4*)(mr + D + c);
            const f32x4 u = x * (sc + 1.0f) + sh;
            o8[64 * j] = (unsigned long long)pk2(u[0], u[1]) | ((unsigned long long)pk2(u[2], u[3]) << 32); }
    }
}
__device__ __forceinline__ void p_layernorm(Frame& F, int lnidx, int koff) {
    const int gw = F.vcu * NWAVES + F.wave, NGW = F.G * NWAVES;
    const float* mod = WSP(float, WS_MOD); bf16* U = WSP(bf16, WS_U); float* X = F.out + O_Y;
    const float* lg = F.in[I_LNG] + lnidx * D; const float* lb = F.in[I_LNB] + lnidx * D;
    for (int m = gw; m < M; m += NGW) {
        float* xr = X + (size_t)m * D;
        f32x4 v[4]; float s = 0.f;
#pragma unroll
        for (int j = 0; j < 4; ++j) { v[j] = *(const f32x4*)(xr + 4 * F.lane + 256 * j); s += (v[j][0] + v[j][1]) + (v[j][2] + v[j][3]); }
        const float mean = wave_sum(s) * (1.f / D); float s2 = 0.f;
#pragma unroll
        for (int j = 0; j < 4; ++j) { v[j] = v[j] - mean; s2 += (v[j][0] * v[j][0] + v[j][1] * v[j][1]) + (v[j][2] * v[j][2] + v[j][3] * v[j][3]); }
        const float rstd = 1.f / sqrtf(wave_sum(s2) * (1.f / D) + LN_EPS);
        const float* mr = mod + (size_t)mod_row_of(m) * MODW + (koff >= 0 ? koff : 0);
        unsigned long long* o8 = (unsigned long long*)(U + (size_t)m * D) + F.lane;
#pragma unroll
        for (int j = 0; j < 4; ++j) { const int c = 4 * F.lane + 256 * j;
            const f32x4 x = v[j] * rstd * *(const f32x4*)(lg + c) + *(const f32x4*)(lb + c);
            *(f32x4*)(xr + c) = x;
            if (koff >= 0) { const f32x4 sh = *(const f32x4*)(mr + c), sc = *(const f32x4*)(mr + D + c); const f32x4 u = x * (sc + 1.0f) + sh;
                o8[64 * j] = (unsigned long long)pk2(u[0], u[1]) | ((unsigned long long)pk2(u[2], u[3]) << 32); } }
    }
}
__device__ __forceinline__ float prev_val(const bf16* P, const float* sshift, int m, int col) {
    if (m < MP) return (m & (TP - 1)) == 0 ? 0.f : bf2f(P[(size_t)(m - 1) * NIN + col]);
    const int ms = m - MP;
    return (ms & (TS - 1)) == 0 ? sshift[(size_t)(ms >> 3) * RWP + col] : bf2f(P[(size_t)(m - 1) * NIN + col]);
}
__device__ __forceinline__ void p_prep(Frame& F) {
    LAS float* L = (LAS float*)F.lds;
    const bf16* P = WSP(bf16, WS_H); const float* sshift = F.in[I_SSHIFT]; const float* mu = F.in[I_MU];
    const float* wdec = F.in[I_WDEC]; const float* wiclr = F.in[I_WICLR]; const float* wgate = F.in[I_WGATE];
    float* WLOG = WSP(float, WS_WLOG); bf16* AA = WSP(bf16, WS_A); bf16* GG = WSP(bf16, WS_G); float* INV = WSP(float, WS_INV);
    const int c = F.tid;
    const float w0c = F.in[I_W0][c], a0c = F.in[I_A0][c], kkc = F.in[I_KK][c], muk = mu[RW + c];
    for (int tb = F.vcu; tb < M / 16; tb += F.G) {
        const int m0 = tb * 16;
        __syncthreads();
#pragma unroll
        for (int k = 0; k < 8; ++k) { const int idx = F.tid + 512 * k, i = idx & 15, j = idx >> 4, m = m0 + i, col = 1536 + j;
            const float p = bf2f(P[(size_t)m * NIN + col]), pv = prev_val(P, sshift, m, col), xs = p + (pv - p) * mu[col];
            L[j * 16 + i] = j < 64 ? tanhf(xs) : (j < 128 ? xs : sigmoidf_(xs)); }
        __syncthreads();
        float aw[16], aa[16], ag[16];
#pragma unroll
        for (int i = 0; i < 16; ++i) { aw[i] = 0.f; aa[i] = 0.f; ag[i] = 0.f; }
#pragma unroll 2
        for (int j = 0; j < 64; ++j) {
            const float wd = wdec[j * RW + c], wi = wiclr[j * RW + c];
            const LAS f32x4* lw = (const LAS f32x4*)(L + j * 16); const LAS f32x4* la = (const LAS f32x4*)(L + (64 + j) * 16);
#pragma unroll
            for (int qq = 0; qq < 4; ++qq) { const f32x4 tw = lw[qq], ta = la[qq];
#pragma unroll
                for (int e = 0; e < 4; ++e) { aw[qq * 4 + e] += wd * tw[e]; aa[qq * 4 + e] += wi * ta[e]; } }
        }
#pragma unroll 2
        for (int j = 0; j < 128; ++j) {
            const float wg = wgate[j * RW + c];
            const LAS f32x4* lg = (const LAS f32x4*)(L + (128 + j) * 16);
#pragma unroll
            for (int qq = 0; qq < 4; ++qq) { const f32x4 tg = lg[qq];
#pragma unroll
                for (int e = 0; e < 4; ++e) ag[qq * 4 + e] += wg * tg[e]; }
        }
#pragma unroll
        for (int i = 0; i < 16; ++i) { const int m = m0 + i;
            const float z = w0c + aw[i];
            const float sp = fmaxf(-z, 0.f) + log1pf(expf(-fabsf(z)));
            WLOG[(size_t)m * RW + c] = -expf(-sp - 0.5f);
            AA[(size_t)m * RW + c] = (bf16)f2bf(sigmoidf_(a0c + aa[i]));
            GG[(size_t)m * RW + c] = (bf16)f2bf(ag[i]);
            const float pk = bf2f(P[(size_t)m * NIN + RW + c]), pvk = prev_val(P, sshift, m, RW + c), xk = pk + (pvk - pk) * muk, kq = xk * kkc;
            const float ss = wave_sum(kq * kq);
            if (F.lane == 0) INV[(size_t)m * 8 + F.wave] = 1.0f / fmaxf(sqrtf(ss), 1e-12f);
        }
    }
    const int gt = F.vcu * 512 + F.tid, NT = F.G * 512;
    const float* ck = F.in[I_CK]; const float* cv = F.in[I_CV];
    for (int i = gt; i < 2 * RWP; i += NT) { const int b = i / RWP, col = i % RWP; F.out[O_SHIFT_P + i] = bf2f(P[(size_t)(b * TP + TP - 1) * NIN + col]); }
    for (int i = gt; i < NBS * RWP; i += NT) { const int b = i / RWP, col = i % RWP; F.out[O_SHIFT_S + i] = bf2f(P[(size_t)(MP + b * TS + TS - 1) * NIN + col]); }
    for (int i = gt; i < 2 * 128 * 128; i += NT) { const int b = i >> 14, j = (i >> 7) & 127, c2 = i & 127; const size_t row = (size_t)(b * TP + TP - 128 + j) * NIN;
        F.out[O_WINK_P + i] = bf2f(P[row + 2304 + c2]); F.out[O_WINV_P + i] = bf2f(P[row + 2432 + c2]); }
    for (int i = gt; i < NBS * 128 * 128; i += NT) { const int b = i >> 14, j = (i >> 7) & 127, c2 = i & 127;
        if (j < 120) { F.out[O_WINK_S + i] = ck[(size_t)(b * 128 + j + 8) * 128 + c2]; F.out[O_WINV_S + i] = cv[(size_t)(b * 128 + j + 8) * 128 + c2]; }
        else { const size_t row = (size_t)(MP + b * TS + (j - 120)) * NIN; F.out[O_WINK_S + i] = bf2f(P[row + 2304 + c2]); F.out[O_WINV_S + i] = bf2f(P[row + 2432 + c2]); } }
}

constexpr int SC_R = 0, SC_DEC = 1, SC_KM = 2, SC_KK = 3, SC_BB = 4, SC_V = 5, SC_Y = 6;
__device__ __forceinline__ void scan_unit(Frame& F, int row0, int T, int h, const float* s_in, float* s_out) {
    LAS float* A = (LAS float*)F.lds;
    const bf16* P = WSP(bf16, WS_H); const float* sshift = F.in[I_SSHIFT]; const float* mu = F.in[I_MU];
    const float* WLOG = WSP(float, WS_WLOG); const bf16* AA = WSP(bf16, WS_A); const bf16* GG = WSP(bf16, WS_G); const float* INV = WSP(float, WS_INV);
    bf16* MIX = WSP(bf16, WS_U);
    const int lane = F.lane, wave = F.wave, rl = lane >> 3, ks = lane & 7, row = 8 * wave + rl;
    float S[8];
#pragma unroll
    for (int j = 0; j < 8; ++j) S[j] = s_in ? s_in[(size_t)row * 64 + 8 * ks + j] : 0.f;
    const int e_ = F.tid & 63, chn = h * 64 + e_;
    const float mur = mu[chn], muk = mu[RW + chn], muv = mu[2 * RW + chn], kkc = F.in[I_KK][chn], kac = F.in[I_KA][chn], rkc = F.in[I_RK][chn], gnw = F.in[I_GNW][chn], gnb = F.in[I_GNB][chn];
    for (int t0 = 0; t0 < T; t0 += 64) {
        const int nb = (T - t0) < 64 ? (T - t0) : 64;
        __syncthreads();
        for (int s = F.tid >> 6; s < nb; s += 8) {
            const int m = row0 + t0 + s;
            const size_t pr = (size_t)m * NIN;
            const float p_r = bf2f(P[pr + chn]), p_k = bf2f(P[pr + RW + chn]), p_v = bf2f(P[pr + 2 * RW + chn]);
            const float q_r = prev_val(P, sshift, m, chn), q_k = prev_val(P, sshift, m, RW + chn), q_v = prev_val(P, sshift, m, 2 * RW + chn);
            const float xr = p_r + (q_r - p_r) * mur, xk = p_k + (q_k - p_k) * muk, xv = p_v + (q_v - p_v) * muv;
            const float a = bf2f(AA[(size_t)m * RW + chn]), wl = WLOG[(size_t)m * RW + chn], inv = INV[(size_t)m * 8 + h];
            const float kk = xk * kkc * inv;
            A[SC_R * 4096 + s * 64 + e_] = xr; A[SC_DEC * 4096 + s * 64 + e_] = expf(wl); A[SC_KM * 4096 + s * 64 + e_] = xk * (1.0f + (a - 1.0f) * kac);
            A[SC_KK * 4096 + s * 64 + e_] = kk; A[SC_BB * 4096 + s * 64 + e_] = kk * a; A[SC_V * 4096 + s * 64 + e_] = xv;
        }
        __syncthreads();
        for (int s = 0; s < nb; ++s) {
            const LAS f32x4* pk = (const LAS f32x4*)(A + SC_KK * 4096 + s * 64 + 8 * ks); const LAS f32x4* pb = (const LAS f32x4*)(A + SC_BB * 4096 + s * 64 + 8 * ks);
            const LAS f32x4* pd = (const LAS f32x4*)(A + SC_DEC * 4096 + s * 64 + 8 * ks); const LAS f32x4* pm = (const LAS f32x4*)(A + SC_KM * 4096 + s * 64 + 8 * ks);
            const LAS f32x4* pq = (const LAS f32x4*)(A + SC_R * 4096 + s * 64 + 8 * ks);
            const f32x4 k0 = pk[0], k1 = pk[1], b0 = pb[0], b1 = pb[1], d0 = pd[0], d1 = pd[1], m0 = pm[0], m1 = pm[1], r0 = pq[0], r1 = pq[1];
            const float v = A[SC_V * 4096 + s * 64 + row];
            float sa = 0.f;
#pragma unroll
            for (int j = 0; j < 4; ++j) { sa += S[j] * k0[j]; sa += S[4 + j] * k1[j]; }
            sa = sum8(sa);
            float y = 0.f;
#pragma unroll
            for (int j = 0; j < 4; ++j) { S[j] = S[j] * d0[j] + (v * m0[j] - sa * b0[j]); S[4 + j] = S[4 + j] * d1[j] + (v * m1[j] - sa * b1[j]); y += S[j] * r0[j]; y += S[4 + j] * r1[j]; }
            y = sum8(y);
            if (ks == 0) A[SC_Y * 4096 + s * 64 + row] = y;
        }
        __syncthreads();
        for (int s = wave; s < nb; s += 8) {
            const int m = row0 + t0 + s;
            const float y = A[SC_Y * 4096 + s * 64 + lane];
            const float mean = wave_sum(y) * (1.f / 64.f), d = y - mean, var = wave_sum(d * d) * (1.f / 64.f);
            const float yn = d * (1.0f / sqrtf(var + GN_EPS));
            const float dot = wave_sum(A[SC_R * 4096 + s * 64 + lane] * A[SC_KM * 4096 + s * 64 + lane] * rkc);
            const float g = bf2f(GG[(size_t)m * RW + chn]);
            const float o = (yn * gnw + gnb + dot * A[SC_V * 4096 + s * 64 + lane]) * g;
            MIX[(size_t)m * D + chn] = (bf16)f2bf(o);
        }
    }
#pragma unroll
    for (int j = 0; j < 8; ++j) s_out[(size_t)row * 64 + 8 * ks + j] = S[j];
    __syncthreads();
}
__device__ __forceinline__ int rel_bucket(int n) {
    if (n < 16) return n;
    const int b = 16 + (int)(logf((float)n * (1.0f / 16.0f)) / 2.0794415416798357f * 16.0f);
    return b < 31 ? b : 31;
}
constexpr int ATT_PITCH = 144, ATT_K_OFF = 0, ATT_V_OFF = 255 * ATT_PITCH + 48  , ATT_B_OFF = 2 * ATT_V_OFF;
static_assert(ATT_V_OFF % 16 == 0 && ATT_B_OFF + 4096 <= RING_BYTES, "attention LDS map");
__device__ __forceinline__ void attn_prompt_unit(Frame& F, int b, int kvh, int qb) {
    LAS unsigned char* lds = F.lds;
    const bf16* P = WSP(bf16, WS_H); bf16* MIX = WSP(bf16, WS_U);
    const float* relb = F.in[I_RELB];
    const int t0 = qb * 128, tid = F.tid;
    __syncthreads();
    for (int idx = tid; idx < 255 * 16; idx += 512) {
        const int rowi = idx >> 4, part = idx & 15, pos = t0 - 127 + rowi;
        v4u val = (v4u){0u, 0u, 0u, 0u};
        if (pos >= 0) val = *(const v4u*)(P + (size_t)(b * TP + pos) * NIN + (part < 8 ? 2304 : 2432) + kvh * 64 + (part & 7) * 8);
        *(LAS v4u*)(lds + (part < 8 ? ATT_K_OFF : ATT_V_OFF) + rowi * ATT_PITCH + (part & 7) * 16) = val;
    }
    for (int idx = tid; idx < 1024; idx += 512) { const int dist = idx >> 3, hq = idx & 7; ((LAS float*)(lds + ATT_B_OFF))[idx] = relb[rel_bucket(dist) * 8 + hq]; }
    __syncthreads();
    const int i = tid & 127, g = tid >> 7, hq = kvh * 4 + g, t = t0 + i, m = b * TP + t;
    v4u qw[8];
    { const v4u* qp = (const v4u*)(P + (size_t)m * NIN + RWP + hq * 64);
#pragma unroll
      for (int c = 0; c < 8; ++c) qw[c] = qp[c]; }
    float o[64];
#pragma unroll
    for (int d = 0; d < 64; ++d) o[d] = 0.f;
    float mrun = -1e30f, l = 0.f;
    const LAS float* bt = (const LAS float*)(lds + ATT_B_OFF);
#pragma unroll 1
    for (int jj = 0; jj < 128; ++jj) {
        const LAS v4u* kp = (const LAS v4u*)(lds + ATT_K_OFF + (i + jj) * ATT_PITCH);
        float a0 = 0.f, a1 = 0.f;
#pragma unroll
        for (int c = 0; c < 8; ++c) { const v4u w = kp[c];
#pragma unroll
            for (int e = 0; e < 4; ++e) { a0 += bflo(qw[c][e]) * bflo(w[e]); a1 += bfhi(qw[c][e]) * bfhi(w[e]); } }
        const int dist = 127 - jj;
        float sv = (a0 + a1) * 0.125f + bt[dist * 8 + hq];
        asm volatile("" : "+v"(sv));
        const bool valid = (t - dist) >= 0;
        sv = valid ? sv : -1e30f;
        const float mx = fmaxf(mrun, sv), corr = __expf(mrun - mx), p = valid ? __expf(sv - mx) : 0.f;
        mrun = mx; l = l * corr + p;
        const LAS v4u* vp = (const LAS v4u*)(lds + ATT_V_OFF + (i + jj) * ATT_PITCH);
#pragma unroll
        for (int c = 0; c < 8; ++c) { const v4u w = vp[c];
#pragma unroll
            for (int e = 0; e < 4; ++e) { o[c * 8 + 2 * e] = o[c * 8 + 2 * e] * corr + p * bflo(w[e]); o[c * 8 + 2 * e + 1] = o[c * 8 + 2 * e + 1] * corr + p * bfhi(w[e]); } }
    }
    l += __expf(F.in[I_SINKS][hq] - mrun);
    const float il = 1.0f / l;
    v4u* op = (v4u*)(MIX + (size_t)m * D + RW + hq * 64);
#pragma unroll
    for (int c = 0; c < 8; ++c) { v4u w;
#pragma unroll
        for (int e = 0; e < 4; ++e) w[e] = pk2(o[c * 8 + 2 * e] * il, o[c * 8 + 2 * e + 1] * il);
        op[c] = w; }
}
__device__ __forceinline__ void attn_sample_unit(Frame& F, int unit) {
    const bf16* P = WSP(bf16, WS_H); bf16* MIX = WSP(bf16, WS_U);
    const float* relb = F.in[I_RELB]; const float* ck = F.in[I_CK]; const float* cv = F.in[I_CV];
    const int idx = unit * 512 + F.tid, hq = idx & 7, t = (idx >> 3) & 7, b = idx >> 6, kvh = hq >> 2, m = MP + b * TS + t;
    float q[64];
    { const v4u* qp = (const v4u*)(P + (size_t)m * NIN + RWP + hq * 64);
#pragma unroll
      for (int c = 0; c < 8; ++c) { const v4u w = qp[c];
#pragma unroll
          for (int e = 0; e < 4; ++e) { q[c * 8 + 2 * e] = bflo(w[e]) * 0.125f; q[c * 8 + 2 * e + 1] = bfhi(w[e]) * 0.125f; } } }
    float o[64];
#pragma unroll
    for (int d = 0; d < 64; ++d) o[d] = 0.f;
    float mrun = -1e30f, l = 0.f;
    for (int jj = 0; jj < 128; ++jj) {
        const int j = t + 1 + jj, dist = 127 - jj;
        float a0 = 0.f, a1 = 0.f;
        const bool cached = j < 128;
        const size_t crow = ((size_t)(b * 128 + (cached ? j : 0)) * 2 + kvh) * 64, prow = (size_t)(MP + b * TS + (cached ? 0 : j - 128)) * NIN + kvh * 64;
        if (cached) { const f32x4* kp = (const f32x4*)(ck + crow);
#pragma unroll
            for (int c = 0; c < 16; ++c) { const f32x4 a = kp[c]; a0 += q[c * 4] * a[0] + q[c * 4 + 2] * a[2]; a1 += q[c * 4 + 1] * a[1] + q[c * 4 + 3] * a[3]; }
        } else { const v4u* kp = (const v4u*)(P + prow + 2304);
#pragma unroll
            for (int c = 0; c < 8; ++c) { const v4u a = kp[c];
#pragma unroll
                for (int e = 0; e < 4; ++e) { a0 += q[c * 8 + 2 * e] * bflo(a[e]); a1 += q[c * 8 + 2 * e + 1] * bfhi(a[e]); } }
        }
        const float s = (a0 + a1) + relb[rel_bucket(dist) * 8 + hq];
        const float mx = fmaxf(mrun, s), corr = __expf(mrun - mx), p = __expf(s - mx);
        mrun = mx; l = l * corr + p;
        if (cached) { const f32x4* vp = (const f32x4*)(cv + crow);
#pragma unroll
            for (int c = 0; c < 16; ++c) { const f32x4 v = vp[c];
#pragma unroll
                for (int e = 0; e < 4; ++e) o[c * 4 + e] = o[c * 4 + e] * corr + p * v[e]; }
        } else { const v4u* vp = (const v4u*)(P + prow + 2432);
#pragma unroll
            for (int c = 0; c < 8; ++c) { const v4u v = vp[c];
#pragma unroll
                for (int e = 0; e < 4; ++e) { o[c * 8 + 2 * e] = o[c * 8 + 2 * e] * corr + p * bflo(v[e]); o[c * 8 + 2 * e + 1] = o[c * 8 + 2 * e + 1] * corr + p * bfhi(v[e]); } }
        }
    }
    l += __expf(F.in[I_SINKS][hq] - mrun);
    const float il = 1.0f / l;
    v4u* op = (v4u*)(MIX + (size_t)m * D + RW + hq * 64);
#pragma unroll
    for (int c = 0; c < 8; ++c) { v4u w;
#pragma unroll
        for (int e = 0; e < 4; ++e) w[e] = pk2(o[c * 8 + 2 * e] * il, o[c * 8 + 2 * e + 1] * il);
        op[c] = w; }
}
__device__ __forceinline__ void mixer_task(Frame& F, int t) {
    if (t < 16 || (t >= 272 && t < 1296)) {
        const bool smp = t >= 16; const int id = smp ? t - 272 : t, b = id >> 3, h = id & 7;
        const float* s_in = smp ? F.in[I_SWKV] + (size_t)id * 4096 : nullptr;
        float* s_out = F.out + (smp ? O_WKV_S : O_WKV_P) + (size_t)id * 4096;
#ifndef NO_SCAN
        scan_unit(F, smp ? MP + b * TS : b * TP, smp ? TS : TP, h, s_in, s_out);
#endif
    } else if (t < 272) { const int u = t - 16;
#ifndef NO_ATTP
        attn_prompt_unit(F, u >> 7, (u >> 6) & 1, u & 63);
#endif
    }
    else {
#ifndef NO_ATTS
        attn_sample_unit(F, t - 1296);
#endif
    }
}
__device__ __forceinline__ void p_mixer(Frame& F) {
    int t = F.vcu, step = F.G, end = 1312;
    if (F.G >= 32) { if (F.vcu < 16) { step = 1 << 20; end = 16; } else step = F.G - 16; }
    for (; t < end; t += step) mixer_task(F, t);
    __syncthreads();
}
#ifndef MK_PER_PHASE
#define MK_PER_PHASE 0
#endif
constexpr int N_PHASES = 13;
struct Args { const float* in[N_IN]; float* out; unsigned char* ws; int ph_lo, ph_hi; };
static_assert(sizeof(Args) == N_IN * 8 + 24, "Args has no padding");
__global__ void __launch_bounds__(NWAVES * 64, 2) fwd_kernel(Args args) {
    extern __shared__ __attribute__((aligned(16))) unsigned char lds[];
    Frame F;
    F.lds = (LAS unsigned char*)lds;
    F.MISC = (volatile LAS unsigned*)(F.lds + MISC_OFF);
    F.tid = threadIdx.x; F.lane = F.tid & 63; F.wave = __builtin_amdgcn_readfirstlane(F.tid >> 6);
    F.G = gridDim.x; { const int bx = blockIdx.x; F.vcu = (F.G % 8 == 0) ? (bx % 8) * (F.G / 8) + bx / 8 : bx; }
    F.ws = args.ws; F.out = args.out; F.ctl = (gu32*)(args.ws + WS_CTL);
#pragma unroll
    for (int i = 0; i < N_IN; ++i) F.in[i] = args.in[i];
    for (int u = F.tid; u < (LDS_BYTES - LDSCTL_OFF) / 4; u += NWAVES * 64) ((LAS unsigned*)(F.lds + LDSCTL_OFF))[u] = 0u;
    __syncthreads();
    const int lo = args.ph_lo, hi = args.ph_hi;
    XcdBarrier bar; bar.bar = (unsigned*)(F.ctl + CW_BAR); bar.x = 0; bar.st = nullptr;
    if (hi - lo > 1) bar = xcd_barrier_post((unsigned*)(F.ctl + CW_BAR), F.MISC + 8);
#ifdef ONLY_PHASE
#define IN(k) ((k) == ONLY_PHASE && lo <= (k) && (k) < hi)
#else
#define IN(k) (lo <= (k) && (k) < hi)
#endif
#define SEAM(k) do { if ((k) + 1 < hi) xcd_barrier(bar); } while (0)
#define GEMM_SWIGLU(k, WOFF) if (IN(k)) { \
        pg8::Gemm g{WSP(bf16, WS_U), WSP(bf16, WOFF), M, NFF, D}; pg8::StaticOrder S; S.init(M, NFF, F.G, (int)blockIdx.x); \
        pg8::EpiSwiglu E{WSP(bf16, WS_H), FF}; \
        pg8::gemm_phase<pg8::EpiSwiglu, pg8::StaticOrder, true, true>(F.lds + RING_OFF, g, S, E); SEAM(k); }
#define GEMM_RESID(k, AOFF, WOFF, KK, XP, XS, GTK, GS) if (IN(k)) { \
        pg8::Gemm g{WSP(bf16, AOFF), WSP(bf16, WOFF), M, D, KK}; pg8::StaticOrder S; S.init(M, D, F.G, (int)blockIdx.x); \
        pg8::EpiResid E{XP, XS, args.out + O_Y, WSP(float, WS_MOD) + (GTK) * D, ALPHA, GS}; \
        pg8::gemm_phase<pg8::EpiResid, pg8::StaticOrder, true, true>(F.lds + RING_OFF, g, S, E); SEAM(k); }
    if (IN(0)) { p0_weights(F); __syncthreads(); p0_mod(F); SEAM(0); }
    if (IN(1)) { p_modulate0(F); SEAM(1); }
    GEMM_SWIGLU(2, WS_W1IN)
    GEMM_RESID(3, WS_H, WS_W1OUT, FF, args.in[I_XP], args.in[I_XS], 2, 0.5f)
    if (IN(4)) { p_layernorm(F, 0, 3 * D); SEAM(4); }
    if (IN(5)) {
        pg8::Gemm g{WSP(bf16, WS_U), WSP(bf16, WS_WIN), M, NIN, D}; pg8::StaticOrder S; S.init(M, NIN, F.G, (int)blockIdx.x);
        pg8::EpiBf16<0> E{WSP(bf16, WS_H), NIN, nullptr, 0, 0, 1.f};
        pg8::gemm_phase<pg8::EpiBf16<0>, pg8::StaticOrder, true, true>(F.lds + RING_OFF, g, S, E); SEAM(5); }
    if (IN(6)) { p_prep(F); SEAM(6); }
    if (IN(7)) { p_mixer(F); SEAM(7); }
    GEMM_RESID(8, WS_U, WS_WOUT, D, args.out + O_Y, args.out + O_Y + (size_t)MP * D, 5, 1.0f)
    if (IN(9)) { p_layernorm(F, 1, 6 * D); SEAM(9); }
    GEMM_SWIGLU(10, WS_W2IN)
    GEMM_RESID(11, WS_H, WS_W2OUT, FF, args.out + O_Y, args.out + O_Y + (size_t)MP * D, 8, 0.5f)
    if (IN(12)) { p_layernorm(F, 2, -1); }
}

extern "C" void kernel_launch(void* const* d_in, const int* in_sizes, int n_in, void* d_out, int out_size, void* d_ws, size_t ws_size, hipStream_t stream) {
    static int grid = 0;
    if (grid == 0) {
        if (n_in != N_IN || in_sizes[0] != MP * D || out_size != (int)O_END || ws_size < WS_END) { fprintf(stderr, "kernel_launch: unexpected shapes (n_in %d, out %d, ws %zu); nothing launched\n", n_in, out_size, ws_size); grid = -1; return; }
        int dev = 0, cus = 0;
        if (hipGetDevice(&dev) != hipSuccess || hipDeviceGetAttribute(&cus, hipDeviceAttributeMultiprocessorCount, dev) != hipSuccess) { grid = -1; return; }
        if (hipFuncSetAttribute((const void*)fwd_kernel, hipFuncAttributeMaxDynamicSharedMemorySize, LDS_BYTES) != hipSuccess) { fprintf(stderr, "kernel_launch: hipFuncSetAttribute failed\n"); grid = -1; return; }
        int per_cu = 0;
        if (hipOccupancyMaxActiveBlocksPerMultiprocessor(&per_cu, (const void*)fwd_kernel, NWAVES * 64, LDS_BYTES) != hipSuccess || per_cu < 1) fprintf(stderr, "kernel_launch: occupancy query reports %d\n", per_cu);
        (void)hipGetLastError();
        grid = cus;
    }
    if (grid < 0) return;
    if (hipMemsetAsync((char*)d_ws + WS_CTL, 0, CTL_ZERO_BYTES, stream) != hipSuccess) return;
    Args a{};
    for (int i = 0; i < N_IN; ++i) a.in[i] = (const float*)d_in[i];
    a.out = (float*)d_out; a.ws = (unsigned char*)d_ws;
#if MK_PER_PHASE
    for (int ph = 0; ph < N_PHASES; ++ph) { a.ph_lo = ph; a.ph_hi = ph + 1; hipLaunchKernelGGL(fwd_kernel, dim3(grid), dim3(NWAVES * 64), LDS_BYTES, stream, a); }
#else
    a.ph_lo = 0; a.ph_hi = N_PHASES;
    hipLaunchKernelGGL(fwd_kernel, dim3(grid), dim3(NWAVES * 64), LDS_BYTES, stream, a);
#endif
}
```

```cpp
#define MK_PER_PHASE 0
#include <hip/hip_runtime.h>
#include <cstdio>
#include <cstdint>
#include <cmath>
namespace pg8 {
#define PG8_LAS __attribute__((address_space(3)))
typedef unsigned short bf16_t;
typedef short bf16x8 __attribute__((ext_vector_type(8)));
typedef float f32x4 __attribute__((ext_vector_type(4)));
typedef unsigned u32x4 __attribute__((ext_vector_type(4)));
constexpr int BM = 256, BK = 64, HALF = 128, HTB = HALF * BK * 2  , STAGE_BYTES = 8 * HTB, NXCD = 8, WGM = 8;

__host__ __device__ __forceinline__ int lds_byte(int r, int c) { const int st = (r >> 4) * 2 + (c >> 5), rr = r & 15, cc = c & 31, ob = rr * 64 + cc * 2; return st * 1024 + (ob ^ (((ob >> 9) & 1) << 5)); }
__host__ __device__ __forceinline__ void stage_rc(int b, int& R, int& C) { const int st = b / 1024, sb = b % 1024, swz = sb ^ (((sb >> 9) & 1) << 5); R = (st >> 1) * 16 + swz / 64; C = (st & 1) * 32 + (swz % 64) / 2; }
__host__ __device__ __forceinline__ int perm32(int rho) { const int n = rho >> 4, i = rho & 15; return 8 * (i >> 2) + 4 * n + (i & 3); }

struct Unit { int pm, pn; };
struct Gemm { const bf16_t* A; const bf16_t* Bt; int M, N, K; };

struct StaticOrder {
    int nM, nN, nwg, G, c;
    __host__ __device__ void init(int M, int N, int G_, int c_) { nM = M / BM; nN = N / BM; nwg = nM * nN; G = G_; c = c_; }
    __host__ __device__ bool next(int i, Unit& u) const {
        const long L = (long)i * G + c; if (L >= nwg) return false;
        int wgid = (int)L; { const int q = nwg / NXCD, r = nwg % NXCD, xcd = wgid % NXCD, off = wgid / NXCD; wgid = (xcd < r ? xcd * (q + 1) : r * (q + 1) + (xcd - r) * q) + off; }
        const int nig = WGM * nN, gid = wgid / nig, fm = gid * WGM, gsz = (nM - fm) < WGM ? (nM - fm) : WGM;
        u.pm = fm + ((wgid % nig) % gsz); u.pn = (wgid % nig) / gsz; return true;
    }
    __device__ __forceinline__ void a_ready(const Unit&) const {}
    __device__ __forceinline__ void done(const Unit&) const {}
};

__device__ __forceinline__ unsigned cvt_pk_bf16(float lo, float hi) { unsigned r; asm volatile("v_cvt_pk_bf16_f32 %0, %1, %2" : "=v"(r) : "v"(lo), "v"(hi)); return r; }
template <int ACT  > struct EpiBf16 {
    static constexpr bool PERM = true, AFTER_DRAIN = false; static_assert(ACT == 0, "EpiBf16: ACT is 0 (none)");
    bf16_t* O; int ldc; const float* bias; int split_cols; size_t split_stride; float scale0;
    __device__ __forceinline__ void operator()(const f32x4 (&acc)[2][2][4][2], const Unit& u, int wr, int wc, int fr, int fq) const {
        const int row0 = u.pm * BM + wr * 64 + fr; int colt = u.pn * BM; bf16_t* base = O;
        float sc = 1.f; if (split_cols) { const int t = colt / split_cols; base += (size_t)t * split_stride; colt -= t * split_cols; if (t == 0) sc = scale0; }
        const int col0 = colt + wc * 32 + 8 * fq, bcol0 = u.pn * BM + wc * 32 + 8 * fq;
        f32x4 bv[2][2];
#pragma unroll
        for (int bj = 0; bj < 2; ++bj)
#pragma unroll
            for (int n = 0; n < 2; ++n) bv[bj][n] = bias ? *(const f32x4*)(bias + bcol0 + bj * HALF + 4 * n) : (f32x4){0.f, 0.f, 0.f, 0.f};
#pragma unroll
        for (int ai = 0; ai < 2; ++ai)
#pragma unroll
            for (int m = 0; m < 4; ++m) { bf16_t* rowp = base + (size_t)(row0 + ai * HALF + m * 16) * ldc + col0;
#pragma unroll
                for (int bj = 0; bj < 2; ++bj) { f32x4 v0 = acc[ai][bj][m][0] + bv[bj][0], v1 = acc[ai][bj][m][1] + bv[bj][1];
                    v0 = v0 * sc; v1 = v1 * sc; u32x4 w; w.x = cvt_pk_bf16(v0[0], v0[1]); w.y = cvt_pk_bf16(v0[2], v0[3]); w.z = cvt_pk_bf16(v1[0], v1[1]); w.w = cvt_pk_bf16(v1[2], v1[3]);
                    *(u32x4*)(rowp + bj * HALF) = w; } }
    }
};

template <class Epi, class Sched, bool ALIGN_EPI = false, bool SP2 = false>
__device__ __forceinline__ void gemm_phase(PG8_LAS unsigned char* lds, const Gemm g, const Sched& S, const Epi& E) {
    const int tid = threadIdx.x, wid = __builtin_amdgcn_readfirstlane(tid >> 6), lane = tid & 63, wr = wid >> 2, wc = wid & 3, fr = lane & 15, fq = lane >> 4;
    const int K = g.K, nt = K / BK;
    unsigned voffA[2], voffB[2];
#pragma unroll
    for (int i = 0; i < 2; ++i) { int R, C; stage_rc(tid * 16 + i * 8192, R, C); const int Rb = Epi::PERM ? ((R & ~31) + perm32(R & 31)) : R;
        voffA[i] = (unsigned)(R * K + C) * 2u; voffB[i] = (unsigned)(Rb * K + C) * 2u; }
    const size_t kstep = (size_t)(BK * 2);
    const size_t hstep = (size_t)HALF * K * 2;
    const size_t tstep = 2 * hstep;
    const unsigned ldsw = (unsigned)wid * 1024u;
    const int aoff = lds_byte(wr * 64 + fr, fq * 8), boff = lds_byte(wc * 32 + fr, fq * 8);
#define PG8_SA(b, h) (((b) * 2 + (h)) * HTB)
#define PG8_SB(b, h) ((4 + (b) * 2 + (h)) * HTB)
#define PG8_STAGE(bufoff, gbase, voff) do { _Pragma("unroll") for (int _i = 0; _i < 2; ++_i) \
        __builtin_amdgcn_global_load_lds((const unsigned*)((const char*)(gbase) + (voff)[_i]), (PG8_LAS unsigned*)(lds + (bufoff) + ldsw + _i * 8192), 16, 0, 0); } while (0)
#define PG8_LDA(dst, b, h) do { _Pragma("unroll") for (int m = 0; m < 4; ++m) _Pragma("unroll") for (int k = 0; k < 2; ++k) dst[m][k] = *(const PG8_LAS bf16x8*)(lds + PG8_SA(b, h) + aoff + m * 2048 + k * 1024); } while (0)
#define PG8_LDB(dst, b, h) do { _Pragma("unroll") for (int n = 0; n < 2; ++n) _Pragma("unroll") for (int k = 0; k < 2; ++k) dst[n][k] = *(const PG8_LAS bf16x8*)(lds + PG8_SB(b, h) + boff + n * 2048 + k * 1024); } while (0)
#define PG8_MMA(ai, bj, At, Bt) do { __builtin_amdgcn_s_setprio(1); _Pragma("unroll") for (int m = 0; m < 4; ++m) _Pragma("unroll") for (int n = 0; n < 2; ++n) _Pragma("unroll") for (int k = 0; k < 2; ++k) \
        acc[ai][bj][m][n] = __builtin_amdgcn_mfma_f32_16x16x32_bf16(Bt[n][k], At[m][k], acc[ai][bj][m][n], 0, 0, 0); __builtin_amdgcn_s_setprio(0); } while (0)
#define PG8_WAIT_V(n) asm volatile("s_waitcnt vmcnt(" #n ")" ::: "memory")
#define PG8_WAIT_L(n) asm volatile("s_waitcnt lgkmcnt(" #n ")" ::: "memory")
#define PG8_BAR __builtin_amdgcn_s_barrier()
#define PG8_SCHED __builtin_amdgcn_sched_barrier(0)
    Unit cur, nxt; int ui = 0;
    if (!S.next(0, cur)) return;
    f32x4 acc[2][2][4][2];
#pragma unroll
    for (int a = 0; a < 2; ++a)
#pragma unroll
        for (int b = 0; b < 2; ++b)
#pragma unroll
            for (int m = 0; m < 4; ++m)
#pragma unroll
                for (int n = 0; n < 2; ++n) acc[a][b][m][n] = (f32x4){0.f, 0.f, 0.f, 0.f};
    bf16x8 At[4][2], B0[2][2], B1[2][2];
    const char* cA = (const char*)g.A + (size_t)cur.pm * tstep; const char* cB = (const char*)g.Bt + (size_t)cur.pn * tstep;
    S.a_ready(cur);
    if constexpr (SP2) {
        PG8_STAGE(PG8_SB(0, 0), cB, voffB); PG8_STAGE(PG8_SB(0, 1), cB + hstep, voffB); PG8_STAGE(PG8_SA(0, 0), cA, voffA); PG8_STAGE(PG8_SA(0, 1), cA + hstep, voffA);
        if (wr == 1) PG8_BAR;
        PG8_WAIT_V(2); PG8_BAR;
        PG8_STAGE(PG8_SB(1, 0), cB + kstep, voffB); PG8_STAGE(PG8_SA(1, 0), cA + kstep, voffA); PG8_STAGE(PG8_SB(1, 1), cB + hstep + kstep, voffB);
        PG8_WAIT_V(6); PG8_BAR;
    } else {
        PG8_STAGE(PG8_SB(0, 0), cB, voffB); PG8_STAGE(PG8_SA(0, 0), cA, voffA); PG8_STAGE(PG8_SB(0, 1), cB + hstep, voffB); PG8_STAGE(PG8_SA(0, 1), cA + hstep, voffA);
        if (wr == 1) PG8_BAR;
        PG8_WAIT_V(4); PG8_BAR;
        PG8_STAGE(PG8_SB(1, 0), cB + kstep, voffB); PG8_STAGE(PG8_SA(1, 0), cA + kstep, voffA); PG8_STAGE(PG8_SB(1, 1), cB + hstep + kstep, voffB);
        PG8_WAIT_V(6); PG8_BAR;
    }
    for (;;) {
        const bool has_next = S.next(ui + 1, nxt);
        const char* nA = has_next ? (const char*)g.A + (size_t)nxt.pm * tstep : cA; const char* nB = has_next ? (const char*)g.Bt + (size_t)nxt.pn * tstep : cB;
        for (int t = 0; t < nt; t += 2) {
            const bool last = (t == nt - 2);
            const char* a1 = cA + (size_t)(t + 1) * kstep;
            const char* a2 = last ? nA : cA + (size_t)(t + 2) * kstep; const char* b2 = last ? nB : cB + (size_t)(t + 2) * kstep;
            const char* a3 = a2 + kstep; const char* b3 = b2 + kstep;
            if (last && has_next) S.a_ready(nxt);
            if constexpr (SP2) {
            PG8_LDB(B0, 0, 0); PG8_LDB(B1, 0, 1); PG8_SCHED; PG8_LDA(At, 0, 0); PG8_STAGE(PG8_SA(1, 1), a1 + hstep, voffA);
            PG8_WAIT_V(8); PG8_WAIT_L(0); PG8_BAR; PG8_MMA(0, 0, At, B0); PG8_MMA(0, 1, At, B1); PG8_BAR; PG8_SCHED;
            PG8_LDA(At, 0, 1); PG8_STAGE(PG8_SB(0, 0), b2, voffB); PG8_STAGE(PG8_SB(0, 1), b2 + hstep, voffB); PG8_STAGE(PG8_SA(0, 0), a2, voffA);
            PG8_WAIT_V(8); PG8_WAIT_L(0); PG8_BAR; PG8_MMA(1, 0, At, B0); PG8_MMA(1, 1, At, B1); PG8_BAR; PG8_SCHED;
            PG8_LDB(B0, 1, 0); PG8_LDB(B1, 1, 1); PG8_SCHED; PG8_LDA(At, 1, 0); PG8_STAGE(PG8_SA(0, 1), a2 + hstep, voffA);
            PG8_WAIT_V(8); PG8_WAIT_L(0); PG8_BAR; PG8_MMA(0, 0, At, B0); PG8_MMA(0, 1, At, B1); PG8_BAR; PG8_SCHED;
            PG8_LDA(At, 1, 1); PG8_STAGE(PG8_SB(1, 0), b3, voffB); PG8_STAGE(PG8_SB(1, 1), b3 + hstep, voffB); PG8_STAGE(PG8_SA(1, 0), a3, voffA);
            PG8_WAIT_V(8); PG8_WAIT_L(0); PG8_BAR; PG8_MMA(1, 0, At, B0); PG8_MMA(1, 1, At, B1); PG8_BAR; PG8_SCHED;
            } else {
            PG8_LDB(B0, 0, 0); PG8_SCHED; PG8_LDA(At, 0, 0); PG8_STAGE(PG8_SA(1, 1), a1 + hstep, voffA);
            PG8_WAIT_L(8); PG8_BAR; PG8_WAIT_L(0); PG8_MMA(0, 0, At, B0); PG8_BAR; PG8_SCHED;
            PG8_LDB(B1, 0, 1); PG8_STAGE(PG8_SB(0, 0), b2, voffB);
            PG8_BAR; PG8_WAIT_L(0); PG8_MMA(0, 1, At, B1); PG8_BAR;
            PG8_LDA(At, 0, 1); PG8_STAGE(PG8_SA(0, 0), a2, voffA);
            PG8_BAR; PG8_WAIT_L(0); PG8_MMA(1, 0, At, B0); PG8_BAR; PG8_SCHED;
            PG8_STAGE(PG8_SB(0, 1), b2 + hstep, voffB);
            PG8_WAIT_V(6); PG8_BAR; PG8_MMA(1, 1, At, B1); PG8_BAR;
            PG8_LDB(B0, 1, 0); PG8_SCHED; PG8_LDA(At, 1, 0); PG8_STAGE(PG8_SA(0, 1), a2 + hstep, voffA);
            PG8_WAIT_L(8); PG8_BAR; PG8_WAIT_L(0); PG8_MMA(0, 0, At, B0); PG8_BAR; PG8_SCHED;
            PG8_LDB(B1, 1, 1); PG8_STAGE(PG8_SB(1, 0), b3, voffB);
            PG8_BAR; PG8_WAIT_L(0); PG8_MMA(0, 1, At, B1); PG8_BAR;
            PG8_LDA(At, 1, 1); PG8_STAGE(PG8_SA(1, 0), a3, voffA);
            PG8_BAR; PG8_WAIT_L(0); PG8_MMA(1, 0, At, B0); PG8_BAR; PG8_SCHED;
            PG8_STAGE(PG8_SB(1, 1), b3 + hstep, voffB);
            PG8_WAIT_V(6); PG8_BAR; PG8_MMA(1, 1, At, B1); PG8_BAR;
            }
        }
        if constexpr (ALIGN_EPI) { if (wr == 0) PG8_BAR; }
        if constexpr (!Epi::AFTER_DRAIN) { E(acc, cur, wr, wc, fr, fq); S.done(cur); }
        if (!has_next) break;
#pragma unroll
        for (int a = 0; a < 2; ++a)
#pragma unroll
            for (int b = 0; b < 2; ++b)
#pragma unroll
                for (int m = 0; m < 4; ++m)
#pragma unroll
                    for (int n = 0; n < 2; ++n) acc[a][b][m][n] = (f32x4){0.f, 0.f, 0.f, 0.f};
        cur = nxt; cA = nA; cB = nB; ++ui;
        if constexpr (ALIGN_EPI) { if (wr == 1) PG8_BAR; }
    }
    PG8_WAIT_V(0);
    if constexpr (!ALIGN_EPI) { if (wr == 0) PG8_BAR; }
    PG8_BAR;
    if constexpr (Epi::AFTER_DRAIN) { E.fused(acc, cur, wr, wc, fr, fq, lds, wid, lane); S.done(cur); }
#undef PG8_SA
#undef PG8_SB
#undef PG8_STAGE
#undef PG8_LDA
#undef PG8_LDB
#undef PG8_MMA
#undef PG8_WAIT_V
#undef PG8_WAIT_L
#undef PG8_BAR
#undef PG8_SCHED
}
struct EpiSwiglu {
    static constexpr bool PERM = true, AFTER_DRAIN = false;
    bf16_t* H; int ldh;
    __device__ __forceinline__ void operator()(const f32x4 (&acc)[2][2][4][2], const Unit& u, int wr, int wc, int fr, int fq) const {
        const int row0 = u.pm * BM + wr * 64 + fr, col0 = u.pn * HALF + wc * 32 + 8 * fq;
#pragma unroll
        for (int ai = 0; ai < 2; ++ai)
#pragma unroll
            for (int m = 0; m < 4; ++m) {
                bf16_t* p = H + (size_t)(row0 + ai * HALF + m * 16) * ldh + col0;
                float h[8];
#pragma unroll
                for (int n = 0; n < 2; ++n)
#pragma unroll
                    for (int i = 0; i < 4; ++i) { const float g = acc[ai][0][m][n][i], up = acc[ai][1][m][n][i];
                        h[n * 4 + i] = g * __builtin_amdgcn_rcpf(1.0f + __expf(-g)) * up; }
                u32x4 w; w.x = cvt_pk_bf16(h[0], h[1]); w.y = cvt_pk_bf16(h[2], h[3]); w.z = cvt_pk_bf16(h[4], h[5]); w.w = cvt_pk_bf16(h[6], h[7]);
                *(u32x4*)p = w;
            }
    }
};
struct EpiResid {
    static constexpr bool PERM = false, AFTER_DRAIN = false;
    const float* xp; const float* xs; float* X; const float* gt; float alpha, gs;
    __device__ __forceinline__ void operator()(const f32x4 (&acc)[2][2][4][2], const Unit& u, int wr, int wc, int fr, int fq) const {
        const int col0 = u.pn * BM + wc * 32 + 4 * fq;
#pragma unroll
        for (int ai = 0; ai < 2; ++ai)
#pragma unroll
            for (int m = 0; m < 4; ++m) {
                const int row = u.pm * BM + ai * HALF + wr * 64 + m * 16 + fr;
                const bool smp = row >= 16384;
                const float* xr = smp ? xs + (size_t)(row - 16384) * 1024 : xp + (size_t)row * 1024;
                const int b = smp ? 2 + ((row - 16384) >> 3) : (row >> 13);
                const float* gr = gt + (size_t)b * 9216;
                float* xo = X + (size_t)row * 1024;
#pragma unroll
                for (int bj = 0; bj < 2; ++bj)
#pragma unroll
                    for (int n = 0; n < 2; ++n) { const int c = col0 + bj * HALF + n * 16;
                        const f32x4 xv = *(const f32x4*)(xr + c), gv = *(const f32x4*)(gr + c);
                        const f32x4 z = xv * alpha + (gv + 1.0f) * gs * acc[ai][bj][m][n];
                        *(f32x4*)(xo + c) = z; }
            }
    }
};
}
#define GAS __attribute__((address_space(1)))
#define LAS __attribute__((address_space(3)))
typedef unsigned short bf16;
typedef unsigned v4u __attribute__((ext_vector_type(4)));
typedef float f32x4 __attribute__((ext_vector_type(4)));
typedef short bf16x8 __attribute__((ext_vector_type(8)));
typedef GAS unsigned gu32;
typedef GAS unsigned long long gu64;
#define RLX_AGENT __ATOMIC_RELAXED, __HIP_MEMORY_SCOPE_AGENT
#define LDS_WAIT() asm volatile("s_waitcnt lgkmcnt(0)" ::: "memory")
#define VM_WAIT() asm volatile("s_waitcnt vmcnt(0)" ::: "memory")
__device__ __forceinline__ unsigned long long rt() { return __builtin_amdgcn_s_memrealtime(); }
__device__ __forceinline__ unsigned f2bf(float f) { unsigned u = __builtin_bit_cast(unsigned, f); return (u + 0x7fffu + ((u >> 16) & 1u)) >> 16; }
__device__ __forceinline__ unsigned pk2(float lo, float hi) { return f2bf(lo) | (f2bf(hi) << 16); }

#define XB_TMO      128
#define XB_XCNT(j)  (256  + 64 * (j))
#define XB_XSUB(j)  (1280 + 64 * (j))
#define XB_XGEN(j)  (2304 + 64 * (j))
#define XB_TOP      3328
#define XB_TOPGEN   3392
#define XCD_BAR_WORDS 3456
#define XB_SPIN_CAP (1u << 18)

__device__ __forceinline__ unsigned xb_ld(unsigned* p)              { return __hip_atomic_load(p, __ATOMIC_RELAXED, __HIP_MEMORY_SCOPE_AGENT); }
__device__ __forceinline__ unsigned xb_add(unsigned* p, unsigned v) { return __hip_atomic_fetch_add(p, v, __ATOMIC_RELAXED, __HIP_MEMORY_SCOPE_AGENT); }
__device__ __forceinline__ unsigned xb_xcc_id() { return (unsigned)__builtin_amdgcn_s_getreg((3 << 11) | 20) & 0xFu; }
#define XB_SPIN(cond, bar) do { unsigned _sp = 0; while (cond) { __builtin_amdgcn_s_sleep(1); \
    if ((++_sp & 255u) == 0u) { if (xb_ld(&(bar)[XB_TMO])) break; if (_sp > XB_SPIN_CAP) { atomicAdd(&(bar)[XB_TMO], 1u); break; } } } } while (0)

struct XcdBarrier {
    unsigned* bar; unsigned x;
    volatile LAS unsigned* st;
};

__device__ __forceinline__ XcdBarrier xcd_barrier_post(unsigned* bar, volatile LAS unsigned* st) {
    XcdBarrier b; b.bar = bar; b.x = xb_xcc_id(); b.st = st;
    if (threadIdx.x == 0) (void)xb_add(&bar[XB_XCNT(b.x)], 1u);
    return b;
}
__device__ __forceinline__ void xcd_barrier_complete(unsigned* bar, unsigned x, unsigned& nloc, unsigned& nx) {
    const unsigned G = gridDim.x * gridDim.y * gridDim.z;
    unsigned sum, cnt, mine, sp = 0u;
    for (;;) {
        sum = 0u; cnt = 0u; mine = 0u;
#pragma unroll
        for (unsigned j = 0; j < 16; ++j) { const unsigned c = xb_ld(&bar[XB_XCNT(j)]); sum += c; cnt += (c > 0u) ? 1u : 0u; mine = (j == x) ? c : mine; }
        if (sum == G) break;
        __builtin_amdgcn_s_sleep(1);
        if ((++sp & 255u) == 0u) { if (xb_ld(&bar[XB_TMO])) break; if (sp > XB_SPIN_CAP) { atomicAdd(&bar[XB_TMO], 1u); break; } }
    }
    nloc = mine > 0u ? mine : 1u; nx = cnt > 0u ? cnt : 1u;
}

__device__ __forceinline__ void xcd_barrier(const XcdBarrier& b) {
    asm volatile("s_waitcnt vmcnt(0)" ::: "memory");
    __syncthreads();
    if (threadIdx.x == 0) {
        unsigned* bar = b.bar;
        __builtin_amdgcn_s_waitcnt(0);
        unsigned nloc = b.st[0], nx = b.st[1];
        if (nloc == 0u) { xcd_barrier_complete(bar, b.x, nloc, nx); b.st[0] = nloc; b.st[1] = nx; }
        const unsigned old = xb_add(&bar[XB_XSUB(b.x)], 1u);
        const unsigned gen = old / nloc;
        if (old + 1u == (gen + 1u) * nloc) {
            __builtin_amdgcn_fence(__ATOMIC_RELEASE, "agent");
            asm volatile("s_waitcnt vmcnt(0)" ::: "memory");
            const unsigned og = xb_add(&bar[XB_TOP], 1u);
            const unsigned tg = og / nx;
            if (og + 1u == (tg + 1u) * nx) xb_add(&bar[XB_TOPGEN], 1u);
            else XB_SPIN(xb_ld(&bar[XB_TOPGEN]) == tg, bar);
            __builtin_amdgcn_fence(__ATOMIC_ACQUIRE, "agent");
            xb_add(&bar[XB_XGEN(b.x)], 1u);
            asm volatile("s_waitcnt vmcnt(0)" ::: "memory");
        } else {
            XB_SPIN(xb_ld(&bar[XB_XGEN(b.x)]) == gen, bar);
            __builtin_amdgcn_fence(__ATOMIC_ACQUIRE, "agent");
            asm volatile("s_waitcnt vmcnt(0)" ::: "memory");
        }
    }
    __syncthreads();
}

constexpr int D = 1024, FF = 2816, NFF = 2 * FF, NIN = 2560, RW = 512, RWP = 1792;
constexpr int MP = 16384, MS = 1024, M = MP + MS, TP = 8192, TS = 8, NBS = 128;
constexpr int MODW = 9216, NMOD = 130;
constexpr float ALPHA = 1.189207115002721f;
constexpr float LN_EPS = 1e-5f, GN_EPS = 64e-5f;
constexpr int NWAVES = 8;
enum { I_XP = 0, I_XS, I_SWKV, I_SSHIFT, I_CK, I_CV, I_CP, I_CS, I_RELB, I_WADA, I_BADA, I_LNG, I_LNB, I_W1IN, I_W1OUT, I_WIN, I_MU, I_W0, I_WDEC, I_A0, I_WICLR, I_WGATE,
       I_KK, I_KA, I_RK, I_GNW, I_GNB, I_SINKS, I_WOUT, I_W2IN, I_W2OUT, N_IN };
constexpr size_t O_Y = 0, O_WKV_P = (size_t)M * D, O_SHIFT_P = O_WKV_P + 65536, O_WINK_P = O_SHIFT_P + 3584, O_WINV_P = O_WINK_P + 32768,
                 O_WKV_S = O_WINV_P + 32768, O_SHIFT_S = O_WKV_S + 4194304, O_WINK_S = O_SHIFT_S + 229376, O_WINV_S = O_WINK_S + 2097152, O_END = O_WINV_S + 2097152;
static_assert(O_END == 26578432, "d_out size");
constexpr size_t MiB = 1u << 20;
constexpr size_t WS_CTL = 0, CTL_ZERO_BYTES = 1 * MiB;
constexpr size_t WS_W1IN = 2 * MiB, WS_W1OUT = 13 * MiB, WS_WIN = 19 * MiB, WS_WOUT = 24 * MiB, WS_W2IN = 26 * MiB, WS_W2OUT = 37 * MiB;
constexpr size_t WS_MOD = 43 * MiB;
constexpr size_t WS_U = 48 * MiB;
constexpr size_t WS_H = 82 * MiB;
constexpr size_t WS_WLOG = 176 * MiB, WS_A = 210 * MiB, WS_G = 227 * MiB, WS_INV = 244 * MiB, WS_END = 245 * MiB;
static_assert(WS_W1IN + (size_t)NFF * D * 2 <= WS_W1OUT && WS_W1OUT + (size_t)D * FF * 2 <= WS_WIN && WS_WIN + (size_t)NIN * D * 2 <= WS_WOUT && WS_WOUT + (size_t)D * D * 2 <= WS_W2IN &&
              WS_W2IN + (size_t)NFF * D * 2 <= WS_W2OUT && WS_W2OUT + (size_t)D * FF * 2 <= WS_MOD && WS_MOD + (size_t)NMOD * MODW * 4 <= WS_U && WS_U + (size_t)M * D * 2 <= WS_H &&
              WS_H + (size_t)M * FF * 2 <= WS_WLOG && WS_WLOG + (size_t)M * RW * 4 <= WS_A && WS_A + (size_t)M * RW * 2 <= WS_G && WS_G + (size_t)M * RW * 2 <= WS_INV &&
              WS_INV + (size_t)M * 8 * 4 <= WS_END && WS_END <= 256 * MiB, "d_ws map");
constexpr int CW_BAR = 4096;
constexpr int RING_OFF = 0, RING_BYTES = 131072;
constexpr int LDSCTL_OFF = RING_BYTES, MISC_OFF = LDSCTL_OFF + 320;
constexpr int LDS_BYTES = 147456;
static_assert(MISC_OFF + 128 <= LDS_BYTES, "LDS map");

__device__ __forceinline__ float bf2f(unsigned short h) { return __uint_as_float((unsigned)h << 16); }
__device__ __forceinline__ float bflo(unsigned u) { return __uint_as_float(u << 16); }
__device__ __forceinline__ float bfhi(unsigned u) { return __uint_as_float(u & 0xffff0000u); }
__device__ __forceinline__ float wave_sum(float v) {
#pragma unroll
    for (int o = 1; o < 64; o <<= 1) v += __shfl_xor(v, o);
    return v;
}
template <int CTRL> __device__ __forceinline__ float dppf(float x) { return __builtin_bit_cast(float, __builtin_amdgcn_update_dpp(0, __builtin_bit_cast(int, x), CTRL, 0xf, 0xf, true)); }
__device__ __forceinline__ float sum8(float x) {
    x += dppf<0xB1>(x);
    x += dppf<0x4E>(x);
    x += dppf<0x141>(x);
    return x;
}
__device__ __forceinline__ float sigmoidf_(float x) { return 1.0f / (1.0f + expf(-x)); }

struct Frame {
    LAS unsigned char* lds;
    volatile LAS unsigned* MISC;
    gu32* ctl;
    int tid, lane, wave, vcu, G;
    const float* in[N_IN];
    float* out; unsigned char* ws;
};
#define WSP(T, off) ((T*)(F.ws + (off)))

__device__ __forceinline__ void p0_transpose_item(const float* W, int K, int N, bf16* WT, int dst_row0, int k0, int n0, LAS float* scr, int lane) {
#pragma unroll 8
    for (int i = 0; i < 32; ++i) { const int kk = 2 * i + (lane >> 5); scr[kk * 33 + (lane & 31)] = W[(size_t)(k0 + kk) * N + n0 + (lane & 31)]; }
    LDS_WAIT(); asm volatile("" ::: "memory");
    const int c = lane & 7;
#pragma unroll
    for (int j = 0; j < 4; ++j) { const int n = (lane >> 3) + 8 * j; const LAS float* s = scr + (8 * c) * 33 + n;
        v4u o; o.x = pk2(s[0 * 33], s[1 * 33]); o.y = pk2(s[2 * 33], s[3 * 33]); o.z = pk2(s[4 * 33], s[5 * 33]); o.w = pk2(s[6 * 33], s[7 * 33]);
        *(GAS v4u*)(WT + (size_t)(dst_row0 + n) * K + k0 + 8 * c) = o; }
    LDS_WAIT(); asm volatile("" ::: "memory");
}
__device__ __forceinline__ void p0_ffin_item(const float* W, bf16* WT, int r, LAS float* scr, int lane) {
    const int kb = r / 176, nb = r % 176, n0 = 32 * nb; const bool up = n0 >= FF; const int j = up ? n0 - FF : n0;
    p0_transpose_item(W, D, NFF, WT, (j >> 7) * 256 + (up ? 128 : 0) + (j & 127), 64 * kb, n0, scr, lane);
}
__device__ __forceinline__ void p0_plain_item(const float* W, int K, int N, bf16* WT, int r, LAS float* scr, int lane) {
    const int nblk = N / 32, kb = r / nblk, nb = r % nblk;
    p0_transpose_item(W, K, N, WT, 32 * nb, 64 * kb, 32 * nb, scr, lane);
}
__device__ __forceinline__ void p0_weights(Frame& F) {
    LAS float* scr = (LAS float*)(F.lds + RING_OFF + F.wave * 16384);
    const int gw = F.vcu * NWAVES + F.wave, NGW = F.G * NWAVES;
    constexpr int I_FI = 16 * 176, I_FO = 44 * 32, I_IN = 16 * 80, I_O = 16 * 32, NITEMS = 2 * I_FI + 2 * I_FO + I_IN + I_O;
    for (int it = gw; it < NITEMS; it += NGW) {
        int r = it;
        if (r < I_FI) { p0_ffin_item(F.in[I_W1IN], WSP(bf16, WS_W1IN), r, scr, F.lane); continue; } r -= I_FI;
        if (r < I_FI) { p0_ffin_item(F.in[I_W2IN], WSP(bf16, WS_W2IN), r, scr, F.lane); continue; } r -= I_FI;
        if (r < I_FO) { p0_plain_item(F.in[I_W1OUT], FF, D, WSP(bf16, WS_W1OUT), r, scr, F.lane); continue; } r -= I_FO;
        if (r < I_FO) { p0_plain_item(F.in[I_W2OUT], FF, D, WSP(bf16, WS_W2OUT), r, scr, F.lane); continue; } r -= I_FO;
        if (r < I_IN) { p0_plain_item(F.in[I_WIN], D, NIN, WSP(bf16, WS_WIN), r, scr, F.lane); continue; } r -= I_IN;
        p0_plain_item(F.in[I_WOUT], D, D, WSP(bf16, WS_WOUT), r, scr, F.lane);
    }
}
__device__ __forceinline__ void p0_mod(Frame& F) {
    constexpr int SCP = 172;
    LAS float* sc = (LAS float*)(F.lds);
    LAS float* red = (LAS float*)(F.lds + 64 * SCP * 4);
    const float* wada = F.in[I_WADA]; const float* bada = F.in[I_BADA]; const float* cp = F.in[I_CP]; const float* cs = F.in[I_CS];
    float* mod = WSP(float, WS_MOD);
    const int tid = F.tid; const bool act = tid < 504; const int q = act ? tid / 126 : 3, r = act ? tid % 126 : 125, g = r / 9, cg = r % 9;
    for (int task = blockIdx.x; task < MODW / 36; task += F.G) {
        const int j0 = 36 * task + 4 * cg;
        float acc[10][4];
#pragma unroll
        for (int s = 0; s < 10; ++s)
#pragma unroll
            for (int jj = 0; jj < 4; ++jj) acc[s][jj] = 0.f;
        for (int ch = 0; ch < 16; ++ch) {
            __syncthreads();
            for (int idx = tid; idx < 64 * NMOD; idx += 512) {
                const int b = idx >> 6, e = idx & 63, i = 256 * (e >> 4) + 16 * ch + (e & 15);
                const float c = b < 2 ? cp[b * D + i] : cs[(b - 2) * D + i];
                sc[e * SCP + (b % 14) * 12 + b / 14] = c / (1.0f + expf(-c));
            }
            __syncthreads();
            if (act) {
#pragma unroll 4
                for (int ii = 0; ii < 16; ++ii) {
                    const int i = 256 * q + 16 * ch + ii;
                    const f32x4 w = *(const f32x4*)(wada + (size_t)i * MODW + j0);
                    const LAS f32x4* sp = (const LAS f32x4*)(sc + (q * 16 + ii) * SCP + g * 12);
                    const f32x4 s0 = sp[0], s1 = sp[1], s2 = sp[2];
                    const float sv[10] = {s0[0], s0[1], s0[2], s0[3], s1[0], s1[1], s1[2], s1[3], s2[0], s2[1]};
#pragma unroll
                    for (int s = 0; s < 10; ++s)
#pragma unroll
                        for (int jj = 0; jj < 4; ++jj) acc[s][jj] += sv[s] * w[jj];
                }
            }
        }
        __syncthreads();
        if (act && q > 0) {
#pragma unroll
            for (int s = 0; s < 10; ++s)
#pragma unroll
                for (int jj = 0; jj < 4; ++jj) red[((q - 1) * 40 + s * 4 + jj) * 126 + r] = acc[s][jj];
        }
        __syncthreads();
        if (act && q == 0) {
            const f32x4 bb = *(const f32x4*)(bada + j0);
#pragma unroll
            for (int s = 0; s < 10; ++s) { const int b = g + 14 * s;
                if (b < NMOD) { f32x4 o;
#pragma unroll
                    for (int jj = 0; jj < 4; ++jj) { const int k = s * 4 + jj; o[jj] = acc[s][jj] + red[(0 * 40 + k) * 126 + r] + red[(1 * 40 + k) * 126 + r] + red[(2 * 40 + k) * 126 + r] + bb[jj]; }
                    *(f32x4*)(mod + (size_t)b * MODW + j0) = o; } }
        }
    }
    __syncthreads();
}

__device__ __forceinline__ int mod_row_of(int m) { return m < MP ? (m >> 13) : 2 + ((m - MP) >> 3); }
__device__ __forceinline__ void p_modulate0(Frame& F) {
    const int gw = F.vcu * NWAVES + F.wave, NGW = F.G * NWAVES;
    const float* mod = WSP(float, WS_MOD); bf16* U = WSP(bf16, WS_U);
    for (int m = gw; m < M; m += NGW) {
        const float* xr = m < MP ? F.in[I_XP] + (size_t)m * D : F.in[I_XS] + (size_t)(m - MP) * D;
        const float* mr = mod + (size_t)mod_row_of(m) * MODW;
        unsigned long long* o8 = (unsigned long long*)(U + (size_t)m * D) + F.lane;
#pragma unroll
        for (int j = 0; j < 4; ++j) { const int c = 4 * F.lane + 256 * j;
            const f32x4 x = *(const f32x4*)(xr + c), sh = *(const f32x4*)(mr + c), sc = *(const f32x4*)(mr + D + c);
            const f32x4 u = x * (sc + 1.0f) + sh;
            o8[64 * j] = (unsigned long long)pk2(u[0], u[1]) | ((unsigned long long)pk2(u[2], u[3]) << 32); }
    }
}
__device__ __forceinline__ void p_layernorm(Frame& F, int lnidx, int koff) {
    const int gw = F.vcu * NWAVES + F.wave, NGW = F.G * NWAVES;
    const float* mod = WSP(float, WS_MOD); bf16* U = WSP(bf16, WS_U); float* X = F.out + O_Y;
    const float* lg = F.in[I_LNG] + lnidx * D; const float* lb = F.in[I_LNB] + lnidx * D;
    for (int m = gw; m < M; m += NGW) {
        float* xr = X + (size_t)m * D;
        f32x4 v[4]; float s = 0.f;
#pragma unroll
        for (int j = 0; j < 4; ++j) { v[j] = *(const f32x4*)(xr + 4 * F.lane + 256 * j); s += (v[j][0] + v[j][1]) + (v[j][2] + v[j][3]); }
        const float mean = wave_sum(s) * (1.f / D); float s2 = 0.f;
#pragma unroll
        for (int j = 0; j < 4; ++j) { v[j] = v[j] - mean; s2 += (v[j][0] * v[j][0] + v[j][1] * v[j][1]) + (v[j][2] * v[j][2] + v[j][3] * v[j][3]); }
        const float rstd = 1.f / sqrtf(wave_sum(s2) * (1.f / D) + LN_EPS);
        const float* mr = mod + (size_t)mod_row_of(m) * MODW + (koff >= 0 ? koff : 0);
        unsigned long long* o8 = (unsigned long long*)(U + (size_t)m * D) + F.lane;
#pragma unroll
        for (int j = 0; j < 4; ++j) { const int c = 4 * F.lane + 256 * j;
            const f32x4 x = v[j] * rstd * *(const f32x4*)(lg + c) + *(const f32x4*)(lb + c);
            *(f32x4*)(xr + c) = x;
            if (koff >= 0) { const f32x4 sh = *(const f32x4*)(mr + c), sc = *(const f32x4*)(mr + D + c); const f32x4 u = x * (sc + 1.0f) + sh;
                o8[64 * j] = (unsigned long long)pk2(u[0], u[1]) | ((unsigned long long)pk2(u[2], u[3]) << 32); } }
    }
}
__device__ __forceinline__ float prev_val(const bf16* P, const float* sshift, int m, int col) {
    if (m < MP) return (m & (TP - 1)) == 0 ? 0.f : bf2f(P[(size_t)(m - 1) * NIN + col]);
    const int ms = m - MP;
    return (ms & (TS - 1)) == 0 ? sshift[(size_t)(ms >> 3) * RWP + col] : bf2f(P[(size_t)(m - 1) * NIN + col]);
}
__device__ __forceinline__ void p_prep(Frame& F) {
    LAS float* L = (LAS float*)F.lds;
    const bf16* P = WSP(bf16, WS_H); const float* sshift = F.in[I_SSHIFT]; const float* mu = F.in[I_MU];
    const float* wdec = F.in[I_WDEC]; const float* wiclr = F.in[I_WICLR]; const float* wgate = F.in[I_WGATE];
    float* WLOG = WSP(float, WS_WLOG); bf16* AA = WSP(bf16, WS_A); bf16* GG = WSP(bf16, WS_G); float* INV = WSP(float, WS_INV);
    const int c = F.tid;
    const float w0c = F.in[I_W0][c], a0c = F.in[I_A0][c], kkc = F.in[I_KK][c], muk = mu[RW + c];
    for (int tb = F.vcu; tb < M / 16; tb += F.G) {
        const int m0 = tb * 16;
        __syncthreads();
#pragma unroll
        for (int k = 0; k < 8; ++k) { const int idx = F.tid + 512 * k, i = idx & 15, j = idx >> 4, m = m0 + i, col = 1536 + j;
            const float p = bf2f(P[(size_t)m * NIN + col]), pv = prev_val(P, sshift, m, col), xs = p + (pv - p) * mu[col];
            L[j * 16 + i] = j < 64 ? tanhf(xs) : (j < 128 ? xs : sigmoidf_(xs)); }
        __syncthreads();
        float aw[16], aa[16], ag[16];
#pragma unroll
        for (int i = 0; i < 16; ++i) { aw[i] = 0.f; aa[i] = 0.f; ag[i] = 0.f; }
#pragma unroll 2
        for (int j = 0; j < 64; ++j) {
            const float wd = wdec[j * RW + c], wi = wiclr[j * RW + c];
            const LAS f32x4* lw = (const LAS f32x4*)(L + j * 16); const LAS f32x4* la = (const LAS f32x4*)(L + (64 + j) * 16);
#pragma unroll
            for (int qq = 0; qq < 4; ++qq) { const f32x4 tw = lw[qq], ta = la[qq];
#pragma unroll
                for (int e = 0; e < 4; ++e) { aw[qq * 4 + e] += wd * tw[e]; aa[qq * 4 + e] += wi * ta[e]; } }
        }
#pragma unroll 2
        for (int j = 0; j < 128; ++j) {
            const float wg = wgate[j * RW + c];
            const LAS f32x4* lg = (const LAS f32x4*)(L + (128 + j) * 16);
#pragma unroll
            for (int qq = 0; qq < 4; ++qq) { const f32x4 tg = lg[qq];
#pragma unroll
                for (int e = 0; e < 4; ++e) ag[qq * 4 + e] += wg * tg[e]; }
        }
#pragma unroll
        for (int i = 0; i < 16; ++i) { const int m = m0 + i;
            const float z = w0c + aw[i];
            const float sp = fmaxf(-z, 0.f) + log1pf(expf(-fabsf(z)));
            WLOG[(size_t)m * RW + c] = -expf(-sp - 0.5f);
            AA[(size_t)m * RW + c] = (bf16)f2bf(sigmoidf_(a0c + aa[i]));
            GG[(size_t)m * RW + c] = (bf16)f2bf(ag[i]);
            const float pk = bf2f(P[(size_t)m * NIN + RW + c]), pvk = prev_val(P, sshift, m, RW + c), xk = pk + (pvk - pk) * muk, kq = xk * kkc;
            const float ss = wave_sum(kq * kq);
            if (F.lane == 0) INV[(size_t)m * 8 + F.wave] = 1.0f / fmaxf(sqrtf(ss), 1e-12f);
        }
    }
    const int gt = F.vcu * 512 + F.tid, NT = F.G * 512;
    const float* ck = F.in[I_CK]; const float* cv = F.in[I_CV];
    for (int i = gt; i < 2 * RWP; i += NT) { const int b = i / RWP, col = i % RWP; F.out[O_SHIFT_P + i] = bf2f(P[(size_t)(b * TP + TP - 1) * NIN + col]); }
    for (int i = gt; i < NBS * RWP; i += NT) { const int b = i / RWP, col = i % RWP; F.out[O_SHIFT_S + i] = bf2f(P[(size_t)(MP + b * TS + TS - 1) * NIN + col]); }
    for (int i = gt; i < 2 * 128 * 128; i += NT) { const int b = i >> 14, j = (i >> 7) & 127, c2 = i & 127; const size_t row = (size_t)(b * TP + TP - 128 + j) * NIN;
        F.out[O_WINK_P + i] = bf2f(P[row + 2304 + c2]); F.out[O_WINV_P + i] = bf2f(P[row + 2432 + c2]); }
    for (int i = gt; i < NBS * 128 * 128; i += NT) { const int b = i >> 14, j = (i >> 7) & 127, c2 = i & 127;
        if (j < 120) { F.out[O_WINK_S + i] = ck[(size_t)(b * 128 + j + 8) * 128 + c2]; F.out[O_WINV_S + i] = cv[(size_t)(b * 128 + j + 8) * 128 + c2]; }
        else { const size_t row = (size_t)(MP + b * TS + (j - 120)) * NIN; F.out[O_WINK_S + i] = bf2f(P[row + 2304 + c2]); F.out[O_WINV_S + i] = bf2f(P[row + 2432 + c2]); } }
}

constexpr int SC_R = 0, SC_DEC = 1, SC_KM = 2, SC_KK = 3, SC_BB = 4, SC_V = 5, SC_Y = 6;
__device__ __forceinline__ void scan_unit(Frame& F, int row0, int T, int h, const float* s_in, float* s_out) {
    LAS float* A = (LAS float*)F.lds;
    const bf16* P = WSP(bf16, WS_H); const float* sshift = F.in[I_SSHIFT]; const float* mu = F.in[I_MU];
    const float* WLOG = WSP(float, WS_WLOG); const bf16* AA = WSP(bf16, WS_A); const bf16* GG = WSP(bf16, WS_G); const float* INV = WSP(float, WS_INV);
    bf16* MIX = WSP(bf16, WS_U);
    const int lane = F.lane, wave = F.wave, rl = lane >> 3, ks = lane & 7, row = 8 * wave + rl;
    float S[8];
#pragma unroll
    for (int j = 0; j < 8; ++j) S[j] = s_in ? s_in[(size_t)row * 64 + 8 * ks + j] : 0.f;
    const int e_ = F.tid & 63, chn = h * 64 + e_;
    const float mur = mu[chn], muk = mu[RW + chn], muv = mu[2 * RW + chn], kkc = F.in[I_KK][chn], kac = F.in[I_KA][chn], rkc = F.in[I_RK][chn], gnw = F.in[I_GNW][chn], gnb = F.in[I_GNB][chn];
    for (int t0 = 0; t0 < T; t0 += 64) {
        const int nb = (T - t0) < 64 ? (T - t0) : 64;
        __syncthreads();
        for (int s = F.tid >> 6; s < nb; s += 8) {
            const int m = row0 + t0 + s;
            const size_t pr = (size_t)m * NIN;
            const float p_r = bf2f(P[pr + chn]), p_k = bf2f(P[pr + RW + chn]), p_v = bf2f(P[pr + 2 * RW + chn]);
            const float q_r = prev_val(P, sshift, m, chn), q_k = prev_val(P, sshift, m, RW + chn), q_v = prev_val(P, sshift, m, 2 * RW + chn);
            const float xr = p_r + (q_r - p_r) * mur, xk = p_k + (q_k - p_k) * muk, xv = p_v + (q_v - p_v) * muv;
            const float a = bf2f(AA[(size_t)m * RW + chn]), wl = WLOG[(size_t)m * RW + chn], inv = INV[(size_t)m * 8 + h];
            const float kk = xk * kkc * inv;
            A[SC_R * 4096 + s * 64 + e_] = xr; A[SC_DEC * 4096 + s * 64 + e_] = expf(wl); A[SC_KM * 4096 + s * 64 + e_] = xk * (1.0f + (a - 1.0f) * kac);
            A[SC_KK * 4096 + s * 64 + e_] = kk; A[SC_BB * 4096 + s * 64 + e_] = kk * a; A[SC_V * 4096 + s * 64 + e_] = xv;
        }
        __syncthreads();
        for (int s = 0; s < nb; ++s) {
            const LAS f32x4* pk = (const LAS f32x4*)(A + SC_KK * 4096 + s * 64 + 8 * ks); const LAS f32x4* pb = (const LAS f32x4*)(A + SC_BB * 4096 + s * 64 + 8 * ks);
            const LAS f32x4* pd = (const LAS f32x4*)(A + SC_DEC * 4096 + s * 64 + 8 * ks); const LAS f32x4* pm = (const LAS f32x4*)(A + SC_KM * 4096 + s * 64 + 8 * ks);
            const LAS f32x4* pq = (const LAS f32x4*)(A + SC_R * 4096 + s * 64 + 8 * ks);
            const f32x4 k0 = pk[0], k1 = pk[1], b0 = pb[0], b1 = pb[1], d0 = pd[0], d1 = pd[1], m0 = pm[0], m1 = pm[1], r0 = pq[0], r1 = pq[1];
            const float v = A[SC_V * 4096 + s * 64 + row];
            float sa = 0.f;
#pragma unroll
            for (int j = 0; j < 4; ++j) { sa += S[j] * k0[j]; sa += S[4 + j] * k1[j]; }
            sa = sum8(sa);
            float y = 0.f;
#pragma unroll
            for (int j = 0; j < 4; ++j) { S[j] = S[j] * d0[j] + (v * m0[j] - sa * b0[j]); S[4 + j] = S[4 + j] * d1[j] + (v * m1[j] - sa * b1[j]); y += S[j] * r0[j]; y += S[4 + j] * r1[j]; }
            y = sum8(y);
            if (ks == 0) A[SC_Y * 4096 + s * 64 + row] = y;
        }
        __syncthreads();
        for (int s = wave; s < nb; s += 8) {
            const int m = row0 + t0 + s;
            const float y = A[SC_Y * 4096 + s * 64 + lane];
            const float mean = wave_sum(y) * (1.f / 64.f), d = y - mean, var = wave_sum(d * d) * (1.f / 64.f);
            const float yn = d * (1.0f / sqrtf(var + GN_EPS));
            const float dot = wave_sum(A[SC_R * 4096 + s * 64 + lane] * A[SC_KM * 4096 + s * 64 + lane] * rkc);
            const float g = bf2f(GG[(size_t)m * RW + chn]);
            const float o = (yn * gnw + gnb + dot * A[SC_V * 4096 + s * 64 + lane]) * g;
            MIX[(size_t)m * D + chn] = (bf16)f2bf(o);
        }
    }
#pragma unroll
    for (int j = 0; j < 8; ++j) s_out[(size_t)row * 64 + 8 * ks + j] = S[j];
    __syncthreads();
}
__device__ __forceinline__ int rel_bucket(int n) {
    if (n < 16) return n;
    const int b = 16 + (int)(logf((float)n * (1.0f / 16.0f)) / 2.0794415416798357f * 16.0f);
    return b < 31 ? b : 31;
}
constexpr int ATT_PITCH = 144, ATT_K_OFF = 0, ATT_V_OFF = 255 * ATT_PITCH + 48  , ATT_B_OFF = 2 * ATT_V_OFF;
static_assert(ATT_V_OFF % 16 == 0 && ATT_B_OFF + 4096 <= RING_BYTES, "attention LDS map");
__device__ __forceinline__ void attn_prompt_unit(Frame& F, int b, int kvh, int qb) {
    LAS unsigned char* lds = F.lds;
    const bf16* P = WSP(bf16, WS_H); bf16* MIX = WSP(bf16, WS_U);
    const float* relb = F.in[I_RELB];
    const int t0 = qb * 128, tid = F.tid;
    __syncthreads();
    for (int idx = tid; idx < 255 * 16; idx += 512) {
        const int rowi = idx >> 4, part = idx & 15, pos = t0 - 127 + rowi;
        v4u val = (v4u){0u, 0u, 0u, 0u};
        if (pos >= 0) val = *(const v4u*)(P + (size_t)(b * TP + pos) * NIN + (part < 8 ? 2304 : 2432) + kvh * 64 + (part & 7) * 8);
        *(LAS v4u*)(lds + (part < 8 ? ATT_K_OFF : ATT_V_OFF) + rowi * ATT_PITCH + (part & 7) * 16) = val;
    }
    for (int idx = tid; idx < 1024; idx += 512) { const int dist = idx >> 3, hq = idx & 7; ((LAS float*)(lds + ATT_B_OFF))[idx] = relb[rel_bucket(dist) * 8 + hq]; }
    __syncthreads();
    const int i = tid & 127, g = tid >> 7, hq = kvh * 4 + g, t = t0 + i, m = b * TP + t;
    v4u qw[8];
    { const v4u* qp = (const v4u*)(P + (size_t)m * NIN + RWP + hq * 64);
#pragma unroll
      for (int c = 0; c < 8; ++c) qw[c] = qp[c]; }
    float o[64];
#pragma unroll
    for (int d = 0; d < 64; ++d) o[d] = 0.f;
    float mrun = -1e30f, l = 0.f;
    const LAS float* bt = (const LAS float*)(lds + ATT_B_OFF);
#pragma unroll 1
    for (int jj = 0; jj < 128; ++jj) {
        const LAS v4u* kp = (const LAS v4u*)(lds + ATT_K_OFF + (i + jj) * ATT_PITCH);
        float a0 = 0.f, a1 = 0.f;
#pragma unroll
        for (int c = 0; c < 8; ++c) { const v4u w = kp[c];
#pragma unroll
            for (int e = 0; e < 4; ++e) { a0 += bflo(qw[c][e]) * bflo(w[e]); a1 += bfhi(qw[c][e]) * bfhi(w[e]); } }
        const int dist = 127 - jj;
        float sv = (a0 + a1) * 0.125f + bt[dist * 8 + hq];
        asm volatile("" : "+v"(sv));
        const bool valid = (t - dist) >= 0;
        sv = valid ? sv : -1e30f;
        const float mx = fmaxf(mrun, sv), corr = __expf(mrun - mx), p = valid ? __expf(sv - mx) : 0.f;
        mrun = mx; l = l * corr + p;
        const LAS v4u* vp = (const LAS v4u*)(lds + ATT_V_OFF + (i + jj) * ATT_PITCH);
#pragma unroll
        for (int c = 0; c < 8; ++c) { const v4u w = vp[c];
#pragma unroll
            for (int e = 0; e < 4; ++e) { o[c * 8 + 2 * e] = o[c * 8 + 2 * e] * corr + p * bflo(w[e]); o[c * 8 + 2 * e + 1] = o[c * 8 + 2 * e + 1] * corr + p * bfhi(w[e]); } }
    }
    l += __expf(F.in[I_SINKS][hq] - mrun);
    const float il = 1.0f / l;
    v4u* op = (v4u*)(MIX + (size_t)m * D + RW + hq * 64);
#pragma unroll
    for (int c = 0; c < 8; ++c) { v4u w;
#pragma unroll
        for (int e = 0; e < 4; ++e) w[e] = pk2(o[c * 8 + 2 * e] * il, o[c * 8 + 2 * e + 1] * il);
        op[c] = w; }
}
__device__ __forceinline__ void attn_sample_unit(Frame& F, int unit) {
    const bf16* P = WSP(bf16, WS_H); bf16* MIX = WSP(bf16, WS_U);
    const float* relb = F.in[I_RELB]; const float* ck = F.in[I_CK]; const float* cv = F.in[I_CV];
    const int idx = unit * 512 + F.tid, hq = idx & 7, t = (idx >> 3) & 7, b = idx >> 6, kvh = hq >> 2, m = MP + b * TS + t;
    float q[64];
    { const v4u* qp = (const v4u*)(P + (size_t)m * NIN + RWP + hq * 64);
#pragma unroll
      for (int c = 0; c < 8; ++c) { const v4u w = qp[c];
#pragma unroll
          for (int e = 0; e < 4; ++e) { q[c * 8 + 2 * e] = bflo(w[e]) * 0.125f; q[c * 8 + 2 * e + 1] = bfhi(w[e]) * 0.125f; } } }
    float o[64];
#pragma unroll
    for (int d = 0; d < 64; ++d) o[d] = 0.f;
    float mrun = -1e30f, l = 0.f;
    for (int jj = 0; jj < 128; ++jj) {
        const int j = t + 1 + jj, dist = 127 - jj;
        float a0 = 0.f, a1 = 0.f;
        const bool cached = j < 128;
        const size_t crow = ((size_t)(b * 128 + (cached ? j : 0)) * 2 + kvh) * 64, prow = (size_t)(MP + b * TS + (cached ? 0 : j - 128)) * NIN + kvh * 64;
        if (cached) { const f32x4* kp = (const f32x4*)(ck + crow);
#pragma unroll
            for (int c = 0; c < 16; ++c) { const f32x4 a = kp[c]; a0 += q[c * 4] * a[0] + q[c * 4 + 2] * a[2]; a1 += q[c * 4 + 1] * a[1] + q[c * 4 + 3] * a[3]; }
        } else { const v4u* kp = (const v4u*)(P + prow + 2304);
#pragma unroll
            for (int c = 0; c < 8; ++c) { const v4u a = kp[c];
#pragma unroll
                for (int e = 0; e < 4; ++e) { a0 += q[c * 8 + 2 * e] * bflo(a[e]); a1 += q[c * 8 + 2 * e + 1] * bfhi(a[e]); } }
        }
        const float s = (a0 + a1) + relb[rel_bucket(dist) * 8 + hq];
        const float mx = fmaxf(mrun, s), corr = __expf(mrun - mx), p = __expf(s - mx);
        mrun = mx; l = l * corr + p;
        if (cached) { const f32x4* vp = (const f32x4*)(cv + crow);
#pragma unroll
            for (int c = 0; c < 16; ++c) { const f32x4 v = vp[c];
#pragma unroll
                for (int e = 0; e < 4; ++e) o[c * 4 + e] = o[c * 4 + e] * corr + p * v[e]; }
        } else { const v4u* vp = (const v4u*)(P + prow + 2432);
#pragma unroll
            for (int c = 0; c < 8; ++c) { const v4u v = vp[c];
#pragma unroll
                for (int e = 0; e < 4; ++e) { o[c * 8 + 2 * e] = o[c * 8 + 2 * e] * corr + p * bflo(v[e]); o[c * 8 + 2 * e + 1] = o[c * 8 + 2 * e + 1] * corr + p * bfhi(v[e]); } }
        }
    }
    l += __expf(F.in[I_SINKS][hq] - mrun);
    const float il = 1.0f / l;
    v4u* op = (v4u*)(MIX + (size_t)m * D + RW + hq * 64);
#pragma unroll
    for (int c = 0; c < 8; ++c) { v4u w;
#pragma unroll
        for (int e = 0; e < 4; ++e) w[e] = pk2(o[c * 8 + 2 * e] * il, o[c * 8 + 2 * e + 1] * il);
        op[c] = w; }
}
__device__ __forceinline__ void mixer_task(Frame& F, int t) {
    if (t < 16 || (t >= 272 && t < 1296)) {
        const bool smp = t >= 16; const int id = smp ? t - 272 : t, b = id >> 3, h = id & 7;
        const float* s_in = smp ? F.in[I_SWKV] + (size_t)id * 4096 : nullptr;
        float* s_out = F.out + (smp ? O_WKV_S : O_WKV_P) + (size_t)id * 4096;
#ifndef NO_SCAN
        scan_unit(F, smp ? MP + b * TS : b * TP, smp ? TS : TP, h, s_in, s_out);
#endif
    } else if (t < 272) { const int u = t - 16;
#ifndef NO_ATTP
        attn_prompt_unit(F, u >> 7, (u >> 6) & 1, u & 63);
#endif
    }
    else {
#ifndef NO_ATTS
        attn_sample_unit(F, t - 1296);
#endif
    }
}
__device__ __forceinline__ void p_mixer(Frame& F) {
    int t = F.vcu, step = F.G, end = 1312;
    if (F.G >= 32) { if (F.vcu < 16) { step = 1 << 20; end = 16; } else step = F.G - 16; }
    for (; t < end; t += step) mixer_task(F, t);
    __syncthreads();
}
#ifndef MK_PER_PHASE
#define MK_PER_PHASE 0
#endif
constexpr int N_PHASES = 13;
struct Args { const float* in[N_IN]; float* out; unsigned char* ws; int ph_lo, ph_hi; };
static_assert(sizeof(Args) == N_IN * 8 + 24, "Args has no padding");
__global__ void __launch_bounds__(NWAVES * 64, 2) fwd_kernel(Args args) {
    extern __shared__ __attribute__((aligned(16))) unsigned char lds[];
    Frame F;
    F.lds = (LAS unsigned char*)lds;
    F.MISC = (volatile LAS unsigned*)(F.lds + MISC_OFF);
    F.tid = threadIdx.x; F.lane = F.tid & 63; F.wave = __builtin_amdgcn_readfirstlane(F.tid >> 6);
    F.G = gridDim.x; { const int bx = blockIdx.x; F.vcu = (F.G % 8 == 0) ? (bx % 8) * (F.G / 8) + bx / 8 : bx; }
    F.ws = args.ws; F.out = args.out; F.ctl = (gu32*)(args.ws + WS_CTL);
#pragma unroll
    for (int i = 0; i < N_IN; ++i) F.in[i] = args.in[i];
    for (int u = F.tid; u < (LDS_BYTES - LDSCTL_OFF) / 4; u += NWAVES * 64) ((LAS unsigned*)(F.lds + LDSCTL_OFF))[u] = 0u;
    __syncthreads();
    const int lo = args.ph_lo, hi = args.ph_hi;
    XcdBarrier bar; bar.bar = (unsigned*)(F.ctl + CW_BAR); bar.x = 0; bar.st = nullptr;
    if (hi - lo > 1) bar = xcd_barrier_post((unsigned*)(F.ctl + CW_BAR), F.MISC + 8);
#ifdef ONLY_PHASE
#define IN(k) ((k) == ONLY_PHASE && lo <= (k) && (k) < hi)
#else
#define IN(k) (lo <= (k) && (k) < hi)
#endif
#define SEAM(k) do { if ((k) + 1 < hi) xcd_barrier(bar); } while (0)
#define GEMM_SWIGLU(k, WOFF) if (IN(k)) { \
        pg8::Gemm g{WSP(bf16, WS_U), WSP(bf16, WOFF), M, NFF, D}; pg8::StaticOrder S; S.init(M, NFF, F.G, (int)blockIdx.x); \
        pg8::EpiSwiglu E{WSP(bf16, WS_H), FF}; \
        pg8::gemm_phase<pg8::EpiSwiglu, pg8::StaticOrder, true, true>(F.lds + RING_OFF, g, S, E); SEAM(k); }
#define GEMM_RESID(k, AOFF, WOFF, KK, XP, XS, GTK, GS) if (IN(k)) { \
        pg8::Gemm g{WSP(bf16, AOFF), WSP(bf16, WOFF), M, D, KK}; pg8::StaticOrder S; S.init(M, D, F.G, (int)blockIdx.x); \
        pg8::EpiResid E{XP, XS, args.out + O_Y, WSP(float, WS_MOD) + (GTK) * D, ALPHA, GS}; \
        pg8::gemm_phase<pg8::EpiResid, pg8::StaticOrder, true, true>(F.lds + RING_OFF, g, S, E); SEAM(k); }
    if (IN(0)) { p0_weights(F); __syncthreads(); p0_mod(F); SEAM(0); }
    if (IN(1)) { p_modulate0(F); SEAM(1); }
    GEMM_SWIGLU(2, WS_W1IN)
    GEMM_RESID(3, WS_H, WS_W1OUT, FF, args.in[I_XP], args.in[I_XS], 2, 0.5f)
    if (IN(4)) { p_layernorm(F, 0, 3 * D); SEAM(4); }
    if (IN(5)) {
        pg8::Gemm g{WSP(bf16, WS_U), WSP(bf16, WS_WIN), M, NIN, D}; pg8::StaticOrder S; S.init(M, NIN, F.G, (int)blockIdx.x);
        pg8::EpiBf16<0> E{WSP(bf16, WS_H), NIN, nullptr, 0, 0, 1.f};
        pg8::gemm_phase<pg8::EpiBf16<0>, pg8::StaticOrder, true, true>(F.lds + RING_OFF, g, S, E); SEAM(5); }
    if (IN(6)) { p_prep(F); SEAM(6); }
    if (IN(7)) { p_mixer(F); SEAM(7); }
    GEMM_RESID(8, WS_U, WS_WOUT, D, args.out + O_Y, args.out + O_Y + (size_t)MP * D, 5, 1.0f)
    if (IN(9)) { p_layernorm(F, 1, 6 * D); SEAM(9); }
    GEMM_SWIGLU(10, WS_W2IN)
    GEMM_RESID(11, WS_H, WS_W2OUT, FF, args.out + O_Y, args.out + O_Y + (size_t)MP * D, 8, 0.5f)
    if (IN(12)) { p_layernorm(F, 2, -1); }
}

extern "C" void kernel_launch(void* const* d_in, const int* in_sizes, int n_in, void* d_out, int out_size, void* d_ws, size_t ws_size, hipStream_t stream) {
    static int grid = 0;
    if (grid == 0) {
        if (n_in != N_IN || in_sizes[0] != MP * D || out_size != (int)O_END || ws_size < WS_END) { fprintf(stderr, "kernel_launch: unexpected shapes (n_in %d, out %d, ws %zu); nothing launched\n", n_in, out_size, ws_size); grid = -1; return; }
        int dev = 0, cus = 0;
        if (hipGetDevice(&dev) != hipSuccess || hipDeviceGetAttribute(&cus, hipDeviceAttributeMultiprocessorCount, dev) != hipSuccess) { grid = -1; return; }
        if (hipFuncSetAttribute((const void*)fwd_kernel, hipFuncAttributeMaxDynamicSharedMemorySize, LDS_BYTES) != hipSuccess) { fprintf(stderr, "kernel_launch: hipFuncSetAttribute failed\n"); grid = -1; return; }
        int per_cu = 0;
        if (hipOccupancyMaxActiveBlocksPerMultiprocessor(&per_cu, (const void*)fwd_kernel, NWAVES * 64, LDS_BYTES) != hipSuccess || per_cu < 1) fprintf(stderr, "kernel_launch: occupancy query reports %d\n", per_cu);
        (void)hipGetLastError();
        grid = cus;
    }
    if (grid < 0) return;
    if (hipMemsetAsync((char*)d_ws + WS_CTL, 0, CTL_ZERO_BYTES, stream) != hipSuccess) return;
    Args a{};
    for (int i = 0; i < N_IN; ++i) a.in[i] = (const float*)d_in[i];
    a.out = (float*)d_out; a.ws = (unsigned char*)d_ws;
#if MK_PER_PHASE
    for (int ph = 0; ph < N_PHASES; ++ph) { a.ph_lo = ph; a.ph_hi = ph + 1; hipLaunchKernelGGL(fwd_kernel, dim3(grid), dim3(NWAVES * 64), LDS_BYTES, stream, a); }
#else
    a.ph_lo = 0; a.ph_hi = N_PHASES;
    hipLaunchKernelGGL(fwd_kernel, dim3(grid), dim3(NWAVES * 64), LDS_BYTES, stream, a);
#endif
}
```

```cpp
#define MK_PER_PHASE 0
#include <hip/hip_runtime.h>
#include <cstdio>
#include <cstdint>
#include <cmath>
namespace pg8 {
#define PG8_LAS __attribute__((address_space(3)))
typedef unsigned short bf16_t;
typedef short bf16x8 __attribute__((ext_vector_type(8)));
typedef float f32x4 __attribute__((ext_vector_type(4)));
typedef unsigned u32x4 __attribute__((ext_vector_type(4)));
constexpr int BM = 256, BK = 64, HALF = 128, HTB = HALF * BK * 2  , STAGE_BYTES = 8 * HTB, NXCD = 8, WGM = 8;

__host__ __device__ __forceinline__ int lds_byte(int r, int c) { const int st = (r >> 4) * 2 + (c >> 5), rr = r & 15, cc = c & 31, ob = rr * 64 + cc * 2; return st * 1024 + (ob ^ (((ob >> 9) & 1) << 5)); }
__host__ __device__ __forceinline__ void stage_rc(int b, int& R, int& C) { const int st = b / 1024, sb = b % 1024, swz = sb ^ (((sb >> 9) & 1) << 5); R = (st >> 1) * 16 + swz / 64; C = (st & 1) * 32 + (swz % 64) / 2; }
__host__ __device__ __forceinline__ int perm32(int rho) { const int n = rho >> 4, i = rho & 15; return 8 * (i >> 2) + 4 * n + (i & 3); }

struct Unit { int pm, pn; };
struct Gemm { const bf16_t* A; const bf16_t* Bt; int M, N, K; };

struct StaticOrder {
    int nM, nN, nwg, G, c;
    __host__ __device__ void init(int M, int N, int G_, int c_) { nM = M / BM; nN = N / BM; nwg = nM * nN; G = G_; c = c_; }
    __host__ __device__ bool next(int i, Unit& u) const {
        const long L = (long)i * G + c; if (L >= nwg) return false;
        int wgid = (int)L; { const int q = nwg / NXCD, r = nwg % NXCD, xcd = wgid % NXCD, off = wgid / NXCD; wgid = (xcd < r ? xcd * (q + 1) : r * (q + 1) + (xcd - r) * q) + off; }
        const int nig = WGM * nN, gid = wgid / nig, fm = gid * WGM, gsz = (nM - fm) < WGM ? (nM - fm) : WGM;
        u.pm = fm + ((wgid % nig) % gsz); u.pn = (wgid % nig) / gsz; return true;
    }
    __device__ __forceinline__ void a_ready(const Unit&) const {}
    __device__ __forceinline__ void done(const Unit&) const {}
};

__device__ __forceinline__ unsigned cvt_pk_bf16(float lo, float hi) { unsigned r; asm volatile("v_cvt_pk_bf16_f32 %0, %1, %2" : "=v"(r) : "v"(lo), "v"(hi)); return r; }
template <int ACT  > struct EpiBf16 {
    static constexpr bool PERM = true, AFTER_DRAIN = false; static_assert(ACT == 0, "EpiBf16: ACT is 0 (none)");
    bf16_t* O; int ldc; const float* bias; int split_cols; size_t split_stride; float scale0;
    __device__ __forceinline__ void operator()(const f32x4 (&acc)[2][2][4][2], const Unit& u, int wr, int wc, int fr, int fq) const {
        const int row0 = u.pm * BM + wr * 64 + fr; int colt = u.pn * BM; bf16_t* base = O;
        float sc = 1.f; if (split_cols) { const int t = colt / split_cols; base += (size_t)t * split_stride; colt -= t * split_cols; if (t == 0) sc = scale0; }
        const int col0 = colt + wc * 32 + 8 * fq, bcol0 = u.pn * BM + wc * 32 + 8 * fq;
        f32x4 bv[2][2];
#pragma unroll
        for (int bj = 0; bj < 2; ++bj)
#pragma unroll
            for (int n = 0; n < 2; ++n) bv[bj][n] = bias ? *(const f32x4*)(bias + bcol0 + bj * HALF + 4 * n) : (f32x4){0.f, 0.f, 0.f, 0.f};
#pragma unroll
        for (int ai = 0; ai < 2; ++ai)
#pragma unroll
            for (int m = 0; m < 4; ++m) { bf16_t* rowp = base + (size_t)(row0 + ai * HALF + m * 16) * ldc + col0;
#pragma unroll
                for (int bj = 0; bj < 2; ++bj) { f32x4 v0 = acc[ai][bj][m][0] + bv[bj][0], v1 = acc[ai][bj][m][1] + bv[bj][1];
                    v0 = v0 * sc; v1 = v1 * sc; u32x4 w; w.x = cvt_pk_bf16(v0[0], v0[1]); w.y = cvt_pk_bf16(v0[2], v0[3]); w.z = cvt_pk_bf16(v1[0], v1[1]); w.w = cvt_pk_bf16(v1[2], v1[3]);
                    *(u32x4*)(rowp + bj * HALF) = w; } }
    }
};

template <class Epi, class Sched, bool ALIGN_EPI = false, bool SP2 = false>
__device__ __forceinline__ void gemm_phase(PG8_LAS unsigned char* lds, const Gemm g, const Sched& S, const Epi& E) {
    const int tid = threadIdx.x, wid = __builtin_amdgcn_readfirstlane(tid >> 6), lane = tid & 63, wr = wid >> 2, wc = wid & 3, fr = lane & 15, fq = lane >> 4;
    const int K = g.K, nt = K / BK;
    unsigned voffA[2], voffB[2];
#pragma unroll
    for (int i = 0; i < 2; ++i) { int R, C; stage_rc(tid * 16 + i * 8192, R, C); const int Rb = Epi::PERM ? ((R & ~31) + perm32(R & 31)) : R;
        voffA[i] = (unsigned)(R * K + C) * 2u; voffB[i] = (unsigned)(Rb * K + C) * 2u; }
    const size_t kstep = (size_t)(BK * 2);
    const size_t hstep = (size_t)HALF * K * 2;
    const size_t tstep = 2 * hstep;
    const unsigned ldsw = (unsigned)wid * 1024u;
    const int aoff = lds_byte(wr * 64 + fr, fq * 8), boff = lds_byte(wc * 32 + fr, fq * 8);
#define PG8_SA(b, h) (((b) * 2 + (h)) * HTB)
#define PG8_SB(b, h) ((4 + (b) * 2 + (h)) * HTB)
#define PG8_STAGE(bufoff, gbase, voff) do { _Pragma("unroll") for (int _i = 0; _i < 2; ++_i) \
        __builtin_amdgcn_global_load_lds((const unsigned*)((const char*)(gbase) + (voff)[_i]), (PG8_LAS unsigned*)(lds + (bufoff) + ldsw + _i * 8192), 16, 0, 0); } while (0)
#define PG8_LDA(dst, b, h) do { _Pragma("unroll") for (int m = 0; m < 4; ++m) _Pragma("unroll") for (int k = 0; k < 2; ++k) dst[m][k] = *(const PG8_LAS bf16x8*)(lds + PG8_SA(b, h) + aoff + m * 2048 + k * 1024); } while (0)
#define PG8_LDB(dst, b, h) do { _Pragma("unroll") for (int n = 0; n < 2; ++n) _Pragma("unroll") for (int k = 0; k < 2; ++k) dst[n][k] = *(const PG8_LAS bf16x8*)(lds + PG8_SB(b, h) + boff + n * 2048 + k * 1024); } while (0)
#define PG8_MMA(ai, bj, At, Bt) do { __builtin_amdgcn_s_setprio(1); _Pragma("unroll") for (int m = 0; m < 4; ++m) _Pragma("unroll") for (int n = 0; n < 2; ++n) _Pragma("unroll") for (int k = 0; k < 2; ++k) \
        acc[ai][bj][m][n] = __builtin_amdgcn_mfma_f32_16x16x32_bf16(Bt[n][k], At[m][k], acc[ai][bj][m][n], 0, 0, 0); __builtin_amdgcn_s_setprio(0); } while (0)
#define PG8_WAIT_V(n) asm volatile("s_waitcnt vmcnt(" #n ")" ::: "memory")
#define PG8_WAIT_L(n) asm volatile("s_waitcnt lgkmcnt(" #n ")" ::: "memory")
#define PG8_BAR __builtin_amdgcn_s_barrier()
#define PG8_SCHED __builtin_amdgcn_sched_barrier(0)
    Unit cur, nxt; int ui = 0;
    if (!S.next(0, cur)) return;
    f32x4 acc[2][2][4][2];
#pragma unroll
    for (int a = 0; a < 2; ++a)
#pragma unroll
        for (int b = 0; b < 2; ++b)
#pragma unroll
            for (int m = 0; m < 4; ++m)
#pragma unroll
                for (int n = 0; n < 2; ++n) acc[a][b][m][n] = (f32x4){0.f, 0.f, 0.f, 0.f};
    bf16x8 At[4][2], B0[2][2], B1[2][2];
    const char* cA = (const char*)g.A + (size_t)cur.pm * tstep; const char* cB = (const char*)g.Bt + (size_t)cur.pn * tstep;
    S.a_ready(cur);
    if constexpr (SP2) {
        PG8_STAGE(PG8_SB(0, 0), cB, voffB); PG8_STAGE(PG8_SB(0, 1), cB + hstep, voffB); PG8_STAGE(PG8_SA(0, 0), cA, voffA); PG8_STAGE(PG8_SA(0, 1), cA + hstep, voffA);
        if (wr == 1) PG8_BAR;
        PG8_WAIT_V(2); PG8_BAR;
        PG8_STAGE(PG8_SB(1, 0), cB + kstep, voffB); PG8_STAGE(PG8_SA(1, 0), cA + kstep, voffA); PG8_STAGE(PG8_SB(1, 1), cB + hstep + kstep, voffB);
        PG8_WAIT_V(6); PG8_BAR;
    } else {
        PG8_STAGE(PG8_SB(0, 0), cB, voffB); PG8_STAGE(PG8_SA(0, 0), cA, voffA); PG8_STAGE(PG8_SB(0, 1), cB + hstep, voffB); PG8_STAGE(PG8_SA(0, 1), cA + hstep, voffA);
        if (wr == 1) PG8_BAR;
        PG8_WAIT_V(4); PG8_BAR;
        PG8_STAGE(PG8_SB(1, 0), cB + kstep, voffB); PG8_STAGE(PG8_SA(1, 0), cA + kstep, voffA); PG8_STAGE(PG8_SB(1, 1), cB + hstep + kstep, voffB);
        PG8_WAIT_V(6); PG8_BAR;
    }
    for (;;) {
        const bool has_next = S.next(ui + 1, nxt);
        const char* nA = has_next ? (const char*)g.A + (size_t)nxt.pm * tstep : cA; const char* nB = has_next ? (const char*)g.Bt + (size_t)nxt.pn * tstep : cB;
        for (int t = 0; t < nt; t += 2) {
            const bool last = (t == nt - 2);
            const char* a1 = cA + (size_t)(t + 1) * kstep;
            const char* a2 = last ? nA : cA + (size_t)(t + 2) * kstep; const char* b2 = last ? nB : cB + (size_t)(t + 2) * kstep;
            const char* a3 = a2 + kstep; const char* b3 = b2 + kstep;
            if (last && has_next) S.a_ready(nxt);
            if constexpr (SP2) {
            PG8_LDB(B0, 0, 0); PG8_LDB(B1, 0, 1); PG8_SCHED; PG8_LDA(At, 0, 0); PG8_STAGE(PG8_SA(1, 1), a1 + hstep, voffA);
            PG8_WAIT_V(8); PG8_WAIT_L(0); PG8_BAR; PG8_MMA(0, 0, At, B0); PG8_MMA(0, 1, At, B1); PG8_BAR; PG8_SCHED;
            PG8_LDA(At, 0, 1); PG8_STAGE(PG8_SB(0, 0), b2, voffB); PG8_STAGE(PG8_SB(0, 1), b2 + hstep, voffB); PG8_STAGE(PG8_SA(0, 0), a2, voffA);
            PG8_WAIT_V(8); PG8_WAIT_L(0); PG8_BAR; PG8_MMA(1, 0, At, B0); PG8_MMA(1, 1, At, B1); PG8_BAR; PG8_SCHED;
            PG8_LDB(B0, 1, 0); PG8_LDB(B1, 1, 1); PG8_SCHED; PG8_LDA(At, 1, 0); PG8_STAGE(PG8_SA(0, 1), a2 + hstep, voffA);
            PG8_WAIT_V(8); PG8_WAIT_L(0); PG8_BAR; PG8_MMA(0, 0, At, B0); PG8_MMA(0, 1, At, B1); PG8_BAR; PG8_SCHED;
            PG8_LDA(At, 1, 1); PG8_STAGE(PG8_SB(1, 0), b3, voffB); PG8_STAGE(PG8_SB(1, 1), b3 + hstep, voffB); PG8_STAGE(PG8_SA(1, 0), a3, voffA);
            PG8_WAIT_V(8); PG8_WAIT_L(0); PG8_BAR; PG8_MMA(1, 0, At, B0); PG8_MMA(1, 1, At, B1); PG8_BAR; PG8_SCHED;
            } else {
            PG8_LDB(B0, 0, 0); PG8_SCHED; PG8_LDA(At, 0, 0); PG8_STAGE(PG8_SA(1, 1), a1 + hstep, voffA);
            PG8_WAIT_L(8); PG8_BAR; PG8_WAIT_L(0); PG8_MMA(0, 0, At, B0); PG8_BAR; PG8_SCHED;
            PG8_LDB(B1, 0, 1); PG8_STAGE(PG8_SB(0, 0), b2, voffB);
            PG8_BAR; PG8_WAIT_L(0); PG8_MMA(0, 1, At, B1); PG8_BAR;
            PG8_LDA(At, 0, 1); PG8_STAGE(PG8_SA(0, 0), a2, voffA);
            PG8_BAR; PG8_WAIT_L(0); PG8_MMA(1, 0, At, B0); PG8_BAR; PG8_SCHED;
            PG8_STAGE(PG8_SB(0, 1), b2 + hstep, voffB);
            PG8_WAIT_V(6); PG8_BAR; PG8_MMA(1, 1, At, B1); PG8_BAR;
            PG8_LDB(B0, 1, 0); PG8_SCHED; PG8_LDA(At, 1, 0); PG8_STAGE(PG8_SA(0, 1), a2 + hstep, voffA);
            PG8_WAIT_L(8); PG8_BAR; PG8_WAIT_L(0); PG8_MMA(0, 0, At, B0); PG8_BAR; PG8_SCHED;
            PG8_LDB(B1, 1, 1); PG8_STAGE(PG8_SB(1, 0), b3, voffB);
            PG8_BAR; PG8_WAIT_L(0); PG8_MMA(0, 1, At, B1); PG8_BAR;
            PG8_LDA(At, 1, 1); PG8_STAGE(PG8_SA(1, 0), a3, voffA);
            PG8_BAR; PG8_WAIT_L(0); PG8_MMA(1, 0, At, B0); PG8_BAR; PG8_SCHED;
            PG8_STAGE(PG8_SB(1, 1), b3 + hstep, voffB);
            PG8_WAIT_V(6); PG8_BAR; PG8_MMA(1, 1, At, B1); PG8_BAR;
            }
        }
        if constexpr (ALIGN_EPI) { if (wr == 0) PG8_BAR; }
        if constexpr (!Epi::AFTER_DRAIN) { E(acc, cur, wr, wc, fr, fq); S.done(cur); }
        if (!has_next) break;
#pragma unroll
        for (int a = 0; a < 2; ++a)
#pragma unroll
            for (int b = 0; b < 2; ++b)
#pragma unroll
                for (int m = 0; m < 4; ++m)
#pragma unroll
                    for (int n = 0; n < 2; ++n) acc[a][b][m][n] = (f32x4){0.f, 0.f, 0.f, 0.f};
        cur = nxt; cA = nA; cB = nB; ++ui;
        if constexpr (ALIGN_EPI) { if (wr == 1) PG8_BAR; }
    }
    PG8_WAIT_V(0);
    if constexpr (!ALIGN_EPI) { if (wr == 0) PG8_BAR; }
    PG8_BAR;
    if constexpr (Epi::AFTER_DRAIN) { E.fused(acc, cur, wr, wc, fr, fq, lds, wid, lane); S.done(cur); }
#undef PG8_SA
#undef PG8_SB
#undef PG8_STAGE
#undef PG8_LDA
#undef PG8_LDB
#undef PG8_MMA
#undef PG8_WAIT_V
#undef PG8_WAIT_L
#undef PG8_BAR
#undef PG8_SCHED
}
struct EpiSwiglu {
    static constexpr bool PERM = true, AFTER_DRAIN = false;
    bf16_t* H; int ldh;
    __device__ __forceinline__ void operator()(const f32x4 (&acc)[2][2][4][2], const Unit& u, int wr, int wc, int fr, int fq) const {
        const int row0 = u.pm * BM + wr * 64 + fr, col0 = u.pn * HALF + wc * 32 + 8 * fq;
#pragma unroll
        for (int ai = 0; ai < 2; ++ai)
#pragma unroll
            for (int m = 0; m < 4; ++m) {
                bf16_t* p = H + (size_t)(row0 + ai * HALF + m * 16) * ldh + col0;
                float h[8];
#pragma unroll
                for (int n = 0; n < 2; ++n)
#pragma unroll
                    for (int i = 0; i < 4; ++i) { const float g = acc[ai][0][m][n][i], up = acc[ai][1][m][n][i];
                        h[n * 4 + i] = g * __builtin_amdgcn_rcpf(1.0f + __expf(-g)) * up; }
                u32x4 w; w.x = cvt_pk_bf16(h[0], h[1]); w.y = cvt_pk_bf16(h[2], h[3]); w.z = cvt_pk_bf16(h[4], h[5]); w.w = cvt_pk_bf16(h[6], h[7]);
                *(u32x4*)p = w;
            }
    }
};
struct EpiResid {
    static constexpr bool PERM = false, AFTER_DRAIN = false;
    const float* xp; const float* xs; float* X; const float* gt; float alpha, gs;
    __device__ __forceinline__ void operator()(const f32x4 (&acc)[2][2][4][2], const Unit& u, int wr, int wc, int fr, int fq) const {
        const int col0 = u.pn * BM + wc * 32 + 4 * fq;
#pragma unroll
        for (int ai = 0; ai < 2; ++ai)
#pragma unroll
            for (int m = 0; m < 4; ++m) {
                const int row = u.pm * BM + ai * HALF + wr * 64 + m * 16 + fr;
                const bool smp = row >= 16384;
                const float* xr = smp ? xs + (size_t)(row - 16384) * 1024 : xp + (size_t)row * 1024;
                const int b = smp ? 2 + ((row - 16384) >> 3) : (row >> 13);
                const float* gr = gt + (size_t)b * 9216;
                float* xo = X + (size_t)row * 1024;
#pragma unroll
                for (int bj = 0; bj < 2; ++bj)
#pragma unroll
                    for (int n = 0; n < 2; ++n) { const int c = col0 + bj * HALF + n * 16;
                        const f32x4 xv = *(const f32x4*)(xr + c), gv = *(const f32x4*)(gr + c);
                        const f32x4 z = xv * alpha + (gv + 1.0f) * gs * acc[ai][bj][m][n];
                        *(f32x4*)(xo + c) = z; }
            }
    }
};
}
#define GAS __attribute__((address_space(1)))
#define LAS __attribute__((address_space(3)))
typedef unsigned short bf16;
typedef unsigned v4u __attribute__((ext_vector_type(4)));
typedef float f32x4 __attribute__((ext_vector_type(4)));
typedef short bf16x8 __attribute__((ext_vector_type(8)));
typedef GAS unsigned gu32;
typedef GAS unsigned long long gu64;
#define RLX_AGENT __ATOMIC_RELAXED, __HIP_MEMORY_SCOPE_AGENT
#define LDS_WAIT() asm volatile("s_waitcnt lgkmcnt(0)" ::: "memory")
#define VM_WAIT() asm volatile("s_waitcnt vmcnt(0)" ::: "memory")
__device__ __forceinline__ unsigned long long rt() { return __builtin_amdgcn_s_memrealtime(); }
__device__ __forceinline__ unsigned f2bf(float f) { unsigned u = __builtin_bit_cast(unsigned, f); return (u + 0x7fffu + ((u >> 16) & 1u)) >> 16; }
__device__ __forceinline__ unsigned pk2(float lo, float hi) { return f2bf(lo) | (f2bf(hi) << 16); }

#define XB_TMO      128
#define XB_XCNT(j)  (256  + 64 * (j))
#define XB_XSUB(j)  (1280 + 64 * (j))
#define XB_XGEN(j)  (2304 + 64 * (j))
#define XB_TOP      3328
#define XB_TOPGEN   3392
#define XCD_BAR_WORDS 3456
#define XB_SPIN_CAP (1u << 18)

__device__ __forceinline__ unsigned xb_ld(unsigned* p)              { return __hip_atomic_load(p, __ATOMIC_RELAXED, __HIP_MEMORY_SCOPE_AGENT); }
__device__ __forceinline__ unsigned xb_add(unsigned* p, unsigned v) { return __hip_atomic_fetch_add(p, v, __ATOMIC_RELAXED, __HIP_MEMORY_SCOPE_AGENT); }
__device__ __forceinline__ unsigned xb_xcc_id() { return (unsigned)__builtin_amdgcn_s_getreg((3 << 11) | 20) & 0xFu; }
#define XB_SPIN(cond, bar) do { unsigned _sp = 0; while (cond) { __builtin_amdgcn_s_sleep(1); \
    if ((++_sp & 255u) == 0u) { if (xb_ld(&(bar)[XB_TMO])) break; if (_sp > XB_SPIN_CAP) { atomicAdd(&(bar)[XB_TMO], 1u); break; } } } } while (0)

struct XcdBarrier {
    unsigned* bar; unsigned x;
    volatile LAS unsigned* st;
};

__device__ __forceinline__ XcdBarrier xcd_barrier_post(unsigned* bar, volatile LAS unsigned* st) {
    XcdBarrier b; b.bar = bar; b.x = xb_xcc_id(); b.st = st;
    if (threadIdx.x == 0) (void)xb_add(&bar[XB_XCNT(b.x)], 1u);
    return b;
}
__device__ __forceinline__ void xcd_barrier_complete(unsigned* bar, unsigned x, unsigned& nloc, unsigned& nx) {
    const unsigned G = gridDim.x * gridDim.y * gridDim.z;
    unsigned sum, cnt, mine, sp = 0u;
    for (;;) {
        sum = 0u; cnt = 0u; mine = 0u;
#pragma unroll
        for (unsigned j = 0; j < 16; ++j) { const unsigned c = xb_ld(&bar[XB_XCNT(j)]); sum += c; cnt += (c > 0u) ? 1u : 0u; mine = (j == x) ? c : mine; }
        if (sum == G) break;
        __builtin_amdgcn_s_sleep(1);
        if ((++sp & 255u) == 0u) { if (xb_ld(&bar[XB_TMO])) break; if (sp > XB_SPIN_CAP) { atomicAdd(&bar[XB_TMO], 1u); break; } }
    }
    nloc = mine > 0u ? mine : 1u; nx = cnt > 0u ? cnt : 1u;
}

__device__ __forceinline__ void xcd_barrier(const XcdBarrier& b) {
    asm volatile("s_waitcnt vmcnt(0)" ::: "memory");
    __syncthreads();
    if (threadIdx.x == 0) {
        unsigned* bar = b.bar;
        __builtin_amdgcn_s_waitcnt(0);
        unsigned nloc = b.st[0], nx = b.st[1];
        if (nloc == 0u) { xcd_barrier_complete(bar, b.x, nloc, nx); b.st[0] = nloc; b.st[1] = nx; }
        const unsigned old = xb_add(&bar[XB_XSUB(b.x)], 1u);
        const unsigned gen = old / nloc;
        if (old + 1u == (gen + 1u) * nloc) {
            __builtin_amdgcn_fence(__ATOMIC_RELEASE, "agent");
            asm volatile("s_waitcnt vmcnt(0)" ::: "memory");
            const unsigned og = xb_add(&bar[XB_TOP], 1u);
            const unsigned tg = og / nx;
            if (og + 1u == (tg + 1u) * nx) xb_add(&bar[XB_TOPGEN], 1u);
            else XB_SPIN(xb_ld(&bar[XB_TOPGEN]) == tg, bar);
            __builtin_amdgcn_fence(__ATOMIC_ACQUIRE, "agent");
            xb_add(&bar[XB_XGEN(b.x)], 1u);
            asm volatile("s_waitcnt vmcnt(0)" ::: "memory");
        } else {
            XB_SPIN(xb_ld(&bar[XB_XGEN(b.x)]) == gen, bar);
            __builtin_amdgcn_fence(__ATOMIC_ACQUIRE, "agent");
            asm volatile("s_waitcnt vmcnt(0)" ::: "memory");
        }
    }
    __syncthreads();
}

constexpr int D = 1024, FF = 2816, NFF = 2 * FF, NIN = 2560, RW = 512, RWP = 1792;
constexpr int MP = 16384, MS = 1024, M = MP + MS, TP = 8192, TS = 8, NBS = 128;
constexpr int MODW = 9216, NMOD = 130;
constexpr float ALPHA = 1.189207115002721f;
constexpr float LN_EPS = 1e-5f, GN_EPS = 64e-5f;
constexpr int NWAVES = 8;
enum { I_XP = 0, I_XS, I_SWKV, I_SSHIFT, I_CK, I_CV, I_CP, I_CS, I_RELB, I_WADA, I_BADA, I_LNG, I_LNB, I_W1IN, I_W1OUT, I_WIN, I_MU, I_W0, I_WDEC, I_A0, I_WICLR, I_WGATE,
       I_KK, I_KA, I_RK, I_GNW, I_GNB, I_SINKS, I_WOUT, I_W2IN, I_W2OUT, N_IN };
constexpr size_t O_Y = 0, O_WKV_P = (size_t)M * D, O_SHIFT_P = O_WKV_P + 65536, O_WINK_P = O_SHIFT_P + 3584, O_WINV_P = O_WINK_P + 32768,
                 O_WKV_S = O_WINV_P + 32768, O_SHIFT_S = O_WKV_S + 4194304, O_WINK_S = O_SHIFT_S + 229376, O_WINV_S = O_WINK_S + 2097152, O_END = O_WINV_S + 2097152;
static_assert(O_END == 26578432, "d_out size");
constexpr size_t MiB = 1u << 20;
constexpr size_t WS_CTL = 0, CTL_ZERO_BYTES = 1 * MiB;
constexpr size_t WS_W1IN = 2 * MiB, WS_W1OUT = 13 * MiB, WS_WIN = 19 * MiB, WS_WOUT = 24 * MiB, WS_W2IN = 26 * MiB, WS_W2OUT = 37 * MiB;
constexpr size_t WS_MOD = 43 * MiB;
constexpr size_t WS_U = 48 * MiB;
constexpr size_t WS_H = 82 * MiB;
constexpr size_t WS_WLOG = 176 * MiB, WS_A = 210 * MiB, WS_G = 227 * MiB, WS_INV = 244 * MiB, WS_END = 245 * MiB;
static_assert(WS_W1IN + (size_t)NFF * D * 2 <= WS_W1OUT && WS_W1OUT + (size_t)D * FF * 2 <= WS_WIN && WS_WIN + (size_t)NIN * D * 2 <= WS_WOUT && WS_WOUT + (size_t)D * D * 2 <= WS_W2IN &&
              WS_W2IN + (size_t)NFF * D * 2 <= WS_W2OUT && WS_W2OUT + (size_t)D * FF * 2 <= WS_MOD && WS_MOD + (size_t)NMOD * MODW * 4 <= WS_U && WS_U + (size_t)M * D * 2 <= WS_H &&
              WS_H + (size_t)M * FF * 2 <= WS_WLOG && WS_WLOG + (size_t)M * RW * 4 <= WS_A && WS_A + (size_t)M * RW * 2 <= WS_G && WS_G + (size_t)M * RW * 2 <= WS_INV &&
              WS_INV + (size_t)M * 8 * 4 <= WS_END && WS_END <= 256 * MiB, "d_ws map");
constexpr int CW_BAR = 4096;
constexpr int RING_OFF = 0, RING_BYTES = 151552;
constexpr int LDSCTL_OFF = RING_BYTES, MISC_OFF = LDSCTL_OFF + 320;
constexpr int LDS_BYTES = 155648;
static_assert(MISC_OFF + 128 <= LDS_BYTES, "LDS map");

__device__ __forceinline__ float bf2f(unsigned short h) { return __uint_as_float((unsigned)h << 16); }
__device__ __forceinline__ float bflo(unsigned u) { return __uint_as_float(u << 16); }
__device__ __forceinline__ float bfhi(unsigned u) { return __uint_as_float(u & 0xffff0000u); }
__device__ __forceinline__ float wave_sum(float v) {
#pragma unroll
    for (int o = 1; o < 64; o <<= 1) v += __shfl_xor(v, o);
    return v;
}
template <int CTRL> __device__ __forceinline__ float dppf(float x) { return __builtin_bit_cast(float, __builtin_amdgcn_update_dpp(0, __builtin_bit_cast(int, x), CTRL, 0xf, 0xf, true)); }
__device__ __forceinline__ float sum8(float x) {
    x += dppf<0xB1>(x);
    x += dppf<0x4E>(x);
    x += dppf<0x141>(x);
    return x;
}
__device__ __forceinline__ float sigmoidf_(float x) { return 1.0f / (1.0f + expf(-x)); }

struct Args { const float* in[N_IN]; float* out; unsigned char* ws; int ph_lo, ph_hi; };
static_assert(sizeof(Args) == N_IN * 8 + 24, "Args has no padding");
struct Frame {
    LAS unsigned char* lds;
    volatile LAS unsigned* MISC;
    gu32* ctl;
    int tid, lane, wave, vcu, G;
    const Args* a;
};
#define WSP(T, off) ((T*)(F.a->ws + (off)))

__device__ __forceinline__ void p0_transpose_item(const float* W, int K, int N, bf16* WT, int dst_row0, int k0, int n0, LAS float* scr, int lane) {
#pragma unroll 8
    for (int i = 0; i < 32; ++i) { const int kk = 2 * i + (lane >> 5); scr[kk * 33 + (lane & 31)] = W[(size_t)(k0 + kk) * N + n0 + (lane & 31)]; }
    LDS_WAIT(); asm volatile("" ::: "memory");
    const int c = lane & 7;
#pragma unroll
    for (int j = 0; j < 4; ++j) { const int n = (lane >> 3) + 8 * j; const LAS float* s = scr + (8 * c) * 33 + n;
        v4u o; o.x = pk2(s[0 * 33], s[1 * 33]); o.y = pk2(s[2 * 33], s[3 * 33]); o.z = pk2(s[4 * 33], s[5 * 33]); o.w = pk2(s[6 * 33], s[7 * 33]);
        *(GAS v4u*)(WT + (size_t)(dst_row0 + n) * K + k0 + 8 * c) = o; }
    LDS_WAIT(); asm volatile("" ::: "memory");
}
__device__ __forceinline__ void p0_ffin_item(const float* W, bf16* WT, int r, LAS float* scr, int lane) {
    const int kb = r / 176, nb = r % 176, n0 = 32 * nb; const bool up = n0 >= FF; const int j = up ? n0 - FF : n0;
    p0_transpose_item(W, D, NFF, WT, (j >> 7) * 256 + (up ? 128 : 0) + (j & 127), 64 * kb, n0, scr, lane);
}
__device__ __forceinline__ void p0_plain_item(const float* W, int K, int N, bf16* WT, int r, LAS float* scr, int lane) {
    const int nblk = N / 32, kb = r / nblk, nb = r % nblk;
    p0_transpose_item(W, K, N, WT, 32 * nb, 64 * kb, 32 * nb, scr, lane);
}
__device__ __forceinline__ void p0_weights(Frame& F) {
    LAS float* scr = (LAS float*)(F.lds + RING_OFF + F.wave * 16384);
    const int gw = F.vcu * NWAVES + F.wave, NGW = F.G * NWAVES;
    constexpr int I_FI = 16 * 176, I_FO = 44 * 32, I_IN = 16 * 80, I_O = 16 * 32, NITEMS = 2 * I_FI + 2 * I_FO + I_IN + I_O;
    for (int it = gw; it < NITEMS; it += NGW) {
        int r = it;
        if (r < I_FI) { p0_ffin_item(F.a->in[I_W1IN], WSP(bf16, WS_W1IN), r, scr, F.lane); continue; } r -= I_FI;
        if (r < I_FI) { p0_ffin_item(F.a->in[I_W2IN], WSP(bf16, WS_W2IN), r, scr, F.lane); continue; } r -= I_FI;
        if (r < I_FO) { p0_plain_item(F.a->in[I_W1OUT], FF, D, WSP(bf16, WS_W1OUT), r, scr, F.lane); continue; } r -= I_FO;
        if (r < I_FO) { p0_plain_item(F.a->in[I_W2OUT], FF, D, WSP(bf16, WS_W2OUT), r, scr, F.lane); continue; } r -= I_FO;
        if (r < I_IN) { p0_plain_item(F.a->in[I_WIN], D, NIN, WSP(bf16, WS_WIN), r, scr, F.lane); continue; } r -= I_IN;
        p0_plain_item(F.a->in[I_WOUT], D, D, WSP(bf16, WS_WOUT), r, scr, F.lane);
    }
}
__device__ __forceinline__ void p0_mod(Frame& F) {
    constexpr int SCP = 172;
    LAS float* sc = (LAS float*)(F.lds);
    LAS float* red = (LAS float*)(F.lds + 64 * SCP * 4);
    const float* wada = F.a->in[I_WADA]; const float* bada = F.a->in[I_BADA]; const float* cp = F.a->in[I_CP]; const float* cs = F.a->in[I_CS];
    float* mod = WSP(float, WS_MOD);
    const int tid = F.tid; const bool act = tid < 504; const int q = act ? tid / 126 : 3, r = act ? tid % 126 : 125, g = r / 9, cg = r % 9;
    for (int task = blockIdx.x; task < MODW / 36; task += F.G) {
        const int j0 = 36 * task + 4 * cg;
        float acc[10][4];
#pragma unroll
        for (int s = 0; s < 10; ++s)
#pragma unroll
            for (int jj = 0; jj < 4; ++jj) acc[s][jj] = 0.f;
        for (int ch = 0; ch < 16; ++ch) {
            __syncthreads();
            for (int idx = tid; idx < 64 * NMOD; idx += 512) {
                const int b = idx >> 6, e = idx & 63, i = 256 * (e >> 4) + 16 * ch + (e & 15);
                const float c = b < 2 ? cp[b * D + i] : cs[(b - 2) * D + i];
                sc[e * SCP + (b % 14) * 12 + b / 14] = c / (1.0f + expf(-c));
            }
            __syncthreads();
            if (act) {
#pragma unroll 4
                for (int ii = 0; ii < 16; ++ii) {
                    const int i = 256 * q + 16 * ch + ii;
                    const f32x4 w = *(const f32x4*)(wada + (size_t)i * MODW + j0);
                    const LAS f32x4* sp = (const LAS f32x4*)(sc + (q * 16 + ii) * SCP + g * 12);
                    const f32x4 s0 = sp[0], s1 = sp[1], s2 = sp[2];
                    const float sv[10] = {s0[0], s0[1], s0[2], s0[3], s1[0], s1[1], s1[2], s1[3], s2[0], s2[1]};
#pragma unroll
                    for (int s = 0; s < 10; ++s)
#pragma unroll
                        for (int jj = 0; jj < 4; ++jj) acc[s][jj] += sv[s] * w[jj];
                }
            }
        }
        __syncthreads();
        if (act && q > 0) {
#pragma unroll
            for (int s = 0; s < 10; ++s)
#pragma unroll
                for (int jj = 0; jj < 4; ++jj) red[((q - 1) * 40 + s * 4 + jj) * 126 + r] = acc[s][jj];
        }
        __syncthreads();
        if (act && q == 0) {
            const f32x4 bb = *(const f32x4*)(bada + j0);
#pragma unroll
            for (int s = 0; s < 10; ++s) { const int b = g + 14 * s;
                if (b < NMOD) { f32x4 o;
#pragma unroll
                    for (int jj = 0; jj < 4; ++jj) { const int k = s * 4 + jj; o[jj] = acc[s][jj] + red[(0 * 40 + k) * 126 + r] + red[(1 * 40 + k) * 126 + r] + red[(2 * 40 + k) * 126 + r] + bb[jj]; }
                    *(f32x4*)(mod + (size_t)b * MODW + j0) = o; } }
        }
    }
    __syncthreads();
}

__device__ __forceinline__ int mod_row_of(int m) { return m < MP ? (m >> 13) : 2 + ((m - MP) >> 3); }
__device__ __forceinline__ void p_modulate0(Frame& F) {
    const int gw = F.vcu * NWAVES + F.wave, NGW = F.G * NWAVES;
    const float* mod = WSP(float, WS_MOD); bf16* U = WSP(bf16, WS_U);
    for (int m = gw; m < M; m += NGW) {
        const float* xr = m < MP ? F.a->in[I_XP] + (size_t)m * D : F.a->in[I_XS] + (size_t)(m - MP) * D;
        const float* mr = mod + (size_t)mod_row_of(m) * MODW;
        unsigned long long* o8 = (unsigned long long*)(U + (size_t)m * D) + F.lane;
#pragma unroll
        for (int j = 0; j < 4; ++j) { const int c = 4 * F.lane + 256 * j;
            const f32x4 x = *(const f32x4*)(xr + c), sh = *(const f32x4*)(mr + c), sc = *(const f32x4*)(mr + D + c);
            const f32x4 u = x * (sc + 1.0f) + sh;
            o8[64 * j] = (unsigned long long)pk2(u[0], u[1]) | ((unsigned long long)pk2(u[2], u[3]) << 32); }
    }
}
__device__ __forceinline__ void p_layernorm(Frame& F, int lnidx, int koff) {
    const int gw = F.vcu * NWAVES + F.wave, NGW = F.G * NWAVES;
    const float* mod = WSP(float, WS_MOD); bf16* U = WSP(bf16, WS_U); float* X = F.a->out + O_Y;
    const float* lg = F.a->in[I_LNG] + lnidx * D; const float* lb = F.a->in[I_LNB] + lnidx * D;
    for (int m = gw; m < M; m += NGW) {
        float* xr = X + (size_t)m * D;
        f32x4 v[4]; float s = 0.f;
#pragma unroll
        for (int j = 0; j < 4; ++j) { v[j] = *(const f32x4*)(xr + 4 * F.lane + 256 * j); s += (v[j][0] + v[j][1]) + (v[j][2] + v[j][3]); }
        const float mean = wave_sum(s) * (1.f / D); float s2 = 0.f;
#pragma unroll
        for (int j = 0; j < 4; ++j) { v[j] = v[j] - mean; s2 += (v[j][0] * v[j][0] + v[j][1] * v[j][1]) + (v[j][2] * v[j][2] + v[j][3] * v[j][3]); }
        const float rstd = 1.f / sqrtf(wave_sum(s2) * (1.f / D) + LN_EPS);
        const float* mr = mod + (size_t)mod_row_of(m) * MODW + (koff >= 0 ? koff : 0);
        unsigned long long* o8 = (unsigned long long*)(U + (size_t)m * D) + F.lane;
#pragma unroll
        for (int j = 0; j < 4; ++j) { const int c = 4 * F.lane + 256 * j;
            const f32x4 x = v[j] * rstd * *(const f32x4*)(lg + c) + *(const f32x4*)(lb + c);
            *(f32x4*)(xr + c) = x;
            if (koff >= 0) { const f32x4 sh = *(const f32x4*)(mr + c), sc = *(const f32x4*)(mr + D + c); const f32x4 u = x * (sc + 1.0f) + sh;
                o8[64 * j] = (unsigned long long)pk2(u[0], u[1]) | ((unsigned long long)pk2(u[2], u[3]) << 32); } }
    }
}
__device__ __forceinline__ float prev_val(const bf16* P, const float* sshift, int m, int col) {
    if (m < MP) return (m & (TP - 1)) == 0 ? 0.f : bf2f(P[(size_t)(m - 1) * NIN + col]);
    const int ms = m - MP;
    return (ms & (TS - 1)) == 0 ? sshift[(size_t)(ms >> 3) * RWP + col] : bf2f(P[(size_t)(m - 1) * NIN + col]);
}
__device__ __forceinline__ void p_prep(Frame& F) {
    LAS float* L = (LAS float*)F.lds;
    const bf16* P = WSP(bf16, WS_H); const float* sshift = F.a->in[I_SSHIFT]; const float* mu = F.a->in[I_MU];
    const float* wdec = F.a->in[I_WDEC]; const float* wiclr = F.a->in[I_WICLR]; const float* wgate = F.a->in[I_WGATE];
    float* WLOG = WSP(float, WS_WLOG); bf16* AA = WSP(bf16, WS_A); bf16* GG = WSP(bf16, WS_G); float* INV = WSP(float, WS_INV);
    const int c = F.tid;
    const float w0c = F.a->in[I_W0][c], a0c = F.a->in[I_A0][c], kkc = F.a->in[I_KK][c], muk = mu[RW + c];
    for (int tb = F.vcu; tb < M / 16; tb += F.G) {
        const int m0 = tb * 16;
        __syncthreads();
#pragma unroll
        for (int k = 0; k < 8; ++k) { const int idx = F.tid + 512 * k, i = idx & 15, j = idx >> 4, m = m0 + i, col = 1536 + j;
            const float p = bf2f(P[(size_t)m * NIN + col]), pv = prev_val(P, sshift, m, col), xs = p + (pv - p) * mu[col];
            L[j * 16 + i] = j < 64 ? tanhf(xs) : (j < 128 ? xs : sigmoidf_(xs)); }
        __syncthreads();
        float aw[16], aa[16], ag[16];
#pragma unroll
        for (int i = 0; i < 16; ++i) { aw[i] = 0.f; aa[i] = 0.f; ag[i] = 0.f; }
#pragma unroll 2
        for (int j = 0; j < 64; ++j) {
            const float wd = wdec[j * RW + c], wi = wiclr[j * RW + c];
            const LAS f32x4* lw = (const LAS f32x4*)(L + j * 16); const LAS f32x4* la = (const LAS f32x4*)(L + (64 + j) * 16);
#pragma unroll
            for (int qq = 0; qq < 4; ++qq) { const f32x4 tw = lw[qq], ta = la[qq];
#pragma unroll
                for (int e = 0; e < 4; ++e) { aw[qq * 4 + e] += wd * tw[e]; aa[qq * 4 + e] += wi * ta[e]; } }
        }
#pragma unroll 2
        for (int j = 0; j < 128; ++j) {
            const float wg = wgate[j * RW + c];
            const LAS f32x4* lg = (const LAS f32x4*)(L + (128 + j) * 16);
#pragma unroll
            for (int qq = 0; qq < 4; ++qq) { const f32x4 tg = lg[qq];
#pragma unroll
                for (int e = 0; e < 4; ++e) ag[qq * 4 + e] += wg * tg[e]; }
        }
#pragma unroll
        for (int i = 0; i < 16; ++i) { const int m = m0 + i;
            const float z = w0c + aw[i];
            const float sp = fmaxf(-z, 0.f) + log1pf(expf(-fabsf(z)));
            WLOG[(size_t)m * RW + c] = -expf(-sp - 0.5f);
            AA[(size_t)m * RW + c] = (bf16)f2bf(sigmoidf_(a0c + aa[i]));
            GG[(size_t)m * RW + c] = (bf16)f2bf(ag[i]);
            const float pk = bf2f(P[(size_t)m * NIN + RW + c]), pvk = prev_val(P, sshift, m, RW + c), xk = pk + (pvk - pk) * muk, kq = xk * kkc;
            const float ss = wave_sum(kq * kq);
            if (F.lane == 0) INV[(size_t)m * 8 + F.wave] = 1.0f / fmaxf(sqrtf(ss), 1e-12f);
        }
    }
    const int gt = F.vcu * 512 + F.tid, NT = F.G * 512;
    const float* ck = F.a->in[I_CK]; const float* cv = F.a->in[I_CV];
    for (int i = gt; i < 2 * RWP; i += NT) { const int b = i / RWP, col = i % RWP; F.a->out[O_SHIFT_P + i] = bf2f(P[(size_t)(b * TP + TP - 1) * NIN + col]); }
    for (int i = gt; i < NBS * RWP; i += NT) { const int b = i / RWP, col = i % RWP; F.a->out[O_SHIFT_S + i] = bf2f(P[(size_t)(MP + b * TS + TS - 1) * NIN + col]); }
    for (int i = gt; i < 2 * 128 * 128; i += NT) { const int b = i >> 14, j = (i >> 7) & 127, c2 = i & 127; const size_t row = (size_t)(b * TP + TP - 128 + j) * NIN;
        F.a->out[O_WINK_P + i] = bf2f(P[row + 2304 + c2]); F.a->out[O_WINV_P + i] = bf2f(P[row + 2432 + c2]); }
    for (int i = gt; i < NBS * 128 * 128; i += NT) { const int b = i >> 14, j = (i >> 7) & 127, c2 = i & 127;
        if (j < 120) { F.a->out[O_WINK_S + i] = ck[(size_t)(b * 128 + j + 8) * 128 + c2]; F.a->out[O_WINV_S + i] = cv[(size_t)(b * 128 + j + 8) * 128 + c2]; }
        else { const size_t row = (size_t)(MP + b * TS + (j - 120)) * NIN; F.a->out[O_WINK_S + i] = bf2f(P[row + 2304 + c2]); F.a->out[O_WINV_S + i] = bf2f(P[row + 2432 + c2]); } }
}

constexpr int SC_R = 0, SC_DEC = 1, SC_KM = 2, SC_KK = 3, SC_BB = 4, SC_V = 5, SC_Y = 6;
__device__ __forceinline__ void scan_unit(Frame& F, int row0, int T, int h, const float* s_in, float* s_out) {
    LAS float* A = (LAS float*)F.lds;
    const bf16* P = WSP(bf16, WS_H); const float* sshift = F.a->in[I_SSHIFT]; const float* mu = F.a->in[I_MU];
    const float* WLOG = WSP(float, WS_WLOG); const bf16* AA = WSP(bf16, WS_A); const bf16* GG = WSP(bf16, WS_G); const float* INV = WSP(float, WS_INV);
    bf16* MIX = WSP(bf16, WS_U);
    const int lane = F.lane, wave = F.wave, rl = lane >> 3, ks = lane & 7, row = 8 * wave + rl;
    float S[8];
#pragma unroll
    for (int j = 0; j < 8; ++j) S[j] = s_in ? s_in[(size_t)row * 64 + 8 * ks + j] : 0.f;
    const int e_ = F.tid & 63, chn = h * 64 + e_;
    const float mur = mu[chn], muk = mu[RW + chn], muv = mu[2 * RW + chn], kkc = F.a->in[I_KK][chn], kac = F.a->in[I_KA][chn], rkc = F.a->in[I_RK][chn], gnw = F.a->in[I_GNW][chn], gnb = F.a->in[I_GNB][chn];
    for (int t0 = 0; t0 < T; t0 += 64) {
        const int nb = (T - t0) < 64 ? (T - t0) : 64;
        __syncthreads();
        for (int s = F.tid >> 6; s < nb; s += 8) {
            const int m = row0 + t0 + s;
            const size_t pr = (size_t)m * NIN;
            const float p_r = bf2f(P[pr + chn]), p_k = bf2f(P[pr + RW + chn]), p_v = bf2f(P[pr + 2 * RW + chn]);
            const float q_r = prev_val(P, sshift, m, chn), q_k = prev_val(P, sshift, m, RW + chn), q_v = prev_val(P, sshift, m, 2 * RW + chn);
            const float xr = p_r + (q_r - p_r) * mur, xk = p_k + (q_k - p_k) * muk, xv = p_v + (q_v - p_v) * muv;
            const float a = bf2f(AA[(size_t)m * RW + chn]), wl = WLOG[(size_t)m * RW + chn], inv = INV[(size_t)m * 8 + h];
            const float kk = xk * kkc * inv;
            A[SC_R * 4096 + s * 64 + e_] = xr; A[SC_DEC * 4096 + s * 64 + e_] = expf(wl); A[SC_KM * 4096 + s * 64 + e_] = xk * (1.0f + (a - 1.0f) * kac);
            A[SC_KK * 4096 + s * 64 + e_] = kk; A[SC_BB * 4096 + s * 64 + e_] = kk * a; A[SC_V * 4096 + s * 64 + e_] = xv;
        }
        __syncthreads();
        for (int s = 0; s < nb; ++s) {
            const LAS f32x4* pk = (const LAS f32x4*)(A + SC_KK * 4096 + s * 64 + 8 * ks); const LAS f32x4* pb = (const LAS f32x4*)(A + SC_BB * 4096 + s * 64 + 8 * ks);
            const LAS f32x4* pd = (const LAS f32x4*)(A + SC_DEC * 4096 + s * 64 + 8 * ks); const LAS f32x4* pm = (const LAS f32x4*)(A + SC_KM * 4096 + s * 64 + 8 * ks);
            const LAS f32x4* pq = (const LAS f32x4*)(A + SC_R * 4096 + s * 64 + 8 * ks);
            const f32x4 k0 = pk[0], k1 = pk[1], b0 = pb[0], b1 = pb[1], d0 = pd[0], d1 = pd[1], m0 = pm[0], m1 = pm[1], r0 = pq[0], r1 = pq[1];
            const float v = A[SC_V * 4096 + s * 64 + row];
            float sa = 0.f;
#pragma unroll
            for (int j = 0; j < 4; ++j) { sa += S[j] * k0[j]; sa += S[4 + j] * k1[j]; }
            sa = sum8(sa);
            float y = 0.f;
#pragma unroll
            for (int j = 0; j < 4; ++j) { S[j] = S[j] * d0[j] + (v * m0[j] - sa * b0[j]); S[4 + j] = S[4 + j] * d1[j] + (v * m1[j] - sa * b1[j]); y += S[j] * r0[j]; y += S[4 + j] * r1[j]; }
            y = sum8(y);
            if (ks == 0) A[SC_Y * 4096 + s * 64 + row] = y;
        }
        __syncthreads();
        for (int s = wave; s < nb; s += 8) {
            const int m = row0 + t0 + s;
            const float y = A[SC_Y * 4096 + s * 64 + lane];
            const float mean = wave_sum(y) * (1.f / 64.f), d = y - mean, var = wave_sum(d * d) * (1.f / 64.f);
            const float yn = d * (1.0f / sqrtf(var + GN_EPS));
            const float dot = wave_sum(A[SC_R * 4096 + s * 64 + lane] * A[SC_KM * 4096 + s * 64 + lane] * rkc);
            const float g = bf2f(GG[(size_t)m * RW + chn]);
            const float o = (yn * gnw + gnb + dot * A[SC_V * 4096 + s * 64 + lane]) * g;
            MIX[(size_t)m * D + chn] = (bf16)f2bf(o);
        }
    }
#pragma unroll
    for (int j = 0; j < 8; ++j) s_out[(size_t)row * 64 + 8 * ks + j] = S[j];
    __syncthreads();
}
constexpr int PB = 144, PF = 272;
constexpr int MB16 = 64 * PB, MF32 = 64 * PF;
constexpr size_t WS_GX = 2 * MiB;
constexpr size_t WS_S0 = 167 * MiB;
static_assert(WS_GX + 512 * 32768 <= WS_WIN && WS_H + (size_t)M * NIN * 2 <= WS_S0 && WS_S0 + 512 * 16384 <= WS_WLOG, "scan scratch map");
constexpr int CA_RHS = 0, CA_LB = 34816, CA_KQ = 52224, CA_KD = 61440, CA_BD = 70656, CA_VT = 79872, CA_KET = 89088, CA_BET = 98304, CA_LK = 107520, CA_SMALL = 116736;
constexpr int CC_RHS = 0, CC_LB = 17408, CC_KQ = 34816, CC_RQ = 44032, CC_KD = 53248, CC_BD = 62464, CC_VT = 71680, CC_KET = 80896, CC_BET = 90112, CC_LK = 99328, CC_MK = 108544, CC_MB = 117760,
              CC_SHI = 126976, CC_SLO = 136192, CC_SMALL = 145408;
constexpr int SM_GL = 0, SM_DOT = 256, SM_TOT = 512, SM_BYTES = 512 + 2048;

__device__ __forceinline__ void mm_nt(f32x4 (&acc)[2], const LAS unsigned char* X, const LAS unsigned char* Y, int wave, int lane) {
    const int tr = wave >> 1, tc0 = (wave & 1) * 2, lr = lane & 15, lq = lane >> 4;
#pragma unroll
    for (int ks = 0; ks < 2; ++ks) {
        const bf16x8 xa = *(const LAS bf16x8*)(X + (16 * tr + lr) * PB + ks * 64 + lq * 16);
#pragma unroll
        for (int j = 0; j < 2; ++j) {
            const bf16x8 yb = *(const LAS bf16x8*)(Y + (16 * (tc0 + j) + lr) * PB + ks * 64 + lq * 16);
            acc[j] = __builtin_amdgcn_mfma_f32_16x16x32_bf16(yb, xa, acc[j], 0, 0, 0);
        }
    }
}
#define ACC_ZERO(a) do { a[0] = (f32x4){0.f, 0.f, 0.f, 0.f}; a[1] = (f32x4){0.f, 0.f, 0.f, 0.f}; } while (0)
#define ACC_M(wave, lane) (16 * ((wave) >> 1) + ((lane) & 15))
#define ACC_N(wave, lane, j) (16 * (((wave) & 1) * 2 + (j)) + 4 * ((lane) >> 4))
__device__ __forceinline__ unsigned long long pk4(f32x4 v) { return (unsigned long long)pk2(v[0], v[1]) | ((unsigned long long)pk2(v[2], v[3]) << 32); }
__device__ __forceinline__ f32x4 bf4_to_f32(unsigned long long w) { return (f32x4){bflo((unsigned)w), bfhi((unsigned)w), bflo((unsigned)(w >> 32)), bfhi((unsigned)(w >> 32))}; }
__device__ __forceinline__ void store_hilo(const f32x4 (&a)[2], LAS unsigned char* HI, LAS unsigned char* LO, int wave, int lane) {
    const int m = ACC_M(wave, lane);
#pragma unroll
    for (int j = 0; j < 2; ++j) { const int n = ACC_N(wave, lane, j);
        const unsigned long long hi = pk4(a[j]); const f32x4 lo = a[j] - bf4_to_f32(hi);
        *(LAS unsigned long long*)(HI + m * PB + n * 2) = hi; *(LAS unsigned long long*)(LO + m * PB + n * 2) = pk4(lo); }
}
template <int NW> __device__ __forceinline__ void tri_solve(const LAS unsigned char* LBT, const LAS unsigned char* RHS, LAS unsigned char* UT, int wave, int lane) {
    if (wave < NW) {
        const int col = wave * 64 + lane;
        f32x4 u[16];
#pragma unroll
        for (int q = 0; q < 16; ++q) u[q] = *(const LAS f32x4*)(RHS + col * PF + q * 16);
#pragma unroll
        for (int i = 0; i < 63; ++i) {
            const float ui = u[i >> 2][i & 3];
#pragma unroll
            for (int q = (i + 1) >> 2; q < 16; ++q) { const f32x4 lv = *(const LAS f32x4*)(LBT + i * PF + q * 16); u[q] -= lv * ui; }
            asm volatile("" ::: "memory");
        }
#pragma unroll
        for (int q = 0; q < 8; ++q) { v4u w; w.x = pk2(u[2 * q][0], u[2 * q][1]); w.y = pk2(u[2 * q][2], u[2 * q][3]); w.z = pk2(u[2 * q + 1][0], u[2 * q + 1][1]); w.w = pk2(u[2 * q + 1][2], u[2 * q + 1][3]);
            *(LAS v4u*)(UT + col * PB + q * 16) = w; }
    }
}
template <bool PHC> __device__ __forceinline__ void chunk_stage(Frame& F, int m0, int h, int oKQ, int oRQ, int oKD, int oBD, int oVT, int oKET, int oBET, int oRHS, int oSMALL) {
    LAS unsigned char* lds = F.lds;
    const bf16* P = WSP(bf16, WS_H); const float* mu = F.a->in[I_MU];
    const float* WLOG = WSP(float, WS_WLOG); const bf16* AA = WSP(bf16, WS_A); const float* INV = WSP(float, WS_INV);
    const int e = F.lane, g = F.wave, chn = h * 64 + e;
    const float mur = mu[chn], muk = mu[RW + chn], muv = mu[2 * RW + chn], kkc = F.a->in[I_KK][chn], kac = F.a->in[I_KA][chn], rkc = F.a->in[I_RK][chn];
    const int mg = m0 + 8 * g;
    float pr[9], pk[9], pv[9];
    if ((mg & (TP - 1)) == 0) { pr[0] = 0.f; pk[0] = 0.f; pv[0] = 0.f; }
    else { const size_t o = (size_t)(mg - 1) * NIN; pr[0] = bf2f(P[o + chn]); pk[0] = bf2f(P[o + RW + chn]); pv[0] = bf2f(P[o + 2 * RW + chn]); }
    float wl[8], av[8], iv[8];
#pragma unroll
    for (int j = 0; j < 8; ++j) { const size_t o = (size_t)(mg + j) * NIN; pr[j + 1] = bf2f(P[o + chn]); pk[j + 1] = bf2f(P[o + RW + chn]); pv[j + 1] = bf2f(P[o + 2 * RW + chn]);
        wl[j] = WLOG[(size_t)(mg + j) * RW + chn]; av[j] = bf2f(AA[(size_t)(mg + j) * RW + chn]); iv[j] = INV[(size_t)(mg + j) * 8 + h]; }
    float cw[8]; { float s = 0.f;
#pragma unroll
        for (int j = 0; j < 8; ++j) { s += wl[j]; cw[j] = s; } }
    LAS float* TOT = (LAS float*)(lds + oSMALL + SM_TOT);
    TOT[g * 64 + e] = cw[7];
    __syncthreads();
    float off = 0.f, cwL = 0.f;
#pragma unroll
    for (int gg = 0; gg < 8; ++gg) { const float tv = TOT[gg * 64 + e]; cwL += tv; if (gg < g) off += tv; }
    if (g == 0) ((LAS float*)(lds + oSMALL + SM_GL))[e] = expf(cwL);
    unsigned vt[8], ket[8], bet[8]; float kq[8];
#pragma unroll
    for (int j = 0; j < 8; ++j) {
        const int t = 8 * g + j;
        const float c = off + cw[j];
        const float xr = pr[j + 1] + (pr[j] - pr[j + 1]) * mur, xk = pk[j + 1] + (pk[j] - pk[j + 1]) * muk, xv = pv[j + 1] + (pv[j] - pv[j + 1]) * muv;
        const float kk = xk * kkc * iv[j], km = xk * (1.0f + (av[j] - 1.0f) * kac), bb = kk * av[j];
        const float e1 = expf(c), e2 = 1.0f / e1, e3 = expf(c - wl[j]), e4 = expf(cwL - c);
        kq[j] = kk * e3;
        *(LAS unsigned short*)(lds + oKQ + t * PB + e * 2) = (unsigned short)f2bf(kq[j]);
        *(LAS unsigned short*)(lds + oKD + t * PB + e * 2) = (unsigned short)f2bf(km * e2);
        *(LAS unsigned short*)(lds + oBD + t * PB + e * 2) = (unsigned short)f2bf(bb * e2);
        if (PHC) { *(LAS unsigned short*)(lds + oRQ + t * PB + e * 2) = (unsigned short)f2bf(xr * e1);
            const float d = wave_sum(xr * km * rkc); if (e == 0) ((LAS float*)(lds + oSMALL + SM_DOT))[t] = d; }
        vt[j] = f2bf(xv); ket[j] = f2bf(km * e4); bet[j] = f2bf(bb * e4);
    }
    { v4u w; w.x = vt[0] | (vt[1] << 16); w.y = vt[2] | (vt[3] << 16); w.z = vt[4] | (vt[5] << 16); w.w = vt[6] | (vt[7] << 16); *(LAS v4u*)(lds + oVT + e * PB + g * 16) = w; }
    { v4u w; w.x = ket[0] | (ket[1] << 16); w.y = ket[2] | (ket[3] << 16); w.z = ket[4] | (ket[5] << 16); w.w = ket[6] | (ket[7] << 16); *(LAS v4u*)(lds + oKET + e * PB + g * 16) = w; }
    { v4u w; w.x = bet[0] | (bet[1] << 16); w.y = bet[2] | (bet[3] << 16); w.z = bet[4] | (bet[5] << 16); w.w = bet[6] | (bet[7] << 16); *(LAS v4u*)(lds + oBET + e * PB + g * 16) = w; }
    if (!PHC) { *(LAS f32x4*)(lds + oRHS + e * PF + g * 32) = (f32x4){kq[0], kq[1], kq[2], kq[3]}; *(LAS f32x4*)(lds + oRHS + e * PF + g * 32 + 16) = (f32x4){kq[4], kq[5], kq[6], kq[7]}; }
}
__device__ __forceinline__ void scanA_task(Frame& F, int task) {
    LAS unsigned char* lds = F.lds; const int wave = F.wave, lane = F.lane;
    const int sc = task & 31, bh = task >> 5, h = bh & 7, b = bh >> 3;
    const int m = ACC_M(wave, lane);
    f32x4 gacc[2], xacc[2];
#pragma unroll
    for (int j = 0; j < 2; ++j) { const int n = ACC_N(wave, lane, j);
#pragma unroll
        for (int r = 0; r < 4; ++r) { gacc[j][r] = (m == n + r) ? 1.f : 0.f; xacc[j][r] = 0.f; } }
    for (int c = 0; c < 4; ++c) {
        __syncthreads();
        chunk_stage<false>(F, b * TP + sc * 256 + c * 64, h, CA_KQ, 0, CA_KD, CA_BD, CA_VT, CA_KET, CA_BET, CA_RHS, CA_SMALL);
        __syncthreads();
        { f32x4 a[2]; ACC_ZERO(a); mm_nt(a, lds + CA_BD, lds + CA_KQ, wave, lane);
#pragma unroll
          for (int j = 0; j < 2; ++j) { const int n = ACC_N(wave, lane, j); f32x4 o;
#pragma unroll
              for (int r = 0; r < 4; ++r) o[r] = (n + r > m) ? a[j][r] : 0.f;
              *(LAS f32x4*)(lds + CA_LB + m * PF + n * 4) = o; } }
        { f32x4 a[2]; ACC_ZERO(a); mm_nt(a, lds + CA_KQ, lds + CA_KD, wave, lane);
#pragma unroll
          for (int j = 0; j < 2; ++j) { const int n = ACC_N(wave, lane, j); f32x4 o;
#pragma unroll
              for (int r = 0; r < 4; ++r) o[r] = (n + r < m) ? a[j][r] : 0.f;
              *(LAS unsigned long long*)(lds + CA_LK + m * PB + n * 2) = pk4(o); } }
        __syncthreads();
        { f32x4 a[2]; ACC_ZERO(a); mm_nt(a, lds + CA_VT, lds + CA_LK, wave, lane);
#pragma unroll
          for (int j = 0; j < 2; ++j) { const int n = ACC_N(wave, lane, j); *(LAS f32x4*)(lds + CA_RHS + (64 + m) * PF + n * 4) = a[j]; } }
        __syncthreads();
        tri_solve<2>(lds + CA_LB, lds + CA_RHS, lds + CA_KD, wave, lane);
        __syncthreads();
        f32x4 pt[2], xc[2];
        { f32x4 a[2]; ACC_ZERO(a); mm_nt(a, lds + CA_BET, lds + CA_KD, wave, lane);
          const LAS float* GL = (const LAS float*)(lds + CA_SMALL + SM_GL);
#pragma unroll
          for (int j = 0; j < 2; ++j) { const int n = ACC_N(wave, lane, j);
#pragma unroll
              for (int r = 0; r < 4; ++r) pt[j][r] = ((m == n + r) ? GL[n + r] : 0.f) - a[j][r]; } }
        { f32x4 a1[2], a2[2]; ACC_ZERO(a1); ACC_ZERO(a2);
          mm_nt(a1, lds + CA_VT, lds + CA_KET, wave, lane); mm_nt(a2, lds + CA_KD + 64 * PB, lds + CA_BET, wave, lane);
          xc[0] = a1[0] - a2[0]; xc[1] = a1[1] - a2[1]; }
        store_hilo(pt, lds + CA_KQ, lds + CA_LK, wave, lane);
        store_hilo(gacc, lds + 0, lds + MB16, wave, lane);
        store_hilo(xacc, lds + 2 * MB16, lds + 3 * MB16, wave, lane);
        __syncthreads();
        { f32x4 a[2]; ACC_ZERO(a);
          mm_nt(a, lds + 0, lds + CA_KQ, wave, lane); mm_nt(a, lds + 0, lds + CA_LK, wave, lane); mm_nt(a, lds + MB16, lds + CA_KQ, wave, lane);
          gacc[0] = a[0]; gacc[1] = a[1]; }
        { f32x4 a[2]; a[0] = xc[0]; a[1] = xc[1];
          mm_nt(a, lds + 2 * MB16, lds + CA_KQ, wave, lane); mm_nt(a, lds + 2 * MB16, lds + CA_LK, wave, lane); mm_nt(a, lds + 3 * MB16, lds + CA_KQ, wave, lane);
          xacc[0] = a[0]; xacc[1] = a[1]; }
    }
    float* GT = (float*)(F.a->ws + WS_GX + (size_t)task * 32768); float* XO = GT + 4096;
#pragma unroll
    for (int j = 0; j < 2; ++j) { const int n = ACC_N(wave, lane, j);
#pragma unroll
        for (int r = 0; r < 4; ++r) GT[(n + r) * 64 + m] = gacc[j][r];
        *(f32x4*)(XO + m * 64 + n) = xacc[j]; }
}
__device__ __forceinline__ void scanB_unit(Frame& F, int bh) {
    LAS unsigned char* lds = F.lds; const int wave = F.wave, lane = F.lane, tid = F.tid;
    const int m = ACC_M(wave, lane);
    f32x4 s[2]; ACC_ZERO(s);
    for (int sc = 0; sc < 32; ++sc) {
        const int task = bh * 32 + sc;
        const float* GT = (const float*)(F.a->ws + WS_GX + (size_t)task * 32768); const float* XI = GT + 4096; float* S0 = (float*)(F.a->ws + WS_S0 + (size_t)task * 16384);
        __syncthreads();
        { const int row = tid >> 3, c8 = (tid & 7) * 8;
          const f32x4 v0 = *(const f32x4*)(GT + row * 64 + c8), v1 = *(const f32x4*)(GT + row * 64 + c8 + 4);
          const unsigned long long h0 = pk4(v0), h1 = pk4(v1); const f32x4 l0 = v0 - bf4_to_f32(h0), l1 = v1 - bf4_to_f32(h1);
          v4u wh, wl; wh.x = (unsigned)h0; wh.y = (unsigned)(h0 >> 32); wh.z = (unsigned)h1; wh.w = (unsigned)(h1 >> 32);
          const unsigned long long q0 = pk4(l0), q1 = pk4(l1); wl.x = (unsigned)q0; wl.y = (unsigned)(q0 >> 32); wl.z = (unsigned)q1; wl.w = (unsigned)(q1 >> 32);
          *(LAS v4u*)(lds + 2 * MB16 + row * PB + c8 * 2) = wh; *(LAS v4u*)(lds + 3 * MB16 + row * PB + c8 * 2) = wl; }
        store_hilo(s, lds + 0, lds + MB16, wave, lane);
#pragma unroll
        for (int j = 0; j < 2; ++j) { const int n = ACC_N(wave, lane, j); *(f32x4*)(S0 + m * 64 + n) = s[j]; }
        __syncthreads();
        f32x4 a[2];
#pragma unroll
        for (int j = 0; j < 2; ++j) { const int n = ACC_N(wave, lane, j); a[j] = *(const f32x4*)(XI + m * 64 + n); }
        mm_nt(a, lds + 0, lds + 2 * MB16, wave, lane); mm_nt(a, lds + 0, lds + 3 * MB16, wave, lane); mm_nt(a, lds + MB16, lds + 2 * MB16, wave, lane);
        s[0] = a[0]; s[1] = a[1];
    }
    __syncthreads();
}
__device__ __forceinline__ void scanC_task(Frame& F, int task) {
    LAS unsigned char* lds = F.lds; const int wave = F.wave, lane = F.lane;
    const int sc = task & 31, bh = task >> 5, h = bh & 7, b = bh >> 3;
    const int m = ACC_M(wave, lane);
    const bf16* GG = WSP(bf16, WS_G); bf16* MIX = WSP(bf16, WS_U);
    const int chn = h * 64 + lane; const float gnw = F.a->in[I_GNW][chn], gnb = F.a->in[I_GNB][chn];
    f32x4 s[2];
    { const float* S0 = (const float*)(F.a->ws + WS_S0 + (size_t)task * 16384);
#pragma unroll
      for (int j = 0; j < 2; ++j) { const int n = ACC_N(wave, lane, j); s[j] = *(const f32x4*)(S0 + m * 64 + n); } }
    for (int c = 0; c < 4; ++c) {
        const int m0 = b * TP + sc * 256 + c * 64;
        __syncthreads();
        chunk_stage<true>(F, m0, h, CC_KQ, CC_RQ, CC_KD, CC_BD, CC_VT, CC_KET, CC_BET, 0, CC_SMALL);
        store_hilo(s, lds + CC_SHI, lds + CC_SLO, wave, lane);
        __syncthreads();
        { f32x4 a[2]; ACC_ZERO(a); mm_nt(a, lds + CC_BD, lds + CC_KQ, wave, lane);
#pragma unroll
          for (int j = 0; j < 2; ++j) { const int n = ACC_N(wave, lane, j); f32x4 o;
#pragma unroll
              for (int r = 0; r < 4; ++r) o[r] = (n + r > m) ? a[j][r] : 0.f;
              *(LAS f32x4*)(lds + CC_LB + m * PF + n * 4) = o; } }
        { f32x4 a[2]; ACC_ZERO(a); mm_nt(a, lds + CC_KQ, lds + CC_KD, wave, lane);
#pragma unroll
          for (int j = 0; j < 2; ++j) { const int n = ACC_N(wave, lane, j); f32x4 o;
#pragma unroll
              for (int r = 0; r < 4; ++r) o[r] = (n + r < m) ? a[j][r] : 0.f;
              *(LAS unsigned long long*)(lds + CC_LK + m * PB + n * 2) = pk4(o); } }
        { f32x4 a[2], a2[2]; ACC_ZERO(a); ACC_ZERO(a2); mm_nt(a, lds + CC_RQ, lds + CC_KD, wave, lane); mm_nt(a2, lds + CC_RQ, lds + CC_BD, wave, lane);
#pragma unroll
          for (int j = 0; j < 2; ++j) { const int n = ACC_N(wave, lane, j); f32x4 o, o2;
#pragma unroll
              for (int r = 0; r < 4; ++r) { o[r] = (n + r <= m) ? a[j][r] : 0.f; o2[r] = (n + r <= m) ? a2[j][r] : 0.f; }
              *(LAS unsigned long long*)(lds + CC_MK + m * PB + n * 2) = pk4(o); *(LAS unsigned long long*)(lds + CC_MB + m * PB + n * 2) = pk4(o2); } }
        __syncthreads();
        { f32x4 a[2]; ACC_ZERO(a);
          mm_nt(a, lds + CC_SHI, lds + CC_KQ, wave, lane); mm_nt(a, lds + CC_SLO, lds + CC_KQ, wave, lane); mm_nt(a, lds + CC_VT, lds + CC_LK, wave, lane);
#pragma unroll
          for (int j = 0; j < 2; ++j) { const int n = ACC_N(wave, lane, j); *(LAS f32x4*)(lds + CC_RHS + m * PF + n * 4) = a[j]; } }
        __syncthreads();
        tri_solve<1>(lds + CC_LB, lds + CC_RHS, lds + CC_KD, wave, lane);
        __syncthreads();
        { f32x4 a[2], a2[2]; ACC_ZERO(a); ACC_ZERO(a2);
          mm_nt(a, lds + CC_RQ, lds + CC_SHI, wave, lane); mm_nt(a, lds + CC_RQ, lds + CC_SLO, wave, lane); mm_nt(a, lds + CC_MK, lds + CC_VT, wave, lane);
          mm_nt(a2, lds + CC_MB, lds + CC_KD, wave, lane);
#pragma unroll
          for (int j = 0; j < 2; ++j) { const int n = ACC_N(wave, lane, j); *(LAS f32x4*)(lds + CC_LB + m * PF + n * 4) = a[j] - a2[j]; } }
        { f32x4 a1[2], a2[2]; ACC_ZERO(a1); ACC_ZERO(a2);
          mm_nt(a1, lds + CC_VT, lds + CC_KET, wave, lane); mm_nt(a2, lds + CC_KD, lds + CC_BET, wave, lane);
          const LAS float* GL = (const LAS float*)(lds + CC_SMALL + SM_GL);
#pragma unroll
          for (int j = 0; j < 2; ++j) { const int n = ACC_N(wave, lane, j); const f32x4 gl = *(const LAS f32x4*)(GL + n); s[j] = s[j] * gl + a1[j] - a2[j]; } }
        __syncthreads();
        for (int t = wave; t < 64; t += 8) {
            const int mm = m0 + t;
            const float y = *(const LAS float*)(lds + CC_LB + t * PF + lane * 4);
            const float mean = wave_sum(y) * (1.f / 64.f), d = y - mean, var = wave_sum(d * d) * (1.f / 64.f);
            const float yn = d * (1.0f / sqrtf(var + GN_EPS));
            const float dot = ((const LAS float*)(lds + CC_SMALL + SM_DOT))[t];
            const float v = bf2f(*(const LAS unsigned short*)(lds + CC_VT + lane * PB + t * 2));
            const float gg = bf2f(GG[(size_t)mm * RW + chn]);
            MIX[(size_t)mm * D + chn] = (bf16)f2bf((yn * gnw + gnb + dot * v) * gg);
        }
    }
    if (sc == 31) { float* so = F.a->out + O_WKV_P + (size_t)bh * 4096;
#pragma unroll
        for (int j = 0; j < 2; ++j) { const int n = ACC_N(wave, lane, j); *(f32x4*)(so + m * 64 + n) = s[j]; } }
}
__device__ __forceinline__ int rel_bucket(int n) {
    if (n < 16) return n;
    const int b = 16 + (int)(logf((float)n * (1.0f / 16.0f)) / 2.0794415416798357f * 16.0f);
    return b < 31 ? b : 31;
}
constexpr int ATT_PITCH = 144, ATT_K_OFF = 0, ATT_V_OFF = 255 * ATT_PITCH + 48  , ATT_B_OFF = 2 * ATT_V_OFF;
static_assert(CC_SMALL + SM_BYTES <= RING_BYTES && CA_SMALL + SM_BYTES <= RING_BYTES && ATT_V_OFF % 16 == 0 && ATT_B_OFF + 4096 <= RING_BYTES, "attention LDS map");
__device__ __forceinline__ void attn_prompt_unit(Frame& F, int b, int kvh, int qb) {
    LAS unsigned char* lds = F.lds;
    const bf16* P = WSP(bf16, WS_H); bf16* MIX = WSP(bf16, WS_U);
    const float* relb = F.a->in[I_RELB];
    const int t0 = qb * 128, tid = F.tid;
    __syncthreads();
    for (int idx = tid; idx < 255 * 16; idx += 512) {
        const int rowi = idx >> 4, part = idx & 15, pos = t0 - 127 + rowi;
        v4u val = (v4u){0u, 0u, 0u, 0u};
        if (pos >= 0) val = *(const v4u*)(P + (size_t)(b * TP + pos) * NIN + (part < 8 ? 2304 : 2432) + kvh * 64 + (part & 7) * 8);
        *(LAS v4u*)(lds + (part < 8 ? ATT_K_OFF : ATT_V_OFF) + rowi * ATT_PITCH + (part & 7) * 16) = val;
    }
    for (int idx = tid; idx < 1024; idx += 512) { const int dist = idx >> 3, hq = idx & 7; ((LAS float*)(lds + ATT_B_OFF))[idx] = relb[rel_bucket(dist) * 8 + hq]; }
    __syncthreads();
    const int i = tid & 127, g = tid >> 7, hq = kvh * 4 + g, t = t0 + i, m = b * TP + t;
    v4u qw[8];
    { const v4u* qp = (const v4u*)(P + (size_t)m * NIN + RWP + hq * 64);
#pragma unroll
      for (int c = 0; c < 8; ++c) qw[c] = qp[c]; }
    float o[64];
#pragma unroll
    for (int d = 0; d < 64; ++d) o[d] = 0.f;
    float mrun = -1e30f, l = 0.f;
    const LAS float* bt = (const LAS float*)(lds + ATT_B_OFF);
#pragma unroll 1
    for (int jj = 0; jj < 128; ++jj) {
        const LAS v4u* kp = (const LAS v4u*)(lds + ATT_K_OFF + (i + jj) * ATT_PITCH);
        float a0 = 0.f, a1 = 0.f;
#pragma unroll
        for (int c = 0; c < 8; ++c) { const v4u w = kp[c];
#pragma unroll
            for (int e = 0; e < 4; ++e) { a0 += bflo(qw[c][e]) * bflo(w[e]); a1 += bfhi(qw[c][e]) * bfhi(w[e]); }
            }
        const int dist = 127 - jj;
        float sv = (a0 + a1) * 0.125f + bt[dist * 8 + hq];
        asm volatile("" : "+v"(sv));
        const bool valid = (t - dist) >= 0;
        sv = valid ? sv : -1e30f;
        const float mx = fmaxf(mrun, sv), corr = __expf(mrun - mx), p = valid ? __expf(sv - mx) : 0.f;
        mrun = mx; l = l * corr + p;
        const LAS v4u* vp = (const LAS v4u*)(lds + ATT_V_OFF + (i + jj) * ATT_PITCH);
#pragma unroll
        for (int c = 0; c < 8; ++c) { const v4u w = vp[c];
#pragma unroll
            for (int e = 0; e < 4; ++e) { o[c * 8 + 2 * e] = o[c * 8 + 2 * e] * corr + p * bflo(w[e]); o[c * 8 + 2 * e + 1] = o[c * 8 + 2 * e + 1] * corr + p * bfhi(w[e]); }
            }
    }
    l += __expf(F.a->in[I_SINKS][hq] - mrun);
    const float il = 1.0f / l;
    v4u* op = (v4u*)(MIX + (size_t)m * D + RW + hq * 64);
#pragma unroll
    for (int c = 0; c < 8; ++c) { v4u w;
#pragma unroll
        for (int e = 0; e < 4; ++e) w[e] = pk2(o[c * 8 + 2 * e] * il, o[c * 8 + 2 * e + 1] * il);
        op[c] = w; }
}
__device__ __forceinline__ void attn_sample_unit(Frame& F, int unit) {
    const bf16* P = WSP(bf16, WS_H); bf16* MIX = WSP(bf16, WS_U);
    const float* relb = F.a->in[I_RELB]; const float* ck = F.a->in[I_CK]; const float* cv = F.a->in[I_CV];
    const int idx = unit * 512 + F.tid, hq = idx & 7, t = (idx >> 3) & 7, b = idx >> 6, kvh = hq >> 2, m = MP + b * TS + t;
    float q[64];
    { const v4u* qp = (const v4u*)(P + (size_t)m * NIN + RWP + hq * 64);
#pragma unroll
      for (int c = 0; c < 8; ++c) { const v4u w = qp[c];
#pragma unroll
          for (int e = 0; e < 4; ++e) { q[c * 8 + 2 * e] = bflo(w[e]) * 0.125f; q[c * 8 + 2 * e + 1] = bfhi(w[e]) * 0.125f; } } }
    float o[64];
#pragma unroll
    for (int d = 0; d < 64; ++d) o[d] = 0.f;
    float mrun = -1e30f, l = 0.f;
    for (int jj = 0; jj < 128; ++jj) {
        const int j = t + 1 + jj, dist = 127 - jj;
        float a0 = 0.f, a1 = 0.f;
        const bool cached = j < 128;
        const size_t crow = ((size_t)(b * 128 + (cached ? j : 0)) * 2 + kvh) * 64, prow = (size_t)(MP + b * TS + (cached ? 0 : j - 128)) * NIN + kvh * 64;
        if (cached) { const f32x4* kp = (const f32x4*)(ck + crow);
#pragma unroll
            for (int c = 0; c < 16; ++c) { const f32x4 a = kp[c]; a0 += q[c * 4] * a[0] + q[c * 4 + 2] * a[2]; a1 += q[c * 4 + 1] * a[1] + q[c * 4 + 3] * a[3]; }
        } else { const v4u* kp = (const v4u*)(P + prow + 2304);
#pragma unroll
            for (int c = 0; c < 8; ++c) { const v4u a = kp[c];
#pragma unroll
                for (int e = 0; e < 4; ++e) { a0 += q[c * 8 + 2 * e] * bflo(a[e]); a1 += q[c * 8 + 2 * e + 1] * bfhi(a[e]); } }
        }
        const float s = (a0 + a1) + relb[rel_bucket(dist) * 8 + hq];
        const float mx = fmaxf(mrun, s), corr = __expf(mrun - mx), p = __expf(s - mx);
        mrun = mx; l = l * corr + p;
        if (cached) { const f32x4* vp = (const f32x4*)(cv + crow);
#pragma unroll
            for (int c = 0; c < 16; ++c) { const f32x4 v = vp[c];
#pragma unroll
                for (int e = 0; e < 4; ++e) o[c * 4 + e] = o[c * 4 + e] * corr + p * v[e];
                }
        } else { const v4u* vp = (const v4u*)(P + prow + 2432);
#pragma unroll
            for (int c = 0; c < 8; ++c) { const v4u v = vp[c];
#pragma unroll
                for (int e = 0; e < 4; ++e) { o[c * 8 + 2 * e] = o[c * 8 + 2 * e] * corr + p * bflo(v[e]); o[c * 8 + 2 * e + 1] = o[c * 8 + 2 * e + 1] * corr + p * bfhi(v[e]); } }
        }
    }
    l += __expf(F.a->in[I_SINKS][hq] - mrun);
    const float il = 1.0f / l;
    v4u* op = (v4u*)(MIX + (size_t)m * D + RW + hq * 64);
#pragma unroll
    for (int c = 0; c < 8; ++c) { v4u w;
#pragma unroll
        for (int e = 0; e < 4; ++e) w[e] = pk2(o[c * 8 + 2 * e] * il, o[c * 8 + 2 * e + 1] * il);
        op[c] = w; }
}
__device__ __forceinline__ void mixer_task(Frame& F0, int t) {
    Frame F = F0;
    { int t_ = threadIdx.x; asm volatile("" : "+v"(t_)); F.tid = t_; F.lane = t_ & 63; F.wave = __builtin_amdgcn_readfirstlane(t_ >> 6); }
    if (t < 16) {
#ifndef NO_SCANB
        scanB_unit(F, t);
#endif
    }
    else if (t >= 272 && t < 1296) {
        const int id = t - 272, b = id >> 3, h = id & 7;
#ifndef NO_SCAN
        scan_unit(F, MP + b * TS, TS, h, F.a->in[I_SWKV] + (size_t)id * 4096, F.a->out + O_WKV_S + (size_t)id * 4096);
#endif
    } else if (t < 272) { const int u = t - 16; (void)u;
#ifndef NO_ATTP
        attn_prompt_unit(F, u >> 7, (u >> 6) & 1, u & 63);
#endif
    }
    else {
#ifndef NO_ATTS
        attn_sample_unit(F, t - 1296);
#endif
    }
}
__device__ __forceinline__ void p_mixer(Frame& F) {
    int t = F.vcu, step = F.G, end = 1312;
    if (F.G >= 32) { if (F.vcu < 16) { step = 1 << 20; end = 16; } else step = F.G - 16; }
    for (; t < end; t += step) mixer_task(F, t);
    __syncthreads();
}
__device__ __forceinline__ void p_scanA(Frame& F) { for (int t = F.vcu; t < 512; t += F.G) scanA_task(F, t); __syncthreads(); }
__device__ __forceinline__ void p_scanC(Frame& F) { for (int t = F.vcu; t < 512; t += F.G) scanC_task(F, t); __syncthreads(); }
#ifndef MK_PER_PHASE
#define MK_PER_PHASE 0
#endif
constexpr int N_PHASES = 15;
__global__ void __launch_bounds__(NWAVES * 64, 2) fwd_kernel(Args args) {
    extern __shared__ __attribute__((aligned(16))) unsigned char lds[];
    Frame F;
    F.lds = (LAS unsigned char*)lds;
    F.MISC = (volatile LAS unsigned*)(F.lds + MISC_OFF);
    F.tid = threadIdx.x; F.lane = F.tid & 63; F.wave = __builtin_amdgcn_readfirstlane(F.tid >> 6);
    F.G = gridDim.x; { const int bx = blockIdx.x; F.vcu = (F.G % 8 == 0) ? (bx % 8) * (F.G / 8) + bx / 8 : bx; }
    F.a = &args; F.ctl = (gu32*)(args.ws + WS_CTL);
    for (int u = F.tid; u < (LDS_BYTES - LDSCTL_OFF) / 4; u += NWAVES * 64) ((LAS unsigned*)(F.lds + LDSCTL_OFF))[u] = 0u;
    __syncthreads();
    const int lo = args.ph_lo, hi = args.ph_hi;
    XcdBarrier bar; bar.bar = (unsigned*)(F.ctl + CW_BAR); bar.x = 0; bar.st = nullptr;
    if (hi - lo > 1) bar = xcd_barrier_post((unsigned*)(F.ctl + CW_BAR), F.MISC + 8);
#ifdef ONLY_PHASE
#define IN(k) ((k) == ONLY_PHASE && lo <= (k) && (k) < hi)
#else
#define IN(k) (lo <= (k) && (k) < hi)
#endif
#define SEAM(k) do { if ((k) + 1 < hi) xcd_barrier(bar); } while (0)
#define GEMM_SWIGLU(k, WOFF) if (IN(k)) { \
        pg8::Gemm g{WSP(bf16, WS_U), WSP(bf16, WOFF), M, NFF, D}; pg8::StaticOrder S; S.init(M, NFF, F.G, (int)blockIdx.x); \
        pg8::EpiSwiglu E{WSP(bf16, WS_H), FF}; \
        pg8::gemm_phase<pg8::EpiSwiglu, pg8::StaticOrder, true, true>(F.lds + RING_OFF, g, S, E); SEAM(k); }
#define GEMM_RESID(k, AOFF, WOFF, KK, XP, XS, GTK, GS) if (IN(k)) { \
        pg8::Gemm g{WSP(bf16, AOFF), WSP(bf16, WOFF), M, D, KK}; pg8::StaticOrder S; S.init(M, D, F.G, (int)blockIdx.x); \
        pg8::EpiResid E{XP, XS, args.out + O_Y, WSP(float, WS_MOD) + (GTK) * D, ALPHA, GS}; \
        pg8::gemm_phase<pg8::EpiResid, pg8::StaticOrder, true, true>(F.lds + RING_OFF, g, S, E); SEAM(k); }
    if (IN(0)) { p0_weights(F); __syncthreads(); p0_mod(F); SEAM(0); }
    if (IN(1)) { p_modulate0(F); SEAM(1); }
    GEMM_SWIGLU(2, WS_W1IN)
    GEMM_RESID(3, WS_H, WS_W1OUT, FF, args.in[I_XP], args.in[I_XS], 2, 0.5f)
    if (IN(4)) { p_layernorm(F, 0, 3 * D); SEAM(4); }
    if (IN(5)) {
        pg8::Gemm g{WSP(bf16, WS_U), WSP(bf16, WS_WIN), M, NIN, D}; pg8::StaticOrder S; S.init(M, NIN, F.G, (int)blockIdx.x);
        pg8::EpiBf16<0> E{WSP(bf16, WS_H), NIN, nullptr, 0, 0, 1.f};
        pg8::gemm_phase<pg8::EpiBf16<0>, pg8::StaticOrder, true, true>(F.lds + RING_OFF, g, S, E); SEAM(5); }
    if (IN(6)) { p_prep(F); SEAM(6); }
    if (IN(7)) { p_scanA(F); SEAM(7); }
    if (IN(8)) { p_mixer(F); SEAM(8); }
    if (IN(9)) { p_scanC(F); SEAM(9); }
    GEMM_RESID(10, WS_U, WS_WOUT, D, args.out + O_Y, args.out + O_Y + (size_t)MP * D, 5, 1.0f)
    if (IN(11)) { p_layernorm(F, 1, 6 * D); SEAM(11); }
    GEMM_SWIGLU(12, WS_W2IN)
    GEMM_RESID(13, WS_H, WS_W2OUT, FF, args.out + O_Y, args.out + O_Y + (size_t)MP * D, 8, 0.5f)
    if (IN(14)) { p_layernorm(F, 2, -1); }
}

extern "C" void kernel_launch(void* const* d_in, const int* in_sizes, int n_in, void* d_out, int out_size, void* d_ws, size_t ws_size, hipStream_t stream) {
    static int grid = 0;
    if (grid == 0) {
        if (n_in != N_IN || in_sizes[0] != MP * D || out_size != (int)O_END || ws_size < WS_END) { fprintf(stderr, "kernel_launch: unexpected shapes (n_in %d, out %d, ws %zu); nothing launched\n", n_in, out_size, ws_size); grid = -1; return; }
        int dev = 0, cus = 0;
        if (hipGetDevice(&dev) != hipSuccess || hipDeviceGetAttribute(&cus, hipDeviceAttributeMultiprocessorCount, dev) != hipSuccess) { grid = -1; return; }
        if (hipFuncSetAttribute((const void*)fwd_kernel, hipFuncAttributeMaxDynamicSharedMemorySize, LDS_BYTES) != hipSuccess) { fprintf(stderr, "kernel_launch: hipFuncSetAttribute failed\n"); grid = -1; return; }
        int per_cu = 0;
        if (hipOccupancyMaxActiveBlocksPerMultiprocessor(&per_cu, (const void*)fwd_kernel, NWAVES * 64, LDS_BYTES) != hipSuccess || per_cu < 1) fprintf(stderr, "kernel_launch: occupancy query reports %d\n", per_cu);
        (void)hipGetLastError();
        grid = cus;
    }
    if (grid < 0) return;
    if (hipMemsetAsync((char*)d_ws + WS_CTL, 0, CTL_ZERO_BYTES, stream) != hipSuccess) return;
    Args a{};
    for (int i = 0; i < N_IN; ++i) a.in[i] = (const float*)d_in[i];
    a.out = (float*)d_out; a.ws = (unsigned char*)d_ws;
#if MK_PER_PHASE
    for (int ph = 0; ph < N_PHASES; ++ph) { a.ph_lo = ph; a.ph_hi = ph + 1; hipLaunchKernelGGL(fwd_kernel, dim3(grid), dim3(NWAVES * 64), LDS_BYTES, stream, a); }
#else
    a.ph_lo = 0; a.ph_hi = N_PHASES;
    hipLaunchKernelGGL(fwd_kernel, dim3(grid), dim3(NWAVES * 64), LDS_BYTES, stream, a);
#endif
}
```

```cpp
#define MK_PER_PHASE 0

#include <hip/hip_runtime.h>
#include <cstdio>
#include <cstdint>
#include <cmath>
namespace pg8 {
#define PG8_LAS __attribute__((address_space(3)))
typedef unsigned short bf16_t;
typedef short bf16x8 __attribute__((ext_vector_type(8)));
typedef float f32x4 __attribute__((ext_vector_type(4)));
typedef unsigned u32x4 __attribute__((ext_vector_type(4)));
constexpr int BM = 256, BK = 64, HALF = 128, HTB = HALF * BK * 2  , STAGE_BYTES = 8 * HTB, NXCD = 8, WGM = 8;

__host__ __device__ __forceinline__ int lds_byte(int r, int c) { const int st = (r >> 4) * 2 + (c >> 5), rr = r & 15, cc = c & 31, ob = rr * 64 + cc * 2; return st * 1024 + (ob ^ (((ob >> 9) & 1) << 5)); }
__host__ __device__ __forceinline__ void stage_rc(int b, int& R, int& C) { const int st = b / 1024, sb = b % 1024, swz = sb ^ (((sb >> 9) & 1) << 5); R = (st >> 1) * 16 + swz / 64; C = (st & 1) * 32 + (swz % 64) / 2; }
__host__ __device__ __forceinline__ int perm32(int rho) { const int n = rho >> 4, i = rho & 15; return 8 * (i >> 2) + 4 * n + (i & 3); }

struct Unit { int pm, pn; };
struct Gemm { const bf16_t* A; const bf16_t* Bt; int M, N, K; };

struct StaticOrder {
    int nM, nN, nwg, G, c;
    __host__ __device__ void init(int M, int N, int G_, int c_) { nM = M / BM; nN = N / BM; nwg = nM * nN; G = G_; c = c_; }
    __host__ __device__ bool next(int i, Unit& u) const {
        const long L = (long)i * G + c; if (L >= nwg) return false;
        int wgid = (int)L; { const int q = nwg / NXCD, r = nwg % NXCD, xcd = wgid % NXCD, off = wgid / NXCD; wgid = (xcd < r ? xcd * (q + 1) : r * (q + 1) + (xcd - r) * q) + off; }
        const int nig = WGM * nN, gid = wgid / nig, fm = gid * WGM, gsz = (nM - fm) < WGM ? (nM - fm) : WGM;
        u.pm = fm + ((wgid % nig) % gsz); u.pn = (wgid % nig) / gsz; return true;
    }
    __device__ __forceinline__ void a_ready(const Unit&) const {}
    __device__ __forceinline__ void done(const Unit&) const {}
};

__device__ __forceinline__ unsigned cvt_pk_bf16(float lo, float hi) { unsigned r; asm volatile("v_cvt_pk_bf16_f32 %0, %1, %2" : "=v"(r) : "v"(lo), "v"(hi)); return r; }
template <int ACT  > struct EpiBf16 {
    static constexpr bool PERM = true, AFTER_DRAIN = false; static_assert(ACT == 0, "EpiBf16: ACT is 0 (none)");
    bf16_t* O; int ldc; const float* bias; int split_cols; size_t split_stride; float scale0;
    __device__ __forceinline__ void operator()(const f32x4 (&acc)[2][2][4][2], const Unit& u, int wr, int wc, int fr, int fq) const {
        const int row0 = u.pm * BM + wr * 64 + fr; int colt = u.pn * BM; bf16_t* base = O;
        float sc = 1.f; if (split_cols) { const int t = colt / split_cols; base += (size_t)t * split_stride; colt -= t * split_cols; if (t == 0) sc = scale0; }
        const int col0 = colt + wc * 32 + 8 * fq, bcol0 = u.pn * BM + wc * 32 + 8 * fq;
        f32x4 bv[2][2];
#pragma unroll
        for (int bj = 0; bj < 2; ++bj)
#pragma unroll
            for (int n = 0; n < 2; ++n) bv[bj][n] = bias ? *(const f32x4*)(bias + bcol0 + bj * HALF + 4 * n) : (f32x4){0.f, 0.f, 0.f, 0.f};
#pragma unroll
        for (int ai = 0; ai < 2; ++ai)
#pragma unroll
            for (int m = 0; m < 4; ++m) { bf16_t* rowp = base + (size_t)(row0 + ai * HALF + m * 16) * ldc + col0;
#pragma unroll
                for (int bj = 0; bj < 2; ++bj) { f32x4 v0 = acc[ai][bj][m][0] + bv[bj][0], v1 = acc[ai][bj][m][1] + bv[bj][1];
                    v0 = v0 * sc; v1 = v1 * sc; u32x4 w; w.x = cvt_pk_bf16(v0[0], v0[1]); w.y = cvt_pk_bf16(v0[2], v0[3]); w.z = cvt_pk_bf16(v1[0], v1[1]); w.w = cvt_pk_bf16(v1[2], v1[3]);
                    *(u32x4*)(rowp + bj * HALF) = w; } }
    }
};

template <class Epi, class Sched, bool ALIGN_EPI = false, bool SP2 = false>
__device__ __forceinline__ void gemm_phase(PG8_LAS unsigned char* lds, const Gemm g, const Sched& S, const Epi& E) {
    const int tid = threadIdx.x, wid = __builtin_amdgcn_readfirstlane(tid >> 6), lane = tid & 63, wr = wid >> 2, wc = wid & 3, fr = lane & 15, fq = lane >> 4;
    const int K = g.K, nt = K / BK;
    unsigned voffA[2], voffB[2];
#pragma unroll
    for (int i = 0; i < 2; ++i) { int R, C; stage_rc(tid * 16 + i * 8192, R, C); const int Rb = Epi::PERM ? ((R & ~31) + perm32(R & 31)) : R;
        voffA[i] = (unsigned)(R * K + C) * 2u; voffB[i] = (unsigned)(Rb * K + C) * 2u; }
    const size_t kstep = (size_t)(BK * 2);
    const size_t hstep = (size_t)HALF * K * 2;
    const size_t tstep = 2 * hstep;
    const unsigned ldsw = (unsigned)wid * 1024u;
    const int aoff = lds_byte(wr * 64 + fr, fq * 8), boff = lds_byte(wc * 32 + fr, fq * 8);
#define PG8_SA(b, h) (((b) * 2 + (h)) * HTB)
#define PG8_SB(b, h) ((4 + (b) * 2 + (h)) * HTB)
#define PG8_STAGE(bufoff, gbase, voff) do { _Pragma("unroll") for (int _i = 0; _i < 2; ++_i) \
        __builtin_amdgcn_global_load_lds((const unsigned*)((const char*)(gbase) + (voff)[_i]), (PG8_LAS unsigned*)(lds + (bufoff) + ldsw + _i * 8192), 16, 0, 0); } while (0)
#define PG8_LDA(dst, b, h) do { _Pragma("unroll") for (int m = 0; m < 4; ++m) _Pragma("unroll") for (int k = 0; k < 2; ++k) dst[m][k] = *(const PG8_LAS bf16x8*)(lds + PG8_SA(b, h) + aoff + m * 2048 + k * 1024); } while (0)
#define PG8_LDB(dst, b, h) do { _Pragma("unroll") for (int n = 0; n < 2; ++n) _Pragma("unroll") for (int k = 0; k < 2; ++k) dst[n][k] = *(const PG8_LAS bf16x8*)(lds + PG8_SB(b, h) + boff + n * 2048 + k * 1024); } while (0)
#define PG8_MMA(ai, bj, At, Bt) do { __builtin_amdgcn_s_setprio(1); _Pragma("unroll") for (int m = 0; m < 4; ++m) _Pragma("unroll") for (int n = 0; n < 2; ++n) _Pragma("unroll") for (int k = 0; k < 2; ++k) \
        acc[ai][bj][m][n] = __builtin_amdgcn_mfma_f32_16x16x32_bf16(Bt[n][k], At[m][k], acc[ai][bj][m][n], 0, 0, 0); __builtin_amdgcn_s_setprio(0); } while (0)
#define PG8_WAIT_V(n) asm volatile("s_waitcnt vmcnt(" #n ")" ::: "memory")
#define PG8_WAIT_L(n) asm volatile("s_waitcnt lgkmcnt(" #n ")" ::: "memory")
#define PG8_BAR __builtin_amdgcn_s_barrier()
#define PG8_SCHED __builtin_amdgcn_sched_barrier(0)
    Unit cur, nxt; int ui = 0;
    if (!S.next(0, cur)) return;
    f32x4 acc[2][2][4][2];
#pragma unroll
    for (int a = 0; a < 2; ++a)
#pragma unroll
        for (int b = 0; b < 2; ++b)
#pragma unroll
            for (int m = 0; m < 4; ++m)
#pragma unroll
                for (int n = 0; n < 2; ++n) acc[a][b][m][n] = (f32x4){0.f, 0.f, 0.f, 0.f};
    bf16x8 At[4][2], B0[2][2], B1[2][2];
    const char* cA = (const char*)g.A + (size_t)cur.pm * tstep; const char* cB = (const char*)g.Bt + (size_t)cur.pn * tstep;
    S.a_ready(cur);
    if constexpr (SP2) {
        PG8_STAGE(PG8_SB(0, 0), cB, voffB); PG8_STAGE(PG8_SB(0, 1), cB + hstep, voffB); PG8_STAGE(PG8_SA(0, 0), cA, voffA); PG8_STAGE(PG8_SA(0, 1), cA + hstep, voffA);
        if (wr == 1) PG8_BAR;
        PG8_WAIT_V(2); PG8_BAR;
        PG8_STAGE(PG8_SB(1, 0), cB + kstep, voffB); PG8_STAGE(PG8_SA(1, 0), cA + kstep, voffA); PG8_STAGE(PG8_SB(1, 1), cB + hstep + kstep, voffB);
        PG8_WAIT_V(6); PG8_BAR;
    } else {
        PG8_STAGE(PG8_SB(0, 0), cB, voffB); PG8_STAGE(PG8_SA(0, 0), cA, voffA); PG8_STAGE(PG8_SB(0, 1), cB + hstep, voffB); PG8_STAGE(PG8_SA(0, 1), cA + hstep, voffA);
        if (wr == 1) PG8_BAR;
        PG8_WAIT_V(4); PG8_BAR;
        PG8_STAGE(PG8_SB(1, 0), cB + kstep, voffB); PG8_STAGE(PG8_SA(1, 0), cA + kstep, voffA); PG8_STAGE(PG8_SB(1, 1), cB + hstep + kstep, voffB);
        PG8_WAIT_V(6); PG8_BAR;
    }
    for (;;) {
        const bool has_next = S.next(ui + 1, nxt);
        const char* nA = has_next ? (const char*)g.A + (size_t)nxt.pm * tstep : cA; const char* nB = has_next ? (const char*)g.Bt + (size_t)nxt.pn * tstep : cB;
        for (int t = 0; t < nt; t += 2) {
            const bool last = (t == nt - 2);
            const char* a1 = cA + (size_t)(t + 1) * kstep;
            const char* a2 = last ? nA : cA + (size_t)(t + 2) * kstep; const char* b2 = last ? nB : cB + (size_t)(t + 2) * kstep;
            const char* a3 = a2 + kstep; const char* b3 = b2 + kstep;
            if (last && has_next) S.a_ready(nxt);
            if constexpr (SP2) {
            PG8_LDB(B0, 0, 0); PG8_LDB(B1, 0, 1); PG8_SCHED; PG8_LDA(At, 0, 0); PG8_STAGE(PG8_SA(1, 1), a1 + hstep, voffA);
            PG8_WAIT_V(8); PG8_WAIT_L(0); PG8_BAR; PG8_MMA(0, 0, At, B0); PG8_MMA(0, 1, At, B1); PG8_BAR; PG8_SCHED;
            PG8_LDA(At, 0, 1); PG8_STAGE(PG8_SB(0, 0), b2, voffB); PG8_STAGE(PG8_SB(0, 1), b2 + hstep, voffB); PG8_STAGE(PG8_SA(0, 0), a2, voffA);
            PG8_WAIT_V(8); PG8_WAIT_L(0); PG8_BAR; PG8_MMA(1, 0, At, B0); PG8_MMA(1, 1, At, B1); PG8_BAR; PG8_SCHED;
            PG8_LDB(B0, 1, 0); PG8_LDB(B1, 1, 1); PG8_SCHED; PG8_LDA(At, 1, 0); PG8_STAGE(PG8_SA(0, 1), a2 + hstep, voffA);
            PG8_WAIT_V(8); PG8_WAIT_L(0); PG8_BAR; PG8_MMA(0, 0, At, B0); PG8_MMA(0, 1, At, B1); PG8_BAR; PG8_SCHED;
            PG8_LDA(At, 1, 1); PG8_STAGE(PG8_SB(1, 0), b3, voffB); PG8_STAGE(PG8_SB(1, 1), b3 + hstep, voffB); PG8_STAGE(PG8_SA(1, 0), a3, voffA);
            PG8_WAIT_V(8); PG8_WAIT_L(0); PG8_BAR; PG8_MMA(1, 0, At, B0); PG8_MMA(1, 1, At, B1); PG8_BAR; PG8_SCHED;
            } else {
            PG8_LDB(B0, 0, 0); PG8_SCHED; PG8_LDA(At, 0, 0); PG8_STAGE(PG8_SA(1, 1), a1 + hstep, voffA);
            PG8_WAIT_L(8); PG8_BAR; PG8_WAIT_L(0); PG8_MMA(0, 0, At, B0); PG8_BAR; PG8_SCHED;
            PG8_LDB(B1, 0, 1); PG8_STAGE(PG8_SB(0, 0), b2, voffB);
            PG8_BAR; PG8_WAIT_L(0); PG8_MMA(0, 1, At, B1); PG8_BAR;
            PG8_LDA(At, 0, 1); PG8_STAGE(PG8_SA(0, 0), a2, voffA);
            PG8_BAR; PG8_WAIT_L(0); PG8_MMA(1, 0, At, B0); PG8_BAR; PG8_SCHED;
            PG8_STAGE(PG8_SB(0, 1), b2 + hstep, voffB);
            PG8_WAIT_V(6); PG8_BAR; PG8_MMA(1, 1, At, B1); PG8_BAR;
            PG8_LDB(B0, 1, 0); PG8_SCHED; PG8_LDA(At, 1, 0); PG8_STAGE(PG8_SA(0, 1), a2 + hstep, voffA);
            PG8_WAIT_L(8); PG8_BAR; PG8_WAIT_L(0); PG8_MMA(0, 0, At, B0); PG8_BAR; PG8_SCHED;
            PG8_LDB(B1, 1, 1); PG8_STAGE(PG8_SB(1, 0), b3, voffB);
            PG8_BAR; PG8_WAIT_L(0); PG8_MMA(0, 1, At, B1); PG8_BAR;
            PG8_LDA(At, 1, 1); PG8_STAGE(PG8_SA(1, 0), a3, voffA);
            PG8_BAR; PG8_WAIT_L(0); PG8_MMA(1, 0, At, B0); PG8_BAR; PG8_SCHED;
            PG8_STAGE(PG8_SB(1, 1), b3 + hstep, voffB);
            PG8_WAIT_V(6); PG8_BAR; PG8_MMA(1, 1, At, B1); PG8_BAR;
            }
        }
        if constexpr (ALIGN_EPI) { if (wr == 0) PG8_BAR; }
        if constexpr (!Epi::AFTER_DRAIN) { E(acc, cur, wr, wc, fr, fq); S.done(cur); }
        if (!has_next) break;
#pragma unroll
        for (int a = 0; a < 2; ++a)
#pragma unroll
            for (int b = 0; b < 2; ++b)
#pragma unroll
                for (int m = 0; m < 4; ++m)
#pragma unroll
                    for (int n = 0; n < 2; ++n) acc[a][b][m][n] = (f32x4){0.f, 0.f, 0.f, 0.f};
        cur = nxt; cA = nA; cB = nB; ++ui;
        if constexpr (ALIGN_EPI) { if (wr == 1) PG8_BAR; }
    }
    PG8_WAIT_V(0);
    if constexpr (!ALIGN_EPI) { if (wr == 0) PG8_BAR; }
    PG8_BAR;
    if constexpr (Epi::AFTER_DRAIN) { E.fused(acc, cur, wr, wc, fr, fq, lds, wid, lane); S.done(cur); }
#undef PG8_SA
#undef PG8_SB
#undef PG8_STAGE
#undef PG8_LDA
#undef PG8_LDB
#undef PG8_MMA
#undef PG8_WAIT_V
#undef PG8_WAIT_L
#undef PG8_BAR
#undef PG8_SCHED
}
struct EpiSwiglu {
    static constexpr bool PERM = true, AFTER_DRAIN = false;
    bf16_t* H; int ldh;
    __device__ __forceinline__ void operator()(const f32x4 (&acc)[2][2][4][2], const Unit& u, int wr, int wc, int fr, int fq) const {
        const int row0 = u.pm * BM + wr * 64 + fr, col0 = u.pn * HALF + wc * 32 + 8 * fq;
#pragma unroll
        for (int ai = 0; ai < 2; ++ai)
#pragma unroll
            for (int m = 0; m < 4; ++m) {
                bf16_t* p = H + (size_t)(row0 + ai * HALF + m * 16) * ldh + col0;
                float h[8];
#pragma unroll
                for (int n = 0; n < 2; ++n)
#pragma unroll
                    for (int i = 0; i < 4; ++i) { const float g = acc[ai][0][m][n][i], up = acc[ai][1][m][n][i];
                        h[n * 4 + i] = g * __builtin_amdgcn_rcpf(1.0f + __expf(-g)) * up; }
                u32x4 w; w.x = cvt_pk_bf16(h[0], h[1]); w.y = cvt_pk_bf16(h[2], h[3]); w.z = cvt_pk_bf16(h[4], h[5]); w.w = cvt_pk_bf16(h[6], h[7]);
                *(u32x4*)p = w;
            }
    }
};
struct EpiResid {
    static constexpr bool PERM = false, AFTER_DRAIN = false;
    const float* xp; const float* xs; float* X; const float* gt; float alpha, gs;
    __device__ __forceinline__ void operator()(const f32x4 (&acc)[2][2][4][2], const Unit& u, int wr, int wc, int fr, int fq) const {
        const int col0 = u.pn * BM + wc * 32 + 4 * fq;
#pragma unroll
        for (int ai = 0; ai < 2; ++ai)
#pragma unroll
            for (int m = 0; m < 4; ++m) {
                const int row = u.pm * BM + ai * HALF + wr * 64 + m * 16 + fr;
                const bool smp = row >= 16384;
                const float* xr = smp ? xs + (size_t)(row - 16384) * 1024 : xp + (size_t)row * 1024;
                const int b = smp ? 2 + ((row - 16384) >> 3) : (row >> 13);
                const float* gr = gt + (size_t)b * 9216;
                float* xo = X + (size_t)row * 1024;
#pragma unroll
                for (int bj = 0; bj < 2; ++bj)
#pragma unroll
                    for (int n = 0; n < 2; ++n) { const int c = col0 + bj * HALF + n * 16;
                        const f32x4 xv = *(const f32x4*)(xr + c), gv = *(const f32x4*)(gr + c);
                        const f32x4 z = xv * alpha + (gv + 1.0f) * gs * acc[ai][bj][m][n];
                        *(f32x4*)(xo + c) = z; }
            }
    }
};
}
#define GAS __attribute__((address_space(1)))
#define LAS __attribute__((address_space(3)))
typedef unsigned short bf16;
typedef unsigned v4u __attribute__((ext_vector_type(4)));
typedef float f32x4 __attribute__((ext_vector_type(4)));
typedef short bf16x8 __attribute__((ext_vector_type(8)));
typedef GAS unsigned gu32;
typedef GAS unsigned long long gu64;
#define RLX_AGENT __ATOMIC_RELAXED, __HIP_MEMORY_SCOPE_AGENT
#define LDS_WAIT() asm volatile("s_waitcnt lgkmcnt(0)" ::: "memory")
#define VM_WAIT() asm volatile("s_waitcnt vmcnt(0)" ::: "memory")
__device__ __forceinline__ unsigned long long rt() { return __builtin_amdgcn_s_memrealtime(); }
__device__ __forceinline__ unsigned f2bf(float f) { unsigned u = __builtin_bit_cast(unsigned, f); return (u + 0x7fffu + ((u >> 16) & 1u)) >> 16; }
__device__ __forceinline__ unsigned pk2(float lo, float hi) { return f2bf(lo) | (f2bf(hi) << 16); }

#define XB_TMO      128
#define XB_XCNT(j)  (256  + 64 * (j))
#define XB_XSUB(j)  (1280 + 64 * (j))
#define XB_XGEN(j)  (2304 + 64 * (j))
#define XB_TOP      3328
#define XB_TOPGEN   3392
#define XCD_BAR_WORDS 3456
#define XB_SPIN_CAP (1u << 18)

__device__ __forceinline__ unsigned xb_ld(unsigned* p)              { return __hip_atomic_load(p, __ATOMIC_RELAXED, __HIP_MEMORY_SCOPE_AGENT); }
__device__ __forceinline__ unsigned xb_add(unsigned* p, unsigned v) { return __hip_atomic_fetch_add(p, v, __ATOMIC_RELAXED, __HIP_MEMORY_SCOPE_AGENT); }
__device__ __forceinline__ unsigned xb_xcc_id() { return (unsigned)__builtin_amdgcn_s_getreg((3 << 11) | 20) & 0xFu; }
#define XB_SPIN(cond, bar) do { unsigned _sp = 0; while (cond) { __builtin_amdgcn_s_sleep(1); \
    if ((++_sp & 255u) == 0u) { if (xb_ld(&(bar)[XB_TMO])) break; if (_sp > XB_SPIN_CAP) { atomicAdd(&(bar)[XB_TMO], 1u); break; } } } } while (0)

struct XcdBarrier {
    unsigned* bar; unsigned x;
    volatile LAS unsigned* st;
};

__device__ __forceinline__ XcdBarrier xcd_barrier_post(unsigned* bar, volatile LAS unsigned* st) {
    XcdBarrier b; b.bar = bar; b.x = xb_xcc_id(); b.st = st;
    if (threadIdx.x == 0) (void)xb_add(&bar[XB_XCNT(b.x)], 1u);
    return b;
}
__device__ __forceinline__ void xcd_barrier_complete(unsigned* bar, unsigned x, unsigned& nloc, unsigned& nx) {
    const unsigned G = gridDim.x * gridDim.y * gridDim.z;
    unsigned sum, cnt, mine, sp = 0u;
    for (;;) {
        sum = 0u; cnt = 0u; mine = 0u;
#pragma unroll
        for (unsigned j = 0; j < 16; ++j) { const unsigned c = xb_ld(&bar[XB_XCNT(j)]); sum += c; cnt += (c > 0u) ? 1u : 0u; mine = (j == x) ? c : mine; }
        if (sum == G) break;
        __builtin_amdgcn_s_sleep(1);
        if ((++sp & 255u) == 0u) { if (xb_ld(&bar[XB_TMO])) break; if (sp > XB_SPIN_CAP) { atomicAdd(&bar[XB_TMO], 1u); break; } }
    }
    nloc = mine > 0u ? mine : 1u; nx = cnt > 0u ? cnt : 1u;
}

__device__ __forceinline__ void xcd_barrier(const XcdBarrier& b) {
    asm volatile("s_waitcnt vmcnt(0)" ::: "memory");
    __syncthreads();
    if (threadIdx.x == 0) {
        unsigned* bar = b.bar;
        __builtin_amdgcn_s_waitcnt(0);
        unsigned nloc = b.st[0], nx = b.st[1];
        if (nloc == 0u) { xcd_barrier_complete(bar, b.x, nloc, nx); b.st[0] = nloc; b.st[1] = nx; }
        const unsigned old = xb_add(&bar[XB_XSUB(b.x)], 1u);
        const unsigned gen = old / nloc;
        if (old + 1u == (gen + 1u) * nloc) {
            __builtin_amdgcn_fence(__ATOMIC_RELEASE, "agent");
            asm volatile("s_waitcnt vmcnt(0)" ::: "memory");
            const unsigned og = xb_add(&bar[XB_TOP], 1u);
            const unsigned tg = og / nx;
            if (og + 1u == (tg + 1u) * nx) xb_add(&bar[XB_TOPGEN], 1u);
            else XB_SPIN(xb_ld(&bar[XB_TOPGEN]) == tg, bar);
            __builtin_amdgcn_fence(__ATOMIC_ACQUIRE, "agent");
            xb_add(&bar[XB_XGEN(b.x)], 1u);
            asm volatile("s_waitcnt vmcnt(0)" ::: "memory");
        } else {
            XB_SPIN(xb_ld(&bar[XB_XGEN(b.x)]) == gen, bar);
            __builtin_amdgcn_fence(__ATOMIC_ACQUIRE, "agent");
            asm volatile("s_waitcnt vmcnt(0)" ::: "memory");
        }
    }
    __syncthreads();
}

constexpr int D = 1024, FF = 2816, NFF = 2 * FF, NIN = 2560, RW = 512, RWP = 1792;
constexpr int MP = 16384, MS = 1024, M = MP + MS, TP = 8192, TS = 8, NBS = 128;
constexpr int MODW = 9216, NMOD = 130;
constexpr float ALPHA = 1.189207115002721f;
constexpr float LN_EPS = 1e-5f, GN_EPS = 64e-5f;
constexpr int NWAVES = 8;
enum { I_XP = 0, I_XS, I_SWKV, I_SSHIFT, I_CK, I_CV, I_CP, I_CS, I_RELB, I_WADA, I_BADA, I_LNG, I_LNB, I_W1IN, I_W1OUT, I_WIN, I_MU, I_W0, I_WDEC, I_A0, I_WICLR, I_WGATE,
       I_KK, I_KA, I_RK, I_GNW, I_GNB, I_SINKS, I_WOUT, I_W2IN, I_W2OUT, N_IN };
constexpr size_t O_Y = 0, O_WKV_P = (size_t)M * D, O_SHIFT_P = O_WKV_P + 65536, O_WINK_P = O_SHIFT_P + 3584, O_WINV_P = O_WINK_P + 32768,
                 O_WKV_S = O_WINV_P + 32768, O_SHIFT_S = O_WKV_S + 4194304, O_WINK_S = O_SHIFT_S + 229376, O_WINV_S = O_WINK_S + 2097152, O_END = O_WINV_S + 2097152;
static_assert(O_END == 26578432, "d_out size");
constexpr size_t MiB = 1u << 20;
constexpr size_t WS_CTL = 0, CTL_ZERO_BYTES = 1 * MiB;
constexpr size_t WS_W1IN = 2 * MiB, WS_W1OUT = 13 * MiB, WS_WIN = 19 * MiB, WS_WOUT = 24 * MiB, WS_W2IN = 26 * MiB, WS_W2OUT = 37 * MiB;
constexpr size_t WS_MOD = 43 * MiB;
constexpr size_t WS_U = 48 * MiB;
constexpr size_t WS_H = 82 * MiB;
constexpr size_t WS_WLOG = 176 * MiB, WS_A = 210 * MiB, WS_G = 227 * MiB, WS_INV = 244 * MiB, WS_END = 245 * MiB;
static_assert(WS_W1IN + (size_t)NFF * D * 2 <= WS_W1OUT && WS_W1OUT + (size_t)D * FF * 2 <= WS_WIN && WS_WIN + (size_t)NIN * D * 2 <= WS_WOUT && WS_WOUT + (size_t)D * D * 2 <= WS_W2IN &&
              WS_W2IN + (size_t)NFF * D * 2 <= WS_W2OUT && WS_W2OUT + (size_t)D * FF * 2 <= WS_MOD && WS_MOD + (size_t)NMOD * MODW * 4 <= WS_U && WS_U + (size_t)M * D * 2 <= WS_H &&
              WS_H + (size_t)M * FF * 2 <= WS_WLOG && WS_WLOG + (size_t)M * RW * 4 <= WS_A && WS_A + (size_t)M * RW * 2 <= WS_G && WS_G + (size_t)M * RW * 2 <= WS_INV &&
              WS_INV + (size_t)M * 8 * 4 <= WS_END && WS_END <= 256 * MiB, "d_ws map");
constexpr int CW_BAR = 4096;
constexpr int RING_OFF = 0, RING_BYTES = 151552;
constexpr int LDSCTL_OFF = RING_BYTES, MISC_OFF = LDSCTL_OFF + 320;
constexpr int LDS_BYTES = 155648;
static_assert(MISC_OFF + 128 <= LDS_BYTES, "LDS map");

__device__ __forceinline__ float bf2f(unsigned short h) { return __uint_as_float((unsigned)h << 16); }
__device__ __forceinline__ float bflo(unsigned u) { return __uint_as_float(u << 16); }
__device__ __forceinline__ float bfhi(unsigned u) { return __uint_as_float(u & 0xffff0000u); }
__device__ __forceinline__ float wave_sum(float v) {
#pragma unroll
    for (int o = 1; o < 64; o <<= 1) v += __shfl_xor(v, o);
    return v;
}
template <int CTRL> __device__ __forceinline__ float dppf(float x) { return __builtin_bit_cast(float, __builtin_amdgcn_update_dpp(0, __builtin_bit_cast(int, x), CTRL, 0xf, 0xf, true)); }
__device__ __forceinline__ float sum8(float x) {
    x += dppf<0xB1>(x);
    x += dppf<0x4E>(x);
    x += dppf<0x141>(x);
    return x;
}
__device__ __forceinline__ float sigmoidf_(float x) { return 1.0f / (1.0f + expf(-x)); }

struct Args { const float* in[N_IN]; float* out; unsigned char* ws; int ph_lo, ph_hi; };
static_assert(sizeof(Args) == N_IN * 8 + 24, "Args has no padding");
struct Frame {
    LAS unsigned char* lds;
    volatile LAS unsigned* MISC;
    gu32* ctl;
    int tid, lane, wave, vcu, G;
    const Args* a;
};
#define WSP(T, off) ((T*)(F.a->ws + (off)))

__device__ __forceinline__ void p0_transpose_item(const float* W, int K, int N, bf16* WT, int dst_row0, int k0, int n0, LAS float* scr, int lane) {
#pragma unroll 8
    for (int i = 0; i < 32; ++i) { const int kk = 2 * i + (lane >> 5); scr[kk * 33 + (lane & 31)] = W[(size_t)(k0 + kk) * N + n0 + (lane & 31)]; }
    LDS_WAIT(); asm volatile("" ::: "memory");
    const int c = lane & 7;
#pragma unroll
    for (int j = 0; j < 4; ++j) { const int n = (lane >> 3) + 8 * j; const LAS float* s = scr + (8 * c) * 33 + n;
        v4u o; o.x = pk2(s[0 * 33], s[1 * 33]); o.y = pk2(s[2 * 33], s[3 * 33]); o.z = pk2(s[4 * 33], s[5 * 33]); o.w = pk2(s[6 * 33], s[7 * 33]);
        *(GAS v4u*)(WT + (size_t)(dst_row0 + n) * K + k0 + 8 * c) = o; }
    LDS_WAIT(); asm volatile("" ::: "memory");
}
__device__ __forceinline__ void p0_ffin_item(const float* W, bf16* WT, int r, LAS float* scr, int lane) {
    const int kb = r / 176, nb = r % 176, n0 = 32 * nb; const bool up = n0 >= FF; const int j = up ? n0 - FF : n0;
    p0_transpose_item(W, D, NFF, WT, (j >> 7) * 256 + (up ? 128 : 0) + (j & 127), 64 * kb, n0, scr, lane);
}
__device__ __forceinline__ void p0_plain_item(const float* W, int K, int N, bf16* WT, int r, LAS float* scr, int lane) {
    const int nblk = N / 32, kb = r / nblk, nb = r % nblk;
    p0_transpose_item(W, K, N, WT, 32 * nb, 64 * kb, 32 * nb, scr, lane);
}
__device__ __forceinline__ void p0_weights(Frame& F) {
    LAS float* scr = (LAS float*)(F.lds + RING_OFF + F.wave * 16384);
    const int gw = F.vcu * NWAVES + F.wave, NGW = F.G * NWAVES;
    constexpr int I_FI = 16 * 176, I_FO = 44 * 32, I_IN = 16 * 80, I_O = 16 * 32, NITEMS = 2 * I_FI + 2 * I_FO + I_IN + I_O;
    for (int it = gw; it < NITEMS; it += NGW) {
        int r = it;
        if (r < I_FI) { p0_ffin_item(F.a->in[I_W1IN], WSP(bf16, WS_W1IN), r, scr, F.lane); continue; } r -= I_FI;
        if (r < I_FI) { p0_ffin_item(F.a->in[I_W2IN], WSP(bf16, WS_W2IN), r, scr, F.lane); continue; } r -= I_FI;
        if (r < I_FO) { p0_plain_item(F.a->in[I_W1OUT], FF, D, WSP(bf16, WS_W1OUT), r, scr, F.lane); continue; } r -= I_FO;
        if (r < I_FO) { p0_plain_item(F.a->in[I_W2OUT], FF, D, WSP(bf16, WS_W2OUT), r, scr, F.lane); continue; } r -= I_FO;
        if (r < I_IN) { p0_plain_item(F.a->in[I_WIN], D, NIN, WSP(bf16, WS_WIN), r, scr, F.lane); continue; } r -= I_IN;
        p0_plain_item(F.a->in[I_WOUT], D, D, WSP(bf16, WS_WOUT), r, scr, F.lane);
    }
}
__device__ __forceinline__ void p0_mod(Frame& F) {
    constexpr int SCP = 172;
    LAS float* sc = (LAS float*)(F.lds);
    LAS float* red = (LAS float*)(F.lds + 64 * SCP * 4);
    const float* wada = F.a->in[I_WADA]; const float* bada = F.a->in[I_BADA]; const float* cp = F.a->in[I_CP]; const float* cs = F.a->in[I_CS];
    float* mod = WSP(float, WS_MOD);
    const int tid = F.tid; const bool act = tid < 504; const int q = act ? tid / 126 : 3, r = act ? tid % 126 : 125, g = r / 9, cg = r % 9;
    for (int task = blockIdx.x; task < MODW / 36; task += F.G) {
        const int j0 = 36 * task + 4 * cg;
        float acc[10][4];
#pragma unroll
        for (int s = 0; s < 10; ++s)
#pragma unroll
            for (int jj = 0; jj < 4; ++jj) acc[s][jj] = 0.f;
        for (int ch = 0; ch < 16; ++ch) {
            __syncthreads();
            for (int idx = tid; idx < 64 * NMOD; idx += 512) {
                const int b = idx >> 6, e = idx & 63, i = 256 * (e >> 4) + 16 * ch + (e & 15);
                const float c = b < 2 ? cp[b * D + i] : cs[(b - 2) * D + i];
                sc[e * SCP + (b % 14) * 12 + b / 14] = c / (1.0f + expf(-c));
            }
            __syncthreads();
            if (act) {
#pragma unroll 4
                for (int ii = 0; ii < 16; ++ii) {
                    const int i = 256 * q + 16 * ch + ii;
                    const f32x4 w = *(const f32x4*)(wada + (size_t)i * MODW + j0);
                    const LAS f32x4* sp = (const LAS f32x4*)(sc + (q * 16 + ii) * SCP + g * 12);
                    const f32x4 s0 = sp[0], s1 = sp[1], s2 = sp[2];
                    const float sv[10] = {s0[0], s0[1], s0[2], s0[3], s1[0], s1[1], s1[2], s1[3], s2[0], s2[1]};
#pragma unroll
                    for (int s = 0; s < 10; ++s)
#pragma unroll
                        for (int jj = 0; jj < 4; ++jj) acc[s][jj] += sv[s] * w[jj];
                }
            }
        }
        __syncthreads();
        if (act && q > 0) {
#pragma unroll
            for (int s = 0; s < 10; ++s)
#pragma unroll
                for (int jj = 0; jj < 4; ++jj) red[((q - 1) * 40 + s * 4 + jj) * 126 + r] = acc[s][jj];
        }
        __syncthreads();
        if (act && q == 0) {
            const f32x4 bb = *(const f32x4*)(bada + j0);
#pragma unroll
            for (int s = 0; s < 10; ++s) { const int b = g + 14 * s;
                if (b < NMOD) { f32x4 o;
#pragma unroll
                    for (int jj = 0; jj < 4; ++jj) { const int k = s * 4 + jj; o[jj] = acc[s][jj] + red[(0 * 40 + k) * 126 + r] + red[(1 * 40 + k) * 126 + r] + red[(2 * 40 + k) * 126 + r] + bb[jj]; }
                    *(f32x4*)(mod + (size_t)b * MODW + j0) = o; } }
        }
    }
    __syncthreads();
}

__device__ __forceinline__ int mod_row_of(int m) { return m < MP ? (m >> 13) : 2 + ((m - MP) >> 3); }
__device__ __forceinline__ void p_modulate0(Frame& F) {
    const int gw = F.vcu * NWAVES + F.wave, NGW = F.G * NWAVES;
    const float* mod = WSP(float, WS_MOD); bf16* U = WSP(bf16, WS_U);
    for (int m = gw; m < M; m += NGW) {
        const float* xr = m < MP ? F.a->in[I_XP] + (size_t)m * D : F.a->in[I_XS] + (size_t)(m - MP) * D;
        const float* mr = mod + (size_t)mod_row_of(m) * MODW;
        unsigned long long* o8 = (unsigned long long*)(U + (size_t)m * D) + F.lane;
#pragma unroll
        for (int j = 0; j < 4; ++j) { const int c = 4 * F.lane + 256 * j;
            const f32x4 x = *(const f32x4*)(xr + c), sh = *(const f32x4*)(mr + c), sc = *(const f32x4*)(mr + D + c);
            const f32x4 u = x * (sc + 1.0f) + sh;
            o8[64 * j] = (unsigned long long)pk2(u[0], u[1]) | ((unsigned long long)pk2(u[2], u[3]) << 32); }
    }
}
__device__ __forceinline__ void p_layernorm(Frame& F, int lnidx, int koff) {
    const int gw = F.vcu * NWAVES + F.wave, NGW = F.G * NWAVES;
    const float* mod = WSP(float, WS_MOD); bf16* U = WSP(bf16, WS_U); float* X = F.a->out + O_Y;
    const float* lg = F.a->in[I_LNG] + lnidx * D; const float* lb = F.a->in[I_LNB] + lnidx * D;
    for (int m = gw; m < M; m += NGW) {
        float* xr = X + (size_t)m * D;
        f32x4 v[4]; float s = 0.f;
#pragma unroll
        for (int j = 0; j < 4; ++j) { v[j] = *(const f32x4*)(xr + 4 * F.lane + 256 * j); s += (v[j][0] + v[j][1]) + (v[j][2] + v[j][3]); }
        const float mean = wave_sum(s) * (1.f / D); float s2 = 0.f;
#pragma unroll
        for (int j = 0; j < 4; ++j) { v[j] = v[j] - mean; s2 += (v[j][0] * v[j][0] + v[j][1] * v[j][1]) + (v[j][2] * v[j][2] + v[j][3] * v[j][3]); }
        const float rstd = 1.f / sqrtf(wave_sum(s2) * (1.f / D) + LN_EPS);
        const float* mr = mod + (size_t)mod_row_of(m) * MODW + (koff >= 0 ? koff : 0);
        unsigned long long* o8 = (unsigned long long*)(U + (size_t)m * D) + F.lane;
#pragma unroll
        for (int j = 0; j < 4; ++j) { const int c = 4 * F.lane + 256 * j;
            const f32x4 x = v[j] * rstd * *(const f32x4*)(lg + c) + *(const f32x4*)(lb + c);
            *(f32x4*)(xr + c) = x;
            if (koff >= 0) { const f32x4 sh = *(const f32x4*)(mr + c), sc = *(const f32x4*)(mr + D + c); const f32x4 u = x * (sc + 1.0f) + sh;
                o8[64 * j] = (unsigned long long)pk2(u[0], u[1]) | ((unsigned long long)pk2(u[2], u[3]) << 32); } }
    }
}
__device__ __forceinline__ float prev_val(const bf16* P, const float* sshift, int m, int col) {
    if (m < MP) return (m & (TP - 1)) == 0 ? 0.f : bf2f(P[(size_t)(m - 1) * NIN + col]);
    const int ms = m - MP;
    return (ms & (TS - 1)) == 0 ? sshift[(size_t)(ms >> 3) * RWP + col] : bf2f(P[(size_t)(m - 1) * NIN + col]);
}
__device__ __forceinline__ void p_prep(Frame& F) {
    LAS float* L = (LAS float*)F.lds;
    const bf16* P = WSP(bf16, WS_H); const float* sshift = F.a->in[I_SSHIFT]; const float* mu = F.a->in[I_MU];
    const float* wdec = F.a->in[I_WDEC]; const float* wiclr = F.a->in[I_WICLR]; const float* wgate = F.a->in[I_WGATE];
    float* WLOG = WSP(float, WS_WLOG); bf16* AA = WSP(bf16, WS_A); bf16* GG = WSP(bf16, WS_G); float* INV = WSP(float, WS_INV);
    const int c = F.tid;
    const float w0c = F.a->in[I_W0][c], a0c = F.a->in[I_A0][c], kkc = F.a->in[I_KK][c], muk = mu[RW + c];
    for (int tb = F.vcu; tb < M / 16; tb += F.G) {
        const int m0 = tb * 16;
        __syncthreads();
#pragma unroll
        for (int k = 0; k < 8; ++k) { const int idx = F.tid + 512 * k, i = idx & 15, j = idx >> 4, m = m0 + i, col = 1536 + j;
            const float p = bf2f(P[(size_t)m * NIN + col]), pv = prev_val(P, sshift, m, col), xs = p + (pv - p) * mu[col];
            L[j * 16 + i] = j < 64 ? tanhf(xs) : (j < 128 ? xs : sigmoidf_(xs)); }
        __syncthreads();
        float aw[16], aa[16], ag[16];
#pragma unroll
        for (int i = 0; i < 16; ++i) { aw[i] = 0.f; aa[i] = 0.f; ag[i] = 0.f; }
#pragma unroll 2
        for (int j = 0; j < 64; ++j) {
            const float wd = wdec[j * RW + c], wi = wiclr[j * RW + c];
            const LAS f32x4* lw = (const LAS f32x4*)(L + j * 16); const LAS f32x4* la = (const LAS f32x4*)(L + (64 + j) * 16);
#pragma unroll
            for (int qq = 0; qq < 4; ++qq) { const f32x4 tw = lw[qq], ta = la[qq];
#pragma unroll
                for (int e = 0; e < 4; ++e) { aw[qq * 4 + e] += wd * tw[e]; aa[qq * 4 + e] += wi * ta[e]; } }
        }
#pragma unroll 2
        for (int j = 0; j < 128; ++j) {
            const float wg = wgate[j * RW + c];
            const LAS f32x4* lg = (const LAS f32x4*)(L + (128 + j) * 16);
#pragma unroll
            for (int qq = 0; qq < 4; ++qq) { const f32x4 tg = lg[qq];
#pragma unroll
                for (int e = 0; e < 4; ++e) ag[qq * 4 + e] += wg * tg[e]; }
        }
#pragma unroll
        for (int i = 0; i < 16; ++i) { const int m = m0 + i;
            const float z = w0c + aw[i];
            const float sp = fmaxf(-z, 0.f) + log1pf(expf(-fabsf(z)));
            WLOG[(size_t)m * RW + c] = -expf(-sp - 0.5f);
            AA[(size_t)m * RW + c] = (bf16)f2bf(sigmoidf_(a0c + aa[i]));
            GG[(size_t)m * RW + c] = (bf16)f2bf(ag[i]);
            const float pk = bf2f(P[(size_t)m * NIN + RW + c]), pvk = prev_val(P, sshift, m, RW + c), xk = pk + (pvk - pk) * muk, kq = xk * kkc;
            const float ss = wave_sum(kq * kq);
            if (F.lane == 0) INV[(size_t)m * 8 + F.wave] = 1.0f / fmaxf(sqrtf(ss), 1e-12f);
        }
    }
    const int gt = F.vcu * 512 + F.tid, NT = F.G * 512;
    const float* ck = F.a->in[I_CK]; const float* cv = F.a->in[I_CV];
    for (int i = gt; i < 2 * RWP; i += NT) { const int b = i / RWP, col = i % RWP; F.a->out[O_SHIFT_P + i] = bf2f(P[(size_t)(b * TP + TP - 1) * NIN + col]); }
    for (int i = gt; i < NBS * RWP; i += NT) { const int b = i / RWP, col = i % RWP; F.a->out[O_SHIFT_S + i] = bf2f(P[(size_t)(MP + b * TS + TS - 1) * NIN + col]); }
    for (int i = gt; i < 2 * 128 * 128; i += NT) { const int b = i >> 14, j = (i >> 7) & 127, c2 = i & 127; const size_t row = (size_t)(b * TP + TP - 128 + j) * NIN;
        F.a->out[O_WINK_P + i] = bf2f(P[row + 2304 + c2]); F.a->out[O_WINV_P + i] = bf2f(P[row + 2432 + c2]); }
    for (int i = gt; i < NBS * 128 * 128; i += NT) { const int b = i >> 14, j = (i >> 7) & 127, c2 = i & 127;
        if (j < 120) { F.a->out[O_WINK_S + i] = ck[(size_t)(b * 128 + j + 8) * 128 + c2]; F.a->out[O_WINV_S + i] = cv[(size_t)(b * 128 + j + 8) * 128 + c2]; }
        else { const size_t row = (size_t)(MP + b * TS + (j - 120)) * NIN; F.a->out[O_WINK_S + i] = bf2f(P[row + 2304 + c2]); F.a->out[O_WINV_S + i] = bf2f(P[row + 2432 + c2]); } }
}

constexpr int SC_R = 0, SC_DEC = 1, SC_KM = 2, SC_KK = 3, SC_BB = 4, SC_V = 5, SC_Y = 6;
__device__ __forceinline__ void scan_unit(Frame& F, int row0, int T, int h, const float* s_in, float* s_out) {
    LAS float* A = (LAS float*)F.lds;
    const bf16* P = WSP(bf16, WS_H); const float* sshift = F.a->in[I_SSHIFT]; const float* mu = F.a->in[I_MU];
    const float* WLOG = WSP(float, WS_WLOG); const bf16* AA = WSP(bf16, WS_A); const bf16* GG = WSP(bf16, WS_G); const float* INV = WSP(float, WS_INV);
    bf16* MIX = WSP(bf16, WS_U);
    const int lane = F.lane, wave = F.wave, rl = lane >> 3, ks = lane & 7, row = 8 * wave + rl;
    float S[8];
#pragma unroll
    for (int j = 0; j < 8; ++j) S[j] = s_in ? s_in[(size_t)row * 64 + 8 * ks + j] : 0.f;
    const int e_ = F.tid & 63, chn = h * 64 + e_;
    const float mur = mu[chn], muk = mu[RW + chn], muv = mu[2 * RW + chn], kkc = F.a->in[I_KK][chn], kac = F.a->in[I_KA][chn], rkc = F.a->in[I_RK][chn], gnw = F.a->in[I_GNW][chn], gnb = F.a->in[I_GNB][chn];
    for (int t0 = 0; t0 < T; t0 += 64) {
        const int nb = (T - t0) < 64 ? (T - t0) : 64;
        __syncthreads();
        for (int s = F.tid >> 6; s < nb; s += 8) {
            const int m = row0 + t0 + s;
            const size_t pr = (size_t)m * NIN;
            const float p_r = bf2f(P[pr + chn]), p_k = bf2f(P[pr + RW + chn]), p_v = bf2f(P[pr + 2 * RW + chn]);
            const float q_r = prev_val(P, sshift, m, chn), q_k = prev_val(P, sshift, m, RW + chn), q_v = prev_val(P, sshift, m, 2 * RW + chn);
            const float xr = p_r + (q_r - p_r) * mur, xk = p_k + (q_k - p_k) * muk, xv = p_v + (q_v - p_v) * muv;
            const float a = bf2f(AA[(size_t)m * RW + chn]), wl = WLOG[(size_t)m * RW + chn], inv = INV[(size_t)m * 8 + h];
            const float kk = xk * kkc * inv;
            A[SC_R * 4096 + s * 64 + e_] = xr; A[SC_DEC * 4096 + s * 64 + e_] = expf(wl); A[SC_KM * 4096 + s * 64 + e_] = xk * (1.0f + (a - 1.0f) * kac);
            A[SC_KK * 4096 + s * 64 + e_] = kk; A[SC_BB * 4096 + s * 64 + e_] = kk * a; A[SC_V * 4096 + s * 64 + e_] = xv;
        }
        __syncthreads();
        for (int s = 0; s < nb; ++s) {
            const LAS f32x4* pk = (const LAS f32x4*)(A + SC_KK * 4096 + s * 64 + 8 * ks); const LAS f32x4* pb = (const LAS f32x4*)(A + SC_BB * 4096 + s * 64 + 8 * ks);
            const LAS f32x4* pd = (const LAS f32x4*)(A + SC_DEC * 4096 + s * 64 + 8 * ks); const LAS f32x4* pm = (const LAS f32x4*)(A + SC_KM * 4096 + s * 64 + 8 * ks);
            const LAS f32x4* pq = (const LAS f32x4*)(A + SC_R * 4096 + s * 64 + 8 * ks);
            const f32x4 k0 = pk[0], k1 = pk[1], b0 = pb[0], b1 = pb[1], d0 = pd[0], d1 = pd[1], m0 = pm[0], m1 = pm[1], r0 = pq[0], r1 = pq[1];
            const float v = A[SC_V * 4096 + s * 64 + row];
            float sa = 0.f;
#pragma unroll
            for (int j = 0; j < 4; ++j) { sa += S[j] * k0[j]; sa += S[4 + j] * k1[j]; }
            sa = sum8(sa);
            float y = 0.f;
#pragma unroll
            for (int j = 0; j < 4; ++j) { S[j] = S[j] * d0[j] + (v * m0[j] - sa * b0[j]); S[4 + j] = S[4 + j] * d1[j] + (v * m1[j] - sa * b1[j]); y += S[j] * r0[j]; y += S[4 + j] * r1[j]; }
            y = sum8(y);
            if (ks == 0) A[SC_Y * 4096 + s * 64 + row] = y;
        }
        __syncthreads();
        for (int s = wave; s < nb; s += 8) {
            const int m = row0 + t0 + s;
            const float y = A[SC_Y * 4096 + s * 64 + lane];
            const float mean = wave_sum(y) * (1.f / 64.f), d = y - mean, var = wave_sum(d * d) * (1.f / 64.f);
            const float yn = d * (1.0f / sqrtf(var + GN_EPS));
            const float dot = wave_sum(A[SC_R * 4096 + s * 64 + lane] * A[SC_KM * 4096 + s * 64 + lane] * rkc);
            const float g = bf2f(GG[(size_t)m * RW + chn]);
            const float o = (yn * gnw + gnb + dot * A[SC_V * 4096 + s * 64 + lane]) * g;
            MIX[(size_t)m * D + chn] = (bf16)f2bf(o);
        }
    }
#pragma unroll
    for (int j = 0; j < 8; ++j) s_out[(size_t)row * 64 + 8 * ks + j] = S[j];
    __syncthreads();
}
constexpr int PB = 144, PF = 272;
constexpr int MB16 = 64 * PB, MF32 = 64 * PF;
constexpr size_t WS_GX = 2 * MiB;
constexpr size_t WS_S0 = 167 * MiB;
static_assert(WS_GX + 512 * 32768 <= WS_WIN && WS_H + (size_t)M * NIN * 2 <= WS_S0 && WS_S0 + 512 * 16384 <= WS_WLOG, "scan scratch map");
constexpr int CA_RHS = 0, CA_LB = 34816, CA_KQ = 52224, CA_KD = 61440, CA_BD = 70656, CA_VT = 79872, CA_KET = 89088, CA_BET = 98304, CA_LK = 107520, CA_SMALL = 116736;
constexpr int CC_RHS = 0, CC_LB = 17408, CC_KQ = 34816, CC_RQ = 44032, CC_KD = 53248, CC_BD = 62464, CC_VT = 71680, CC_KET = 80896, CC_BET = 90112, CC_LK = 99328, CC_MK = 108544, CC_MB = 117760,
              CC_SHI = 126976, CC_SLO = 136192, CC_SMALL = 145408;
constexpr int SM_GL = 0, SM_DOT = 256, SM_TOT = 512, SM_BYTES = 512 + 2048;

__device__ __forceinline__ void mm_nt(f32x4 (&acc)[2], const LAS unsigned char* X, const LAS unsigned char* Y, int wave, int lane) {
    const int tr = wave >> 1, tc0 = (wave & 1) * 2, lr = lane & 15, lq = lane >> 4;
#pragma unroll
    for (int ks = 0; ks < 2; ++ks) {
        const bf16x8 xa = *(const LAS bf16x8*)(X + (16 * tr + lr) * PB + ks * 64 + lq * 16);
#pragma unroll
        for (int j = 0; j < 2; ++j) {
            const bf16x8 yb = *(const LAS bf16x8*)(Y + (16 * (tc0 + j) + lr) * PB + ks * 64 + lq * 16);
            acc[j] = __builtin_amdgcn_mfma_f32_16x16x32_bf16(yb, xa, acc[j], 0, 0, 0);
        }
    }
}
#define ACC_ZERO(a) do { a[0] = (f32x4){0.f, 0.f, 0.f, 0.f}; a[1] = (f32x4){0.f, 0.f, 0.f, 0.f}; } while (0)
#define ACC_M(wave, lane) (16 * ((wave) >> 1) + ((lane) & 15))
#define ACC_N(wave, lane, j) (16 * (((wave) & 1) * 2 + (j)) + 4 * ((lane) >> 4))
__device__ __forceinline__ unsigned long long pk4(f32x4 v) { return (unsigned long long)pk2(v[0], v[1]) | ((unsigned long long)pk2(v[2], v[3]) << 32); }
__device__ __forceinline__ f32x4 bf4_to_f32(unsigned long long w) { return (f32x4){bflo((unsigned)w), bfhi((unsigned)w), bflo((unsigned)(w >> 32)), bfhi((unsigned)(w >> 32))}; }
__device__ __forceinline__ void store_hilo(const f32x4 (&a)[2], LAS unsigned char* HI, LAS unsigned char* LO, int wave, int lane) {
    const int m = ACC_M(wave, lane);
#pragma unroll
    for (int j = 0; j < 2; ++j) { const int n = ACC_N(wave, lane, j);
        const unsigned long long hi = pk4(a[j]); const f32x4 lo = a[j] - bf4_to_f32(hi);
        *(LAS unsigned long long*)(HI + m * PB + n * 2) = hi; *(LAS unsigned long long*)(LO + m * PB + n * 2) = pk4(lo); }
}
template <int NW> __device__ __forceinline__ void tri_solve(const LAS unsigned char* LBT, const LAS unsigned char* RHS, LAS unsigned char* UT, int wave, int lane) {
    if (wave < NW) {
        const int col = wave * 64 + lane;
        f32x4 u[16];
#pragma unroll
        for (int q = 0; q < 16; ++q) u[q] = *(const LAS f32x4*)(RHS + col * PF + q * 16);
#pragma unroll
        for (int i = 0; i < 63; ++i) {
            const float ui = u[i >> 2][i & 3];
#pragma unroll
            for (int q = (i + 1) >> 2; q < 16; ++q) { const f32x4 lv = *(const LAS f32x4*)(LBT + i * PF + q * 16); u[q] -= lv * ui; }
            asm volatile("" ::: "memory");
        }
#pragma unroll
        for (int q = 0; q < 8; ++q) { v4u w; w.x = pk2(u[2 * q][0], u[2 * q][1]); w.y = pk2(u[2 * q][2], u[2 * q][3]); w.z = pk2(u[2 * q + 1][0], u[2 * q + 1][1]); w.w = pk2(u[2 * q + 1][2], u[2 * q + 1][3]);
            *(LAS v4u*)(UT + col * PB + q * 16) = w; }
    }
}
template <bool PHC> __device__ __forceinline__ void chunk_stage(Frame& F, int m0, int h, int oKQ, int oRQ, int oKD, int oBD, int oVT, int oKET, int oBET, int oRHS, int oSMALL) {
    LAS unsigned char* lds = F.lds;
    const bf16* P = WSP(bf16, WS_H); const float* mu = F.a->in[I_MU];
    const float* WLOG = WSP(float, WS_WLOG); const bf16* AA = WSP(bf16, WS_A); const float* INV = WSP(float, WS_INV);
    const int e = F.lane, g = F.wave, chn = h * 64 + e;
    const float mur = mu[chn], muk = mu[RW + chn], muv = mu[2 * RW + chn], kkc = F.a->in[I_KK][chn], kac = F.a->in[I_KA][chn], rkc = F.a->in[I_RK][chn];
    const int mg = m0 + 8 * g;
    float pr[9], pk[9], pv[9];
    if ((mg & (TP - 1)) == 0) { pr[0] = 0.f; pk[0] = 0.f; pv[0] = 0.f; }
    else { const size_t o = (size_t)(mg - 1) * NIN; pr[0] = bf2f(P[o + chn]); pk[0] = bf2f(P[o + RW + chn]); pv[0] = bf2f(P[o + 2 * RW + chn]); }
    float wl[8], av[8], iv[8];
#pragma unroll
    for (int j = 0; j < 8; ++j) { const size_t o = (size_t)(mg + j) * NIN; pr[j + 1] = bf2f(P[o + chn]); pk[j + 1] = bf2f(P[o + RW + chn]); pv[j + 1] = bf2f(P[o + 2 * RW + chn]);
        wl[j] = WLOG[(size_t)(mg + j) * RW + chn]; av[j] = bf2f(AA[(size_t)(mg + j) * RW + chn]); iv[j] = INV[(size_t)(mg + j) * 8 + h]; }
    float cw[8]; { float s = 0.f;
#pragma unroll
        for (int j = 0; j < 8; ++j) { s += wl[j]; cw[j] = s; } }
    LAS float* TOT = (LAS float*)(lds + oSMALL + SM_TOT);
    TOT[g * 64 + e] = cw[7];
    __syncthreads();
    float off = 0.f, cwL = 0.f;
#pragma unroll
    for (int gg = 0; gg < 8; ++gg) { const float tv = TOT[gg * 64 + e]; cwL += tv; if (gg < g) off += tv; }
    if (g == 0) ((LAS float*)(lds + oSMALL + SM_GL))[e] = expf(cwL);
    unsigned vt[8], ket[8], bet[8]; float kq[8];
#pragma unroll
    for (int j = 0; j < 8; ++j) {
        const int t = 8 * g + j;
        const float c = off + cw[j];
        const float xr = pr[j + 1] + (pr[j] - pr[j + 1]) * mur, xk = pk[j + 1] + (pk[j] - pk[j + 1]) * muk, xv = pv[j + 1] + (pv[j] - pv[j + 1]) * muv;
        const float kk = xk * kkc * iv[j], km = xk * (1.0f + (av[j] - 1.0f) * kac), bb = kk * av[j];
        const float e1 = expf(c), e2 = 1.0f / e1, e3 = expf(c - wl[j]), e4 = expf(cwL - c);
        kq[j] = kk * e3;
        *(LAS unsigned short*)(lds + oKQ + t * PB + e * 2) = (unsigned short)f2bf(kq[j]);
        *(LAS unsigned short*)(lds + oKD + t * PB + e * 2) = (unsigned short)f2bf(km * e2);
        *(LAS unsigned short*)(lds + oBD + t * PB + e * 2) = (unsigned short)f2bf(bb * e2);
        if (PHC) { *(LAS unsigned short*)(lds + oRQ + t * PB + e * 2) = (unsigned short)f2bf(xr * e1);
            const float d = wave_sum(xr * km * rkc); if (e == 0) ((LAS float*)(lds + oSMALL + SM_DOT))[t] = d; }
        vt[j] = f2bf(xv); ket[j] = f2bf(km * e4); bet[j] = f2bf(bb * e4);
    }
    { v4u w; w.x = vt[0] | (vt[1] << 16); w.y = vt[2] | (vt[3] << 16); w.z = vt[4] | (vt[5] << 16); w.w = vt[6] | (vt[7] << 16); *(LAS v4u*)(lds + oVT + e * PB + g * 16) = w; }
    { v4u w; w.x = ket[0] | (ket[1] << 16); w.y = ket[2] | (ket[3] << 16); w.z = ket[4] | (ket[5] << 16); w.w = ket[6] | (ket[7] << 16); *(LAS v4u*)(lds + oKET + e * PB + g * 16) = w; }
    { v4u w; w.x = bet[0] | (bet[1] << 16); w.y = bet[2] | (bet[3] << 16); w.z = bet[4] | (bet[5] << 16); w.w = bet[6] | (bet[7] << 16); *(LAS v4u*)(lds + oBET + e * PB + g * 16) = w; }
    if (!PHC) { *(LAS f32x4*)(lds + oRHS + e * PF + g * 32) = (f32x4){kq[0], kq[1], kq[2], kq[3]}; *(LAS f32x4*)(lds + oRHS + e * PF + g * 32 + 16) = (f32x4){kq[4], kq[5], kq[6], kq[7]}; }
}
__device__ __forceinline__ void scanA_task(Frame& F, int task) {
    LAS unsigned char* lds = F.lds; const int wave = F.wave, lane = F.lane;
    const int sc = task & 31, bh = task >> 5, h = bh & 7, b = bh >> 3;
    const int m = ACC_M(wave, lane);
    f32x4 gacc[2], xacc[2];
#pragma unroll
    for (int j = 0; j < 2; ++j) { const int n = ACC_N(wave, lane, j);
#pragma unroll
        for (int r = 0; r < 4; ++r) { gacc[j][r] = (m == n + r) ? 1.f : 0.f; xacc[j][r] = 0.f; } }
    for (int c = 0; c < 4; ++c) {
        __syncthreads();
        chunk_stage<false>(F, b * TP + sc * 256 + c * 64, h, CA_KQ, 0, CA_KD, CA_BD, CA_VT, CA_KET, CA_BET, CA_RHS, CA_SMALL);
        __syncthreads();
        { f32x4 a[2]; ACC_ZERO(a); mm_nt(a, lds + CA_BD, lds + CA_KQ, wave, lane);
#pragma unroll
          for (int j = 0; j < 2; ++j) { const int n = ACC_N(wave, lane, j); f32x4 o;
#pragma unroll
              for (int r = 0; r < 4; ++r) o[r] = (n + r > m) ? a[j][r] : 0.f;
              *(LAS f32x4*)(lds + CA_LB + m * PF + n * 4) = o; } }
        { f32x4 a[2]; ACC_ZERO(a); mm_nt(a, lds + CA_KQ, lds + CA_KD, wave, lane);
#pragma unroll
          for (int j = 0; j < 2; ++j) { const int n = ACC_N(wave, lane, j); f32x4 o;
#pragma unroll
              for (int r = 0; r < 4; ++r) o[r] = (n + r < m) ? a[j][r] : 0.f;
              *(LAS unsigned long long*)(lds + CA_LK + m * PB + n * 2) = pk4(o); } }
        __syncthreads();
        { f32x4 a[2]; ACC_ZERO(a); mm_nt(a, lds + CA_VT, lds + CA_LK, wave, lane);
#pragma unroll
          for (int j = 0; j < 2; ++j) { const int n = ACC_N(wave, lane, j); *(LAS f32x4*)(lds + CA_RHS + (64 + m) * PF + n * 4) = a[j]; } }
        __syncthreads();
        tri_solve<2>(lds + CA_LB, lds + CA_RHS, lds + CA_KD, wave, lane);
        __syncthreads();
        f32x4 pt[2], xc[2];
        { f32x4 a[2]; ACC_ZERO(a); mm_nt(a, lds + CA_BET, lds + CA_KD, wave, lane);
          const LAS float* GL = (const LAS float*)(lds + CA_SMALL + SM_GL);
#pragma unroll
          for (int j = 0; j < 2; ++j) { const int n = ACC_N(wave, lane, j);
#pragma unroll
              for (int r = 0; r < 4; ++r) pt[j][r] = ((m == n + r) ? GL[n + r] : 0.f) - a[j][r]; } }
        { f32x4 a1[2], a2[2]; ACC_ZERO(a1); ACC_ZERO(a2);
          mm_nt(a1, lds + CA_VT, lds + CA_KET, wave, lane); mm_nt(a2, lds + CA_KD + 64 * PB, lds + CA_BET, wave, lane);
          xc[0] = a1[0] - a2[0]; xc[1] = a1[1] - a2[1]; }
        store_hilo(pt, lds + CA_KQ, lds + CA_LK, wave, lane);
        store_hilo(gacc, lds + 0, lds + MB16, wave, lane);
        store_hilo(xacc, lds + 2 * MB16, lds + 3 * MB16, wave, lane);
        __syncthreads();
        { f32x4 a[2]; ACC_ZERO(a);
          mm_nt(a, lds + 0, lds + CA_KQ, wave, lane); mm_nt(a, lds + 0, lds + CA_LK, wave, lane); mm_nt(a, lds + MB16, lds + CA_KQ, wave, lane);
          gacc[0] = a[0]; gacc[1] = a[1]; }
        { f32x4 a[2]; a[0] = xc[0]; a[1] = xc[1];
          mm_nt(a, lds + 2 * MB16, lds + CA_KQ, wave, lane); mm_nt(a, lds + 2 * MB16, lds + CA_LK, wave, lane); mm_nt(a, lds + 3 * MB16, lds + CA_KQ, wave, lane);
          xacc[0] = a[0]; xacc[1] = a[1]; }
    }
    float* GT = (float*)(F.a->ws + WS_GX + (size_t)task * 32768); float* XO = GT + 4096;
#pragma unroll
    for (int j = 0; j < 2; ++j) { const int n = ACC_N(wave, lane, j);
#pragma unroll
        for (int r = 0; r < 4; ++r) GT[(n + r) * 64 + m] = gacc[j][r];
        *(f32x4*)(XO + m * 64 + n) = xacc[j]; }
}
__device__ __forceinline__ void scanB_unit(Frame& F, int bh) {
    LAS unsigned char* lds = F.lds; const int wave = F.wave, lane = F.lane, tid = F.tid;
    const int m = ACC_M(wave, lane);
    f32x4 s[2]; ACC_ZERO(s);
    for (int sc = 0; sc < 32; ++sc) {
        const int task = bh * 32 + sc;
        const float* GT = (const float*)(F.a->ws + WS_GX + (size_t)task * 32768); const float* XI = GT + 4096; float* S0 = (float*)(F.a->ws + WS_S0 + (size_t)task * 16384);
        __syncthreads();
        { const int row = tid >> 3, c8 = (tid & 7) * 8;
          const f32x4 v0 = *(const f32x4*)(GT + row * 64 + c8), v1 = *(const f32x4*)(GT + row * 64 + c8 + 4);
          const unsigned long long h0 = pk4(v0), h1 = pk4(v1); const f32x4 l0 = v0 - bf4_to_f32(h0), l1 = v1 - bf4_to_f32(h1);
          v4u wh, wl; wh.x = (unsigned)h0; wh.y = (unsigned)(h0 >> 32); wh.z = (unsigned)h1; wh.w = (unsigned)(h1 >> 32);
          const unsigned long long q0 = pk4(l0), q1 = pk4(l1); wl.x = (unsigned)q0; wl.y = (unsigned)(q0 >> 32); wl.z = (unsigned)q1; wl.w = (unsigned)(q1 >> 32);
          *(LAS v4u*)(lds + 2 * MB16 + row * PB + c8 * 2) = wh; *(LAS v4u*)(lds + 3 * MB16 + row * PB + c8 * 2) = wl; }
        store_hilo(s, lds + 0, lds + MB16, wave, lane);
#pragma unroll
        for (int j = 0; j < 2; ++j) { const int n = ACC_N(wave, lane, j); *(f32x4*)(S0 + m * 64 + n) = s[j]; }
        __syncthreads();
        f32x4 a[2];
#pragma unroll
        for (int j = 0; j < 2; ++j) { const int n = ACC_N(wave, lane, j); a[j] = *(const f32x4*)(XI + m * 64 + n); }
        mm_nt(a, lds + 0, lds + 2 * MB16, wave, lane); mm_nt(a, lds + 0, lds + 3 * MB16, wave, lane); mm_nt(a, lds + MB16, lds + 2 * MB16, wave, lane);
        s[0] = a[0]; s[1] = a[1];
    }
    __syncthreads();
}
__device__ __forceinline__ void scanC_task(Frame& F, int task) {
    LAS unsigned char* lds = F.lds; const int wave = F.wave, lane = F.lane;
    const int sc = task & 31, bh = task >> 5, h = bh & 7, b = bh >> 3;
    const int m = ACC_M(wave, lane);
    const bf16* GG = WSP(bf16, WS_G); bf16* MIX = WSP(bf16, WS_U);
    const int chn = h * 64 + lane; const float gnw = F.a->in[I_GNW][chn], gnb = F.a->in[I_GNB][chn];
    f32x4 s[2];
    { const float* S0 = (const float*)(F.a->ws + WS_S0 + (size_t)task * 16384);
#pragma unroll
      for (int j = 0; j < 2; ++j) { const int n = ACC_N(wave, lane, j); s[j] = *(const f32x4*)(S0 + m * 64 + n); } }
    for (int c = 0; c < 4; ++c) {
        const int m0 = b * TP + sc * 256 + c * 64;
        __syncthreads();
        chunk_stage<true>(F, m0, h, CC_KQ, CC_RQ, CC_KD, CC_BD, CC_VT, CC_KET, CC_BET, 0, CC_SMALL);
        store_hilo(s, lds + CC_SHI, lds + CC_SLO, wave, lane);
        __syncthreads();
        { f32x4 a[2]; ACC_ZERO(a); mm_nt(a, lds + CC_BD, lds + CC_KQ, wave, lane);
#pragma unroll
          for (int j = 0; j < 2; ++j) { const int n = ACC_N(wave, lane, j); f32x4 o;
#pragma unroll
              for (int r = 0; r < 4; ++r) o[r] = (n + r > m) ? a[j][r] : 0.f;
              *(LAS f32x4*)(lds + CC_LB + m * PF + n * 4) = o; } }
        { f32x4 a[2]; ACC_ZERO(a); mm_nt(a, lds + CC_KQ, lds + CC_KD, wave, lane);
#pragma unroll
          for (int j = 0; j < 2; ++j) { const int n = ACC_N(wave, lane, j); f32x4 o;
#pragma unroll
              for (int r = 0; r < 4; ++r) o[r] = (n + r < m) ? a[j][r] : 0.f;
              *(LAS unsigned long long*)(lds + CC_LK + m * PB + n * 2) = pk4(o); } }
        { f32x4 a[2], a2[2]; ACC_ZERO(a); ACC_ZERO(a2); mm_nt(a, lds + CC_RQ, lds + CC_KD, wave, lane); mm_nt(a2, lds + CC_RQ, lds + CC_BD, wave, lane);
#pragma unroll
          for (int j = 0; j < 2; ++j) { const int n = ACC_N(wave, lane, j); f32x4 o, o2;
#pragma unroll
              for (int r = 0; r < 4; ++r) { o[r] = (n + r <= m) ? a[j][r] : 0.f; o2[r] = (n + r <= m) ? a2[j][r] : 0.f; }
              *(LAS unsigned long long*)(lds + CC_MK + m * PB + n * 2) = pk4(o); *(LAS unsigned long long*)(lds + CC_MB + m * PB + n * 2) = pk4(o2); } }
        __syncthreads();
        { f32x4 a[2]; ACC_ZERO(a);
          mm_nt(a, lds + CC_SHI, lds + CC_KQ, wave, lane); mm_nt(a, lds + CC_SLO, lds + CC_KQ, wave, lane); mm_nt(a, lds + CC_VT, lds + CC_LK, wave, lane);
#pragma unroll
          for (int j = 0; j < 2; ++j) { const int n = ACC_N(wave, lane, j); *(LAS f32x4*)(lds + CC_RHS + m * PF + n * 4) = a[j]; } }
        __syncthreads();
        tri_solve<1>(lds + CC_LB, lds + CC_RHS, lds + CC_KD, wave, lane);
        __syncthreads();
        { f32x4 a[2], a2[2]; ACC_ZERO(a); ACC_ZERO(a2);
          mm_nt(a, lds + CC_RQ, lds + CC_SHI, wave, lane); mm_nt(a, lds + CC_RQ, lds + CC_SLO, wave, lane); mm_nt(a, lds + CC_MK, lds + CC_VT, wave, lane);
          mm_nt(a2, lds + CC_MB, lds + CC_KD, wave, lane);
#pragma unroll
          for (int j = 0; j < 2; ++j) { const int n = ACC_N(wave, lane, j); *(LAS f32x4*)(lds + CC_LB + m * PF + n * 4) = a[j] - a2[j]; } }
        { f32x4 a1[2], a2[2]; ACC_ZERO(a1); ACC_ZERO(a2);
          mm_nt(a1, lds + CC_VT, lds + CC_KET, wave, lane); mm_nt(a2, lds + CC_KD, lds + CC_BET, wave, lane);
          const LAS float* GL = (const LAS float*)(lds + CC_SMALL + SM_GL);
#pragma unroll
          for (int j = 0; j < 2; ++j) { const int n = ACC_N(wave, lane, j); const f32x4 gl = *(const LAS f32x4*)(GL + n); s[j] = s[j] * gl + a1[j] - a2[j]; } }
        __syncthreads();
        for (int t = wave; t < 64; t += 8) {
            const int mm = m0 + t;
            const float y = *(const LAS float*)(lds + CC_LB + t * PF + lane * 4);
            const float mean = wave_sum(y) * (1.f / 64.f), d = y - mean, var = wave_sum(d * d) * (1.f / 64.f);
            const float yn = d * (1.0f / sqrtf(var + GN_EPS));
            const float dot = ((const LAS float*)(lds + CC_SMALL + SM_DOT))[t];
            const float v = bf2f(*(const LAS unsigned short*)(lds + CC_VT + lane * PB + t * 2));
            const float gg = bf2f(GG[(size_t)mm * RW + chn]);
            MIX[(size_t)mm * D + chn] = (bf16)f2bf((yn * gnw + gnb + dot * v) * gg);
        }
    }
    if (sc == 31) { float* so = F.a->out + O_WKV_P + (size_t)bh * 4096;
#pragma unroll
        for (int j = 0; j < 2; ++j) { const int n = ACC_N(wave, lane, j); *(f32x4*)(so + m * 64 + n) = s[j]; } }
}
__device__ __forceinline__ int rel_bucket(int n) {
    if (n < 16) return n;
    const int b = 16 + (int)(logf((float)n * (1.0f / 16.0f)) / 2.0794415416798357f * 16.0f);
    return b < 31 ? b : 31;
}
typedef float f32x16 __attribute__((ext_vector_type(16)));
typedef short s16x4 __attribute__((ext_vector_type(4)));
struct AttnLane { const bf16* qrow; int qrel; int rmin; const LAS float* btab; float sink; bf16* orow; };
__device__ __forceinline__ void attn_core32(const LAS unsigned char* Kl, const LAS unsigned char* Vt, int VTP, int kt0, const AttnLane L, int lane) {
    const int r = lane & 31, h = lane >> 5;
    bf16x8 qf[4];
#pragma unroll
    for (int ds = 0; ds < 4; ++ds) qf[ds] = *(const bf16x8*)(L.qrow + 16 * ds + 8 * h);
    f32x16 sc[5];
#pragma unroll
    for (int T = 0; T < 5; ++T) {
#pragma unroll
        for (int e = 0; e < 16; ++e) sc[T][e] = 0.f;
#pragma unroll
        for (int ds = 0; ds < 4; ++ds) { const bf16x8 kf = *(const LAS bf16x8*)(Kl + ((kt0 + T) * 32 + r) * 144 + (16 * ds + 8 * h) * 2);
            sc[T] = __builtin_amdgcn_mfma_f32_32x32x16_bf16(kf, qf[ds], sc[T], 0, 0, 0); }
    }
    float mx = L.sink;
#pragma unroll
    for (int T = 0; T < 5; ++T)
#pragma unroll
        for (int e = 0; e < 16; ++e) { const int rabs = (kt0 + T) * 32 + (e & 3) + 8 * (e >> 2) + 4 * h, dist = L.qrel - rabs;
            const bool valid = dist >= 0 && dist < 128 && rabs >= L.rmin;
            const float s = valid ? sc[T][e] * 0.125f + L.btab[dist & 127] : -1e30f;
            sc[T][e] = s; mx = fmaxf(mx, s); }
    mx = fmaxf(mx, __shfl_xor(mx, 32));
    float l = 0.f;
#pragma unroll
    for (int T = 0; T < 5; ++T)
#pragma unroll
        for (int e = 0; e < 16; ++e) { const float p = sc[T][e] > -1e29f ? __expf(sc[T][e] - mx) : 0.f; sc[T][e] = p; l += p; }
    l += __shfl_xor(l, 32);
    l += __expf(L.sink - mx);
    f32x16 o[2];
#pragma unroll
    for (int e = 0; e < 16; ++e) { o[0][e] = 0.f; o[1][e] = 0.f; }
#pragma unroll
    for (int T = 0; T < 5; ++T)
#pragma unroll
        for (int s2 = 0; s2 < 2; ++s2) {
            v4u pw; pw.x = pk2(sc[T][8 * s2], sc[T][8 * s2 + 1]); pw.y = pk2(sc[T][8 * s2 + 2], sc[T][8 * s2 + 3]); pw.z = pk2(sc[T][8 * s2 + 4], sc[T][8 * s2 + 5]); pw.w = pk2(sc[T][8 * s2 + 6], sc[T][8 * s2 + 7]);
            const bf16x8 pb = __builtin_bit_cast(bf16x8, pw);
#pragma unroll
            for (int dt = 0; dt < 2; ++dt) {
                const LAS unsigned char* vp = Vt + (32 * dt + r) * VTP + ((kt0 + T) * 32 + 16 * s2 + 4 * h) * 2;
                const s16x4 lo = *(const LAS s16x4*)vp, hi = *(const LAS s16x4*)(vp + 16);
                const bf16x8 va = (bf16x8){lo[0], lo[1], lo[2], lo[3], hi[0], hi[1], hi[2], hi[3]};
                o[dt] = __builtin_amdgcn_mfma_f32_32x32x16_bf16(va, pb, o[dt], 0, 0, 0);
            }
        }
    const float il = 1.0f / l;
#pragma unroll
    for (int dt = 0; dt < 2; ++dt)
#pragma unroll
        for (int gq = 0; gq < 4; ++gq) { const int d = 32 * dt + 8 * gq + 4 * h;
            const unsigned long long w = (unsigned long long)pk2(o[dt][4 * gq] * il, o[dt][4 * gq + 1] * il) | ((unsigned long long)pk2(o[dt][4 * gq + 2] * il, o[dt][4 * gq + 3] * il) << 32);
            *(unsigned long long*)(L.orow + d) = w; }
}
constexpr int AP_K = 0, AP_VTP = 528, AP_VT = 256 * 144, AP_BT = AP_VT + 64 * AP_VTP, AP_END = AP_BT + 4 * 128 * 4;
__device__ __forceinline__ void attn_prompt_unit(Frame& F, int b, int kvh, int qb) {
    LAS unsigned char* lds = F.lds;
    const bf16* P = WSP(bf16, WS_H); bf16* MIX = WSP(bf16, WS_U); const float* relb = F.a->in[I_RELB];
    const int t0 = qb * 128, tid = F.tid;
    __syncthreads();
    for (int idx = tid; idx < 256 * 8; idx += 512) {
        const int row = idx >> 3, part = idx & 7, pos = t0 - 128 + row;
        v4u val = (v4u){0u, 0u, 0u, 0u};
        if (pos >= 0) val = *(const v4u*)(P + (size_t)(b * TP + pos) * NIN + 2304 + kvh * 64 + part * 8);
        *(LAS v4u*)(lds + AP_K + row * 144 + part * 16) = val;
    }
    for (int idx = tid; idx < 256 * 8; idx += 512) {
        const int row = idx & 255, part = idx >> 8, pos = t0 - 128 + row;
        v4u val = (v4u){0u, 0u, 0u, 0u};
        if (pos >= 0) val = *(const v4u*)(P + (size_t)(b * TP + pos) * NIN + 2432 + kvh * 64 + part * 8);
#pragma unroll
        for (int e = 0; e < 4; ++e) { *(LAS unsigned short*)(lds + AP_VT + (part * 8 + 2 * e) * AP_VTP + row * 2) = (unsigned short)(val[e] & 0xffffu);
                                      *(LAS unsigned short*)(lds + AP_VT + (part * 8 + 2 * e + 1) * AP_VTP + row * 2) = (unsigned short)(val[e] >> 16); }
    }
    { const int g = tid >> 7, dist = tid & 127; ((LAS float*)(lds + AP_BT))[g * 128 + dist] = relb[rel_bucket(dist) * 8 + kvh * 4 + g]; }
    __syncthreads();
    const int g = F.wave & 3, qh = F.wave >> 2, hq = kvh * 4 + g;
#pragma unroll 1
    for (int bq = 0; bq < 2; ++bq) {
        const int i = 64 * qh + 32 * bq + (F.lane & 31), m = b * TP + t0 + i;
        AttnLane L; L.qrow = P + (size_t)m * NIN + RWP + hq * 64; L.qrel = i + 128; L.rmin = t0 == 0 ? 128 : 0;
        L.btab = (const LAS float*)(lds + AP_BT) + g * 128; L.sink = F.a->in[I_SINKS][hq]; L.orow = MIX + (size_t)m * D + RW + hq * 64;
        attn_core32(lds + AP_K, lds + AP_VT, AP_VTP, 2 * qh + bq, L, F.lane);
    }
}
static_assert(AP_END <= RING_BYTES && AP_VT % 16 == 0 && CC_SMALL + SM_BYTES <= RING_BYTES && CA_SMALL + SM_BYTES <= RING_BYTES, "LDS maps");
constexpr int AS_KB = 160 * 144, AS_VTP = 336, AS_VT = 2 * AS_KB, AS_VB = 64 * AS_VTP, AS_BT = AS_VT + 2 * AS_VB, AS_END = AS_BT + 8 * 128 * 4;
static_assert(AS_END <= RING_BYTES && AS_VT % 16 == 0 && AS_VB % 16 == 0, "LDS maps");
__device__ __forceinline__ void attn_sample_unit(Frame& F, int b) {
    LAS unsigned char* lds = F.lds;
    const bf16* P = WSP(bf16, WS_H); bf16* MIX = WSP(bf16, WS_U); const float* relb = F.a->in[I_RELB]; const float* ck = F.a->in[I_CK]; const float* cv = F.a->in[I_CV];
    const int tid = F.tid;
    __syncthreads();
    for (int idx = tid; idx < 160 * 32; idx += 512) {
        const int j = idx >> 5, c4 = (idx & 31) * 4, kvh = c4 >> 6, d = c4 & 63;
        f32x4 kx = (f32x4){0.f, 0.f, 0.f, 0.f}, vx = kx;
        if (j < 128) { kx = *(const f32x4*)(ck + (size_t)(b * 128 + j) * 128 + c4); vx = *(const f32x4*)(cv + (size_t)(b * 128 + j) * 128 + c4); }
        else if (j < 136) { const bf16* pr = P + (size_t)(MP + b * TS + (j - 128)) * NIN;
            const unsigned long long kw = *(const unsigned long long*)(pr + 2304 + c4), vw = *(const unsigned long long*)(pr + 2432 + c4); kx = bf4_to_f32(kw); vx = bf4_to_f32(vw); }
        *(LAS unsigned long long*)(lds + kvh * AS_KB + j * 144 + d * 2) = pk4(kx);
#pragma unroll
        for (int e = 0; e < 4; ++e) *(LAS unsigned short*)(lds + AS_VT + kvh * AS_VB + (d + e) * AS_VTP + j * 2) = (unsigned short)f2bf(vx[e]);
    }
    for (int idx = tid; idx < 1024; idx += 512) { const int hq = idx >> 7, dist = idx & 127; ((LAS float*)(lds + AS_BT))[idx] = relb[rel_bucket(dist) * 8 + hq]; }
    __syncthreads();
    if (F.wave < 2) {
        const int kvh = F.wave, rr = F.lane & 31, g = rr >> 3, t = rr & 7, hq = kvh * 4 + g, m = MP + b * TS + t;
        AttnLane L; L.qrow = P + (size_t)m * NIN + RWP + hq * 64; L.qrel = t + 128; L.rmin = 0;
        L.btab = (const LAS float*)(lds + AS_BT) + hq * 128; L.sink = F.a->in[I_SINKS][hq]; L.orow = MIX + (size_t)m * D + RW + hq * 64;
        attn_core32(lds + kvh * AS_KB, lds + AS_VT + kvh * AS_VB, AS_VTP, 0, L, F.lane);
    }
}
__device__ __forceinline__ void mixer_task(Frame& F0, int t) {
    Frame F = F0;
    { int t_ = threadIdx.x; asm volatile("" : "+v"(t_)); F.tid = t_; F.lane = t_ & 63; F.wave = __builtin_amdgcn_readfirstlane(t_ >> 6); }
    if (t < 16) {
#ifndef NO_SCANB
        scanB_unit(F, t);
#endif
    }
    else if (t >= 272 && t < 1296) {
        const int id = t - 272, b = id >> 3, h = id & 7;
#ifndef NO_SCAN
        scan_unit(F, MP + b * TS, TS, h, F.a->in[I_SWKV] + (size_t)id * 4096, F.a->out + O_WKV_S + (size_t)id * 4096);
#endif
    } else if (t < 272) { const int u = t - 16; (void)u;
#ifndef NO_ATTP
        attn_prompt_unit(F, u >> 7, (u >> 6) & 1, u & 63);
#endif
    }
    else {
#ifndef NO_ATTS
        attn_sample_unit(F, t - 1296);
#endif
    }
}
__device__ __forceinline__ void p_mixer(Frame& F) {
    int t = F.vcu, step = F.G, end = 1424;
    if (F.G >= 32) { if (F.vcu < 16) { step = 1 << 20; end = 16; } else step = F.G - 16; }
    for (; t < end; t += step) mixer_task(F, t);
    __syncthreads();
}
__device__ __forceinline__ void p_scanA(Frame& F) { for (int t = F.vcu; t < 512; t += F.G) scanA_task(F, t); __syncthreads(); }
__device__ __forceinline__ void p_scanC(Frame& F) { for (int t = F.vcu; t < 512; t += F.G) scanC_task(F, t); __syncthreads(); }
#ifndef MK_PER_PHASE
#define MK_PER_PHASE 0
#endif
constexpr int N_PHASES = 15;
__global__ void __launch_bounds__(NWAVES * 64, 2) fwd_kernel(Args args) {
    extern __shared__ __attribute__((aligned(16))) unsigned char lds[];
    Frame F;
    F.lds = (LAS unsigned char*)lds;
    F.MISC = (volatile LAS unsigned*)(F.lds + MISC_OFF);
    F.tid = threadIdx.x; F.lane = F.tid & 63; F.wave = __builtin_amdgcn_readfirstlane(F.tid >> 6);
    F.G = gridDim.x; { const int bx = blockIdx.x; F.vcu = (F.G % 8 == 0) ? (bx % 8) * (F.G / 8) + bx / 8 : bx; }
    F.a = &args; F.ctl = (gu32*)(args.ws + WS_CTL);
    for (int u = F.tid; u < (LDS_BYTES - LDSCTL_OFF) / 4; u += NWAVES * 64) ((LAS unsigned*)(F.lds + LDSCTL_OFF))[u] = 0u;
    __syncthreads();
    const int lo = args.ph_lo, hi = args.ph_hi;
    XcdBarrier bar; bar.bar = (unsigned*)(F.ctl + CW_BAR); bar.x = 0; bar.st = nullptr;
    if (hi - lo > 1) bar = xcd_barrier_post((unsigned*)(F.ctl + CW_BAR), F.MISC + 8);
#ifdef ONLY_PHASE
#define IN(k) ((k) == ONLY_PHASE && lo <= (k) && (k) < hi)
#else
#define IN(k) (lo <= (k) && (k) < hi)
#endif
#ifndef REP_PHASE
#define REP_PHASE -1
#endif
#define SEAM(k) do { if ((k) + 1 < hi) xcd_barrier(bar); } while (0)
#define PH(k, BODY) if (IN(k)) { BODY; if ((k) == REP_PHASE) { xcd_barrier(bar); BODY; } SEAM(k); }
#define GEMM_SWIGLU(WOFF) { \
        pg8::Gemm g{WSP(bf16, WS_U), WSP(bf16, WOFF), M, NFF, D}; pg8::StaticOrder S; S.init(M, NFF, F.G, (int)blockIdx.x); \
        pg8::EpiSwiglu E{WSP(bf16, WS_H), FF}; \
        pg8::gemm_phase<pg8::EpiSwiglu, pg8::StaticOrder, true, true>(F.lds + RING_OFF, g, S, E); }
#define GEMM_RESID(AOFF, WOFF, KK, XP, XS, GTK, GS) { \
        pg8::Gemm g{WSP(bf16, AOFF), WSP(bf16, WOFF), M, D, KK}; pg8::StaticOrder S; S.init(M, D, F.G, (int)blockIdx.x); \
        pg8::EpiResid E{XP, XS, args.out + O_Y, WSP(float, WS_MOD) + (GTK) * D, ALPHA, GS}; \
        pg8::gemm_phase<pg8::EpiResid, pg8::StaticOrder, true, true>(F.lds + RING_OFF, g, S, E); }
#define GEMM_WIN() { \
        pg8::Gemm g{WSP(bf16, WS_U), WSP(bf16, WS_WIN), M, NIN, D}; pg8::StaticOrder S; S.init(M, NIN, F.G, (int)blockIdx.x); \
        pg8::EpiBf16<0> E{WSP(bf16, WS_H), NIN, nullptr, 0, 0, 1.f}; \
        pg8::gemm_phase<pg8::EpiBf16<0>, pg8::StaticOrder, true, true>(F.lds + RING_OFF, g, S, E); }
    PH(0, { p0_weights(F); __syncthreads(); p0_mod(F); })
    PH(1, p_modulate0(F))
    PH(2, GEMM_SWIGLU(WS_W1IN))
    PH(3, GEMM_RESID(WS_H, WS_W1OUT, FF, args.in[I_XP], args.in[I_XS], 2, 0.5f))
    PH(4, p_layernorm(F, 0, 3 * D))
    PH(5, GEMM_WIN())
    PH(6, p_prep(F))
    PH(7, p_scanA(F))
    PH(8, p_mixer(F))
    PH(9, p_scanC(F))
    PH(10, GEMM_RESID(WS_U, WS_WOUT, D, args.out + O_Y, args.out + O_Y + (size_t)MP * D, 5, 1.0f))
    PH(11, p_layernorm(F, 1, 6 * D))
    PH(12, GEMM_SWIGLU(WS_W2IN))
    PH(13, GEMM_RESID(WS_H, WS_W2OUT, FF, args.out + O_Y, args.out + O_Y + (size_t)MP * D, 8, 0.5f))
    PH(14, p_layernorm(F, 2, -1))
}

extern "C" void kernel_launch(void* const* d_in, const int* in_sizes, int n_in, void* d_out, int out_size, void* d_ws, size_t ws_size, hipStream_t stream) {
    static int grid = 0;
    if (grid == 0) {
        if (n_in != N_IN || in_sizes[0] != MP * D || out_size != (int)O_END || ws_size < WS_END) { fprintf(stderr, "kernel_launch: unexpected shapes (n_in %d, out %d, ws %zu); nothing launched\n", n_in, out_size, ws_size); grid = -1; return; }
        int dev = 0, cus = 0;
        if (hipGetDevice(&dev) != hipSuccess || hipDeviceGetAttribute(&cus, hipDeviceAttributeMultiprocessorCount, dev) != hipSuccess) { grid = -1; return; }
        if (hipFuncSetAttribute((const void*)fwd_kernel, hipFuncAttributeMaxDynamicSharedMemorySize, LDS_BYTES) != hipSuccess) { fprintf(stderr, "kernel_launch: hipFuncSetAttribute failed\n"); grid = -1; return; }
        int per_cu = 0;
        if (hipOccupancyMaxActiveBlocksPerMultiprocessor(&per_cu, (const void*)fwd_kernel, NWAVES * 64, LDS_BYTES) != hipSuccess || per_cu < 1) fprintf(stderr, "kernel_launch: occupancy query reports %d\n", per_cu);
        (void)hipGetLastError();
        grid = cus;
    }
    if (grid < 0) return;
    if (hipMemsetAsync((char*)d_ws + WS_CTL, 0, CTL_ZERO_BYTES, stream) != hipSuccess) return;
    Args a{};
    for (int i = 0; i < N_IN; ++i) a.in[i] = (const float*)d_in[i];
    a.out = (float*)d_out; a.ws = (unsigned char*)d_ws;
#if MK_PER_PHASE
    for (int ph = 0; ph < N_PHASES; ++ph) { a.ph_lo = ph; a.ph_hi = ph + 1; hipLaunchKernelGGL(fwd_kernel, dim3(grid), dim3(NWAVES * 64), LDS_BYTES, stream, a); }
#else
    a.ph_lo = 0; a.ph_hi = N_PHASES;
    hipLaunchKernelGGL(fwd_kernel, dim3(grid), dim3(NWAVES * 64), LDS_BYTES, stream, a);
#endif
}
```

```cpp
#define MK_PER_PHASE 0

#include <hip/hip_runtime.h>
#include <cstdio>
#include <cstdint>
#include <cmath>
namespace pg8 {
#define PG8_LAS __attribute__((address_space(3)))
typedef unsigned short bf16_t;
typedef short bf16x8 __attribute__((ext_vector_type(8)));
typedef float f32x4 __attribute__((ext_vector_type(4)));
typedef unsigned u32x4 __attribute__((ext_vector_type(4)));
constexpr int BM = 256, BK = 64, HALF = 128, HTB = HALF * BK * 2  , STAGE_BYTES = 8 * HTB, NXCD = 8, WGM = 8;

__host__ __device__ __forceinline__ int lds_byte(int r, int c) { const int st = (r >> 4) * 2 + (c >> 5), rr = r & 15, cc = c & 31, ob = rr * 64 + cc * 2; return st * 1024 + (ob ^ (((ob >> 9) & 1) << 5)); }
__host__ __device__ __forceinline__ void stage_rc(int b, int& R, int& C) { const int st = b / 1024, sb = b % 1024, swz = sb ^ (((sb >> 9) & 1) << 5); R = (st >> 1) * 16 + swz / 64; C = (st & 1) * 32 + (swz % 64) / 2; }
__host__ __device__ __forceinline__ int perm32(int rho) { const int n = rho >> 4, i = rho & 15; return 8 * (i >> 2) + 4 * n + (i & 3); }

struct Unit { int pm, pn; };
struct Gemm { const bf16_t* A; const bf16_t* Bt; int M, N, K; };

struct StaticOrder {
    int nM, nN, nwg, G, c;
    __host__ __device__ void init(int M, int N, int G_, int c_) { nM = M / BM; nN = N / BM; nwg = nM * nN; G = G_; c = c_; }
    __host__ __device__ bool next(int i, Unit& u) const {
        const long L = (long)i * G + c; if (L >= nwg) return false;
        int wgid = (int)L; { const int q = nwg / NXCD, r = nwg % NXCD, xcd = wgid % NXCD, off = wgid / NXCD; wgid = (xcd < r ? xcd * (q + 1) : r * (q + 1) + (xcd - r) * q) + off; }
        const int nig = WGM * nN, gid = wgid / nig, fm = gid * WGM, gsz = (nM - fm) < WGM ? (nM - fm) : WGM;
        u.pm = fm + ((wgid % nig) % gsz); u.pn = (wgid % nig) / gsz; return true;
    }
    __device__ __forceinline__ void a_ready(const Unit&) const {}
    __device__ __forceinline__ void done(const Unit&) const {}
};

__device__ __forceinline__ unsigned cvt_pk_bf16(float lo, float hi) { unsigned r; asm volatile("v_cvt_pk_bf16_f32 %0, %1, %2" : "=v"(r) : "v"(lo), "v"(hi)); return r; }
template <int ACT  > struct EpiBf16 {
    static constexpr bool PERM = true, AFTER_DRAIN = false; static_assert(ACT == 0, "EpiBf16: ACT is 0 (none)");
    bf16_t* O; int ldc; const float* bias; int split_cols; size_t split_stride; float scale0;
    __device__ __forceinline__ void operator()(const f32x4 (&acc)[2][2][4][2], const Unit& u, int wr, int wc, int fr, int fq) const {
        const int row0 = u.pm * BM + wr * 64 + fr; int colt = u.pn * BM; bf16_t* base = O;
        float sc = 1.f; if (split_cols) { const int t = colt / split_cols; base += (size_t)t * split_stride; colt -= t * split_cols; if (t == 0) sc = scale0; }
        const int col0 = colt + wc * 32 + 8 * fq, bcol0 = u.pn * BM + wc * 32 + 8 * fq;
        f32x4 bv[2][2];
#pragma unroll
        for (int bj = 0; bj < 2; ++bj)
#pragma unroll
            for (int n = 0; n < 2; ++n) bv[bj][n] = bias ? *(const f32x4*)(bias + bcol0 + bj * HALF + 4 * n) : (f32x4){0.f, 0.f, 0.f, 0.f};
#pragma unroll
        for (int ai = 0; ai < 2; ++ai)
#pragma unroll
            for (int m = 0; m < 4; ++m) { bf16_t* rowp = base + (size_t)(row0 + ai * HALF + m * 16) * ldc + col0;
#pragma unroll
                for (int bj = 0; bj < 2; ++bj) { f32x4 v0 = acc[ai][bj][m][0] + bv[bj][0], v1 = acc[ai][bj][m][1] + bv[bj][1];
                    v0 = v0 * sc; v1 = v1 * sc; u32x4 w; w.x = cvt_pk_bf16(v0[0], v0[1]); w.y = cvt_pk_bf16(v0[2], v0[3]); w.z = cvt_pk_bf16(v1[0], v1[1]); w.w = cvt_pk_bf16(v1[2], v1[3]);
                    *(u32x4*)(rowp + bj * HALF) = w; } }
    }
};

template <class Epi, class Sched, bool ALIGN_EPI = false, bool SP2 = false>
__device__ __forceinline__ void gemm_phase(PG8_LAS unsigned char* lds, const Gemm g, const Sched& S, const Epi& E) {
    const int tid = threadIdx.x, wid = __builtin_amdgcn_readfirstlane(tid >> 6), lane = tid & 63, wr = wid >> 2, wc = wid & 3, fr = lane & 15, fq = lane >> 4;
    const int K = g.K, nt = K / BK;
    unsigned voffA[2], voffB[2];
#pragma unroll
    for (int i = 0; i < 2; ++i) { int R, C; stage_rc(tid * 16 + i * 8192, R, C); const int Rb = Epi::PERM ? ((R & ~31) + perm32(R & 31)) : R;
        voffA[i] = (unsigned)(R * K + C) * 2u; voffB[i] = (unsigned)(Rb * K + C) * 2u; }
    const size_t kstep = (size_t)(BK * 2);
    const size_t hstep = (size_t)HALF * K * 2;
    const size_t tstep = 2 * hstep;
    const unsigned ldsw = (unsigned)wid * 1024u;
    const int aoff = lds_byte(wr * 64 + fr, fq * 8), boff = lds_byte(wc * 32 + fr, fq * 8);
#define PG8_SA(b, h) (((b) * 2 + (h)) * HTB)
#define PG8_SB(b, h) ((4 + (b) * 2 + (h)) * HTB)
#define PG8_STAGE(bufoff, gbase, voff) do { _Pragma("unroll") for (int _i = 0; _i < 2; ++_i) \
        __builtin_amdgcn_global_load_lds((const unsigned*)((const char*)(gbase) + (voff)[_i]), (PG8_LAS unsigned*)(lds + (bufoff) + ldsw + _i * 8192), 16, 0, 0); } while (0)
#define PG8_LDA(dst, b, h) do { _Pragma("unroll") for (int m = 0; m < 4; ++m) _Pragma("unroll") for (int k = 0; k < 2; ++k) dst[m][k] = *(const PG8_LAS bf16x8*)(lds + PG8_SA(b, h) + aoff + m * 2048 + k * 1024); } while (0)
#define PG8_LDB(dst, b, h) do { _Pragma("unroll") for (int n = 0; n < 2; ++n) _Pragma("unroll") for (int k = 0; k < 2; ++k) dst[n][k] = *(const PG8_LAS bf16x8*)(lds + PG8_SB(b, h) + boff + n * 2048 + k * 1024); } while (0)
#define PG8_MMA(ai, bj, At, Bt) do { __builtin_amdgcn_s_setprio(1); _Pragma("unroll") for (int m = 0; m < 4; ++m) _Pragma("unroll") for (int n = 0; n < 2; ++n) _Pragma("unroll") for (int k = 0; k < 2; ++k) \
        acc[ai][bj][m][n] = __builtin_amdgcn_mfma_f32_16x16x32_bf16(Bt[n][k], At[m][k], acc[ai][bj][m][n], 0, 0, 0); __builtin_amdgcn_s_setprio(0); } while (0)
#define PG8_WAIT_V(n) asm volatile("s_waitcnt vmcnt(" #n ")" ::: "memory")
#define PG8_WAIT_L(n) asm volatile("s_waitcnt lgkmcnt(" #n ")" ::: "memory")
#define PG8_BAR __builtin_amdgcn_s_barrier()
#define PG8_SCHED __builtin_amdgcn_sched_barrier(0)
    Unit cur, nxt; int ui = 0;
    if (!S.next(0, cur)) return;
    f32x4 acc[2][2][4][2];
#pragma unroll
    for (int a = 0; a < 2; ++a)
#pragma unroll
        for (int b = 0; b < 2; ++b)
#pragma unroll
            for (int m = 0; m < 4; ++m)
#pragma unroll
                for (int n = 0; n < 2; ++n) acc[a][b][m][n] = (f32x4){0.f, 0.f, 0.f, 0.f};
    bf16x8 At[4][2], B0[2][2], B1[2][2];
    const char* cA = (const char*)g.A + (size_t)cur.pm * tstep; const char* cB = (const char*)g.Bt + (size_t)cur.pn * tstep;
    S.a_ready(cur);
    if constexpr (SP2) {
        PG8_STAGE(PG8_SB(0, 0), cB, voffB); PG8_STAGE(PG8_SB(0, 1), cB + hstep, voffB); PG8_STAGE(PG8_SA(0, 0), cA, voffA); PG8_STAGE(PG8_SA(0, 1), cA + hstep, voffA);
        if (wr == 1) PG8_BAR;
        PG8_WAIT_V(2); PG8_BAR;
        PG8_STAGE(PG8_SB(1, 0), cB + kstep, voffB); PG8_STAGE(PG8_SA(1, 0), cA + kstep, voffA); PG8_STAGE(PG8_SB(1, 1), cB + hstep + kstep, voffB);
        PG8_WAIT_V(6); PG8_BAR;
    } else {
        PG8_STAGE(PG8_SB(0, 0), cB, voffB); PG8_STAGE(PG8_SA(0, 0), cA, voffA); PG8_STAGE(PG8_SB(0, 1), cB + hstep, voffB); PG8_STAGE(PG8_SA(0, 1), cA + hstep, voffA);
        if (wr == 1) PG8_BAR;
        PG8_WAIT_V(4); PG8_BAR;
        PG8_STAGE(PG8_SB(1, 0), cB + kstep, voffB); PG8_STAGE(PG8_SA(1, 0), cA + kstep, voffA); PG8_STAGE(PG8_SB(1, 1), cB + hstep + kstep, voffB);
        PG8_WAIT_V(6); PG8_BAR;
    }
    for (;;) {
        const bool has_next = S.next(ui + 1, nxt);
        const char* nA = has_next ? (const char*)g.A + (size_t)nxt.pm * tstep : cA; const char* nB = has_next ? (const char*)g.Bt + (size_t)nxt.pn * tstep : cB;
        for (int t = 0; t < nt; t += 2) {
            const bool last = (t == nt - 2);
            const char* a1 = cA + (size_t)(t + 1) * kstep;
            const char* a2 = last ? nA : cA + (size_t)(t + 2) * kstep; const char* b2 = last ? nB : cB + (size_t)(t + 2) * kstep;
            const char* a3 = a2 + kstep; const char* b3 = b2 + kstep;
            if (last && has_next) S.a_ready(nxt);
            if constexpr (SP2) {
            PG8_LDB(B0, 0, 0); PG8_LDB(B1, 0, 1); PG8_SCHED; PG8_LDA(At, 0, 0); PG8_STAGE(PG8_SA(1, 1), a1 + hstep, voffA);
            PG8_WAIT_V(8); PG8_WAIT_L(0); PG8_BAR; PG8_MMA(0, 0, At, B0); PG8_MMA(0, 1, At, B1); PG8_BAR; PG8_SCHED;
            PG8_LDA(At, 0, 1); PG8_STAGE(PG8_SB(0, 0), b2, voffB); PG8_STAGE(PG8_SB(0, 1), b2 + hstep, voffB); PG8_STAGE(PG8_SA(0, 0), a2, voffA);
            PG8_WAIT_V(8); PG8_WAIT_L(0); PG8_BAR; PG8_MMA(1, 0, At, B0); PG8_MMA(1, 1, At, B1); PG8_BAR; PG8_SCHED;
            PG8_LDB(B0, 1, 0); PG8_LDB(B1, 1, 1); PG8_SCHED; PG8_LDA(At, 1, 0); PG8_STAGE(PG8_SA(0, 1), a2 + hstep, voffA);
            PG8_WAIT_V(8); PG8_WAIT_L(0); PG8_BAR; PG8_MMA(0, 0, At, B0); PG8_MMA(0, 1, At, B1); PG8_BAR; PG8_SCHED;
            PG8_LDA(At, 1, 1); PG8_STAGE(PG8_SB(1, 0), b3, voffB); PG8_STAGE(PG8_SB(1, 1), b3 + hstep, voffB); PG8_STAGE(PG8_SA(1, 0), a3, voffA);
            PG8_WAIT_V(8); PG8_WAIT_L(0); PG8_BAR; PG8_MMA(1, 0, At, B0); PG8_MMA(1, 1, At, B1); PG8_BAR; PG8_SCHED;
            } else {
            PG8_LDB(B0, 0, 0); PG8_SCHED; PG8_LDA(At, 0, 0); PG8_STAGE(PG8_SA(1, 1), a1 + hstep, voffA);
            PG8_WAIT_L(8); PG8_BAR; PG8_WAIT_L(0); PG8_MMA(0, 0, At, B0); PG8_BAR; PG8_SCHED;
            PG8_LDB(B1, 0, 1); PG8_STAGE(PG8_SB(0, 0), b2, voffB);
            PG8_BAR; PG8_WAIT_L(0); PG8_MMA(0, 1, At, B1); PG8_BAR;
            PG8_LDA(At, 0, 1); PG8_STAGE(PG8_SA(0, 0), a2, voffA);
            PG8_BAR; PG8_WAIT_L(0); PG8_MMA(1, 0, At, B0); PG8_BAR; PG8_SCHED;
            PG8_STAGE(PG8_SB(0, 1), b2 + hstep, voffB);
            PG8_WAIT_V(6); PG8_BAR; PG8_MMA(1, 1, At, B1); PG8_BAR;
            PG8_LDB(B0, 1, 0); PG8_SCHED; PG8_LDA(At, 1, 0); PG8_STAGE(PG8_SA(0, 1), a2 + hstep, voffA);
            PG8_WAIT_L(8); PG8_BAR; PG8_WAIT_L(0); PG8_MMA(0, 0, At, B0); PG8_BAR; PG8_SCHED;
            PG8_LDB(B1, 1, 1); PG8_STAGE(PG8_SB(1, 0), b3, voffB);
            PG8_BAR; PG8_WAIT_L(0); PG8_MMA(0, 1, At, B1); PG8_BAR;
            PG8_LDA(At, 1, 1); PG8_STAGE(PG8_SA(1, 0), a3, voffA);
            PG8_BAR; PG8_WAIT_L(0); PG8_MMA(1, 0, At, B0); PG8_BAR; PG8_SCHED;
            PG8_STAGE(PG8_SB(1, 1), b3 + hstep, voffB);
            PG8_WAIT_V(6); PG8_BAR; PG8_MMA(1, 1, At, B1); PG8_BAR;
            }
        }
        if constexpr (ALIGN_EPI) { if (wr == 0) PG8_BAR; }
        if constexpr (!Epi::AFTER_DRAIN) { E(acc, cur, wr, wc, fr, fq); S.done(cur); }
        if (!has_next) break;
#pragma unroll
        for (int a = 0; a < 2; ++a)
#pragma unroll
            for (int b = 0; b < 2; ++b)
#pragma unroll
                for (int m = 0; m < 4; ++m)
#pragma unroll
                    for (int n = 0; n < 2; ++n) acc[a][b][m][n] = (f32x4){0.f, 0.f, 0.f, 0.f};
        cur = nxt; cA = nA; cB = nB; ++ui;
        if constexpr (ALIGN_EPI) { if (wr == 1) PG8_BAR; }
    }
    PG8_WAIT_V(0);
    if constexpr (!ALIGN_EPI) { if (wr == 0) PG8_BAR; }
    PG8_BAR;
    if constexpr (Epi::AFTER_DRAIN) { E.fused(acc, cur, wr, wc, fr, fq, lds, wid, lane); S.done(cur); }
#undef PG8_SA
#undef PG8_SB
#undef PG8_STAGE
#undef PG8_LDA
#undef PG8_LDB
#undef PG8_MMA
#undef PG8_WAIT_V
#undef PG8_WAIT_L
#undef PG8_BAR
#undef PG8_SCHED
}
struct EpiSwiglu {
    static constexpr bool PERM = true, AFTER_DRAIN = false;
    bf16_t* H; int ldh;
    __device__ __forceinline__ void operator()(const f32x4 (&acc)[2][2][4][2], const Unit& u, int wr, int wc, int fr, int fq) const {
        const int row0 = u.pm * BM + wr * 64 + fr, col0 = u.pn * HALF + wc * 32 + 8 * fq;
#pragma unroll
        for (int ai = 0; ai < 2; ++ai)
#pragma unroll
            for (int m = 0; m < 4; ++m) {
                bf16_t* p = H + (size_t)(row0 + ai * HALF + m * 16) * ldh + col0;
                float h[8];
#pragma unroll
                for (int n = 0; n < 2; ++n)
#pragma unroll
                    for (int i = 0; i < 4; ++i) { const float g = acc[ai][0][m][n][i], up = acc[ai][1][m][n][i];
                        h[n * 4 + i] = g * __builtin_amdgcn_rcpf(1.0f + __expf(-g)) * up; }
                u32x4 w; w.x = cvt_pk_bf16(h[0], h[1]); w.y = cvt_pk_bf16(h[2], h[3]); w.z = cvt_pk_bf16(h[4], h[5]); w.w = cvt_pk_bf16(h[6], h[7]);
                *(u32x4*)p = w;
            }
    }
};
struct EpiResid {
    static constexpr bool PERM = false, AFTER_DRAIN = false;
    const float* xp; const float* xs; float* X; const float* gt; float alpha, gs;
    __device__ __forceinline__ void operator()(const f32x4 (&acc)[2][2][4][2], const Unit& u, int wr, int wc, int fr, int fq) const {
        const int col0 = u.pn * BM + wc * 32 + 4 * fq;
#pragma unroll
        for (int ai = 0; ai < 2; ++ai)
#pragma unroll
            for (int m = 0; m < 4; ++m) {
                const int row = u.pm * BM + ai * HALF + wr * 64 + m * 16 + fr;
                const bool smp = row >= 16384;
                const float* xr = smp ? xs + (size_t)(row - 16384) * 1024 : xp + (size_t)row * 1024;
                const int b = smp ? 2 + ((row - 16384) >> 3) : (row >> 13);
                const float* gr = gt + (size_t)b * 9216;
                float* xo = X + (size_t)row * 1024;
#pragma unroll
                for (int bj = 0; bj < 2; ++bj)
#pragma unroll
                    for (int n = 0; n < 2; ++n) { const int c = col0 + bj * HALF + n * 16;
                        const f32x4 xv = *(const f32x4*)(xr + c), gv = *(const f32x4*)(gr + c);
                        const f32x4 z = xv * alpha + (gv + 1.0f) * gs * acc[ai][bj][m][n];
                        *(f32x4*)(xo + c) = z; }
            }
    }
};
}
#define GAS __attribute__((address_space(1)))
#define LAS __attribute__((address_space(3)))
typedef unsigned short bf16;
typedef unsigned v4u __attribute__((ext_vector_type(4)));
typedef float f32x4 __attribute__((ext_vector_type(4)));
typedef short bf16x8 __attribute__((ext_vector_type(8)));
typedef GAS unsigned gu32;
typedef GAS unsigned long long gu64;
#define RLX_AGENT __ATOMIC_RELAXED, __HIP_MEMORY_SCOPE_AGENT
#define LDS_WAIT() asm volatile("s_waitcnt lgkmcnt(0)" ::: "memory")
#define VM_WAIT() asm volatile("s_waitcnt vmcnt(0)" ::: "memory")
__device__ __forceinline__ unsigned long long rt() { return __builtin_amdgcn_s_memrealtime(); }
__device__ __forceinline__ unsigned f2bf(float f) { unsigned u = __builtin_bit_cast(unsigned, f); return (u + 0x7fffu + ((u >> 16) & 1u)) >> 16; }
__device__ __forceinline__ unsigned pk2(float lo, float hi) { return f2bf(lo) | (f2bf(hi) << 16); }

#define XB_TMO      128
#define XB_XCNT(j)  (256  + 64 * (j))
#define XB_XSUB(j)  (1280 + 64 * (j))
#define XB_XGEN(j)  (2304 + 64 * (j))
#define XB_TOP      3328
#define XB_TOPGEN   3392
#define XCD_BAR_WORDS 3456
#define XB_SPIN_CAP (1u << 18)

__device__ __forceinline__ unsigned xb_ld(unsigned* p)              { return __hip_atomic_load(p, __ATOMIC_RELAXED, __HIP_MEMORY_SCOPE_AGENT); }
__device__ __forceinline__ unsigned xb_add(unsigned* p, unsigned v) { return __hip_atomic_fetch_add(p, v, __ATOMIC_RELAXED, __HIP_MEMORY_SCOPE_AGENT); }
__device__ __forceinline__ unsigned xb_xcc_id() { return (unsigned)__builtin_amdgcn_s_getreg((3 << 11) | 20) & 0xFu; }
#define XB_SPIN(cond, bar) do { unsigned _sp = 0; while (cond) { __builtin_amdgcn_s_sleep(1); \
    if ((++_sp & 255u) == 0u) { if (xb_ld(&(bar)[XB_TMO])) break; if (_sp > XB_SPIN_CAP) { atomicAdd(&(bar)[XB_TMO], 1u); break; } } } } while (0)

struct XcdBarrier {
    unsigned* bar; unsigned x;
    volatile LAS unsigned* st;
};

__device__ __forceinline__ XcdBarrier xcd_barrier_post(unsigned* bar, volatile LAS unsigned* st) {
    XcdBarrier b; b.bar = bar; b.x = xb_xcc_id(); b.st = st;
    if (threadIdx.x == 0) (void)xb_add(&bar[XB_XCNT(b.x)], 1u);
    return b;
}
__device__ __forceinline__ void xcd_barrier_complete(unsigned* bar, unsigned x, unsigned& nloc, unsigned& nx) {
    const unsigned G = gridDim.x * gridDim.y * gridDim.z;
    unsigned sum, cnt, mine, sp = 0u;
    for (;;) {
        sum = 0u; cnt = 0u; mine = 0u;
#pragma unroll
        for (unsigned j = 0; j < 16; ++j) { const unsigned c = xb_ld(&bar[XB_XCNT(j)]); sum += c; cnt += (c > 0u) ? 1u : 0u; mine = (j == x) ? c : mine; }
        if (sum == G) break;
        __builtin_amdgcn_s_sleep(1);
        if ((++sp & 255u) == 0u) { if (xb_ld(&bar[XB_TMO])) break; if (sp > XB_SPIN_CAP) { atomicAdd(&bar[XB_TMO], 1u); break; } }
    }
    nloc = mine > 0u ? mine : 1u; nx = cnt > 0u ? cnt : 1u;
}

__device__ __forceinline__ void xcd_barrier(const XcdBarrier& b) {
    asm volatile("s_waitcnt vmcnt(0)" ::: "memory");
    __syncthreads();
    if (threadIdx.x == 0) {
        unsigned* bar = b.bar;
        __builtin_amdgcn_s_waitcnt(0);
        unsigned nloc = b.st[0], nx = b.st[1];
        if (nloc == 0u) { xcd_barrier_complete(bar, b.x, nloc, nx); b.st[0] = nloc; b.st[1] = nx; }
        const unsigned old = xb_add(&bar[XB_XSUB(b.x)], 1u);
        const unsigned gen = old / nloc;
        if (old + 1u == (gen + 1u) * nloc) {
            __builtin_amdgcn_fence(__ATOMIC_RELEASE, "agent");
            asm volatile("s_waitcnt vmcnt(0)" ::: "memory");
            const unsigned og = xb_add(&bar[XB_TOP], 1u);
            const unsigned tg = og / nx;
            if (og + 1u == (tg + 1u) * nx) xb_add(&bar[XB_TOPGEN], 1u);
            else XB_SPIN(xb_ld(&bar[XB_TOPGEN]) == tg, bar);
            __builtin_amdgcn_fence(__ATOMIC_ACQUIRE, "agent");
            xb_add(&bar[XB_XGEN(b.x)], 1u);
            asm volatile("s_waitcnt vmcnt(0)" ::: "memory");
        } else {
            XB_SPIN(xb_ld(&bar[XB_XGEN(b.x)]) == gen, bar);
            __builtin_amdgcn_fence(__ATOMIC_ACQUIRE, "agent");
            asm volatile("s_waitcnt vmcnt(0)" ::: "memory");
        }
    }
    __syncthreads();
}

constexpr int D = 1024, FF = 2816, NFF = 2 * FF, NIN = 2560, RW = 512, RWP = 1792;
constexpr int MP = 16384, MS = 1024, M = MP + MS, TP = 8192, TS = 8, NBS = 128;
constexpr int MODW = 9216, NMOD = 130;
constexpr float ALPHA = 1.189207115002721f;
constexpr float LN_EPS = 1e-5f, GN_EPS = 64e-5f;
constexpr int NWAVES = 8;
enum { I_XP = 0, I_XS, I_SWKV, I_SSHIFT, I_CK, I_CV, I_CP, I_CS, I_RELB, I_WADA, I_BADA, I_LNG, I_LNB, I_W1IN, I_W1OUT, I_WIN, I_MU, I_W0, I_WDEC, I_A0, I_WICLR, I_WGATE,
       I_KK, I_KA, I_RK, I_GNW, I_GNB, I_SINKS, I_WOUT, I_W2IN, I_W2OUT, N_IN };
constexpr size_t O_Y = 0, O_WKV_P = (size_t)M * D, O_SHIFT_P = O_WKV_P + 65536, O_WINK_P = O_SHIFT_P + 3584, O_WINV_P = O_WINK_P + 32768,
                 O_WKV_S = O_WINV_P + 32768, O_SHIFT_S = O_WKV_S + 4194304, O_WINK_S = O_SHIFT_S + 229376, O_WINV_S = O_WINK_S + 2097152, O_END = O_WINV_S + 2097152;
static_assert(O_END == 26578432, "d_out size");
constexpr size_t MiB = 1u << 20;
constexpr size_t WS_CTL = 0, CTL_ZERO_BYTES = 1 * MiB;
constexpr size_t WS_W1IN = 2 * MiB, WS_W1OUT = 13 * MiB, WS_WIN = 19 * MiB, WS_WOUT = 24 * MiB, WS_W2IN = 26 * MiB, WS_W2OUT = 37 * MiB;
constexpr size_t WS_MOD = 43 * MiB;
constexpr size_t WS_U = 48 * MiB;
constexpr size_t WS_H = 82 * MiB;
constexpr size_t WS_WLOG = 176 * MiB, WS_A = 210 * MiB, WS_G = 227 * MiB, WS_INV = 244 * MiB, WS_LORA = 245 * MiB, WS_END = 246 * MiB;
constexpr size_t LORA_WI = 512 * 64 * 2, LORA_WG = 2 * 512 * 64 * 2;
static_assert(WS_W1IN + (size_t)NFF * D * 2 <= WS_W1OUT && WS_W1OUT + (size_t)D * FF * 2 <= WS_WIN && WS_WIN + (size_t)NIN * D * 2 <= WS_WOUT && WS_WOUT + (size_t)D * D * 2 <= WS_W2IN &&
              WS_W2IN + (size_t)NFF * D * 2 <= WS_W2OUT && WS_W2OUT + (size_t)D * FF * 2 <= WS_MOD && WS_MOD + (size_t)NMOD * MODW * 4 <= WS_U && WS_U + (size_t)M * D * 2 <= WS_H &&
              WS_H + (size_t)M * FF * 2 <= WS_WLOG && WS_WLOG + (size_t)M * RW * 4 <= WS_A && WS_A + (size_t)M * RW * 2 <= WS_G && WS_G + (size_t)M * RW * 2 <= WS_INV &&
              WS_INV + (size_t)M * 8 * 4 <= WS_LORA && WS_LORA + 4 * 512 * 64 * 2 <= WS_END && WS_END <= 256 * MiB, "d_ws map");
constexpr int CW_BAR = 4096;
constexpr int RING_OFF = 0, RING_BYTES = 151552;
constexpr int LDSCTL_OFF = RING_BYTES, MISC_OFF = LDSCTL_OFF + 320;
constexpr int LDS_BYTES = 155648;
static_assert(MISC_OFF + 128 <= LDS_BYTES, "LDS map");

__device__ __forceinline__ float bf2f(unsigned short h) { return __uint_as_float((unsigned)h << 16); }
__device__ __forceinline__ float bflo(unsigned u) { return __uint_as_float(u << 16); }
__device__ __forceinline__ float bfhi(unsigned u) { return __uint_as_float(u & 0xffff0000u); }
__device__ __forceinline__ unsigned long long pk4(f32x4 v) { return (unsigned long long)pk2(v[0], v[1]) | ((unsigned long long)pk2(v[2], v[3]) << 32); }
__device__ __forceinline__ f32x4 bf4_to_f32(unsigned long long w) { return (f32x4){bflo((unsigned)w), bfhi((unsigned)w), bflo((unsigned)(w >> 32)), bfhi((unsigned)(w >> 32))}; }
__device__ __forceinline__ float wave_sum(float v) {
#pragma unroll
    for (int o = 1; o < 64; o <<= 1) v += __shfl_xor(v, o);
    return v;
}
template <int CTRL> __device__ __forceinline__ float dppf(float x) { return __builtin_bit_cast(float, __builtin_amdgcn_update_dpp(0, __builtin_bit_cast(int, x), CTRL, 0xf, 0xf, true)); }
__device__ __forceinline__ float sum8(float x) {
    x += dppf<0xB1>(x);
    x += dppf<0x4E>(x);
    x += dppf<0x141>(x);
    return x;
}
__device__ __forceinline__ float wave_sum_dpp(float x) {
    x += dppf<0xB1>(x); x += dppf<0x4E>(x); x += dppf<0x141>(x);
    x += dppf<0x140>(x);
    const int xi = __builtin_bit_cast(int, x);
    return __builtin_bit_cast(float, __builtin_amdgcn_readlane(xi, 0)) + __builtin_bit_cast(float, __builtin_amdgcn_readlane(xi, 16)) +
           __builtin_bit_cast(float, __builtin_amdgcn_readlane(xi, 32)) + __builtin_bit_cast(float, __builtin_amdgcn_readlane(xi, 48));
}
__device__ __forceinline__ float sigmoidf_(float x) { return 1.0f / (1.0f + expf(-x)); }

struct Args { const float* in[N_IN]; float* out; unsigned char* ws; int ph_lo, ph_hi; };
static_assert(sizeof(Args) == N_IN * 8 + 24, "Args has no padding");
struct Frame {
    LAS unsigned char* lds;
    volatile LAS unsigned* MISC;
    gu32* ctl;
    int tid, lane, wave, vcu, G;
    const Args* a;
};
#define WSP(T, off) ((T*)(F.a->ws + (off)))

__device__ __forceinline__ void p0_transpose_item(const float* W, int K, int N, bf16* WT, int dst_row0, int k0, int n0, LAS float* scr, int lane) {
#pragma unroll 8
    for (int i = 0; i < 32; ++i) { const int kk = 2 * i + (lane >> 5); scr[kk * 33 + (lane & 31)] = W[(size_t)(k0 + kk) * N + n0 + (lane & 31)]; }
    LDS_WAIT(); asm volatile("" ::: "memory");
    const int c = lane & 7;
#pragma unroll
    for (int j = 0; j < 4; ++j) { const int n = (lane >> 3) + 8 * j; const LAS float* s = scr + (8 * c) * 33 + n;
        v4u o; o.x = pk2(s[0 * 33], s[1 * 33]); o.y = pk2(s[2 * 33], s[3 * 33]); o.z = pk2(s[4 * 33], s[5 * 33]); o.w = pk2(s[6 * 33], s[7 * 33]);
        *(GAS v4u*)(WT + (size_t)(dst_row0 + n) * K + k0 + 8 * c) = o; }
    LDS_WAIT(); asm volatile("" ::: "memory");
}
__device__ __forceinline__ void p0_ffin_item(const float* W, bf16* WT, int r, LAS float* scr, int lane) {
    const int kb = r / 176, nb = r % 176, n0 = 32 * nb; const bool up = n0 >= FF; const int j = up ? n0 - FF : n0;
    p0_transpose_item(W, D, NFF, WT, (j >> 7) * 256 + (up ? 128 : 0) + (j & 127), 64 * kb, n0, scr, lane);
}
__device__ __forceinline__ void p0_plain_item(const float* W, int K, int N, bf16* WT, int r, LAS float* scr, int lane) {
    const int nblk = N / 32, kb = r / nblk, nb = r % nblk;
    p0_transpose_item(W, K, N, WT, 32 * nb, 64 * kb, 32 * nb, scr, lane);
}
__device__ __forceinline__ void p0_weights(Frame& F) {
    LAS float* scr = (LAS float*)(F.lds + RING_OFF + F.wave * 16384);
    const int gw = F.vcu * NWAVES + F.wave, NGW = F.G * NWAVES;
    constexpr int I_FI = 16 * 176, I_FO = 44 * 32, I_IN = 16 * 80, I_O = 16 * 32, I_L = 16, NITEMS = 2 * I_FI + 2 * I_FO + I_IN + I_O + 4 * I_L;
    for (int it = gw; it < NITEMS; it += NGW) {
        int r = it;
        if (r < I_FI) { p0_ffin_item(F.a->in[I_W1IN], WSP(bf16, WS_W1IN), r, scr, F.lane); continue; } r -= I_FI;
        if (r < I_FI) { p0_ffin_item(F.a->in[I_W2IN], WSP(bf16, WS_W2IN), r, scr, F.lane); continue; } r -= I_FI;
        if (r < I_FO) { p0_plain_item(F.a->in[I_W1OUT], FF, D, WSP(bf16, WS_W1OUT), r, scr, F.lane); continue; } r -= I_FO;
        if (r < I_FO) { p0_plain_item(F.a->in[I_W2OUT], FF, D, WSP(bf16, WS_W2OUT), r, scr, F.lane); continue; } r -= I_FO;
        if (r < I_IN) { p0_plain_item(F.a->in[I_WIN], D, NIN, WSP(bf16, WS_WIN), r, scr, F.lane); continue; } r -= I_IN;
        if (r < I_O) { p0_plain_item(F.a->in[I_WOUT], D, D, WSP(bf16, WS_WOUT), r, scr, F.lane); continue; } r -= I_O;
        if (r < I_L) { p0_plain_item(F.a->in[I_WDEC], 64, RW, WSP(bf16, WS_LORA), r, scr, F.lane); continue; } r -= I_L;
        if (r < I_L) { p0_plain_item(F.a->in[I_WICLR], 64, RW, WSP(bf16, WS_LORA + LORA_WI), r, scr, F.lane); continue; } r -= I_L;
        p0_plain_item(F.a->in[I_WGATE], 128, RW, WSP(bf16, WS_LORA + LORA_WG), r, scr, F.lane);
    }
}
typedef float f32x16m __attribute__((ext_vector_type(16)));
__device__ __forceinline__ void p0_mod(Frame& F) {
    const float* wada = F.a->in[I_WADA]; const float* bada = F.a->in[I_BADA]; const float* cp = F.a->in[I_CP]; const float* cs = F.a->in[I_CS];
    float* mod = WSP(float, WS_MOD);
    LAS float* red = (LAS float*)F.lds;
    const int lane = F.lane, wave = F.wave, r = lane & 31, h = lane >> 5;
    for (int task = blockIdx.x; task < MODW / 32; task += F.G) {
        const int j0 = 32 * task;
        f32x16m acc[5];
#pragma unroll
        for (int bt = 0; bt < 5; ++bt)
#pragma unroll
            for (int e = 0; e < 16; ++e) acc[bt][e] = 0.f;
#pragma unroll 1
        for (int ks = 0; ks < 8; ++ks) {
            const int i0 = 128 * wave + 16 * ks + 8 * h;
            unsigned aw[4];
#pragma unroll
            for (int e = 0; e < 4; ++e) aw[e] = pk2(wada[(size_t)(i0 + 2 * e) * MODW + j0 + r], wada[(size_t)(i0 + 2 * e + 1) * MODW + j0 + r]);
            const bf16x8 af = __builtin_bit_cast(bf16x8, (v4u){aw[0], aw[1], aw[2], aw[3]});
#pragma unroll
            for (int bt = 0; bt < 5; ++bt) {
                const int b = 32 * bt + r;
                f32x4 c0 = (f32x4){0.f, 0.f, 0.f, 0.f}, c1 = c0;
                if (b < NMOD) { const float* cr = (b < 2 ? cp + (size_t)b * D : cs + (size_t)(b - 2) * D) + i0; c0 = *(const f32x4*)cr; c1 = *(const f32x4*)(cr + 4); }
                float sv[8];
#pragma unroll
                for (int e = 0; e < 4; ++e) { sv[e] = c0[e] * __builtin_amdgcn_rcpf(1.0f + __expf(-c0[e])); sv[4 + e] = c1[e] * __builtin_amdgcn_rcpf(1.0f + __expf(-c1[e])); }
                const bf16x8 bfm = __builtin_bit_cast(bf16x8, (v4u){pk2(sv[0], sv[1]), pk2(sv[2], sv[3]), pk2(sv[4], sv[5]), pk2(sv[6], sv[7])});
                acc[bt] = __builtin_amdgcn_mfma_f32_32x32x16_bf16(af, bfm, acc[bt], 0, 0, 0);
            }
        }
#pragma unroll
        for (int rd = 0; rd < 2; ++rd) {
            const int nv = rd == 0 ? 48 : 32, bt0 = rd == 0 ? 0 : 3;
            __syncthreads();
#pragma unroll
            for (int bt = 0; bt < 3; ++bt) if (bt0 + bt < 5)
#pragma unroll
                for (int e = 0; e < 16; ++e) red[(wave * 48 + bt * 16 + e) * 64 + lane] = acc[bt0 + bt][e];
            __syncthreads();
            for (int idx = F.tid; idx < nv * 64; idx += 512) {
                const int v = idx >> 6, ln = idx & 63, bt = bt0 + (v >> 4), e = v & 15;
                float s = 0.f;
#pragma unroll
                for (int w = 0; w < 8; ++w) s += red[(w * 48 + v) * 64 + ln];
                const int b = 32 * bt + (ln & 31), j = j0 + (e & 3) + 8 * (e >> 2) + 4 * (ln >> 5);
                if (b < NMOD) mod[(size_t)b * MODW + j] = s + bada[j];
            }
        }
    }
    __syncthreads();
}

__device__ __forceinline__ int mod_row_of(int m) { return m < MP ? (m >> 13) : 2 + ((m - MP) >> 3); }
__device__ __forceinline__ void p_modulate0(Frame& F) {
    const int gw = F.vcu * NWAVES + F.wave, NGW = F.G * NWAVES;
    const float* mod = WSP(float, WS_MOD); bf16* U = WSP(bf16, WS_U);
    for (int m = gw; m < M; m += NGW) {
        const float* xr = m < MP ? F.a->in[I_XP] + (size_t)m * D : F.a->in[I_XS] + (size_t)(m - MP) * D;
        const float* mr = mod + (size_t)mod_row_of(m) * MODW;
        unsigned long long* o8 = (unsigned long long*)(U + (size_t)m * D) + F.lane;
#pragma unroll
        for (int j = 0; j < 4; ++j) { const int c = 4 * F.lane + 256 * j;
            const f32x4 x = *(const f32x4*)(xr + c), sh = *(const f32x4*)(mr + c), sc = *(const f32x4*)(mr + D + c);
            const f32x4 u = x * (sc + 1.0f) + sh;
            o8[64 * j] = (unsigned long long)pk2(u[0], u[1]) | ((unsigned long long)pk2(u[2], u[3]) << 32); }
    }
}
__device__ __forceinline__ void p_layernorm(Frame& F, int lnidx, int koff) {
    const int gw = F.vcu * NWAVES + F.wave, NGW = F.G * NWAVES;
    const float* mod = WSP(float, WS_MOD); bf16* U = WSP(bf16, WS_U); float* X = F.a->out + O_Y;
    const float* lg = F.a->in[I_LNG] + lnidx * D; const float* lb = F.a->in[I_LNB] + lnidx * D;
    for (int m = gw; m < M; m += NGW) {
        float* xr = X + (size_t)m * D;
        f32x4 v[4]; float s = 0.f;
#pragma unroll
        for (int j = 0; j < 4; ++j) { v[j] = *(const f32x4*)(xr + 4 * F.lane + 256 * j); s += (v[j][0] + v[j][1]) + (v[j][2] + v[j][3]); }
        const float mean = wave_sum(s) * (1.f / D); float s2 = 0.f;
#pragma unroll
        for (int j = 0; j < 4; ++j) { v[j] = v[j] - mean; s2 += (v[j][0] * v[j][0] + v[j][1] * v[j][1]) + (v[j][2] * v[j][2] + v[j][3] * v[j][3]); }
        const float rstd = 1.f / sqrtf(wave_sum(s2) * (1.f / D) + LN_EPS);
        const float* mr = mod + (size_t)mod_row_of(m) * MODW + (koff >= 0 ? koff : 0);
        unsigned long long* o8 = (unsigned long long*)(U + (size_t)m * D) + F.lane;
#pragma unroll
        for (int j = 0; j < 4; ++j) { const int c = 4 * F.lane + 256 * j;
            const f32x4 x = v[j] * rstd * *(const f32x4*)(lg + c) + *(const f32x4*)(lb + c);
            *(f32x4*)(xr + c) = x;
            if (koff >= 0) { const f32x4 sh = *(const f32x4*)(mr + c), sc = *(const f32x4*)(mr + D + c); const f32x4 u = x * (sc + 1.0f) + sh;
                o8[64 * j] = (unsigned long long)pk2(u[0], u[1]) | ((unsigned long long)pk2(u[2], u[3]) << 32); } }
    }
}
__device__ __forceinline__ float prev_val(const bf16* P, const float* sshift, int m, int col) {
    if (m < MP) return (m & (TP - 1)) == 0 ? 0.f : bf2f(P[(size_t)(m - 1) * NIN + col]);
    const int ms = m - MP;
    return (ms & (TS - 1)) == 0 ? sshift[(size_t)(ms >> 3) * RWP + col] : bf2f(P[(size_t)(m - 1) * NIN + col]);
}
constexpr int PP_PITCH = 528;
__device__ __forceinline__ void p_prep(Frame& F) {
    LAS unsigned char* lds = F.lds;
    const bf16* P = WSP(bf16, WS_H); const float* sshift = F.a->in[I_SSHIFT]; const float* mu = F.a->in[I_MU];
    float* WLOG = WSP(float, WS_WLOG); bf16* AA = WSP(bf16, WS_A); bf16* GG = WSP(bf16, WS_G); float* INV = WSP(float, WS_INV);
    const int tid = F.tid, lane = F.lane, wave = F.wave;
    const int tile_lo0 = (F.vcu * (M / 16)) / F.G, tile_hi0 = ((F.vcu + 1) * (M / 16)) / F.G;
    for (int tile_lo = tile_lo0; tile_lo < tile_hi0; tile_lo += 5) {
    const int ntile = (tile_hi0 - tile_lo) < 5 ? (tile_hi0 - tile_lo) : 5;
    const int m_lo = tile_lo * 16, ntok = ntile * 16;
    __syncthreads();
    {
        const int j = tid & 255, hf = tid >> 8, col = 1536 + j; const float muj = mu[col];
        const int ta = hf == 0 ? 0 : (ntok >> 1), tb = hf == 0 ? (ntok >> 1) : ntok;
        float prev = ta < tb ? prev_val(P, sshift, m_lo + ta, col) : 0.f;
        for (int t = ta; t < tb; ++t) { const int m = m_lo + t;
            if (((m < MP) ? (m & (TP - 1)) : ((m - MP) & (TS - 1))) == 0) prev = prev_val(P, sshift, m, col);
            const float p = bf2f(P[(size_t)m * NIN + col]), xs = p + (prev - p) * muj; prev = p;
            const float f = j < 64 ? tanhf(xs) : (j < 128 ? xs : sigmoidf_(xs));
            *(LAS unsigned short*)(lds + t * PP_PITCH + j * 2) = (unsigned short)f2bf(f); }
    }
    {
        const int c = tid, col = RW + c; const float muk = mu[col], kkc = F.a->in[I_KK][c];
        float prev = ntok > 0 ? prev_val(P, sshift, m_lo, col) : 0.f;
        for (int t = 0; t < ntok; ++t) { const int m = m_lo + t;
            if (((m < MP) ? (m & (TP - 1)) : ((m - MP) & (TS - 1))) == 0) prev = prev_val(P, sshift, m, col);
            const float p = bf2f(P[(size_t)m * NIN + col]), xk = p + (prev - p) * muk, kq = xk * kkc; prev = p;
            const float ss = wave_sum_dpp(kq * kq);
            if (lane == 0) INV[(size_t)m * 8 + wave] = 1.0f / fmaxf(sqrtf(ss), 1e-12f); }
    }
    __syncthreads();
    const int lr = lane & 15, lq = lane >> 4, c0 = 64 * wave;
#pragma unroll 1
    for (int lo = 0; lo < 3; ++lo) {
        const int kin = lo == 0 ? 0 : (lo == 1 ? 64 : 128), nks = lo == 2 ? 4 : 2, wpitch = lo == 2 ? 128 : 64;
        const bf16* Wt = WSP(bf16, WS_LORA) + (lo == 0 ? 0 : (lo == 1 ? 512 * 64 : 2 * 512 * 64));
        f32x4 acc[5][4];
#pragma unroll
        for (int tt = 0; tt < 5; ++tt)
#pragma unroll
            for (int ct = 0; ct < 4; ++ct) acc[tt][ct] = (f32x4){0.f, 0.f, 0.f, 0.f};
        for (int ks = 0; ks < nks; ++ks) {
            bf16x8 wf[4];
#pragma unroll
            for (int ct = 0; ct < 4; ++ct) wf[ct] = *(const bf16x8*)(Wt + (size_t)(c0 + 16 * ct + lr) * wpitch + ks * 32 + lq * 8);
#pragma unroll
            for (int tt = 0; tt < 5; ++tt) if (tt < ntile) {
                const bf16x8 af = *(const LAS bf16x8*)(lds + (16 * tt + lr) * PP_PITCH + (kin + ks * 32 + lq * 8) * 2);
#pragma unroll
                for (int ct = 0; ct < 4; ++ct) acc[tt][ct] = __builtin_amdgcn_mfma_f32_16x16x32_bf16(wf[ct], af, acc[tt][ct], 0, 0, 0);
            }
        }
#pragma unroll
        for (int tt = 0; tt < 5; ++tt) if (tt < ntile) { const int m = m_lo + 16 * tt + lr;
#pragma unroll
            for (int ct = 0; ct < 4; ++ct) { const int c = c0 + 16 * ct + 4 * lq; const f32x4 a = acc[tt][ct];
                if (lo == 0) { const f32x4 w0v = *(const f32x4*)(F.a->in[I_W0] + c); f32x4 o;
#pragma unroll
                    for (int e = 0; e < 4; ++e) { const float z = w0v[e] + a[e]; const float sp = fmaxf(-z, 0.f) + log1pf(expf(-fabsf(z))); o[e] = -expf(-sp - 0.5f); }
                    *(f32x4*)(WLOG + (size_t)m * RW + c) = o; }
                else if (lo == 1) { const f32x4 a0v = *(const f32x4*)(F.a->in[I_A0] + c); f32x4 o;
#pragma unroll
                    for (int e = 0; e < 4; ++e) o[e] = sigmoidf_(a0v[e] + a[e]);
                    *(unsigned long long*)(AA + (size_t)m * RW + c) = pk4(o); }
                else *(unsigned long long*)(GG + (size_t)m * RW + c) = pk4(a); }
        }
    }
    }
    const int gt = F.vcu * 512 + F.tid, NT = F.G * 512;
    const float* ck = F.a->in[I_CK]; const float* cv = F.a->in[I_CV];
    for (int i = gt; i < 2 * RWP; i += NT) { const int b = i / RWP, col = i % RWP; F.a->out[O_SHIFT_P + i] = bf2f(P[(size_t)(b * TP + TP - 1) * NIN + col]); }
    for (int i = gt; i < NBS * RWP; i += NT) { const int b = i / RWP, col = i % RWP; F.a->out[O_SHIFT_S + i] = bf2f(P[(size_t)(MP + b * TS + TS - 1) * NIN + col]); }
    for (int i = gt; i < 2 * 128 * 128; i += NT) { const int b = i >> 14, j = (i >> 7) & 127, c2 = i & 127; const size_t row = (size_t)(b * TP + TP - 128 + j) * NIN;
        F.a->out[O_WINK_P + i] = bf2f(P[row + 2304 + c2]); F.a->out[O_WINV_P + i] = bf2f(P[row + 2432 + c2]); }
    for (int i = gt; i < NBS * 128 * 128; i += NT) { const int b = i >> 14, j = (i >> 7) & 127, c2 = i & 127;
        if (j < 120) { F.a->out[O_WINK_S + i] = ck[(size_t)(b * 128 + j + 8) * 128 + c2]; F.a->out[O_WINV_S + i] = cv[(size_t)(b * 128 + j + 8) * 128 + c2]; }
        else { const size_t row = (size_t)(MP + b * TS + (j - 120)) * NIN; F.a->out[O_WINK_S + i] = bf2f(P[row + 2304 + c2]); F.a->out[O_WINV_S + i] = bf2f(P[row + 2432 + c2]); } }
}

constexpr int SS_R = 0, SS_DEC = 1, SS_KM = 2, SS_KK = 3, SS_BB = 4, SS_V = 5;
__device__ __forceinline__ void sample_scan_unit(Frame& F, int b) {
    const int h = F.wave, lane = F.lane, chn = h * 64 + lane;
    LAS float* A = (LAS float*)F.lds + h * (6 * 8 * 64);
    const bf16* P = WSP(bf16, WS_H); const float* sshift = F.a->in[I_SSHIFT]; const float* mu = F.a->in[I_MU];
    const float* WLOG = WSP(float, WS_WLOG); const bf16* AA = WSP(bf16, WS_A); const bf16* GG = WSP(bf16, WS_G); const float* INV = WSP(float, WS_INV);
    bf16* MIX = WSP(bf16, WS_U);
    const float mur = mu[chn], muk = mu[RW + chn], muv = mu[2 * RW + chn], kkc = F.a->in[I_KK][chn], kac = F.a->in[I_KA][chn], rkc = F.a->in[I_RK][chn], gnw = F.a->in[I_GNW][chn], gnb = F.a->in[I_GNB][chn];
    __syncthreads();
    float q_r = sshift[(size_t)b * RWP + chn], q_k = sshift[(size_t)b * RWP + RW + chn], q_v = sshift[(size_t)b * RWP + 2 * RW + chn];
#pragma unroll
    for (int t = 0; t < TS; ++t) {
        const int m = MP + b * TS + t; const size_t pr = (size_t)m * NIN;
        const float p_r = bf2f(P[pr + chn]), p_k = bf2f(P[pr + RW + chn]), p_v = bf2f(P[pr + 2 * RW + chn]);
        const float xr = p_r + (q_r - p_r) * mur, xk = p_k + (q_k - p_k) * muk, xv = p_v + (q_v - p_v) * muv;
        q_r = p_r; q_k = p_k; q_v = p_v;
        const float a = bf2f(AA[(size_t)m * RW + chn]), wl = WLOG[(size_t)m * RW + chn], inv = INV[(size_t)m * 8 + h];
        const float kk = xk * kkc * inv;
        A[(SS_R * 8 + t) * 64 + lane] = xr; A[(SS_DEC * 8 + t) * 64 + lane] = expf(wl); A[(SS_KM * 8 + t) * 64 + lane] = xk * (1.0f + (a - 1.0f) * kac);
        A[(SS_KK * 8 + t) * 64 + lane] = kk; A[(SS_BB * 8 + t) * 64 + lane] = kk * a; A[(SS_V * 8 + t) * 64 + lane] = xv;
    }
    f32x4 S[16];
    { const f32x4* sp = (const f32x4*)(F.a->in[I_SWKV] + ((size_t)(b * 8 + h) * 64 + lane) * 64);
#pragma unroll
      for (int q = 0; q < 16; ++q) S[q] = sp[q]; }
    LDS_WAIT(); asm volatile("" ::: "memory");
#pragma unroll 1
    for (int t = 0; t < TS; ++t) {
        const LAS f32x4* pk = (const LAS f32x4*)(A + (SS_KK * 8 + t) * 64); const LAS f32x4* pb = (const LAS f32x4*)(A + (SS_BB * 8 + t) * 64);
        const LAS f32x4* pd = (const LAS f32x4*)(A + (SS_DEC * 8 + t) * 64); const LAS f32x4* pm = (const LAS f32x4*)(A + (SS_KM * 8 + t) * 64);
        const LAS f32x4* pq = (const LAS f32x4*)(A + (SS_R * 8 + t) * 64);
        const float v = A[(SS_V * 8 + t) * 64 + lane];
        f32x4 sa4 = (f32x4){0.f, 0.f, 0.f, 0.f};
#pragma unroll
        for (int q = 0; q < 16; ++q) sa4 += S[q] * pk[q];
        const float sa = (sa4[0] + sa4[1]) + (sa4[2] + sa4[3]);
        f32x4 y4 = (f32x4){0.f, 0.f, 0.f, 0.f};
#pragma unroll
        for (int q = 0; q < 16; ++q) { S[q] = S[q] * pd[q] + (pm[q] * v - pb[q] * sa); y4 += S[q] * pq[q]; }
        const float y = (y4[0] + y4[1]) + (y4[2] + y4[3]);
        const float mean = wave_sum_dpp(y) * (1.f / 64.f), d = y - mean, var = wave_sum_dpp(d * d) * (1.f / 64.f);
        const float yn = d * (1.0f / sqrtf(var + GN_EPS));
        const float dot = wave_sum_dpp(A[(SS_R * 8 + t) * 64 + lane] * A[(SS_KM * 8 + t) * 64 + lane] * rkc);
        const int m = MP + b * TS + t;
        const float g = bf2f(GG[(size_t)m * RW + chn]);
        MIX[(size_t)m * D + chn] = (bf16)f2bf((yn * gnw + gnb + dot * v) * g);
    }
    { f32x4* so = (f32x4*)(F.a->out + O_WKV_S + ((size_t)(b * 8 + h) * 64 + lane) * 64);
#pragma unroll
      for (int q = 0; q < 16; ++q) so[q] = S[q]; }
}
constexpr int PB = 144, PF = 272;
constexpr int MB16 = 64 * PB, MF32 = 64 * PF;
constexpr size_t WS_GX = 2 * MiB;
constexpr size_t WS_S0 = 167 * MiB;
static_assert(WS_GX + 512 * 32768 <= WS_WIN && WS_H + (size_t)M * NIN * 2 <= WS_S0 && WS_S0 + 512 * 16384 <= WS_WLOG, "scan scratch map");
constexpr int CA_RHS = 0, CA_LB = 34816, CA_KQ = 52224, CA_KD = 61440, CA_BD = 70656, CA_VT = 79872, CA_KET = 89088, CA_BET = 98304, CA_LK = 107520, CA_SMALL = 116736;
constexpr int CC_RHS = 0, CC_LB = 17408, CC_KQ = 34816, CC_RQ = 44032, CC_KD = 53248, CC_BD = 62464, CC_VT = 71680, CC_KET = 80896, CC_BET = 90112, CC_LK = 99328, CC_MK = 108544, CC_MB = 117760,
              CC_SHI = 126976, CC_SLO = 136192, CC_SMALL = 145408;
constexpr int SM_GL = 0, SM_DOT = 256, SM_TOT = 512, SM_BYTES = 512 + 2048;

__device__ __forceinline__ void mm_nt(f32x4 (&acc)[2], const LAS unsigned char* X, const LAS unsigned char* Y, int wave, int lane) {
    const int tr = wave >> 1, tc0 = (wave & 1) * 2, lr = lane & 15, lq = lane >> 4;
#pragma unroll
    for (int ks = 0; ks < 2; ++ks) {
        const bf16x8 xa = *(const LAS bf16x8*)(X + (16 * tr + lr) * PB + ks * 64 + lq * 16);
#pragma unroll
        for (int j = 0; j < 2; ++j) {
            const bf16x8 yb = *(const LAS bf16x8*)(Y + (16 * (tc0 + j) + lr) * PB + ks * 64 + lq * 16);
            acc[j] = __builtin_amdgcn_mfma_f32_16x16x32_bf16(yb, xa, acc[j], 0, 0, 0);
        }
    }
}
#define ACC_ZERO(a) do { a[0] = (f32x4){0.f, 0.f, 0.f, 0.f}; a[1] = (f32x4){0.f, 0.f, 0.f, 0.f}; } while (0)
#define ACC_M(wave, lane) (16 * ((wave) >> 1) + ((lane) & 15))
#define ACC_N(wave, lane, j) (16 * (((wave) & 1) * 2 + (j)) + 4 * ((lane) >> 4))
__device__ __forceinline__ void store_hilo(const f32x4 (&a)[2], LAS unsigned char* HI, LAS unsigned char* LO, int wave, int lane) {
    const int m = ACC_M(wave, lane);
#pragma unroll
    for (int j = 0; j < 2; ++j) { const int n = ACC_N(wave, lane, j);
        const unsigned long long hi = pk4(a[j]); const f32x4 lo = a[j] - bf4_to_f32(hi);
        *(LAS unsigned long long*)(HI + m * PB + n * 2) = hi; *(LAS unsigned long long*)(LO + m * PB + n * 2) = pk4(lo); }
}
template <int NW> __device__ __forceinline__ void tri_solve(const LAS unsigned char* LBT, const LAS unsigned char* RHS, LAS unsigned char* UT, int wave, int lane) {
    if (wave < NW) {
        const int col = wave * 64 + lane;
        f32x4 u[16], lv[8];
#pragma unroll
        for (int q = 0; q < 16; ++q) u[q] = *(const LAS f32x4*)(RHS + col * PF + q * 16);
#define TS_SWEEP(I0, I1, QOFF, QLO)                                                                                                      \
        _Pragma("unroll") for (int q = 0; q < 8; ++q) lv[q] = *(const LAS f32x4*)(LBT + (I0) * PF + (QOFF + q) * 16);                  \
        _Pragma("unroll") for (int i = (I0); i < (I1); ++i) {                                                                            \
            f32x4 ln[8];                                                                                                                 \
            _Pragma("unroll") for (int q = 0; q < 8; ++q) if (i + 1 < (I1) && q >= QLO(i + 1)) ln[q] = *(const LAS f32x4*)(LBT + (i + 1) * PF + (QOFF + q) * 16); \
            asm volatile("" ::: "memory");                                                                                               \
            const float ui = u[i >> 2][i & 3];                                                                                           \
            _Pragma("unroll") for (int q = 0; q < 8; ++q) if (q >= QLO(i)) u[QOFF + q] -= lv[q] * ui;                                    \
            _Pragma("unroll") for (int q = 0; q < 8; ++q) if (i + 1 < (I1) && q >= QLO(i + 1)) lv[q] = ln[q];                            \
        }
#define TS_QLO_A(i) (((i) + 1) >> 2)
#define TS_QLO_B(i) 0
#define TS_QLO_C(i) ((((i) + 1) >> 2) - 8)
        TS_SWEEP(0, 31, 0, TS_QLO_A)
        TS_SWEEP(0, 32, 8, TS_QLO_B)
        TS_SWEEP(32, 63, 8, TS_QLO_C)
#undef TS_SWEEP
#pragma unroll
        for (int q = 0; q < 8; ++q) { v4u w; w.x = pk2(u[2 * q][0], u[2 * q][1]); w.y = pk2(u[2 * q][2], u[2 * q][3]); w.z = pk2(u[2 * q + 1][0], u[2 * q + 1][1]); w.w = pk2(u[2 * q + 1][2], u[2 * q + 1][3]);
            *(LAS v4u*)(UT + col * PB + q * 16) = w; }
    }
}
template <bool PHC> __device__ __forceinline__ void chunk_stage(Frame& F, int m0, int h, int oKQ, int oRQ, int oKD, int oBD, int oVT, int oKET, int oBET, int oRHS, int oSMALL) {
    LAS unsigned char* lds = F.lds;
    const bf16* P = WSP(bf16, WS_H); const float* mu = F.a->in[I_MU];
    const float* WLOG = WSP(float, WS_WLOG); const bf16* AA = WSP(bf16, WS_A); const float* INV = WSP(float, WS_INV);
    const int e = F.lane, g = F.wave, chn = h * 64 + e;
    const float mur = mu[chn], muk = mu[RW + chn], muv = mu[2 * RW + chn], kkc = F.a->in[I_KK][chn], kac = F.a->in[I_KA][chn], rkc = F.a->in[I_RK][chn];
    const int mg = m0 + 8 * g;
    float pr[9], pk[9], pv[9];
    if ((mg & (TP - 1)) == 0) { pr[0] = 0.f; pk[0] = 0.f; pv[0] = 0.f; }
    else { const size_t o = (size_t)(mg - 1) * NIN; pr[0] = bf2f(P[o + chn]); pk[0] = bf2f(P[o + RW + chn]); pv[0] = bf2f(P[o + 2 * RW + chn]); }
    float wl[8], av[8], iv[8];
#pragma unroll
    for (int j = 0; j < 8; ++j) { const size_t o = (size_t)(mg + j) * NIN; pr[j + 1] = bf2f(P[o + chn]); pk[j + 1] = bf2f(P[o + RW + chn]); pv[j + 1] = bf2f(P[o + 2 * RW + chn]);
        wl[j] = WLOG[(size_t)(mg + j) * RW + chn]; av[j] = bf2f(AA[(size_t)(mg + j) * RW + chn]); iv[j] = INV[(size_t)(mg + j) * 8 + h]; }
    float cw[8]; { float s = 0.f;
#pragma unroll
        for (int j = 0; j < 8; ++j) { s += wl[j]; cw[j] = s; } }
    LAS float* TOT = (LAS float*)(lds + oSMALL + SM_TOT);
    TOT[g * 64 + e] = cw[7];
    __syncthreads();
    float off = 0.f, cwL = 0.f;
#pragma unroll
    for (int gg = 0; gg < 8; ++gg) { const float tv = TOT[gg * 64 + e]; cwL += tv; if (gg < g) off += tv; }
    if (g == 0) ((LAS float*)(lds + oSMALL + SM_GL))[e] = expf(cwL);
    unsigned vt[8], ket[8], bet[8]; float kq[8];
#pragma unroll
    for (int j = 0; j < 8; ++j) {
        const int t = 8 * g + j;
        const float c = off + cw[j];
        const float xr = pr[j + 1] + (pr[j] - pr[j + 1]) * mur, xk = pk[j + 1] + (pk[j] - pk[j + 1]) * muk, xv = pv[j + 1] + (pv[j] - pv[j + 1]) * muv;
        const float kk = xk * kkc * iv[j], km = xk * (1.0f + (av[j] - 1.0f) * kac), bb = kk * av[j];
        const float e1 = expf(c), e2 = 1.0f / e1, e3 = expf(c - wl[j]), e4 = expf(cwL - c);
        kq[j] = kk * e3;
        *(LAS unsigned short*)(lds + oKQ + t * PB + e * 2) = (unsigned short)f2bf(kq[j]);
        *(LAS unsigned short*)(lds + oKD + t * PB + e * 2) = (unsigned short)f2bf(km * e2);
        *(LAS unsigned short*)(lds + oBD + t * PB + e * 2) = (unsigned short)f2bf(bb * e2);
        if (PHC) { *(LAS unsigned short*)(lds + oRQ + t * PB + e * 2) = (unsigned short)f2bf(xr * e1);
            const float d = wave_sum_dpp(xr * km * rkc); if (e == 0) ((LAS float*)(lds + oSMALL + SM_DOT))[t] = d; }
        vt[j] = f2bf(xv); ket[j] = f2bf(km * e4); bet[j] = f2bf(bb * e4);
    }
    { v4u w; w.x = vt[0] | (vt[1] << 16); w.y = vt[2] | (vt[3] << 16); w.z = vt[4] | (vt[5] << 16); w.w = vt[6] | (vt[7] << 16); *(LAS v4u*)(lds + oVT + e * PB + g * 16) = w; }
    { v4u w; w.x = ket[0] | (ket[1] << 16); w.y = ket[2] | (ket[3] << 16); w.z = ket[4] | (ket[5] << 16); w.w = ket[6] | (ket[7] << 16); *(LAS v4u*)(lds + oKET + e * PB + g * 16) = w; }
    { v4u w; w.x = bet[0] | (bet[1] << 16); w.y = bet[2] | (bet[3] << 16); w.z = bet[4] | (bet[5] << 16); w.w = bet[6] | (bet[7] << 16); *(LAS v4u*)(lds + oBET + e * PB + g * 16) = w; }
    if (!PHC) { *(LAS f32x4*)(lds + oRHS + e * PF + g * 32) = (f32x4){kq[0], kq[1], kq[2], kq[3]}; *(LAS f32x4*)(lds + oRHS + e * PF + g * 32 + 16) = (f32x4){kq[4], kq[5], kq[6], kq[7]}; }
}
__device__ __forceinline__ void scanA_task(Frame& F, int task) {
    LAS unsigned char* lds = F.lds; const int wave = F.wave, lane = F.lane;
    const int sc = task & 31, bh = task >> 5, h = bh & 7, b = bh >> 3;
    const int m = ACC_M(wave, lane);
    f32x4 gacc[2], xacc[2];
#pragma unroll
    for (int j = 0; j < 2; ++j) { const int n = ACC_N(wave, lane, j);
#pragma unroll
        for (int r = 0; r < 4; ++r) { gacc[j][r] = (m == n + r) ? 1.f : 0.f; xacc[j][r] = 0.f; } }
    for (int c = 0; c < 4; ++c) {
        __syncthreads();
        chunk_stage<false>(F, b * TP + sc * 256 + c * 64, h, CA_KQ, 0, CA_KD, CA_BD, CA_VT, CA_KET, CA_BET, CA_RHS, CA_SMALL);
        __syncthreads();
        { f32x4 a[2]; ACC_ZERO(a); mm_nt(a, lds + CA_BD, lds + CA_KQ, wave, lane);
#pragma unroll
          for (int j = 0; j < 2; ++j) { const int n = ACC_N(wave, lane, j); f32x4 o;
#pragma unroll
              for (int r = 0; r < 4; ++r) o[r] = (n + r > m) ? a[j][r] : 0.f;
              *(LAS f32x4*)(lds + CA_LB + m * PF + n * 4) = o; } }
        { f32x4 a[2]; ACC_ZERO(a); mm_nt(a, lds + CA_KQ, lds + CA_KD, wave, lane);
#pragma unroll
          for (int j = 0; j < 2; ++j) { const int n = ACC_N(wave, lane, j); f32x4 o;
#pragma unroll
              for (int r = 0; r < 4; ++r) o[r] = (n + r < m) ? a[j][r] : 0.f;
              *(LAS unsigned long long*)(lds + CA_LK + m * PB + n * 2) = pk4(o); } }
        __syncthreads();
        { f32x4 a[2]; ACC_ZERO(a); mm_nt(a, lds + CA_VT, lds + CA_LK, wave, lane);
#pragma unroll
          for (int j = 0; j < 2; ++j) { const int n = ACC_N(wave, lane, j); *(LAS f32x4*)(lds + CA_RHS + (64 + m) * PF + n * 4) = a[j]; } }
        __syncthreads();
        tri_solve<2>(lds + CA_LB, lds + CA_RHS, lds + CA_KD, wave, lane);
        __syncthreads();
        f32x4 pt[2], xc[2];
        { f32x4 a[2]; ACC_ZERO(a); mm_nt(a, lds + CA_BET, lds + CA_KD, wave, lane);
          const LAS float* GL = (const LAS float*)(lds + CA_SMALL + SM_GL);
#pragma unroll
          for (int j = 0; j < 2; ++j) { const int n = ACC_N(wave, lane, j);
#pragma unroll
              for (int r = 0; r < 4; ++r) pt[j][r] = ((m == n + r) ? GL[n + r] : 0.f) - a[j][r]; } }
        { f32x4 a1[2], a2[2]; ACC_ZERO(a1); ACC_ZERO(a2);
          mm_nt(a1, lds + CA_VT, lds + CA_KET, wave, lane); mm_nt(a2, lds + CA_KD + 64 * PB, lds + CA_BET, wave, lane);
          xc[0] = a1[0] - a2[0]; xc[1] = a1[1] - a2[1]; }
        store_hilo(pt, lds + CA_KQ, lds + CA_LK, wave, lane);
        store_hilo(gacc, lds + 0, lds + MB16, wave, lane);
        store_hilo(xacc, lds + 2 * MB16, lds + 3 * MB16, wave, lane);
        __syncthreads();
        { f32x4 a[2]; ACC_ZERO(a);
          mm_nt(a, lds + 0, lds + CA_KQ, wave, lane); mm_nt(a, lds + 0, lds + CA_LK, wave, lane); mm_nt(a, lds + MB16, lds + CA_KQ, wave, lane);
          gacc[0] = a[0]; gacc[1] = a[1]; }
        { f32x4 a[2]; a[0] = xc[0]; a[1] = xc[1];
          mm_nt(a, lds + 2 * MB16, lds + CA_KQ, wave, lane); mm_nt(a, lds + 2 * MB16, lds + CA_LK, wave, lane); mm_nt(a, lds + 3 * MB16, lds + CA_KQ, wave, lane);
          xacc[0] = a[0]; xacc[1] = a[1]; }
    }
    float* GT = (float*)(F.a->ws + WS_GX + (size_t)task * 32768); float* XO = GT + 4096;
#pragma unroll
    for (int j = 0; j < 2; ++j) { const int n = ACC_N(wave, lane, j);
#pragma unroll
        for (int r = 0; r < 4; ++r) GT[(n + r) * 64 + m] = gacc[j][r];
        *(f32x4*)(XO + m * 64 + n) = xacc[j]; }
}
__device__ __forceinline__ void scanB_unit(Frame& F, int bh) {
    LAS unsigned char* lds = F.lds; const int wave = F.wave, lane = F.lane, tid = F.tid;
    const int m = ACC_M(wave, lane);
    f32x4 s[2]; ACC_ZERO(s);
    for (int sc = 0; sc < 32; ++sc) {
        const int task = bh * 32 + sc;
        const float* GT = (const float*)(F.a->ws + WS_GX + (size_t)task * 32768); const float* XI = GT + 4096; float* S0 = (float*)(F.a->ws + WS_S0 + (size_t)task * 16384);
        __syncthreads();
        { const int row = tid >> 3, c8 = (tid & 7) * 8;
          const f32x4 v0 = *(const f32x4*)(GT + row * 64 + c8), v1 = *(const f32x4*)(GT + row * 64 + c8 + 4);
          const unsigned long long h0 = pk4(v0), h1 = pk4(v1); const f32x4 l0 = v0 - bf4_to_f32(h0), l1 = v1 - bf4_to_f32(h1);
          v4u wh, wl; wh.x = (unsigned)h0; wh.y = (unsigned)(h0 >> 32); wh.z = (unsigned)h1; wh.w = (unsigned)(h1 >> 32);
          const unsigned long long q0 = pk4(l0), q1 = pk4(l1); wl.x = (unsigned)q0; wl.y = (unsigned)(q0 >> 32); wl.z = (unsigned)q1; wl.w = (unsigned)(q1 >> 32);
          *(LAS v4u*)(lds + 2 * MB16 + row * PB + c8 * 2) = wh; *(LAS v4u*)(lds + 3 * MB16 + row * PB + c8 * 2) = wl; }
        store_hilo(s, lds + 0, lds + MB16, wave, lane);
#pragma unroll
        for (int j = 0; j < 2; ++j) { const int n = ACC_N(wave, lane, j); *(f32x4*)(S0 + m * 64 + n) = s[j]; }
        __syncthreads();
        f32x4 a[2];
#pragma unroll
        for (int j = 0; j < 2; ++j) { const int n = ACC_N(wave, lane, j); a[j] = *(const f32x4*)(XI + m * 64 + n); }
        mm_nt(a, lds + 0, lds + 2 * MB16, wave, lane); mm_nt(a, lds + 0, lds + 3 * MB16, wave, lane); mm_nt(a, lds + MB16, lds + 2 * MB16, wave, lane);
        s[0] = a[0]; s[1] = a[1];
    }
    __syncthreads();
}
__device__ __forceinline__ void scanC_task(Frame& F, int task) {
    LAS unsigned char* lds = F.lds; const int wave = F.wave, lane = F.lane;
    const int sc = task & 31, bh = task >> 5, h = bh & 7, b = bh >> 3;
    const int m = ACC_M(wave, lane);
    const bf16* GG = WSP(bf16, WS_G); bf16* MIX = WSP(bf16, WS_U);
    const int chn = h * 64 + lane; const float gnw = F.a->in[I_GNW][chn], gnb = F.a->in[I_GNB][chn];
    f32x4 s[2];
    { const float* S0 = (const float*)(F.a->ws + WS_S0 + (size_t)task * 16384);
#pragma unroll
      for (int j = 0; j < 2; ++j) { const int n = ACC_N(wave, lane, j); s[j] = *(const f32x4*)(S0 + m * 64 + n); } }
    for (int c = 0; c < 4; ++c) {
        const int m0 = b * TP + sc * 256 + c * 64;
        __syncthreads();
        chunk_stage<true>(F, m0, h, CC_KQ, CC_RQ, CC_KD, CC_BD, CC_VT, CC_KET, CC_BET, 0, CC_SMALL);
        store_hilo(s, lds + CC_SHI, lds + CC_SLO, wave, lane);
        __syncthreads();
        { f32x4 a[2]; ACC_ZERO(a); mm_nt(a, lds + CC_BD, lds + CC_KQ, wave, lane);
#pragma unroll
          for (int j = 0; j < 2; ++j) { const int n = ACC_N(wave, lane, j); f32x4 o;
#pragma unroll
              for (int r = 0; r < 4; ++r) o[r] = (n + r > m) ? a[j][r] : 0.f;
              *(LAS f32x4*)(lds + CC_LB + m * PF + n * 4) = o; } }
        { f32x4 a[2]; ACC_ZERO(a); mm_nt(a, lds + CC_KQ, lds + CC_KD, wave, lane);
#pragma unroll
          for (int j = 0; j < 2; ++j) { const int n = ACC_N(wave, lane, j); f32x4 o;
#pragma unroll
              for (int r = 0; r < 4; ++r) o[r] = (n + r < m) ? a[j][r] : 0.f;
              *(LAS unsigned long long*)(lds + CC_LK + m * PB + n * 2) = pk4(o); } }
        { f32x4 a[2], a2[2]; ACC_ZERO(a); ACC_ZERO(a2); mm_nt(a, lds + CC_RQ, lds + CC_KD, wave, lane); mm_nt(a2, lds + CC_RQ, lds + CC_BD, wave, lane);
#pragma unroll
          for (int j = 0; j < 2; ++j) { const int n = ACC_N(wave, lane, j); f32x4 o, o2;
#pragma unroll
              for (int r = 0; r < 4; ++r) { o[r] = (n + r <= m) ? a[j][r] : 0.f; o2[r] = (n + r <= m) ? a2[j][r] : 0.f; }
              *(LAS unsigned long long*)(lds + CC_MK + m * PB + n * 2) = pk4(o); *(LAS unsigned long long*)(lds + CC_MB + m * PB + n * 2) = pk4(o2); } }
        __syncthreads();
        { f32x4 a[2]; ACC_ZERO(a);
          mm_nt(a, lds + CC_SHI, lds + CC_KQ, wave, lane); mm_nt(a, lds + CC_SLO, lds + CC_KQ, wave, lane); mm_nt(a, lds + CC_VT, lds + CC_LK, wave, lane);
#pragma unroll
          for (int j = 0; j < 2; ++j) { const int n = ACC_N(wave, lane, j); *(LAS f32x4*)(lds + CC_RHS + m * PF + n * 4) = a[j]; } }
        __syncthreads();
        tri_solve<1>(lds + CC_LB, lds + CC_RHS, lds + CC_KD, wave, lane);
        __syncthreads();
        { f32x4 a[2], a2[2]; ACC_ZERO(a); ACC_ZERO(a2);
          mm_nt(a, lds + CC_RQ, lds + CC_SHI, wave, lane); mm_nt(a, lds + CC_RQ, lds + CC_SLO, wave, lane); mm_nt(a, lds + CC_MK, lds + CC_VT, wave, lane);
          mm_nt(a2, lds + CC_MB, lds + CC_KD, wave, lane);
#pragma unroll
          for (int j = 0; j < 2; ++j) { const int n = ACC_N(wave, lane, j); *(LAS f32x4*)(lds + CC_LB + m * PF + n * 4) = a[j] - a2[j]; } }
        { f32x4 a1[2], a2[2]; ACC_ZERO(a1); ACC_ZERO(a2);
          mm_nt(a1, lds + CC_VT, lds + CC_KET, wave, lane); mm_nt(a2, lds + CC_KD, lds + CC_BET, wave, lane);
          const LAS float* GL = (const LAS float*)(lds + CC_SMALL + SM_GL);
#pragma unroll
          for (int j = 0; j < 2; ++j) { const int n = ACC_N(wave, lane, j); const f32x4 gl = *(const LAS f32x4*)(GL + n); s[j] = s[j] * gl + a1[j] - a2[j]; } }
        __syncthreads();
        for (int t = wave; t < 64; t += 8) {
            const int mm = m0 + t;
            const float y = *(const LAS float*)(lds + CC_LB + t * PF + lane * 4);
            const float mean = wave_sum_dpp(y) * (1.f / 64.f), d = y - mean, var = wave_sum_dpp(d * d) * (1.f / 64.f);
            const float yn = d * (1.0f / sqrtf(var + GN_EPS));
            const float dot = ((const LAS float*)(lds + CC_SMALL + SM_DOT))[t];
            const float v = bf2f(*(const LAS unsigned short*)(lds + CC_VT + lane * PB + t * 2));
            const float gg = bf2f(GG[(size_t)mm * RW + chn]);
            MIX[(size_t)mm * D + chn] = (bf16)f2bf((yn * gnw + gnb + dot * v) * gg);
        }
    }
    if (sc == 31) { float* so = F.a->out + O_WKV_P + (size_t)bh * 4096;
#pragma unroll
        for (int j = 0; j < 2; ++j) { const int n = ACC_N(wave, lane, j); *(f32x4*)(so + m * 64 + n) = s[j]; } }
}
__device__ __forceinline__ int rel_bucket(int n) {
    if (n < 16) return n;
    const int b = 16 + (int)(logf((float)n * (1.0f / 16.0f)) / 2.0794415416798357f * 16.0f);
    return b < 31 ? b : 31;
}
typedef float f32x16 __attribute__((ext_vector_type(16)));
typedef short s16x4 __attribute__((ext_vector_type(4)));
struct AttnLane { const bf16* qrow; int qrel; int rmin; const LAS float* btab; float sink; bf16* orow; };
__device__ __forceinline__ void attn_core32(const LAS unsigned char* Kl, const LAS unsigned char* Vt, int VTP, int kt0, const AttnLane L, int lane) {
    const int r = lane & 31, h = lane >> 5;
    bf16x8 qf[4];
#pragma unroll
    for (int ds = 0; ds < 4; ++ds) qf[ds] = *(const bf16x8*)(L.qrow + 16 * ds + 8 * h);
    f32x16 sc[5];
#pragma unroll
    for (int T = 0; T < 5; ++T) {
#pragma unroll
        for (int e = 0; e < 16; ++e) sc[T][e] = 0.f;
#pragma unroll
        for (int ds = 0; ds < 4; ++ds) { const bf16x8 kf = *(const LAS bf16x8*)(Kl + ((kt0 + T) * 32 + r) * 144 + (16 * ds + 8 * h) * 2);
            sc[T] = __builtin_amdgcn_mfma_f32_32x32x16_bf16(kf, qf[ds], sc[T], 0, 0, 0); }
    }
    float mx = L.sink;
#pragma unroll
    for (int T = 0; T < 5; ++T)
#pragma unroll
        for (int e = 0; e < 16; ++e) { const int rabs = (kt0 + T) * 32 + (e & 3) + 8 * (e >> 2) + 4 * h, dist = L.qrel - rabs;
            const bool valid = dist >= 0 && dist < 128 && rabs >= L.rmin;
            const float s = valid ? sc[T][e] * 0.125f + L.btab[dist & 127] : -1e30f;
            sc[T][e] = s; mx = fmaxf(mx, s); }
    mx = fmaxf(mx, __shfl_xor(mx, 32));
    float l = 0.f;
#pragma unroll
    for (int T = 0; T < 5; ++T)
#pragma unroll
        for (int e = 0; e < 16; ++e) { const float p = sc[T][e] > -1e29f ? __expf(sc[T][e] - mx) : 0.f; sc[T][e] = p; l += p; }
    l += __shfl_xor(l, 32);
    l += __expf(L.sink - mx);
    f32x16 o[2];
#pragma unroll
    for (int e = 0; e < 16; ++e) { o[0][e] = 0.f; o[1][e] = 0.f; }
#pragma unroll
    for (int T = 0; T < 5; ++T)
#pragma unroll
        for (int s2 = 0; s2 < 2; ++s2) {
            v4u pw; pw.x = pk2(sc[T][8 * s2], sc[T][8 * s2 + 1]); pw.y = pk2(sc[T][8 * s2 + 2], sc[T][8 * s2 + 3]); pw.z = pk2(sc[T][8 * s2 + 4], sc[T][8 * s2 + 5]); pw.w = pk2(sc[T][8 * s2 + 6], sc[T][8 * s2 + 7]);
            const bf16x8 pb = __builtin_bit_cast(bf16x8, pw);
#pragma unroll
            for (int dt = 0; dt < 2; ++dt) {
                const LAS unsigned char* vp = Vt + (32 * dt + r) * VTP + ((kt0 + T) * 32 + 16 * s2 + 4 * h) * 2;
                const s16x4 lo = *(const LAS s16x4*)vp, hi = *(const LAS s16x4*)(vp + 16);
                const bf16x8 va = (bf16x8){lo[0], lo[1], lo[2], lo[3], hi[0], hi[1], hi[2], hi[3]};
                o[dt] = __builtin_amdgcn_mfma_f32_32x32x16_bf16(va, pb, o[dt], 0, 0, 0);
            }
        }
    const float il = 1.0f / l;
#pragma unroll
    for (int dt = 0; dt < 2; ++dt)
#pragma unroll
        for (int gq = 0; gq < 4; ++gq) { const int d = 32 * dt + 8 * gq + 4 * h;
            const unsigned long long w = (unsigned long long)pk2(o[dt][4 * gq] * il, o[dt][4 * gq + 1] * il) | ((unsigned long long)pk2(o[dt][4 * gq + 2] * il, o[dt][4 * gq + 3] * il) << 32);
            *(unsigned long long*)(L.orow + d) = w; }
}
constexpr int AP_K = 0, AP_VTP = 528, AP_VT = 256 * 144, AP_BT = AP_VT + 64 * AP_VTP, AP_END = AP_BT + 4 * 128 * 4;
__device__ __forceinline__ void attn_prompt_unit(Frame& F, int b, int kvh, int qb) {
    LAS unsigned char* lds = F.lds;
    const bf16* P = WSP(bf16, WS_H); bf16* MIX = WSP(bf16, WS_U); const float* relb = F.a->in[I_RELB];
    const int t0 = qb * 128, tid = F.tid;
    __syncthreads();
    for (int idx = tid; idx < 256 * 8; idx += 512) {
        const int row = idx >> 3, part = idx & 7, pos = t0 - 128 + row;
        v4u val = (v4u){0u, 0u, 0u, 0u};
        if (pos >= 0) val = *(const v4u*)(P + (size_t)(b * TP + pos) * NIN + 2304 + kvh * 64 + part * 8);
        *(LAS v4u*)(lds + AP_K + row * 144 + part * 16) = val;
    }
    for (int idx = tid; idx < 256 * 8; idx += 512) {
        const int row = idx & 255, part = idx >> 8, pos = t0 - 128 + row;
        v4u val = (v4u){0u, 0u, 0u, 0u};
        if (pos >= 0) val = *(const v4u*)(P + (size_t)(b * TP + pos) * NIN + 2432 + kvh * 64 + part * 8);
#pragma unroll
        for (int e = 0; e < 4; ++e) { *(LAS unsigned short*)(lds + AP_VT + (part * 8 + 2 * e) * AP_VTP + row * 2) = (unsigned short)(val[e] & 0xffffu);
                                      *(LAS unsigned short*)(lds + AP_VT + (part * 8 + 2 * e + 1) * AP_VTP + row * 2) = (unsigned short)(val[e] >> 16); }
    }
    { const int g = tid >> 7, dist = tid & 127; ((LAS float*)(lds + AP_BT))[g * 128 + dist] = relb[rel_bucket(dist) * 8 + kvh * 4 + g]; }
    __syncthreads();
    const int g = F.wave & 3, qh = F.wave >> 2, hq = kvh * 4 + g;
#pragma unroll 1
    for (int bq = 0; bq < 2; ++bq) {
        const int i = 64 * qh + 32 * bq + (F.lane & 31), m = b * TP + t0 + i;
        AttnLane L; L.qrow = P + (size_t)m * NIN + RWP + hq * 64; L.qrel = i + 128; L.rmin = t0 == 0 ? 128 : 0;
        L.btab = (const LAS float*)(lds + AP_BT) + g * 128; L.sink = F.a->in[I_SINKS][hq]; L.orow = MIX + (size_t)m * D + RW + hq * 64;
        attn_core32(lds + AP_K, lds + AP_VT, AP_VTP, 2 * qh + bq, L, F.lane);
    }
}
static_assert(AP_END <= RING_BYTES && AP_VT % 16 == 0 && CC_SMALL + SM_BYTES <= RING_BYTES && CA_SMALL + SM_BYTES <= RING_BYTES, "LDS maps");
constexpr int AS_KB = 160 * 144, AS_VTP = 336, AS_VT = 2 * AS_KB, AS_VB = 64 * AS_VTP, AS_BT = AS_VT + 2 * AS_VB, AS_END = AS_BT + 8 * 128 * 4;
static_assert(AS_END <= RING_BYTES && AS_VT % 16 == 0 && AS_VB % 16 == 0, "LDS maps");
__device__ __forceinline__ void attn_sample_unit(Frame& F, int b) {
    LAS unsigned char* lds = F.lds;
    const bf16* P = WSP(bf16, WS_H); bf16* MIX = WSP(bf16, WS_U); const float* relb = F.a->in[I_RELB]; const float* ck = F.a->in[I_CK]; const float* cv = F.a->in[I_CV];
    const int tid = F.tid;
    __syncthreads();
    for (int idx = tid; idx < 160 * 32; idx += 512) {
        const int j = idx >> 5, c4 = (idx & 31) * 4, kvh = c4 >> 6, d = c4 & 63;
        f32x4 kx = (f32x4){0.f, 0.f, 0.f, 0.f}, vx = kx;
        if (j < 128) { kx = *(const f32x4*)(ck + (size_t)(b * 128 + j) * 128 + c4); vx = *(const f32x4*)(cv + (size_t)(b * 128 + j) * 128 + c4); }
        else if (j < 136) { const bf16* pr = P + (size_t)(MP + b * TS + (j - 128)) * NIN;
            const unsigned long long kw = *(const unsigned long long*)(pr + 2304 + c4), vw = *(const unsigned long long*)(pr + 2432 + c4); kx = bf4_to_f32(kw); vx = bf4_to_f32(vw); }
        *(LAS unsigned long long*)(lds + kvh * AS_KB + j * 144 + d * 2) = pk4(kx);
#pragma unroll
        for (int e = 0; e < 4; ++e) *(LAS unsigned short*)(lds + AS_VT + kvh * AS_VB + (d + e) * AS_VTP + j * 2) = (unsigned short)f2bf(vx[e]);
    }
    for (int idx = tid; idx < 1024; idx += 512) { const int hq = idx >> 7, dist = idx & 127; ((LAS float*)(lds + AS_BT))[idx] = relb[rel_bucket(dist) * 8 + hq]; }
    __syncthreads();
    if (F.wave < 2) {
        const int kvh = F.wave, rr = F.lane & 31, g = rr >> 3, t = rr & 7, hq = kvh * 4 + g, m = MP + b * TS + t;
        AttnLane L; L.qrow = P + (size_t)m * NIN + RWP + hq * 64; L.qrel = t + 128; L.rmin = 0;
        L.btab = (const LAS float*)(lds + AS_BT) + hq * 128; L.sink = F.a->in[I_SINKS][hq]; L.orow = MIX + (size_t)m * D + RW + hq * 64;
        attn_core32(lds + kvh * AS_KB, lds + AS_VT + kvh * AS_VB, AS_VTP, 0, L, F.lane);
    }
}
__device__ __forceinline__ void mixer_task(Frame& F0, int t) {
    Frame F = F0;
    { int t_ = threadIdx.x; asm volatile("" : "+v"(t_)); F.tid = t_; F.lane = t_ & 63; F.wave = __builtin_amdgcn_readfirstlane(t_ >> 6); }
    if (t < 16) scanB_unit(F, t);
    else if (t < 272) { const int u = t - 16; attn_prompt_unit(F, u >> 7, (u >> 6) & 1, u & 63); }
    else if (t < 400) sample_scan_unit(F, t - 272);
    else attn_sample_unit(F, t - 400);
}
__device__ __forceinline__ void p_mixer(Frame& F) {
    int t = F.vcu, step = F.G, end = 528;
    if (F.G >= 32) { if (F.vcu < 16) { step = 1 << 20; end = 16; } else step = F.G - 16; }
    for (; t < end; t += step) mixer_task(F, t);
    __syncthreads();
}
__device__ __forceinline__ void p_scanA(Frame& F) { for (int t = F.vcu; t < 512; t += F.G) scanA_task(F, t); __syncthreads(); }
__device__ __forceinline__ void p_scanC(Frame& F) { for (int t = F.vcu; t < 512; t += F.G) scanC_task(F, t); __syncthreads(); }
#ifndef MK_PER_PHASE
#define MK_PER_PHASE 0
#endif
constexpr int N_PHASES = 15;
__global__ void __launch_bounds__(NWAVES * 64, 2) fwd_kernel(Args args) {
    extern __shared__ __attribute__((aligned(16))) unsigned char lds[];
    Frame F;
    F.lds = (LAS unsigned char*)lds;
    F.MISC = (volatile LAS unsigned*)(F.lds + MISC_OFF);
    F.tid = threadIdx.x; F.lane = F.tid & 63; F.wave = __builtin_amdgcn_readfirstlane(F.tid >> 6);
    F.G = gridDim.x; { const int bx = blockIdx.x; F.vcu = (F.G % 8 == 0) ? (bx % 8) * (F.G / 8) + bx / 8 : bx; }
    F.a = &args; F.ctl = (gu32*)(args.ws + WS_CTL);
    for (int u = F.tid; u < (LDS_BYTES - LDSCTL_OFF) / 4; u += NWAVES * 64) ((LAS unsigned*)(F.lds + LDSCTL_OFF))[u] = 0u;
    __syncthreads();
    const int lo = args.ph_lo, hi = args.ph_hi;
    XcdBarrier bar; bar.bar = (unsigned*)(F.ctl + CW_BAR); bar.x = 0; bar.st = nullptr;
    if (hi - lo > 1) bar = xcd_barrier_post((unsigned*)(F.ctl + CW_BAR), F.MISC + 8);
#ifdef ONLY_PHASE
#define IN(k) ((k) == ONLY_PHASE && lo <= (k) && (k) < hi)
#else
#define IN(k) (lo <= (k) && (k) < hi)
#endif
#ifndef REP_PHASE
#define REP_PHASE -1
#endif
#define SEAM(k) do { if ((k) + 1 < hi) xcd_barrier(bar); } while (0)
#define PH(k, BODY) if (IN(k)) { BODY; if ((k) == REP_PHASE) { xcd_barrier(bar); BODY; } SEAM(k); }
#define GEMM_SWIGLU(WOFF) { \
        pg8::Gemm g{WSP(bf16, WS_U), WSP(bf16, WOFF), M, NFF, D}; pg8::StaticOrder S; S.init(M, NFF, F.G, (int)blockIdx.x); \
        pg8::EpiSwiglu E{WSP(bf16, WS_H), FF}; \
        pg8::gemm_phase<pg8::EpiSwiglu, pg8::StaticOrder, true, true>(F.lds + RING_OFF, g, S, E); }
#define GEMM_RESID(AOFF, WOFF, KK, XP, XS, GTK, GS) { \
        pg8::Gemm g{WSP(bf16, AOFF), WSP(bf16, WOFF), M, D, KK}; pg8::StaticOrder S; S.init(M, D, F.G, (int)blockIdx.x); \
        pg8::EpiResid E{XP, XS, args.out + O_Y, WSP(float, WS_MOD) + (GTK) * D, ALPHA, GS}; \
        pg8::gemm_phase<pg8::EpiResid, pg8::StaticOrder, true, true>(F.lds + RING_OFF, g, S, E); }
#define GEMM_WIN() { \
        pg8::Gemm g{WSP(bf16, WS_U), WSP(bf16, WS_WIN), M, NIN, D}; pg8::StaticOrder S; S.init(M, NIN, F.G, (int)blockIdx.x); \
        pg8::EpiBf16<0> E{WSP(bf16, WS_H), NIN, nullptr, 0, 0, 1.f}; \
        pg8::gemm_phase<pg8::EpiBf16<0>, pg8::StaticOrder, true, true>(F.lds + RING_OFF, g, S, E); }
    PH(0, { p0_weights(F); if (REP_PHASE == 100) { __syncthreads(); p0_weights(F); } __syncthreads(); p0_mod(F); if (REP_PHASE == 101) { __syncthreads(); p0_mod(F); } })
    PH(1, p_modulate0(F))
    PH(2, GEMM_SWIGLU(WS_W1IN))
    PH(3, GEMM_RESID(WS_H, WS_W1OUT, FF, args.in[I_XP], args.in[I_XS], 2, 0.5f))
    PH(4, p_layernorm(F, 0, 3 * D))
    PH(5, GEMM_WIN())
    PH(6, p_prep(F))
    PH(7, p_scanA(F))
    PH(8, p_mixer(F))
    PH(9, p_scanC(F))
    PH(10, GEMM_RESID(WS_U, WS_WOUT, D, args.out + O_Y, args.out + O_Y + (size_t)MP * D, 5, 1.0f))
    PH(11, p_layernorm(F, 1, 6 * D))
    PH(12, GEMM_SWIGLU(WS_W2IN))
    PH(13, GEMM_RESID(WS_H, WS_W2OUT, FF, args.out + O_Y, args.out + O_Y + (size_t)MP * D, 8, 0.5f))
    PH(14, p_layernorm(F, 2, -1))
}

extern "C" void kernel_launch(void* const* d_in, const int* in_sizes, int n_in, void* d_out, int out_size, void* d_ws, size_t ws_size, hipStream_t stream) {
    static int grid = 0;
    if (grid == 0) {
        if (n_in != N_IN || in_sizes[0] != MP * D || out_size != (int)O_END || ws_size < WS_END) { fprintf(stderr, "kernel_launch: unexpected shapes (n_in %d, out %d, ws %zu); nothing launched\n", n_in, out_size, ws_size); grid = -1; return; }
        int dev = 0, cus = 0;
        if (hipGetDevice(&dev) != hipSuccess || hipDeviceGetAttribute(&cus, hipDeviceAttributeMultiprocessorCount, dev) != hipSuccess) { grid = -1; return; }
        if (hipFuncSetAttribute((const void*)fwd_kernel, hipFuncAttributeMaxDynamicSharedMemorySize, LDS_BYTES) != hipSuccess) { fprintf(stderr, "kernel_launch: hipFuncSetAttribute failed\n"); grid = -1; return; }
        int per_cu = 0;
        if (hipOccupancyMaxActiveBlocksPerMultiprocessor(&per_cu, (const void*)fwd_kernel, NWAVES * 64, LDS_BYTES) != hipSuccess || per_cu < 1) fprintf(stderr, "kernel_launch: occupancy query reports %d\n", per_cu);
        (void)hipGetLastError();
        grid = cus;
    }
    if (grid < 0) return;
    if (hipMemsetAsync((char*)d_ws + WS_CTL, 0, CTL_ZERO_BYTES, stream) != hipSuccess) return;
    Args a{};
    for (int i = 0; i < N_IN; ++i) a.in[i] = (const float*)d_in[i];
    a.out = (float*)d_out; a.ws = (unsigned char*)d_ws;
#if MK_PER_PHASE
    for (int ph = 0; ph < N_PHASES; ++ph) { a.ph_lo = ph; a.ph_hi = ph + 1; hipLaunchKernelGGL(fwd_kernel, dim3(grid), dim3(NWAVES * 64), LDS_BYTES, stream, a); }
#else
    a.ph_lo = 0; a.ph_hi = N_PHASES;
    hipLaunchKernelGGL(fwd_kernel, dim3(grid), dim3(NWAVES * 64), LDS_BYTES, stream, a);
#endif
}
```

```cpp
#define MK_PER_PHASE 0

#include <hip/hip_runtime.h>
#include <cstdio>
#include <cstdint>
#include <cmath>
namespace pg8 {
#define PG8_LAS __attribute__((address_space(3)))
typedef unsigned short bf16_t;
typedef short bf16x8 __attribute__((ext_vector_type(8)));
typedef float f32x4 __attribute__((ext_vector_type(4)));
typedef unsigned u32x4 __attribute__((ext_vector_type(4)));
constexpr int BM = 256, BK = 64, HALF = 128, HTB = HALF * BK * 2  , STAGE_BYTES = 8 * HTB, NXCD = 8, WGM = 8;

__host__ __device__ __forceinline__ int lds_byte(int r, int c) { const int st = (r >> 4) * 2 + (c >> 5), rr = r & 15, cc = c & 31, ob = rr * 64 + cc * 2; return st * 1024 + (ob ^ (((ob >> 9) & 1) << 5)); }
__host__ __device__ __forceinline__ void stage_rc(int b, int& R, int& C) { const int st = b / 1024, sb = b % 1024, swz = sb ^ (((sb >> 9) & 1) << 5); R = (st >> 1) * 16 + swz / 64; C = (st & 1) * 32 + (swz % 64) / 2; }
__host__ __device__ __forceinline__ int perm32(int rho) { const int n = rho >> 4, i = rho & 15; return 8 * (i >> 2) + 4 * n + (i & 3); }

struct Unit { int pm, pn; };
struct Gemm { const bf16_t* A; const bf16_t* Bt; int M, N, K; };

struct StaticOrder {
    int nM, nN, nwg, G, c;
    __host__ __device__ void init(int M, int N, int G_, int c_) { nM = M / BM; nN = N / BM; nwg = nM * nN; G = G_; c = c_; }
    __host__ __device__ bool next(int i, Unit& u) const {
        const long L = (long)i * G + c; if (L >= nwg) return false;
        int wgid = (int)L; { const int q = nwg / NXCD, r = nwg % NXCD, xcd = wgid % NXCD, off = wgid / NXCD; wgid = (xcd < r ? xcd * (q + 1) : r * (q + 1) + (xcd - r) * q) + off; }
        const int nig = WGM * nN, gid = wgid / nig, fm = gid * WGM, gsz = (nM - fm) < WGM ? (nM - fm) : WGM;
        u.pm = fm + ((wgid % nig) % gsz); u.pn = (wgid % nig) / gsz; return true;
    }
    __device__ __forceinline__ void a_ready(const Unit&) const {}
    __device__ __forceinline__ void done(const Unit&) const {}
};

__device__ __forceinline__ unsigned cvt_pk_bf16(float lo, float hi) { unsigned r; asm volatile("v_cvt_pk_bf16_f32 %0, %1, %2" : "=v"(r) : "v"(lo), "v"(hi)); return r; }
template <int ACT  > struct EpiBf16 {
    static constexpr bool PERM = true, AFTER_DRAIN = false; static_assert(ACT == 0, "EpiBf16: ACT is 0 (none)");
    bf16_t* O; int ldc; const float* bias; int split_cols; size_t split_stride; float scale0;
    __device__ __forceinline__ void operator()(const f32x4 (&acc)[2][2][4][2], const Unit& u, int wr, int wc, int fr, int fq) const {
        const int row0 = u.pm * BM + wr * 64 + fr; int colt = u.pn * BM; bf16_t* base = O;
        float sc = 1.f; if (split_cols) { const int t = colt / split_cols; base += (size_t)t * split_stride; colt -= t * split_cols; if (t == 0) sc = scale0; }
        const int col0 = colt + wc * 32 + 8 * fq, bcol0 = u.pn * BM + wc * 32 + 8 * fq;
        f32x4 bv[2][2];
#pragma unroll
        for (int bj = 0; bj < 2; ++bj)
#pragma unroll
            for (int n = 0; n < 2; ++n) bv[bj][n] = bias ? *(const f32x4*)(bias + bcol0 + bj * HALF + 4 * n) : (f32x4){0.f, 0.f, 0.f, 0.f};
#pragma unroll
        for (int ai = 0; ai < 2; ++ai)
#pragma unroll
            for (int m = 0; m < 4; ++m) { bf16_t* rowp = base + (size_t)(row0 + ai * HALF + m * 16) * ldc + col0;
#pragma unroll
                for (int bj = 0; bj < 2; ++bj) { f32x4 v0 = acc[ai][bj][m][0] + bv[bj][0], v1 = acc[ai][bj][m][1] + bv[bj][1];
                    v0 = v0 * sc; v1 = v1 * sc; u32x4 w; w.x = cvt_pk_bf16(v0[0], v0[1]); w.y = cvt_pk_bf16(v0[2], v0[3]); w.z = cvt_pk_bf16(v1[0], v1[1]); w.w = cvt_pk_bf16(v1[2], v1[3]);
                    *(u32x4*)(rowp + bj * HALF) = w; } }
    }
};

template <class Epi, class Sched, bool ALIGN_EPI = false, bool SP2 = false>
__device__ __forceinline__ void gemm_phase(PG8_LAS unsigned char* lds, const Gemm g, const Sched& S, const Epi& E) {
    const int tid = threadIdx.x, wid = __builtin_amdgcn_readfirstlane(tid >> 6), lane = tid & 63, wr = wid >> 2, wc = wid & 3, fr = lane & 15, fq = lane >> 4;
    const int K = g.K, nt = K / BK;
    unsigned voffA[2], voffB[2];
#pragma unroll
    for (int i = 0; i < 2; ++i) { int R, C; stage_rc(tid * 16 + i * 8192, R, C); const int Rb = Epi::PERM ? ((R & ~31) + perm32(R & 31)) : R;
        voffA[i] = (unsigned)(R * K + C) * 2u; voffB[i] = (unsigned)(Rb * K + C) * 2u; }
    const size_t kstep = (size_t)(BK * 2);
    const size_t hstep = (size_t)HALF * K * 2;
    const size_t tstep = 2 * hstep;
    const unsigned ldsw = (unsigned)wid * 1024u;
    const int aoff = lds_byte(wr * 64 + fr, fq * 8), boff = lds_byte(wc * 32 + fr, fq * 8);
#define PG8_SA(b, h) (((b) * 2 + (h)) * HTB)
#define PG8_SB(b, h) ((4 + (b) * 2 + (h)) * HTB)
#define PG8_STAGE(bufoff, gbase, voff) do { _Pragma("unroll") for (int _i = 0; _i < 2; ++_i) \
        __builtin_amdgcn_global_load_lds((const unsigned*)((const char*)(gbase) + (voff)[_i]), (PG8_LAS unsigned*)(lds + (bufoff) + ldsw + _i * 8192), 16, 0, 0); } while (0)
#define PG8_LDA(dst, b, h) do { _Pragma("unroll") for (int m = 0; m < 4; ++m) _Pragma("unroll") for (int k = 0; k < 2; ++k) dst[m][k] = *(const PG8_LAS bf16x8*)(lds + PG8_SA(b, h) + aoff + m * 2048 + k * 1024); } while (0)
#define PG8_LDB(dst, b, h) do { _Pragma("unroll") for (int n = 0; n < 2; ++n) _Pragma("unroll") for (int k = 0; k < 2; ++k) dst[n][k] = *(const PG8_LAS bf16x8*)(lds + PG8_SB(b, h) + boff + n * 2048 + k * 1024); } while (0)
#define PG8_MMA(ai, bj, At, Bt) do { __builtin_amdgcn_s_setprio(1); _Pragma("unroll") for (int m = 0; m < 4; ++m) _Pragma("unroll") for (int n = 0; n < 2; ++n) _Pragma("unroll") for (int k = 0; k < 2; ++k) \
        acc[ai][bj][m][n] = __builtin_amdgcn_mfma_f32_16x16x32_bf16(Bt[n][k], At[m][k], acc[ai][bj][m][n], 0, 0, 0); __builtin_amdgcn_s_setprio(0); } while (0)
#define PG8_WAIT_V(n) asm volatile("s_waitcnt vmcnt(" #n ")" ::: "memory")
#define PG8_WAIT_L(n) asm volatile("s_waitcnt lgkmcnt(" #n ")" ::: "memory")
#define PG8_BAR __builtin_amdgcn_s_barrier()
#define PG8_SCHED __builtin_amdgcn_sched_barrier(0)
    Unit cur, nxt; int ui = 0;
    if (!S.next(0, cur)) return;
    f32x4 acc[2][2][4][2];
#pragma unroll
    for (int a = 0; a < 2; ++a)
#pragma unroll
        for (int b = 0; b < 2; ++b)
#pragma unroll
            for (int m = 0; m < 4; ++m)
#pragma unroll
                for (int n = 0; n < 2; ++n) acc[a][b][m][n] = (f32x4){0.f, 0.f, 0.f, 0.f};
    bf16x8 At[4][2], B0[2][2], B1[2][2];
    const char* cA = (const char*)g.A + (size_t)cur.pm * tstep; const char* cB = (const char*)g.Bt + (size_t)cur.pn * tstep;
    S.a_ready(cur);
    if constexpr (SP2) {
        PG8_STAGE(PG8_SB(0, 0), cB, voffB); PG8_STAGE(PG8_SB(0, 1), cB + hstep, voffB); PG8_STAGE(PG8_SA(0, 0), cA, voffA); PG8_STAGE(PG8_SA(0, 1), cA + hstep, voffA);
        if (wr == 1) PG8_BAR;
        PG8_WAIT_V(2); PG8_BAR;
        PG8_STAGE(PG8_SB(1, 0), cB + kstep, voffB); PG8_STAGE(PG8_SA(1, 0), cA + kstep, voffA); PG8_STAGE(PG8_SB(1, 1), cB + hstep + kstep, voffB);
        PG8_WAIT_V(6); PG8_BAR;
    } else {
        PG8_STAGE(PG8_SB(0, 0), cB, voffB); PG8_STAGE(PG8_SA(0, 0), cA, voffA); PG8_STAGE(PG8_SB(0, 1), cB + hstep, voffB); PG8_STAGE(PG8_SA(0, 1), cA + hstep, voffA);
        if (wr == 1) PG8_BAR;
        PG8_WAIT_V(4); PG8_BAR;
        PG8_STAGE(PG8_SB(1, 0), cB + kstep, voffB); PG8_STAGE(PG8_SA(1, 0), cA + kstep, voffA); PG8_STAGE(PG8_SB(1, 1), cB + hstep + kstep, voffB);
        PG8_WAIT_V(6); PG8_BAR;
    }
    for (;;) {
        const bool has_next = S.next(ui + 1, nxt);
        const char* nA = has_next ? (const char*)g.A + (size_t)nxt.pm * tstep : cA; const char* nB = has_next ? (const char*)g.Bt + (size_t)nxt.pn * tstep : cB;
        for (int t = 0; t < nt; t += 2) {
            const bool last = (t == nt - 2);
            const char* a1 = cA + (size_t)(t + 1) * kstep;
            const char* a2 = last ? nA : cA + (size_t)(t + 2) * kstep; const char* b2 = last ? nB : cB + (size_t)(t + 2) * kstep;
            const char* a3 = a2 + kstep; const char* b3 = b2 + kstep;
            if (last && has_next) S.a_ready(nxt);
            if constexpr (SP2) {
            PG8_LDB(B0, 0, 0); PG8_LDB(B1, 0, 1); PG8_SCHED; PG8_LDA(At, 0, 0); PG8_STAGE(PG8_SA(1, 1), a1 + hstep, voffA);
            PG8_WAIT_V(8); PG8_WAIT_L(0); PG8_BAR; PG8_MMA(0, 0, At, B0); PG8_MMA(0, 1, At, B1); PG8_BAR; PG8_SCHED;
            PG8_LDA(At, 0, 1); PG8_STAGE(PG8_SB(0, 0), b2, voffB); PG8_STAGE(PG8_SB(0, 1), b2 + hstep, voffB); PG8_STAGE(PG8_SA(0, 0), a2, voffA);
            PG8_WAIT_V(8); PG8_WAIT_L(0); PG8_BAR; PG8_MMA(1, 0, At, B0); PG8_MMA(1, 1, At, B1); PG8_BAR; PG8_SCHED;
            PG8_LDB(B0, 1, 0); PG8_LDB(B1, 1, 1); PG8_SCHED; PG8_LDA(At, 1, 0); PG8_STAGE(PG8_SA(0, 1), a2 + hstep, voffA);
            PG8_WAIT_V(8); PG8_WAIT_L(0); PG8_BAR; PG8_MMA(0, 0, At, B0); PG8_MMA(0, 1, At, B1); PG8_BAR; PG8_SCHED;
            PG8_LDA(At, 1, 1); PG8_STAGE(PG8_SB(1, 0), b3, voffB); PG8_STAGE(PG8_SB(1, 1), b3 + hstep, voffB); PG8_STAGE(PG8_SA(1, 0), a3, voffA);
            PG8_WAIT_V(8); PG8_WAIT_L(0); PG8_BAR; PG8_MMA(1, 0, At, B0); PG8_MMA(1, 1, At, B1); PG8_BAR; PG8_SCHED;
            } else {
            PG8_LDB(B0, 0, 0); PG8_SCHED; PG8_LDA(At, 0, 0); PG8_STAGE(PG8_SA(1, 1), a1 + hstep, voffA);
            PG8_WAIT_L(8); PG8_BAR; PG8_WAIT_L(0); PG8_MMA(0, 0, At, B0); PG8_BAR; PG8_SCHED;
            PG8_LDB(B1, 0, 1); PG8_STAGE(PG8_SB(0, 0), b2, voffB);
            PG8_BAR; PG8_WAIT_L(0); PG8_MMA(0, 1, At, B1); PG8_BAR;
            PG8_LDA(At, 0, 1); PG8_STAGE(PG8_SA(0, 0), a2, voffA);
            PG8_BAR; PG8_WAIT_L(0); PG8_MMA(1, 0, At, B0); PG8_BAR; PG8_SCHED;
            PG8_STAGE(PG8_SB(0, 1), b2 + hstep, voffB);
            PG8_WAIT_V(6); PG8_BAR; PG8_MMA(1, 1, At, B1); PG8_BAR;
            PG8_LDB(B0, 1, 0); PG8_SCHED; PG8_LDA(At, 1, 0); PG8_STAGE(PG8_SA(0, 1), a2 + hstep, voffA);
            PG8_WAIT_L(8); PG8_BAR; PG8_WAIT_L(0); PG8_MMA(0, 0, At, B0); PG8_BAR; PG8_SCHED;
            PG8_LDB(B1, 1, 1); PG8_STAGE(PG8_SB(1, 0), b3, voffB);
            PG8_BAR; PG8_WAIT_L(0); PG8_MMA(0, 1, At, B1); PG8_BAR;
            PG8_LDA(At, 1, 1); PG8_STAGE(PG8_SA(1, 0), a3, voffA);
            PG8_BAR; PG8_WAIT_L(0); PG8_MMA(1, 0, At, B0); PG8_BAR; PG8_SCHED;
            PG8_STAGE(PG8_SB(1, 1), b3 + hstep, voffB);
            PG8_WAIT_V(6); PG8_BAR; PG8_MMA(1, 1, At, B1); PG8_BAR;
            }
        }
        if constexpr (ALIGN_EPI) { if (wr == 0) PG8_BAR; }
        if constexpr (!Epi::AFTER_DRAIN) { E(acc, cur, wr, wc, fr, fq); S.done(cur); }
        if (!has_next) break;
#pragma unroll
        for (int a = 0; a < 2; ++a)
#pragma unroll
            for (int b = 0; b < 2; ++b)
#pragma unroll
                for (int m = 0; m < 4; ++m)
#pragma unroll
                    for (int n = 0; n < 2; ++n) acc[a][b][m][n] = (f32x4){0.f, 0.f, 0.f, 0.f};
        cur = nxt; cA = nA; cB = nB; ++ui;
        if constexpr (ALIGN_EPI) { if (wr == 1) PG8_BAR; }
    }
    PG8_WAIT_V(0);
    if constexpr (!ALIGN_EPI) { if (wr == 0) PG8_BAR; }
    PG8_BAR;
    if constexpr (Epi::AFTER_DRAIN) { E.fused(acc, cur, wr, wc, fr, fq, lds, wid, lane); S.done(cur); }
#undef PG8_SA
#undef PG8_SB
#undef PG8_STAGE
#undef PG8_LDA
#undef PG8_LDB
#undef PG8_MMA
#undef PG8_WAIT_V
#undef PG8_WAIT_L
#undef PG8_BAR
#undef PG8_SCHED
}
struct EpiSwiglu {
    static constexpr bool PERM = true, AFTER_DRAIN = false;
    bf16_t* H; int ldh;
    __device__ __forceinline__ void operator()(const f32x4 (&acc)[2][2][4][2], const Unit& u, int wr, int wc, int fr, int fq) const {
        const int row0 = u.pm * BM + wr * 64 + fr, col0 = u.pn * HALF + wc * 32 + 8 * fq;
#pragma unroll
        for (int ai = 0; ai < 2; ++ai)
#pragma unroll
            for (int m = 0; m < 4; ++m) {
                bf16_t* p = H + (size_t)(row0 + ai * HALF + m * 16) * ldh + col0;
                float h[8];
#pragma unroll
                for (int n = 0; n < 2; ++n)
#pragma unroll
                    for (int i = 0; i < 4; ++i) { const float g = acc[ai][0][m][n][i], up = acc[ai][1][m][n][i];
                        h[n * 4 + i] = g * __builtin_amdgcn_rcpf(1.0f + __expf(-g)) * up; }
                u32x4 w; w.x = cvt_pk_bf16(h[0], h[1]); w.y = cvt_pk_bf16(h[2], h[3]); w.z = cvt_pk_bf16(h[4], h[5]); w.w = cvt_pk_bf16(h[6], h[7]);
                *(u32x4*)p = w;
            }
    }
};
struct EpiResid {
    static constexpr bool PERM = false, AFTER_DRAIN = false;
    const float* xp; const float* xs; float* X; const float* gt; float alpha, gs;
    __device__ __forceinline__ void operator()(const f32x4 (&acc)[2][2][4][2], const Unit& u, int wr, int wc, int fr, int fq) const {
        const int col0 = u.pn * BM + wc * 32 + 4 * fq;
#pragma unroll
        for (int ai = 0; ai < 2; ++ai)
#pragma unroll
            for (int m = 0; m < 4; ++m) {
                const int row = u.pm * BM + ai * HALF + wr * 64 + m * 16 + fr;
                const bool smp = row >= 16384;
                const float* xr = smp ? xs + (size_t)(row - 16384) * 1024 : xp + (size_t)row * 1024;
                const int b = smp ? 2 + ((row - 16384) >> 3) : (row >> 13);
                const float* gr = gt + (size_t)b * 9216;
                float* xo = X + (size_t)row * 1024;
#pragma unroll
                for (int bj = 0; bj < 2; ++bj)
#pragma unroll
                    for (int n = 0; n < 2; ++n) { const int c = col0 + bj * HALF + n * 16;
                        const f32x4 xv = *(const f32x4*)(xr + c), gv = *(const f32x4*)(gr + c);
                        const f32x4 z = xv * alpha + (gv + 1.0f) * gs * acc[ai][bj][m][n];
                        *(f32x4*)(xo + c) = z; }
            }
    }
};
}
#define GAS __attribute__((address_space(1)))
#define LAS __attribute__((address_space(3)))
typedef unsigned short bf16;
typedef unsigned v4u __attribute__((ext_vector_type(4)));
typedef float f32x4 __attribute__((ext_vector_type(4)));
typedef short bf16x8 __attribute__((ext_vector_type(8)));
typedef GAS unsigned gu32;
typedef GAS unsigned long long gu64;
#define RLX_AGENT __ATOMIC_RELAXED, __HIP_MEMORY_SCOPE_AGENT
#define LDS_WAIT() asm volatile("s_waitcnt lgkmcnt(0)" ::: "memory")
#define VM_WAIT() asm volatile("s_waitcnt vmcnt(0)" ::: "memory")
__device__ __forceinline__ unsigned long long rt() { return __builtin_amdgcn_s_memrealtime(); }
__device__ __forceinline__ unsigned f2bf(float f) { unsigned u = __builtin_bit_cast(unsigned, f); return (u + 0x7fffu + ((u >> 16) & 1u)) >> 16; }
__device__ __forceinline__ unsigned pk2(float lo, float hi) { return f2bf(lo) | (f2bf(hi) << 16); }

#define XB_TMO      128
#define XB_XCNT(j)  (256  + 64 * (j))
#define XB_XSUB(j)  (1280 + 64 * (j))
#define XB_XGEN(j)  (2304 + 64 * (j))
#define XB_TOP      3328
#define XB_TOPGEN   3392
#define XCD_BAR_WORDS 3456
#define XB_SPIN_CAP (1u << 18)

__device__ __forceinline__ unsigned xb_ld(unsigned* p)              { return __hip_atomic_load(p, __ATOMIC_RELAXED, __HIP_MEMORY_SCOPE_AGENT); }
__device__ __forceinline__ unsigned xb_add(unsigned* p, unsigned v) { return __hip_atomic_fetch_add(p, v, __ATOMIC_RELAXED, __HIP_MEMORY_SCOPE_AGENT); }
__device__ __forceinline__ unsigned xb_xcc_id() { return (unsigned)__builtin_amdgcn_s_getreg((3 << 11) | 20) & 0xFu; }
#define XB_SPIN(cond, bar) do { unsigned _sp = 0; while (cond) { __builtin_amdgcn_s_sleep(1); \
    if ((++_sp & 255u) == 0u) { if (xb_ld(&(bar)[XB_TMO])) break; if (_sp > XB_SPIN_CAP) { atomicAdd(&(bar)[XB_TMO], 1u); break; } } } } while (0)

struct XcdBarrier {
    unsigned* bar; unsigned x;
    volatile LAS unsigned* st;
};

__device__ __forceinline__ XcdBarrier xcd_barrier_post(unsigned* bar, volatile LAS unsigned* st) {
    XcdBarrier b; b.bar = bar; b.x = xb_xcc_id(); b.st = st;
    if (threadIdx.x == 0) (void)xb_add(&bar[XB_XCNT(b.x)], 1u);
    return b;
}
__device__ __forceinline__ void xcd_barrier_complete(unsigned* bar, unsigned x, unsigned& nloc, unsigned& nx) {
    const unsigned G = gridDim.x * gridDim.y * gridDim.z;
    unsigned sum, cnt, mine, sp = 0u;
    for (;;) {
        sum = 0u; cnt = 0u; mine = 0u;
#pragma unroll
        for (unsigned j = 0; j < 16; ++j) { const unsigned c = xb_ld(&bar[XB_XCNT(j)]); sum += c; cnt += (c > 0u) ? 1u : 0u; mine = (j == x) ? c : mine; }
        if (sum == G) break;
        __builtin_amdgcn_s_sleep(1);
        if ((++sp & 255u) == 0u) { if (xb_ld(&bar[XB_TMO])) break; if (sp > XB_SPIN_CAP) { atomicAdd(&bar[XB_TMO], 1u); break; } }
    }
    nloc = mine > 0u ? mine : 1u; nx = cnt > 0u ? cnt : 1u;
}

__device__ __forceinline__ void xcd_barrier(const XcdBarrier& b) {
    asm volatile("s_waitcnt vmcnt(0)" ::: "memory");
    __syncthreads();
    if (threadIdx.x == 0) {
        unsigned* bar = b.bar;
        __builtin_amdgcn_s_waitcnt(0);
        unsigned nloc = b.st[0], nx = b.st[1];
        if (nloc == 0u) { xcd_barrier_complete(bar, b.x, nloc, nx); b.st[0] = nloc; b.st[1] = nx; }
        const unsigned old = xb_add(&bar[XB_XSUB(b.x)], 1u);
        const unsigned gen = old / nloc;
        if (old + 1u == (gen + 1u) * nloc) {
            __builtin_amdgcn_fence(__ATOMIC_RELEASE, "agent");
            asm volatile("s_waitcnt vmcnt(0)" ::: "memory");
            const unsigned og = xb_add(&bar[XB_TOP], 1u);
            const unsigned tg = og / nx;
            if (og + 1u == (tg + 1u) * nx) xb_add(&bar[XB_TOPGEN], 1u);
            else XB_SPIN(xb_ld(&bar[XB_TOPGEN]) == tg, bar);
            __builtin_amdgcn_fence(__ATOMIC_ACQUIRE, "agent");
            xb_add(&bar[XB_XGEN(b.x)], 1u);
            asm volatile("s_waitcnt vmcnt(0)" ::: "memory");
        } else {
            XB_SPIN(xb_ld(&bar[XB_XGEN(b.x)]) == gen, bar);
            __builtin_amdgcn_fence(__ATOMIC_ACQUIRE, "agent");
            asm volatile("s_waitcnt vmcnt(0)" ::: "memory");
        }
    }
    __syncthreads();
}

constexpr int D = 1024, FF = 2816, NFF = 2 * FF, NIN = 2560, RW = 512, RWP = 1792;
constexpr int MP = 16384, MS = 1024, M = MP + MS, TP = 8192, TS = 8, NBS = 128;
constexpr int MODW = 9216, NMOD = 130;
constexpr float ALPHA = 1.189207115002721f;
constexpr float LN_EPS = 1e-5f, GN_EPS = 64e-5f;
constexpr int NWAVES = 8;
enum { I_XP = 0, I_XS, I_SWKV, I_SSHIFT, I_CK, I_CV, I_CP, I_CS, I_RELB, I_WADA, I_BADA, I_LNG, I_LNB, I_W1IN, I_W1OUT, I_WIN, I_MU, I_W0, I_WDEC, I_A0, I_WICLR, I_WGATE,
       I_KK, I_KA, I_RK, I_GNW, I_GNB, I_SINKS, I_WOUT, I_W2IN, I_W2OUT, N_IN };
constexpr size_t O_Y = 0, O_WKV_P = (size_t)M * D, O_SHIFT_P = O_WKV_P + 65536, O_WINK_P = O_SHIFT_P + 3584, O_WINV_P = O_WINK_P + 32768,
                 O_WKV_S = O_WINV_P + 32768, O_SHIFT_S = O_WKV_S + 4194304, O_WINK_S = O_SHIFT_S + 229376, O_WINV_S = O_WINK_S + 2097152, O_END = O_WINV_S + 2097152;
static_assert(O_END == 26578432, "d_out size");
constexpr size_t MiB = 1u << 20;
constexpr size_t WS_CTL = 0, CTL_ZERO_BYTES = 1 * MiB;
constexpr size_t WS_W1IN = 2 * MiB, WS_W1OUT = 13 * MiB, WS_WIN = 19 * MiB, WS_WOUT = 24 * MiB, WS_W2IN = 26 * MiB, WS_W2OUT = 37 * MiB;
constexpr size_t WS_MOD = 43 * MiB;
constexpr size_t WS_U = 48 * MiB;
constexpr size_t WS_H = 82 * MiB;
constexpr size_t WS_WLOG = 176 * MiB, WS_A = 210 * MiB, WS_G = 227 * MiB, WS_INV = 244 * MiB, WS_LORA = 245 * MiB, WS_END = 246 * MiB;
constexpr size_t LORA_WI = 512 * 64 * 2, LORA_WG = 2 * 512 * 64 * 2;
static_assert(WS_W1IN + (size_t)NFF * D * 2 <= WS_W1OUT && WS_W1OUT + (size_t)D * FF * 2 <= WS_WIN && WS_WIN + (size_t)NIN * D * 2 <= WS_WOUT && WS_WOUT + (size_t)D * D * 2 <= WS_W2IN &&
              WS_W2IN + (size_t)NFF * D * 2 <= WS_W2OUT && WS_W2OUT + (size_t)D * FF * 2 <= WS_MOD && WS_MOD + (size_t)NMOD * MODW * 4 <= WS_U && WS_U + (size_t)M * D * 2 <= WS_H &&
              WS_H + (size_t)M * FF * 2 <= WS_WLOG && WS_WLOG + (size_t)M * RW * 4 <= WS_A && WS_A + (size_t)M * RW * 2 <= WS_G && WS_G + (size_t)M * RW * 2 <= WS_INV &&
              WS_INV + (size_t)M * 8 * 4 <= WS_LORA && WS_LORA + 4 * 512 * 64 * 2 <= WS_END && WS_END <= 256 * MiB, "d_ws map");
constexpr int CW_BAR = 4096;
constexpr int RING_OFF = 0, RING_BYTES = 151552;
constexpr int LDSCTL_OFF = RING_BYTES, MISC_OFF = LDSCTL_OFF + 320;
constexpr int LDS_BYTES = 155648;
static_assert(MISC_OFF + 128 <= LDS_BYTES, "LDS map");

__device__ __forceinline__ float bf2f(unsigned short h) { return __uint_as_float((unsigned)h << 16); }
__device__ __forceinline__ float bflo(unsigned u) { return __uint_as_float(u << 16); }
__device__ __forceinline__ float bfhi(unsigned u) { return __uint_as_float(u & 0xffff0000u); }
__device__ __forceinline__ unsigned long long pk4(f32x4 v) { return (unsigned long long)pk2(v[0], v[1]) | ((unsigned long long)pk2(v[2], v[3]) << 32); }
__device__ __forceinline__ f32x4 bf4_to_f32(unsigned long long w) { return (f32x4){bflo((unsigned)w), bfhi((unsigned)w), bflo((unsigned)(w >> 32)), bfhi((unsigned)(w >> 32))}; }
__device__ __forceinline__ float wave_sum(float v) {
#pragma unroll
    for (int o = 1; o < 64; o <<= 1) v += __shfl_xor(v, o);
    return v;
}
template <int CTRL> __device__ __forceinline__ float dppf(float x) { return __builtin_bit_cast(float, __builtin_amdgcn_update_dpp(0, __builtin_bit_cast(int, x), CTRL, 0xf, 0xf, true)); }
__device__ __forceinline__ float sum8(float x) {
    x += dppf<0xB1>(x);
    x += dppf<0x4E>(x);
    x += dppf<0x141>(x);
    return x;
}
__device__ __forceinline__ float wave_sum_dpp(float x) {
    x += dppf<0xB1>(x); x += dppf<0x4E>(x); x += dppf<0x141>(x);
    x += dppf<0x140>(x);
    const int xi = __builtin_bit_cast(int, x);
    return __builtin_bit_cast(float, __builtin_amdgcn_readlane(xi, 0)) + __builtin_bit_cast(float, __builtin_amdgcn_readlane(xi, 16)) +
           __builtin_bit_cast(float, __builtin_amdgcn_readlane(xi, 32)) + __builtin_bit_cast(float, __builtin_amdgcn_readlane(xi, 48));
}
__device__ __forceinline__ float sigmoidf_(float x) { return 1.0f / (1.0f + expf(-x)); }

struct Args { const float* in[N_IN]; float* out; unsigned char* ws; int ph_lo, ph_hi; };
static_assert(sizeof(Args) == N_IN * 8 + 24, "Args has no padding");
struct Frame {
    LAS unsigned char* lds;
    volatile LAS unsigned* MISC;
    gu32* ctl;
    int tid, lane, wave, vcu, G;
    const Args* a;
};
#define WSP(T, off) ((T*)(F.a->ws + (off)))

__device__ __forceinline__ void p0_transpose_item(const float* W, int K, int N, bf16* WT, int dst_row0, int k0, int n0, LAS float* scr, int lane) {
#pragma unroll 8
    for (int i = 0; i < 32; ++i) { const int kk = 2 * i + (lane >> 5); scr[kk * 33 + (lane & 31)] = W[(size_t)(k0 + kk) * N + n0 + (lane & 31)]; }
    LDS_WAIT(); asm volatile("" ::: "memory");
    const int c = lane & 7;
#pragma unroll
    for (int j = 0; j < 4; ++j) { const int n = (lane >> 3) + 8 * j; const LAS float* s = scr + (8 * c) * 33 + n;
        v4u o; o.x = pk2(s[0 * 33], s[1 * 33]); o.y = pk2(s[2 * 33], s[3 * 33]); o.z = pk2(s[4 * 33], s[5 * 33]); o.w = pk2(s[6 * 33], s[7 * 33]);
        *(GAS v4u*)(WT + (size_t)(dst_row0 + n) * K + k0 + 8 * c) = o; }
    LDS_WAIT(); asm volatile("" ::: "memory");
}
__device__ __forceinline__ void p0_ffin_item(const float* W, bf16* WT, int r, LAS float* scr, int lane) {
    const int kb = r / 176, nb = r % 176, n0 = 32 * nb; const bool up = n0 >= FF; const int j = up ? n0 - FF : n0;
    p0_transpose_item(W, D, NFF, WT, (j >> 7) * 256 + (up ? 128 : 0) + (j & 127), 64 * kb, n0, scr, lane);
}
__device__ __forceinline__ void p0_plain_item(const float* W, int K, int N, bf16* WT, int r, LAS float* scr, int lane) {
    const int nblk = N / 32, kb = r / nblk, nb = r % nblk;
    p0_transpose_item(W, K, N, WT, 32 * nb, 64 * kb, 32 * nb, scr, lane);
}
__device__ __forceinline__ void p0_weights(Frame& F) {
    LAS float* scr = (LAS float*)(F.lds + RING_OFF + F.wave * 16384);
    const int gw = F.vcu * NWAVES + F.wave, NGW = F.G * NWAVES;
    constexpr int I_FI = 16 * 176, I_FO = 44 * 32, I_IN = 16 * 80, I_O = 16 * 32, I_L = 16, NITEMS = 2 * I_FI + 2 * I_FO + I_IN + I_O + 4 * I_L;
    for (int it = gw; it < NITEMS; it += NGW) {
        int r = it;
        if (r < I_FI) { p0_ffin_item(F.a->in[I_W1IN], WSP(bf16, WS_W1IN), r, scr, F.lane); continue; } r -= I_FI;
        if (r < I_FI) { p0_ffin_item(F.a->in[I_W2IN], WSP(bf16, WS_W2IN), r, scr, F.lane); continue; } r -= I_FI;
        if (r < I_FO) { p0_plain_item(F.a->in[I_W1OUT], FF, D, WSP(bf16, WS_W1OUT), r, scr, F.lane); continue; } r -= I_FO;
        if (r < I_FO) { p0_plain_item(F.a->in[I_W2OUT], FF, D, WSP(bf16, WS_W2OUT), r, scr, F.lane); continue; } r -= I_FO;
        if (r < I_IN) { p0_plain_item(F.a->in[I_WIN], D, NIN, WSP(bf16, WS_WIN), r, scr, F.lane); continue; } r -= I_IN;
        if (r < I_O) { p0_plain_item(F.a->in[I_WOUT], D, D, WSP(bf16, WS_WOUT), r, scr, F.lane); continue; } r -= I_O;
        if (r < I_L) { p0_plain_item(F.a->in[I_WDEC], 64, RW, WSP(bf16, WS_LORA), r, scr, F.lane); continue; } r -= I_L;
        if (r < I_L) { p0_plain_item(F.a->in[I_WICLR], 64, RW, WSP(bf16, WS_LORA + LORA_WI), r, scr, F.lane); continue; } r -= I_L;
        p0_plain_item(F.a->in[I_WGATE], 128, RW, WSP(bf16, WS_LORA + LORA_WG), r, scr, F.lane);
    }
}
typedef float f32x16m __attribute__((ext_vector_type(16)));
__device__ __forceinline__ void p0_mod(Frame& F) {
    const float* wada = F.a->in[I_WADA]; const float* bada = F.a->in[I_BADA]; const float* cp = F.a->in[I_CP]; const float* cs = F.a->in[I_CS];
    float* mod = WSP(float, WS_MOD);
    LAS float* red = (LAS float*)F.lds;
    const int lane = F.lane, wave = F.wave, r = lane & 31, h = lane >> 5;
    for (int task = blockIdx.x; task < MODW / 32; task += F.G) {
        const int j0 = 32 * task;
        f32x16m acc[5];
#pragma unroll
        for (int bt = 0; bt < 5; ++bt)
#pragma unroll
            for (int e = 0; e < 16; ++e) acc[bt][e] = 0.f;
#pragma unroll 1
        for (int ks = 0; ks < 8; ++ks) {
            const int i0 = 128 * wave + 16 * ks + 8 * h;
            unsigned aw[4];
#pragma unroll
            for (int e = 0; e < 4; ++e) aw[e] = pk2(wada[(size_t)(i0 + 2 * e) * MODW + j0 + r], wada[(size_t)(i0 + 2 * e + 1) * MODW + j0 + r]);
            const bf16x8 af = __builtin_bit_cast(bf16x8, (v4u){aw[0], aw[1], aw[2], aw[3]});
#pragma unroll
            for (int bt = 0; bt < 5; ++bt) {
                const int b = 32 * bt + r;
                f32x4 c0 = (f32x4){0.f, 0.f, 0.f, 0.f}, c1 = c0;
                if (b < NMOD) { const float* cr = (b < 2 ? cp + (size_t)b * D : cs + (size_t)(b - 2) * D) + i0; c0 = *(const f32x4*)cr; c1 = *(const f32x4*)(cr + 4); }
                float sv[8];
#pragma unroll
                for (int e = 0; e < 4; ++e) { sv[e] = c0[e] * __builtin_amdgcn_rcpf(1.0f + __expf(-c0[e])); sv[4 + e] = c1[e] * __builtin_amdgcn_rcpf(1.0f + __expf(-c1[e])); }
                const bf16x8 bfm = __builtin_bit_cast(bf16x8, (v4u){pk2(sv[0], sv[1]), pk2(sv[2], sv[3]), pk2(sv[4], sv[5]), pk2(sv[6], sv[7])});
                acc[bt] = __builtin_amdgcn_mfma_f32_32x32x16_bf16(af, bfm, acc[bt], 0, 0, 0);
            }
        }
#pragma unroll
        for (int rd = 0; rd < 2; ++rd) {
            const int nv = rd == 0 ? 48 : 32, bt0 = rd == 0 ? 0 : 3;
            __syncthreads();
#pragma unroll
            for (int bt = 0; bt < 3; ++bt) if (bt0 + bt < 5)
#pragma unroll
                for (int e = 0; e < 16; ++e) red[(wave * 48 + bt * 16 + e) * 64 + lane] = acc[bt0 + bt][e];
            __syncthreads();
            for (int idx = F.tid; idx < nv * 64; idx += 512) {
                const int v = idx >> 6, ln = idx & 63, bt = bt0 + (v >> 4), e = v & 15;
                float s = 0.f;
#pragma unroll
                for (int w = 0; w < 8; ++w) s += red[(w * 48 + v) * 64 + ln];
                const int b = 32 * bt + (ln & 31), j = j0 + (e & 3) + 8 * (e >> 2) + 4 * (ln >> 5);
                if (b < NMOD) mod[(size_t)b * MODW + j] = s + bada[j];
            }
        }
    }
    __syncthreads();
}

__device__ __forceinline__ int mod_row_of(int m) { return m < MP ? (m >> 13) : 2 + ((m - MP) >> 3); }
__device__ __forceinline__ void p_modulate0(Frame& F) {
    const int gw = F.vcu * NWAVES + F.wave, NGW = F.G * NWAVES;
    const float* mod = WSP(float, WS_MOD); bf16* U = WSP(bf16, WS_U);
    for (int m = gw; m < M; m += NGW) {
        const float* xr = m < MP ? F.a->in[I_XP] + (size_t)m * D : F.a->in[I_XS] + (size_t)(m - MP) * D;
        const float* mr = mod + (size_t)mod_row_of(m) * MODW;
        unsigned long long* o8 = (unsigned long long*)(U + (size_t)m * D) + F.lane;
#pragma unroll
        for (int j = 0; j < 4; ++j) { const int c = 4 * F.lane + 256 * j;
            const f32x4 x = *(const f32x4*)(xr + c), sh = *(const f32x4*)(mr + c), sc = *(const f32x4*)(mr + D + c);
            const f32x4 u = x * (sc + 1.0f) + sh;
            o8[64 * j] = (unsigned long long)pk2(u[0], u[1]) | ((unsigned long long)pk2(u[2], u[3]) << 32); }
    }
}
__device__ __forceinline__ void p_layernorm(Frame& F, int lnidx, int koff) {
    const int gw = F.vcu * NWAVES + F.wave, NGW = F.G * NWAVES;
    const float* mod = WSP(float, WS_MOD); bf16* U = WSP(bf16, WS_U); float* X = F.a->out + O_Y;
    const float* lg = F.a->in[I_LNG] + lnidx * D; const float* lb = F.a->in[I_LNB] + lnidx * D;
    for (int m = gw; m < M; m += NGW) {
        float* xr = X + (size_t)m * D;
        f32x4 v[4]; float s = 0.f;
#pragma unroll
        for (int j = 0; j < 4; ++j) { v[j] = *(const f32x4*)(xr + 4 * F.lane + 256 * j); s += (v[j][0] + v[j][1]) + (v[j][2] + v[j][3]); }
        const float mean = wave_sum(s) * (1.f / D); float s2 = 0.f;
#pragma unroll
        for (int j = 0; j < 4; ++j) { v[j] = v[j] - mean; s2 += (v[j][0] * v[j][0] + v[j][1] * v[j][1]) + (v[j][2] * v[j][2] + v[j][3] * v[j][3]); }
        const float rstd = 1.f / sqrtf(wave_sum(s2) * (1.f / D) + LN_EPS);
        const float* mr = mod + (size_t)mod_row_of(m) * MODW + (koff >= 0 ? koff : 0);
        unsigned long long* o8 = (unsigned long long*)(U + (size_t)m * D) + F.lane;
#pragma unroll
        for (int j = 0; j < 4; ++j) { const int c = 4 * F.lane + 256 * j;
            const f32x4 x = v[j] * rstd * *(const f32x4*)(lg + c) + *(const f32x4*)(lb + c);
            *(f32x4*)(xr + c) = x;
            if (koff >= 0) { const f32x4 sh = *(const f32x4*)(mr + c), sc = *(const f32x4*)(mr + D + c); const f32x4 u = x * (sc + 1.0f) + sh;
                o8[64 * j] = (unsigned long long)pk2(u[0], u[1]) | ((unsigned long long)pk2(u[2], u[3]) << 32); } }
    }
}
__device__ __forceinline__ float prev_val(const bf16* P, const float* sshift, int m, int col) {
    if (m < MP) return (m & (TP - 1)) == 0 ? 0.f : bf2f(P[(size_t)(m - 1) * NIN + col]);
    const int ms = m - MP;
    return (ms & (TS - 1)) == 0 ? sshift[(size_t)(ms >> 3) * RWP + col] : bf2f(P[(size_t)(m - 1) * NIN + col]);
}
constexpr int PP_PITCH = 528;
__device__ __forceinline__ void p_prep(Frame& F) {
    LAS unsigned char* lds = F.lds;
    const bf16* P = WSP(bf16, WS_H); const float* sshift = F.a->in[I_SSHIFT]; const float* mu = F.a->in[I_MU];
    float* WLOG = WSP(float, WS_WLOG); bf16* AA = WSP(bf16, WS_A); bf16* GG = WSP(bf16, WS_G);
    const int tid = F.tid, lane = F.lane, wave = F.wave;
    const int tile_lo0 = (F.vcu * (M / 16)) / F.G, tile_hi0 = ((F.vcu + 1) * (M / 16)) / F.G;
    for (int tile_lo = tile_lo0; tile_lo < tile_hi0; tile_lo += 5) {
    const int ntile = (tile_hi0 - tile_lo) < 5 ? (tile_hi0 - tile_lo) : 5;
    const int m_lo = tile_lo * 16, ntok = ntile * 16;
    __syncthreads();
    {
        const int j = tid & 255, hf = tid >> 8, col = 1536 + j; const float muj = mu[col];
        const int ga = hf == 0 ? 0 : ntile, gb = hf == 0 ? ntile : 2 * ntile;
        float carry = 0.f;
        for (int gi = ga; gi < gb; ++gi) { const int mg = m_lo + 8 * gi;
            float p[8];
#pragma unroll
            for (int t = 0; t < 8; ++t) p[t] = bf2f(P[(size_t)(mg + t) * NIN + col]);
            float prev = (gi == ga || ((mg < MP) ? (mg & (TP - 1)) : ((mg - MP) & (TS - 1))) == 0) ? prev_val(P, sshift, mg, col) : carry;
#pragma unroll
            for (int t = 0; t < 8; ++t) { const float xs = p[t] + (prev - p[t]) * muj; prev = p[t];
                const float f = j < 64 ? tanhf(xs) : (j < 128 ? xs : sigmoidf_(xs));
                *(LAS unsigned short*)(lds + (8 * gi + t) * PP_PITCH + j * 2) = (unsigned short)f2bf(f); }
            carry = p[7]; }
    }
    __syncthreads();
    const int lr = lane & 15, lq = lane >> 4, c0 = 64 * wave;
#pragma unroll 1
    for (int lo = 0; lo < 3; ++lo) {
        const int kin = lo == 0 ? 0 : (lo == 1 ? 64 : 128), nks = lo == 2 ? 4 : 2, wpitch = lo == 2 ? 128 : 64;
        const bf16* Wt = WSP(bf16, WS_LORA) + (lo == 0 ? 0 : (lo == 1 ? 512 * 64 : 2 * 512 * 64));
        f32x4 acc[5][4];
#pragma unroll
        for (int tt = 0; tt < 5; ++tt)
#pragma unroll
            for (int ct = 0; ct < 4; ++ct) acc[tt][ct] = (f32x4){0.f, 0.f, 0.f, 0.f};
        for (int ks = 0; ks < nks; ++ks) {
            bf16x8 wf[4];
#pragma unroll
            for (int ct = 0; ct < 4; ++ct) wf[ct] = *(const bf16x8*)(Wt + (size_t)(c0 + 16 * ct + lr) * wpitch + ks * 32 + lq * 8);
#pragma unroll
            for (int tt = 0; tt < 5; ++tt) if (tt < ntile) {
                const bf16x8 af = *(const LAS bf16x8*)(lds + (16 * tt + lr) * PP_PITCH + (kin + ks * 32 + lq * 8) * 2);
#pragma unroll
                for (int ct = 0; ct < 4; ++ct) acc[tt][ct] = __builtin_amdgcn_mfma_f32_16x16x32_bf16(wf[ct], af, acc[tt][ct], 0, 0, 0);
            }
        }
#pragma unroll
        for (int tt = 0; tt < 5; ++tt) if (tt < ntile) { const int m = m_lo + 16 * tt + lr;
#pragma unroll
            for (int ct = 0; ct < 4; ++ct) { const int c = c0 + 16 * ct + 4 * lq; const f32x4 a = acc[tt][ct];
                if (lo == 0) { const f32x4 w0v = *(const f32x4*)(F.a->in[I_W0] + c); f32x4 o;
#pragma unroll
                    for (int e = 0; e < 4; ++e) { const float z = w0v[e] + a[e]; const float sp = fmaxf(-z, 0.f) + log1pf(expf(-fabsf(z))); o[e] = -expf(-sp - 0.5f); }
                    *(f32x4*)(WLOG + (size_t)m * RW + c) = o; }
                else if (lo == 1) { const f32x4 a0v = *(const f32x4*)(F.a->in[I_A0] + c); f32x4 o;
#pragma unroll
                    for (int e = 0; e < 4; ++e) o[e] = sigmoidf_(a0v[e] + a[e]);
                    *(unsigned long long*)(AA + (size_t)m * RW + c) = pk4(o); }
                else *(unsigned long long*)(GG + (size_t)m * RW + c) = pk4(a); }
        }
    }
    }
    const int gt = F.vcu * 512 + F.tid, NT = F.G * 512;
    const float* ck = F.a->in[I_CK]; const float* cv = F.a->in[I_CV];
    for (int i = gt; i < 2 * RWP; i += NT) { const int b = i / RWP, col = i % RWP; F.a->out[O_SHIFT_P + i] = bf2f(P[(size_t)(b * TP + TP - 1) * NIN + col]); }
#pragma unroll 2
    for (int i = gt; i < NBS * RWP; i += NT) { const int b = i / RWP, col = i % RWP; F.a->out[O_SHIFT_S + i] = bf2f(P[(size_t)(MP + b * TS + TS - 1) * NIN + col]); }
    for (int i = gt; i < 2 * 128 * 128; i += NT) { const int b = i >> 14, j = (i >> 7) & 127, c2 = i & 127; const size_t row = (size_t)(b * TP + TP - 128 + j) * NIN;
        F.a->out[O_WINK_P + i] = bf2f(P[row + 2304 + c2]); F.a->out[O_WINV_P + i] = bf2f(P[row + 2432 + c2]); }
#pragma unroll 4
    for (int i = gt; i < NBS * 128 * 128; i += NT) { const int b = i >> 14, j = (i >> 7) & 127, c2 = i & 127;
        if (j < 120) { F.a->out[O_WINK_S + i] = ck[(size_t)(b * 128 + j + 8) * 128 + c2]; F.a->out[O_WINV_S + i] = cv[(size_t)(b * 128 + j + 8) * 128 + c2]; }
        else { const size_t row = (size_t)(MP + b * TS + (j - 120)) * NIN; F.a->out[O_WINK_S + i] = bf2f(P[row + 2304 + c2]); F.a->out[O_WINV_S + i] = bf2f(P[row + 2432 + c2]); } }
}

constexpr int SS_R = 0, SS_DEC = 1, SS_KM = 2, SS_KK = 3, SS_BB = 4, SS_V = 5;
__device__ __forceinline__ void sample_scan_unit(Frame& F, int b) {
    const int h = F.wave, lane = F.lane, chn = h * 64 + lane;
    LAS float* A = (LAS float*)F.lds + h * (6 * 8 * 64);
    const bf16* P = WSP(bf16, WS_H); const float* sshift = F.a->in[I_SSHIFT]; const float* mu = F.a->in[I_MU];
    const float* WLOG = WSP(float, WS_WLOG); const bf16* AA = WSP(bf16, WS_A); const bf16* GG = WSP(bf16, WS_G);
    bf16* MIX = WSP(bf16, WS_U);
    const float mur = mu[chn], muk = mu[RW + chn], muv = mu[2 * RW + chn], kkc = F.a->in[I_KK][chn], kac = F.a->in[I_KA][chn], rkc = F.a->in[I_RK][chn], gnw = F.a->in[I_GNW][chn], gnb = F.a->in[I_GNB][chn];
    __syncthreads();
    float q_r = sshift[(size_t)b * RWP + chn], q_k = sshift[(size_t)b * RWP + RW + chn], q_v = sshift[(size_t)b * RWP + 2 * RW + chn];
#pragma unroll
    for (int t = 0; t < TS; ++t) {
        const int m = MP + b * TS + t; const size_t pr = (size_t)m * NIN;
        const float p_r = bf2f(P[pr + chn]), p_k = bf2f(P[pr + RW + chn]), p_v = bf2f(P[pr + 2 * RW + chn]);
        const float xr = p_r + (q_r - p_r) * mur, xk = p_k + (q_k - p_k) * muk, xv = p_v + (q_v - p_v) * muv;
        q_r = p_r; q_k = p_k; q_v = p_v;
        const float a = bf2f(AA[(size_t)m * RW + chn]), wl = WLOG[(size_t)m * RW + chn];
        const float kq0 = xk * kkc, kk = kq0 * (1.0f / fmaxf(sqrtf(wave_sum_dpp(kq0 * kq0)), 1e-12f));
        A[(SS_R * 8 + t) * 64 + lane] = xr; A[(SS_DEC * 8 + t) * 64 + lane] = expf(wl); A[(SS_KM * 8 + t) * 64 + lane] = xk * (1.0f + (a - 1.0f) * kac);
        A[(SS_KK * 8 + t) * 64 + lane] = kk; A[(SS_BB * 8 + t) * 64 + lane] = kk * a; A[(SS_V * 8 + t) * 64 + lane] = xv;
    }
    f32x4 S[16];
    { const f32x4* sp = (const f32x4*)(F.a->in[I_SWKV] + ((size_t)(b * 8 + h) * 64 + lane) * 64);
#pragma unroll
      for (int q = 0; q < 16; ++q) S[q] = sp[q]; }
    LDS_WAIT(); asm volatile("" ::: "memory");
#pragma unroll 1
    for (int t = 0; t < TS; ++t) {
        const LAS f32x4* pk = (const LAS f32x4*)(A + (SS_KK * 8 + t) * 64); const LAS f32x4* pb = (const LAS f32x4*)(A + (SS_BB * 8 + t) * 64);
        const LAS f32x4* pd = (const LAS f32x4*)(A + (SS_DEC * 8 + t) * 64); const LAS f32x4* pm = (const LAS f32x4*)(A + (SS_KM * 8 + t) * 64);
        const LAS f32x4* pq = (const LAS f32x4*)(A + (SS_R * 8 + t) * 64);
        const float v = A[(SS_V * 8 + t) * 64 + lane];
        f32x4 sa4 = (f32x4){0.f, 0.f, 0.f, 0.f};
#pragma unroll
        for (int q = 0; q < 16; ++q) sa4 += S[q] * pk[q];
        const float sa = (sa4[0] + sa4[1]) + (sa4[2] + sa4[3]);
        f32x4 y4 = (f32x4){0.f, 0.f, 0.f, 0.f};
#pragma unroll
        for (int q = 0; q < 16; ++q) { S[q] = S[q] * pd[q] + (pm[q] * v - pb[q] * sa); y4 += S[q] * pq[q]; }
        const float y = (y4[0] + y4[1]) + (y4[2] + y4[3]);
        const float mean = wave_sum_dpp(y) * (1.f / 64.f), d = y - mean, var = wave_sum_dpp(d * d) * (1.f / 64.f);
        const float yn = d * (1.0f / sqrtf(var + GN_EPS));
        const float dot = wave_sum_dpp(A[(SS_R * 8 + t) * 64 + lane] * A[(SS_KM * 8 + t) * 64 + lane] * rkc);
        const int m = MP + b * TS + t;
        const float g = bf2f(GG[(size_t)m * RW + chn]);
        MIX[(size_t)m * D + chn] = (bf16)f2bf((yn * gnw + gnb + dot * v) * g);
    }
    { f32x4* so = (f32x4*)(F.a->out + O_WKV_S + ((size_t)(b * 8 + h) * 64 + lane) * 64);
#pragma unroll
      for (int q = 0; q < 16; ++q) so[q] = S[q]; }
}
constexpr int PB = 144, PF = 272;
constexpr int MB16 = 64 * PB, MF32 = 64 * PF;
constexpr size_t WS_GX = 2 * MiB;
constexpr size_t WS_S0 = 167 * MiB;
static_assert(WS_GX + 512 * 32768 <= WS_WIN && WS_H + (size_t)M * NIN * 2 <= WS_S0 && WS_S0 + 512 * 16384 <= WS_WLOG, "scan scratch map");
constexpr int CA_RHS = 0, CA_LB = 34816, CA_KQ = 52224, CA_KD = 61440, CA_BD = 70656, CA_VT = 79872, CA_KET = 89088, CA_BET = 98304, CA_LK = 107520, CA_SMALL = 116736;
constexpr int CC_RHS = 0, CC_LB = 17408, CC_KQ = 34816, CC_RQ = 44032, CC_KD = 53248, CC_BD = 62464, CC_VT = 71680, CC_KET = 80896, CC_BET = 90112, CC_LK = 99328, CC_MK = 108544, CC_MB = 117760,
              CC_SHI = 126976, CC_SLO = 136192, CC_SMALL = 145408;
constexpr int SM_GL = 0, SM_DOT = 256, SM_TOT = 512, SM_BYTES = 512 + 2048;

__device__ __forceinline__ void mm_nt(f32x4 (&acc)[2], const LAS unsigned char* X, const LAS unsigned char* Y, int wave, int lane) {
    const int tr = wave >> 1, tc0 = (wave & 1) * 2, lr = lane & 15, lq = lane >> 4;
#pragma unroll
    for (int ks = 0; ks < 2; ++ks) {
        const bf16x8 xa = *(const LAS bf16x8*)(X + (16 * tr + lr) * PB + ks * 64 + lq * 16);
#pragma unroll
        for (int j = 0; j < 2; ++j) {
            const bf16x8 yb = *(const LAS bf16x8*)(Y + (16 * (tc0 + j) + lr) * PB + ks * 64 + lq * 16);
            acc[j] = __builtin_amdgcn_mfma_f32_16x16x32_bf16(yb, xa, acc[j], 0, 0, 0);
        }
    }
}
#define ACC_ZERO(a) do { a[0] = (f32x4){0.f, 0.f, 0.f, 0.f}; a[1] = (f32x4){0.f, 0.f, 0.f, 0.f}; } while (0)
#define ACC_M(wave, lane) (16 * ((wave) >> 1) + ((lane) & 15))
#define ACC_N(wave, lane, j) (16 * (((wave) & 1) * 2 + (j)) + 4 * ((lane) >> 4))
__device__ __forceinline__ void store_hilo(const f32x4 (&a)[2], LAS unsigned char* HI, LAS unsigned char* LO, int wave, int lane) {
    const int m = ACC_M(wave, lane);
#pragma unroll
    for (int j = 0; j < 2; ++j) { const int n = ACC_N(wave, lane, j);
        const unsigned long long hi = pk4(a[j]); const f32x4 lo = a[j] - bf4_to_f32(hi);
        *(LAS unsigned long long*)(HI + m * PB + n * 2) = hi; *(LAS unsigned long long*)(LO + m * PB + n * 2) = pk4(lo); }
}
template <int NW> __device__ __forceinline__ void tri_solve(const LAS unsigned char* LBT, const LAS unsigned char* RHS, LAS unsigned char* UT, int wave, int lane) {
    if (wave < NW) {
        const int col = wave * 64 + lane;
        f32x4 u[16], lv[8];
#pragma unroll
        for (int q = 0; q < 16; ++q) u[q] = *(const LAS f32x4*)(RHS + col * PF + q * 16);
#define TS_SWEEP(I0, I1, QOFF, QLO)                                                                                                      \
        _Pragma("unroll") for (int q = 0; q < 8; ++q) lv[q] = *(const LAS f32x4*)(LBT + (I0) * PF + (QOFF + q) * 16);                  \
        _Pragma("unroll") for (int i = (I0); i < (I1); ++i) {                                                                            \
            f32x4 ln[8];                                                                                                                 \
            _Pragma("unroll") for (int q = 0; q < 8; ++q) if (i + 1 < (I1) && q >= QLO(i + 1)) ln[q] = *(const LAS f32x4*)(LBT + (i + 1) * PF + (QOFF + q) * 16); \
            asm volatile("" ::: "memory");                                                                                               \
            const float ui = u[i >> 2][i & 3];                                                                                           \
            _Pragma("unroll") for (int q = 0; q < 8; ++q) if (q >= QLO(i)) u[QOFF + q] -= lv[q] * ui;                                    \
            _Pragma("unroll") for (int q = 0; q < 8; ++q) if (i + 1 < (I1) && q >= QLO(i + 1)) lv[q] = ln[q];                            \
        }
#define TS_QLO_A(i) (((i) + 1) >> 2)
#define TS_QLO_B(i) 0
#define TS_QLO_C(i) ((((i) + 1) >> 2) - 8)
        TS_SWEEP(0, 31, 0, TS_QLO_A)
        TS_SWEEP(0, 32, 8, TS_QLO_B)
        TS_SWEEP(32, 63, 8, TS_QLO_C)
#undef TS_SWEEP
#pragma unroll
        for (int q = 0; q < 8; ++q) { v4u w; w.x = pk2(u[2 * q][0], u[2 * q][1]); w.y = pk2(u[2 * q][2], u[2 * q][3]); w.z = pk2(u[2 * q + 1][0], u[2 * q + 1][1]); w.w = pk2(u[2 * q + 1][2], u[2 * q + 1][3]);
            *(LAS v4u*)(UT + col * PB + q * 16) = w; }
    }
}
struct ChunkRaw { unsigned rk[9], vv[5], aa[4]; float wl[8]; };
__device__ __forceinline__ void chunk_load(Frame& F, int m0, int h, ChunkRaw& R) {
    const bf16* P = WSP(bf16, WS_H); const float* WLOG = WSP(float, WS_WLOG); const bf16* AA = WSP(bf16, WS_A);
    const int chn = h * 64 + F.lane, mg = m0 + 8 * F.wave;
    unsigned pv[10], av[8];
    if ((mg & (TP - 1)) == 0) { R.rk[0] = 0u; pv[0] = 0u; }
    else { const size_t o = (size_t)(mg - 1) * NIN; R.rk[0] = (unsigned)P[o + chn] | ((unsigned)P[o + RW + chn] << 16); pv[0] = P[o + 2 * RW + chn]; }
#pragma unroll
    for (int j = 0; j < 8; ++j) { const size_t o = (size_t)(mg + j) * NIN; R.rk[j + 1] = (unsigned)P[o + chn] | ((unsigned)P[o + RW + chn] << 16); pv[j + 1] = P[o + 2 * RW + chn];
        R.wl[j] = WLOG[(size_t)(mg + j) * RW + chn]; av[j] = AA[(size_t)(mg + j) * RW + chn]; }
    pv[9] = 0u;
#pragma unroll
    for (int j = 0; j < 5; ++j) R.vv[j] = pv[2 * j] | (pv[2 * j + 1] << 16);
#pragma unroll
    for (int j = 0; j < 4; ++j) R.aa[j] = av[2 * j] | (av[2 * j + 1] << 16);
}
template <bool PHC> __device__ __forceinline__ void chunk_stage(Frame& F, const ChunkRaw& R, int h, int oKQ, int oRQ, int oKD, int oBD, int oVT, int oKET, int oBET, int oRHS, int oSMALL) {
    LAS unsigned char* lds = F.lds;
    const float* mu = F.a->in[I_MU];
    const int e = F.lane, g = F.wave, chn = h * 64 + e;
    const float mur = mu[chn], muk = mu[RW + chn], muv = mu[2 * RW + chn], kkc = F.a->in[I_KK][chn], kac = F.a->in[I_KA][chn], rkc = F.a->in[I_RK][chn];
    float pr[9], pk[9], pv[9], av[8];
#pragma unroll
    for (int j = 0; j < 9; ++j) { pr[j] = bflo(R.rk[j]); pk[j] = bfhi(R.rk[j]); pv[j] = (j & 1) ? bfhi(R.vv[j >> 1]) : bflo(R.vv[j >> 1]); }
#pragma unroll
    for (int j = 0; j < 8; ++j) av[j] = (j & 1) ? bfhi(R.aa[j >> 1]) : bflo(R.aa[j >> 1]);
    const float (&wl)[8] = R.wl;
    float cw[8]; { float s = 0.f;
#pragma unroll
        for (int j = 0; j < 8; ++j) { s += wl[j]; cw[j] = s; } }
    LAS float* TOT = (LAS float*)(lds + oSMALL + SM_TOT);
    TOT[g * 64 + e] = cw[7];
    __syncthreads();
    float off = 0.f, cwL = 0.f;
#pragma unroll
    for (int gg = 0; gg < 8; ++gg) { const float tv = TOT[gg * 64 + e]; cwL += tv; if (gg < g) off += tv; }
    if (g == 0) ((LAS float*)(lds + oSMALL + SM_GL))[e] = expf(cwL);
    unsigned vt[8], ket[8], bet[8]; float kq[8];
#pragma unroll
    for (int j = 0; j < 8; ++j) {
        const int t = 8 * g + j;
        const float c = off + cw[j];
        const float xr = pr[j + 1] + (pr[j] - pr[j + 1]) * mur, xk = pk[j + 1] + (pk[j] - pk[j + 1]) * muk, xv = pv[j + 1] + (pv[j] - pv[j + 1]) * muv;
        const float kq0 = xk * kkc, kk = kq0 * (1.0f / fmaxf(sqrtf(wave_sum_dpp(kq0 * kq0)), 1e-12f)), km = xk * (1.0f + (av[j] - 1.0f) * kac), bb = kk * av[j];
        const float e1 = expf(c), e2 = 1.0f / e1, e3 = expf(c - wl[j]), e4 = expf(cwL - c);
        kq[j] = kk * e3;
        *(LAS unsigned short*)(lds + oKQ + t * PB + e * 2) = (unsigned short)f2bf(kq[j]);
        *(LAS unsigned short*)(lds + oKD + t * PB + e * 2) = (unsigned short)f2bf(km * e2);
        *(LAS unsigned short*)(lds + oBD + t * PB + e * 2) = (unsigned short)f2bf(bb * e2);
        if (PHC) { *(LAS unsigned short*)(lds + oRQ + t * PB + e * 2) = (unsigned short)f2bf(xr * e1);
            const float d = wave_sum_dpp(xr * km * rkc); if (e == 0) ((LAS float*)(lds + oSMALL + SM_DOT))[t] = d; }
        vt[j] = f2bf(xv); ket[j] = f2bf(km * e4); bet[j] = f2bf(bb * e4);
    }
    { v4u w; w.x = vt[0] | (vt[1] << 16); w.y = vt[2] | (vt[3] << 16); w.z = vt[4] | (vt[5] << 16); w.w = vt[6] | (vt[7] << 16); *(LAS v4u*)(lds + oVT + e * PB + g * 16) = w; }
    { v4u w; w.x = ket[0] | (ket[1] << 16); w.y = ket[2] | (ket[3] << 16); w.z = ket[4] | (ket[5] << 16); w.w = ket[6] | (ket[7] << 16); *(LAS v4u*)(lds + oKET + e * PB + g * 16) = w; }
    { v4u w; w.x = bet[0] | (bet[1] << 16); w.y = bet[2] | (bet[3] << 16); w.z = bet[4] | (bet[5] << 16); w.w = bet[6] | (bet[7] << 16); *(LAS v4u*)(lds + oBET + e * PB + g * 16) = w; }
    if (!PHC) { *(LAS f32x4*)(lds + oRHS + e * PF + g * 32) = (f32x4){kq[0], kq[1], kq[2], kq[3]}; *(LAS f32x4*)(lds + oRHS + e * PF + g * 32 + 16) = (f32x4){kq[4], kq[5], kq[6], kq[7]}; }
}
__device__ __forceinline__ void scanA_task(Frame& F, int task) {
    LAS unsigned char* lds = F.lds; const int wave = F.wave, lane = F.lane;
    const int sc = task & 31, bh = task >> 5, h = bh & 7, b = bh >> 3;
    const int m = ACC_M(wave, lane);
    f32x4 gacc[2], xacc[2];
#pragma unroll
    for (int j = 0; j < 2; ++j) { const int n = ACC_N(wave, lane, j);
#pragma unroll
        for (int r = 0; r < 4; ++r) { gacc[j][r] = (m == n + r) ? 1.f : 0.f; xacc[j][r] = 0.f; } }
    ChunkRaw raw; chunk_load(F, b * TP + sc * 256, h, raw);
    for (int c = 0; c < 4; ++c) {
        __syncthreads();
        chunk_stage<false>(F, raw, h, CA_KQ, 0, CA_KD, CA_BD, CA_VT, CA_KET, CA_BET, CA_RHS, CA_SMALL);
        __syncthreads();
        { f32x4 a[2]; ACC_ZERO(a); mm_nt(a, lds + CA_BD, lds + CA_KQ, wave, lane);
#pragma unroll
          for (int j = 0; j < 2; ++j) { const int n = ACC_N(wave, lane, j); f32x4 o;
#pragma unroll
              for (int r = 0; r < 4; ++r) o[r] = (n + r > m) ? a[j][r] : 0.f;
              *(LAS f32x4*)(lds + CA_LB + m * PF + n * 4) = o; } }
        { f32x4 a[2]; ACC_ZERO(a); mm_nt(a, lds + CA_KQ, lds + CA_KD, wave, lane);
#pragma unroll
          for (int j = 0; j < 2; ++j) { const int n = ACC_N(wave, lane, j); f32x4 o;
#pragma unroll
              for (int r = 0; r < 4; ++r) o[r] = (n + r < m) ? a[j][r] : 0.f;
              *(LAS unsigned long long*)(lds + CA_LK + m * PB + n * 2) = pk4(o); } }
        __syncthreads();
        { f32x4 a[2]; ACC_ZERO(a); mm_nt(a, lds + CA_VT, lds + CA_LK, wave, lane);
#pragma unroll
          for (int j = 0; j < 2; ++j) { const int n = ACC_N(wave, lane, j); *(LAS f32x4*)(lds + CA_RHS + (64 + m) * PF + n * 4) = a[j]; } }
        __syncthreads();
        if (c < 3) chunk_load(F, b * TP + sc * 256 + (c + 1) * 64, h, raw);
        tri_solve<2>(lds + CA_LB, lds + CA_RHS, lds + CA_KD, wave, lane);
        __syncthreads();
        f32x4 pt[2], xc[2];
        { f32x4 a[2]; ACC_ZERO(a); mm_nt(a, lds + CA_BET, lds + CA_KD, wave, lane);
          const LAS float* GL = (const LAS float*)(lds + CA_SMALL + SM_GL);
#pragma unroll
          for (int j = 0; j < 2; ++j) { const int n = ACC_N(wave, lane, j);
#pragma unroll
              for (int r = 0; r < 4; ++r) pt[j][r] = ((m == n + r) ? GL[n + r] : 0.f) - a[j][r]; } }
        { f32x4 a1[2], a2[2]; ACC_ZERO(a1); ACC_ZERO(a2);
          mm_nt(a1, lds + CA_VT, lds + CA_KET, wave, lane); mm_nt(a2, lds + CA_KD + 64 * PB, lds + CA_BET, wave, lane);
          xc[0] = a1[0] - a2[0]; xc[1] = a1[1] - a2[1]; }
        store_hilo(pt, lds + CA_KQ, lds + CA_LK, wave, lane);
        store_hilo(gacc, lds + 0, lds + MB16, wave, lane);
        store_hilo(xacc, lds + 2 * MB16, lds + 3 * MB16, wave, lane);
        __syncthreads();
        { f32x4 a[2]; ACC_ZERO(a);
          mm_nt(a, lds + 0, lds + CA_KQ, wave, lane); mm_nt(a, lds + 0, lds + CA_LK, wave, lane); mm_nt(a, lds + MB16, lds + CA_KQ, wave, lane);
          gacc[0] = a[0]; gacc[1] = a[1]; }
        { f32x4 a[2]; a[0] = xc[0]; a[1] = xc[1];
          mm_nt(a, lds + 2 * MB16, lds + CA_KQ, wave, lane); mm_nt(a, lds + 2 * MB16, lds + CA_LK, wave, lane); mm_nt(a, lds + 3 * MB16, lds + CA_KQ, wave, lane);
          xacc[0] = a[0]; xacc[1] = a[1]; }
    }
    float* GT = (float*)(F.a->ws + WS_GX + (size_t)task * 32768); float* XO = GT + 4096;
#pragma unroll
    for (int j = 0; j < 2; ++j) { const int n = ACC_N(wave, lane, j);
#pragma unroll
        for (int r = 0; r < 4; ++r) GT[(n + r) * 64 + m] = gacc[j][r];
        *(f32x4*)(XO + m * 64 + n) = xacc[j]; }
}
__device__ __forceinline__ void scanB_unit(Frame& F, int bh) {
    LAS unsigned char* lds = F.lds; const int wave = F.wave, lane = F.lane, tid = F.tid;
    const int m = ACC_M(wave, lane);
    const int row = tid >> 3, c8 = (tid & 7) * 8;
    f32x4 s[2]; ACC_ZERO(s);
    const float* GT0 = (const float*)(F.a->ws + WS_GX + (size_t)(bh * 32) * 32768);
    f32x4 g0 = *(const f32x4*)(GT0 + row * 64 + c8), g1 = *(const f32x4*)(GT0 + row * 64 + c8 + 4), x0, x1;
    x0 = *(const f32x4*)(GT0 + 4096 + m * 64 + ACC_N(wave, lane, 0)); x1 = *(const f32x4*)(GT0 + 4096 + m * 64 + ACC_N(wave, lane, 1));
    for (int sc = 0; sc < 32; ++sc) {
        const int task = bh * 32 + sc;
        float* S0 = (float*)(F.a->ws + WS_S0 + (size_t)task * 16384);
        __syncthreads();
        { const unsigned long long h0 = pk4(g0), h1 = pk4(g1); const f32x4 l0 = g0 - bf4_to_f32(h0), l1 = g1 - bf4_to_f32(h1);
          v4u wh, wl; wh.x = (unsigned)h0; wh.y = (unsigned)(h0 >> 32); wh.z = (unsigned)h1; wh.w = (unsigned)(h1 >> 32);
          const unsigned long long q0 = pk4(l0), q1 = pk4(l1); wl.x = (unsigned)q0; wl.y = (unsigned)(q0 >> 32); wl.z = (unsigned)q1; wl.w = (unsigned)(q1 >> 32);
          *(LAS v4u*)(lds + 2 * MB16 + row * PB + c8 * 2) = wh; *(LAS v4u*)(lds + 3 * MB16 + row * PB + c8 * 2) = wl; }
        store_hilo(s, lds + 0, lds + MB16, wave, lane);
#pragma unroll
        for (int j = 0; j < 2; ++j) { const int n = ACC_N(wave, lane, j); *(f32x4*)(S0 + m * 64 + n) = s[j]; }
        f32x4 a[2]; a[0] = x0; a[1] = x1;
        if (sc + 1 < 32) { const float* GTn = (const float*)(F.a->ws + WS_GX + (size_t)(task + 1) * 32768);
            g0 = *(const f32x4*)(GTn + row * 64 + c8); g1 = *(const f32x4*)(GTn + row * 64 + c8 + 4);
            x0 = *(const f32x4*)(GTn + 4096 + m * 64 + ACC_N(wave, lane, 0)); x1 = *(const f32x4*)(GTn + 4096 + m * 64 + ACC_N(wave, lane, 1)); }
        __syncthreads();
        mm_nt(a, lds + 0, lds + 2 * MB16, wave, lane); mm_nt(a, lds + 0, lds + 3 * MB16, wave, lane); mm_nt(a, lds + MB16, lds + 2 * MB16, wave, lane);
        s[0] = a[0]; s[1] = a[1];
    }
    __syncthreads();
}
__device__ __forceinline__ void scanC_task(Frame& F, int task) {
    LAS unsigned char* lds = F.lds; const int wave = F.wave, lane = F.lane;
    const int sc = task & 31, bh = task >> 5, h = bh & 7, b = bh >> 3;
    const int m = ACC_M(wave, lane);
    const bf16* GG = WSP(bf16, WS_G); bf16* MIX = WSP(bf16, WS_U);
    const int chn = h * 64 + lane; const float gnw = F.a->in[I_GNW][chn], gnb = F.a->in[I_GNB][chn];
    f32x4 s[2];
    { const float* S0 = (const float*)(F.a->ws + WS_S0 + (size_t)task * 16384);
#pragma unroll
      for (int j = 0; j < 2; ++j) { const int n = ACC_N(wave, lane, j); s[j] = *(const f32x4*)(S0 + m * 64 + n); } }
    ChunkRaw raw; chunk_load(F, b * TP + sc * 256, h, raw);
    for (int c = 0; c < 4; ++c) {
        const int m0 = b * TP + sc * 256 + c * 64;
        __syncthreads();
        chunk_stage<true>(F, raw, h, CC_KQ, CC_RQ, CC_KD, CC_BD, CC_VT, CC_KET, CC_BET, 0, CC_SMALL);
        store_hilo(s, lds + CC_SHI, lds + CC_SLO, wave, lane);
        __syncthreads();
        { f32x4 a[2]; ACC_ZERO(a); mm_nt(a, lds + CC_BD, lds + CC_KQ, wave, lane);
#pragma unroll
          for (int j = 0; j < 2; ++j) { const int n = ACC_N(wave, lane, j); f32x4 o;
#pragma unroll
              for (int r = 0; r < 4; ++r) o[r] = (n + r > m) ? a[j][r] : 0.f;
              *(LAS f32x4*)(lds + CC_LB + m * PF + n * 4) = o; } }
        { f32x4 a[2]; ACC_ZERO(a); mm_nt(a, lds + CC_KQ, lds + CC_KD, wave, lane);
#pragma unroll
          for (int j = 0; j < 2; ++j) { const int n = ACC_N(wave, lane, j); f32x4 o;
#pragma unroll
              for (int r = 0; r < 4; ++r) o[r] = (n + r < m) ? a[j][r] : 0.f;
              *(LAS unsigned long long*)(lds + CC_LK + m * PB + n * 2) = pk4(o); } }
        { f32x4 a[2], a2[2]; ACC_ZERO(a); ACC_ZERO(a2); mm_nt(a, lds + CC_RQ, lds + CC_KD, wave, lane); mm_nt(a2, lds + CC_RQ, lds + CC_BD, wave, lane);
#pragma unroll
          for (int j = 0; j < 2; ++j) { const int n = ACC_N(wave, lane, j); f32x4 o, o2;
#pragma unroll
              for (int r = 0; r < 4; ++r) { o[r] = (n + r <= m) ? a[j][r] : 0.f; o2[r] = (n + r <= m) ? a2[j][r] : 0.f; }
              *(LAS unsigned long long*)(lds + CC_MK + m * PB + n * 2) = pk4(o); *(LAS unsigned long long*)(lds + CC_MB + m * PB + n * 2) = pk4(o2); } }
        __syncthreads();
        { f32x4 a[2]; ACC_ZERO(a);
          mm_nt(a, lds + CC_SHI, lds + CC_KQ, wave, lane); mm_nt(a, lds + CC_SLO, lds + CC_KQ, wave, lane); mm_nt(a, lds + CC_VT, lds + CC_LK, wave, lane);
#pragma unroll
          for (int j = 0; j < 2; ++j) { const int n = ACC_N(wave, lane, j); *(LAS f32x4*)(lds + CC_RHS + m * PF + n * 4) = a[j]; } }
        __syncthreads();
        if (c < 3) chunk_load(F, m0 + 64, h, raw);
        tri_solve<1>(lds + CC_LB, lds + CC_RHS, lds + CC_KD, wave, lane);
        __syncthreads();
        { f32x4 a[2], a2[2]; ACC_ZERO(a); ACC_ZERO(a2);
          mm_nt(a, lds + CC_RQ, lds + CC_SHI, wave, lane); mm_nt(a, lds + CC_RQ, lds + CC_SLO, wave, lane); mm_nt(a, lds + CC_MK, lds + CC_VT, wave, lane);
          mm_nt(a2, lds + CC_MB, lds + CC_KD, wave, lane);
#pragma unroll
          for (int j = 0; j < 2; ++j) { const int n = ACC_N(wave, lane, j); *(LAS f32x4*)(lds + CC_LB + m * PF + n * 4) = a[j] - a2[j]; } }
        { f32x4 a1[2], a2[2]; ACC_ZERO(a1); ACC_ZERO(a2);
          mm_nt(a1, lds + CC_VT, lds + CC_KET, wave, lane); mm_nt(a2, lds + CC_KD, lds + CC_BET, wave, lane);
          const LAS float* GL = (const LAS float*)(lds + CC_SMALL + SM_GL);
#pragma unroll
          for (int j = 0; j < 2; ++j) { const int n = ACC_N(wave, lane, j); const f32x4 gl = *(const LAS f32x4*)(GL + n); s[j] = s[j] * gl + a1[j] - a2[j]; } }
        __syncthreads();
        for (int t = wave; t < 64; t += 8) {
            const int mm = m0 + t;
            const float y = *(const LAS float*)(lds + CC_LB + t * PF + lane * 4);
            const float mean = wave_sum_dpp(y) * (1.f / 64.f), d = y - mean, var = wave_sum_dpp(d * d) * (1.f / 64.f);
            const float yn = d * (1.0f / sqrtf(var + GN_EPS));
            const float dot = ((const LAS float*)(lds + CC_SMALL + SM_DOT))[t];
            const float v = bf2f(*(const LAS unsigned short*)(lds + CC_VT + lane * PB + t * 2));
            const float gg = bf2f(GG[(size_t)mm * RW + chn]);
            MIX[(size_t)mm * D + chn] = (bf16)f2bf((yn * gnw + gnb + dot * v) * gg);
        }
    }
    if (sc == 31) { float* so = F.a->out + O_WKV_P + (size_t)bh * 4096;
#pragma unroll
        for (int j = 0; j < 2; ++j) { const int n = ACC_N(wave, lane, j); *(f32x4*)(so + m * 64 + n) = s[j]; } }
}
__device__ __forceinline__ int rel_bucket(int n) {
    if (n < 16) return n;
    const int b = 16 + (int)(logf((float)n * (1.0f / 16.0f)) / 2.0794415416798357f * 16.0f);
    return b < 31 ? b : 31;
}
typedef float f32x16 __attribute__((ext_vector_type(16)));
typedef short s16x4 __attribute__((ext_vector_type(4)));
struct AttnLane { const bf16* qrow; int qrel; int rmin; const LAS float* btab; float sink; bf16* orow; };
__device__ __forceinline__ void attn_core32(const LAS unsigned char* Kl, const LAS unsigned char* Vt, int VTP, int kt0, const AttnLane L, int lane) {
    const int r = lane & 31, h = lane >> 5;
    bf16x8 qf[4];
#pragma unroll
    for (int ds = 0; ds < 4; ++ds) qf[ds] = *(const bf16x8*)(L.qrow + 16 * ds + 8 * h);
    f32x16 sc[5];
#pragma unroll
    for (int T = 0; T < 5; ++T) {
#pragma unroll
        for (int e = 0; e < 16; ++e) sc[T][e] = 0.f;
#pragma unroll
        for (int ds = 0; ds < 4; ++ds) { const bf16x8 kf = *(const LAS bf16x8*)(Kl + ((kt0 + T) * 32 + r) * 144 + (16 * ds + 8 * h) * 2);
            sc[T] = __builtin_amdgcn_mfma_f32_32x32x16_bf16(kf, qf[ds], sc[T], 0, 0, 0); }
    }
    float mx = L.sink;
#pragma unroll
    for (int T = 0; T < 5; ++T)
#pragma unroll
        for (int e = 0; e < 16; ++e) { const int rabs = (kt0 + T) * 32 + (e & 3) + 8 * (e >> 2) + 4 * h, dist = L.qrel - rabs;
            const bool valid = dist >= 0 && dist < 128 && rabs >= L.rmin;
            const float s = valid ? sc[T][e] * 0.125f + L.btab[dist & 127] : -1e30f;
            sc[T][e] = s; mx = fmaxf(mx, s); }
    mx = fmaxf(mx, __shfl_xor(mx, 32));
    float l = 0.f;
#pragma unroll
    for (int T = 0; T < 5; ++T)
#pragma unroll
        for (int e = 0; e < 16; ++e) { const float p = sc[T][e] > -1e29f ? __expf(sc[T][e] - mx) : 0.f; sc[T][e] = p; l += p; }
    l += __shfl_xor(l, 32);
    l += __expf(L.sink - mx);
    f32x16 o[2];
#pragma unroll
    for (int e = 0; e < 16; ++e) { o[0][e] = 0.f; o[1][e] = 0.f; }
#pragma unroll
    for (int T = 0; T < 5; ++T)
#pragma unroll
        for (int s2 = 0; s2 < 2; ++s2) {
            v4u pw; pw.x = pk2(sc[T][8 * s2], sc[T][8 * s2 + 1]); pw.y = pk2(sc[T][8 * s2 + 2], sc[T][8 * s2 + 3]); pw.z = pk2(sc[T][8 * s2 + 4], sc[T][8 * s2 + 5]); pw.w = pk2(sc[T][8 * s2 + 6], sc[T][8 * s2 + 7]);
            const bf16x8 pb = __builtin_bit_cast(bf16x8, pw);
#pragma unroll
            for (int dt = 0; dt < 2; ++dt) {
                const LAS unsigned char* vp = Vt + (32 * dt + r) * VTP + ((kt0 + T) * 32 + 16 * s2 + 4 * h) * 2;
                const s16x4 lo = *(const LAS s16x4*)vp, hi = *(const LAS s16x4*)(vp + 16);
                const bf16x8 va = (bf16x8){lo[0], lo[1], lo[2], lo[3], hi[0], hi[1], hi[2], hi[3]};
                o[dt] = __builtin_amdgcn_mfma_f32_32x32x16_bf16(va, pb, o[dt], 0, 0, 0);
            }
        }
    const float il = 1.0f / l;
#pragma unroll
    for (int dt = 0; dt < 2; ++dt)
#pragma unroll
        for (int gq = 0; gq < 4; ++gq) { const int d = 32 * dt + 8 * gq + 4 * h;
            const unsigned long long w = (unsigned long long)pk2(o[dt][4 * gq] * il, o[dt][4 * gq + 1] * il) | ((unsigned long long)pk2(o[dt][4 * gq + 2] * il, o[dt][4 * gq + 3] * il) << 32);
            *(unsigned long long*)(L.orow + d) = w; }
}
constexpr int AP_K = 0, AP_VTP = 528, AP_VT = 256 * 144, AP_BT = AP_VT + 64 * AP_VTP, AP_END = AP_BT + 4 * 128 * 4;
__device__ __forceinline__ void attn_prompt_unit(Frame& F, int b, int kvh, int qb) {
    LAS unsigned char* lds = F.lds;
    const bf16* P = WSP(bf16, WS_H); bf16* MIX = WSP(bf16, WS_U); const float* relb = F.a->in[I_RELB];
    const int t0 = qb * 128, tid = F.tid;
    __syncthreads();
    for (int idx = tid; idx < 256 * 8; idx += 512) {
        const int row = idx >> 3, part = idx & 7, pos = t0 - 128 + row;
        v4u val = (v4u){0u, 0u, 0u, 0u};
        if (pos >= 0) val = *(const v4u*)(P + (size_t)(b * TP + pos) * NIN + 2304 + kvh * 64 + part * 8);
        *(LAS v4u*)(lds + AP_K + row * 144 + part * 16) = val;
    }
    for (int idx = tid; idx < 256 * 8; idx += 512) {
        const int row = idx & 255, part = idx >> 8, pos = t0 - 128 + row;
        v4u val = (v4u){0u, 0u, 0u, 0u};
        if (pos >= 0) val = *(const v4u*)(P + (size_t)(b * TP + pos) * NIN + 2432 + kvh * 64 + part * 8);
#pragma unroll
        for (int e = 0; e < 4; ++e) { *(LAS unsigned short*)(lds + AP_VT + (part * 8 + 2 * e) * AP_VTP + row * 2) = (unsigned short)(val[e] & 0xffffu);
                                      *(LAS unsigned short*)(lds + AP_VT + (part * 8 + 2 * e + 1) * AP_VTP + row * 2) = (unsigned short)(val[e] >> 16); }
    }
    { const int g = tid >> 7, dist = tid & 127; ((LAS float*)(lds + AP_BT))[g * 128 + dist] = relb[rel_bucket(dist) * 8 + kvh * 4 + g]; }
    __syncthreads();
    const int g = F.wave & 3, qh = F.wave >> 2, hq = kvh * 4 + g;
#pragma unroll 1
    for (int bq = 0; bq < 2; ++bq) {
        const int i = 64 * qh + 32 * bq + (F.lane & 31), m = b * TP + t0 + i;
        AttnLane L; L.qrow = P + (size_t)m * NIN + RWP + hq * 64; L.qrel = i + 128; L.rmin = t0 == 0 ? 128 : 0;
        L.btab = (const LAS float*)(lds + AP_BT) + g * 128; L.sink = F.a->in[I_SINKS][hq]; L.orow = MIX + (size_t)m * D + RW + hq * 64;
        attn_core32(lds + AP_K, lds + AP_VT, AP_VTP, 2 * qh + bq, L, F.lane);
    }
}
static_assert(AP_END <= RING_BYTES && AP_VT % 16 == 0 && CC_SMALL + SM_BYTES <= RING_BYTES && CA_SMALL + SM_BYTES <= RING_BYTES, "LDS maps");
constexpr int AS_KB = 160 * 144, AS_VTP = 336, AS_VT = 2 * AS_KB, AS_VB = 64 * AS_VTP, AS_BT = AS_VT + 2 * AS_VB, AS_END = AS_BT + 8 * 128 * 4;
static_assert(AS_END <= RING_BYTES && AS_VT % 16 == 0 && AS_VB % 16 == 0, "LDS maps");
__device__ __forceinline__ void attn_sample_unit(Frame& F, int b) {
    LAS unsigned char* lds = F.lds;
    const bf16* P = WSP(bf16, WS_H); bf16* MIX = WSP(bf16, WS_U); const float* relb = F.a->in[I_RELB]; const float* ck = F.a->in[I_CK]; const float* cv = F.a->in[I_CV];
    const int tid = F.tid;
    __syncthreads();
    for (int idx = tid; idx < 160 * 32; idx += 512) {
        const int j = idx >> 5, c4 = (idx & 31) * 4, kvh = c4 >> 6, d = c4 & 63;
        f32x4 kx = (f32x4){0.f, 0.f, 0.f, 0.f}, vx = kx;
        if (j < 128) { kx = *(const f32x4*)(ck + (size_t)(b * 128 + j) * 128 + c4); vx = *(const f32x4*)(cv + (size_t)(b * 128 + j) * 128 + c4); }
        else if (j < 136) { const bf16* pr = P + (size_t)(MP + b * TS + (j - 128)) * NIN;
            const unsigned long long kw = *(const unsigned long long*)(pr + 2304 + c4), vw = *(const unsigned long long*)(pr + 2432 + c4); kx = bf4_to_f32(kw); vx = bf4_to_f32(vw); }
        *(LAS unsigned long long*)(lds + kvh * AS_KB + j * 144 + d * 2) = pk4(kx);
#pragma unroll
        for (int e = 0; e < 4; ++e) *(LAS unsigned short*)(lds + AS_VT + kvh * AS_VB + (d + e) * AS_VTP + j * 2) = (unsigned short)f2bf(vx[e]);
    }
    for (int idx = tid; idx < 1024; idx += 512) { const int hq = idx >> 7, dist = idx & 127; ((LAS float*)(lds + AS_BT))[idx] = relb[rel_bucket(dist) * 8 + hq]; }
    __syncthreads();
    if (F.wave < 2) {
        const int kvh = F.wave, rr = F.lane & 31, g = rr >> 3, t = rr & 7, hq = kvh * 4 + g, m = MP + b * TS + t;
        AttnLane L; L.qrow = P + (size_t)m * NIN + RWP + hq * 64; L.qrel = t + 128; L.rmin = 0;
        L.btab = (const LAS float*)(lds + AS_BT) + hq * 128; L.sink = F.a->in[I_SINKS][hq]; L.orow = MIX + (size_t)m * D + RW + hq * 64;
        attn_core32(lds + kvh * AS_KB, lds + AS_VT + kvh * AS_VB, AS_VTP, 0, L, F.lane);
    }
}
__device__ __forceinline__ void mixer_task(Frame& F0, int t) {
    Frame F = F0;
    { int t_ = threadIdx.x; asm volatile("" : "+v"(t_)); F.tid = t_; F.lane = t_ & 63; F.wave = __builtin_amdgcn_readfirstlane(t_ >> 6); }
    if (t < 16) scanB_unit(F, t);
    else if (t < 272) { const int u = t - 16; attn_prompt_unit(F, u >> 7, (u >> 6) & 1, u & 63); }
    else if (t < 400) sample_scan_unit(F, t - 272);
    else attn_sample_unit(F, t - 400);
}
__device__ __forceinline__ void p_mixer(Frame& F) {
    int t = F.vcu, step = F.G, end = 528;
    if (F.G >= 32) { if (F.vcu < 16) { step = 1 << 20; end = 16; } else step = F.G - 16; }
    for (; t < end; t += step) mixer_task(F, t);
    __syncthreads();
}
__device__ __forceinline__ void p_scanA(Frame& F) { for (int t = F.vcu; t < 512; t += F.G) scanA_task(F, t); __syncthreads(); }
__device__ __forceinline__ void p_scanC(Frame& F) { for (int t = F.vcu; t < 512; t += F.G) scanC_task(F, t); __syncthreads(); }
#ifndef MK_PER_PHASE
#define MK_PER_PHASE 0
#endif
constexpr int N_PHASES = 15;
__global__ void __launch_bounds__(NWAVES * 64, 2) fwd_kernel(Args args) {
    extern __shared__ __attribute__((aligned(16))) unsigned char lds[];
    Frame F;
    F.lds = (LAS unsigned char*)lds;
    F.MISC = (volatile LAS unsigned*)(F.lds + MISC_OFF);
    F.tid = threadIdx.x; F.lane = F.tid & 63; F.wave = __builtin_amdgcn_readfirstlane(F.tid >> 6);
    F.G = gridDim.x; { const int bx = blockIdx.x; F.vcu = (F.G % 8 == 0) ? (bx % 8) * (F.G / 8) + bx / 8 : bx; }
    F.a = &args; F.ctl = (gu32*)(args.ws + WS_CTL);
    for (int u = F.tid; u < (LDS_BYTES - LDSCTL_OFF) / 4; u += NWAVES * 64) ((LAS unsigned*)(F.lds + LDSCTL_OFF))[u] = 0u;
    __syncthreads();
    const int lo = args.ph_lo, hi = args.ph_hi;
    XcdBarrier bar; bar.bar = (unsigned*)(F.ctl + CW_BAR); bar.x = 0; bar.st = nullptr;
    if (hi - lo > 1) bar = xcd_barrier_post((unsigned*)(F.ctl + CW_BAR), F.MISC + 8);
#ifdef ONLY_PHASE
#define IN(k) ((k) == ONLY_PHASE && lo <= (k) && (k) < hi)
#else
#define IN(k) (lo <= (k) && (k) < hi)
#endif
#ifndef REP_PHASE
#define REP_PHASE -1
#endif
#define SEAM(k) do { if ((k) + 1 < hi) xcd_barrier(bar); } while (0)
#define PH(k, BODY) if (IN(k)) { BODY; if ((k) == REP_PHASE) { xcd_barrier(bar); BODY; } SEAM(k); }
#define GEMM_SWIGLU(WOFF) { \
        pg8::Gemm g{WSP(bf16, WS_U), WSP(bf16, WOFF), M, NFF, D}; pg8::StaticOrder S; S.init(M, NFF, F.G, (int)blockIdx.x); \
        pg8::EpiSwiglu E{WSP(bf16, WS_H), FF}; \
        pg8::gemm_phase<pg8::EpiSwiglu, pg8::StaticOrder, true, true>(F.lds + RING_OFF, g, S, E); }
#define GEMM_RESID(AOFF, WOFF, KK, XP, XS, GTK, GS) { \
        pg8::Gemm g{WSP(bf16, AOFF), WSP(bf16, WOFF), M, D, KK}; pg8::StaticOrder S; S.init(M, D, F.G, (int)blockIdx.x); \
        pg8::EpiResid E{XP, XS, args.out + O_Y, WSP(float, WS_MOD) + (GTK) * D, ALPHA, GS}; \
        pg8::gemm_phase<pg8::EpiResid, pg8::StaticOrder, true, true>(F.lds + RING_OFF, g, S, E); }
#define GEMM_WIN() { \
        pg8::Gemm g{WSP(bf16, WS_U), WSP(bf16, WS_WIN), M, NIN, D}; pg8::StaticOrder S; S.init(M, NIN, F.G, (int)blockIdx.x); \
        pg8::EpiBf16<0> E{WSP(bf16, WS_H), NIN, nullptr, 0, 0, 1.f}; \
        pg8::gemm_phase<pg8::EpiBf16<0>, pg8::StaticOrder, true, true>(F.lds + RING_OFF, g, S, E); }
    PH(0, { p0_weights(F); if (REP_PHASE == 100) { __syncthreads(); p0_weights(F); } __syncthreads(); p0_mod(F); if (REP_PHASE == 101) { __syncthreads(); p0_mod(F); } })
    PH(1, p_modulate0(F))
    PH(2, GEMM_SWIGLU(WS_W1IN))
    PH(3, GEMM_RESID(WS_H, WS_W1OUT, FF, args.in[I_XP], args.in[I_XS], 2, 0.5f))
    PH(4, p_layernorm(F, 0, 3 * D))
    PH(5, GEMM_WIN())
    PH(6, p_prep(F))
    PH(7, p_scanA(F))
    PH(8, p_mixer(F))
    PH(9, p_scanC(F))
    PH(10, GEMM_RESID(WS_U, WS_WOUT, D, args.out + O_Y, args.out + O_Y + (size_t)MP * D, 5, 1.0f))
    PH(11, p_layernorm(F, 1, 6 * D))
    PH(12, GEMM_SWIGLU(WS_W2IN))
    PH(13, GEMM_RESID(WS_H, WS_W2OUT, FF, args.out + O_Y, args.out + O_Y + (size_t)MP * D, 8, 0.5f))
    PH(14, p_layernorm(F, 2, -1))
}

extern "C" void kernel_launch(void* const* d_in, const int* in_sizes, int n_in, void* d_out, int out_size, void* d_ws, size_t ws_size, hipStream_t stream) {
    static int grid = 0;
    if (grid == 0) {
        if (n_in != N_IN || in_sizes[0] != MP * D || out_size != (int)O_END || ws_size < WS_END) { fprintf(stderr, "kernel_launch: unexpected shapes (n_in %d, out %d, ws %zu); nothing launched\n", n_in, out_size, ws_size); grid = -1; return; }
        int dev = 0, cus = 0;
        if (hipGetDevice(&dev) != hipSuccess || hipDeviceGetAttribute(&cus, hipDeviceAttributeMultiprocessorCount, dev) != hipSuccess) { grid = -1; return; }
        if (hipFuncSetAttribute((const void*)fwd_kernel, hipFuncAttributeMaxDynamicSharedMemorySize, LDS_BYTES) != hipSuccess) { fprintf(stderr, "kernel_launch: hipFuncSetAttribute failed\n"); grid = -1; return; }
        int per_cu = 0;
        if (hipOccupancyMaxActiveBlocksPerMultiprocessor(&per_cu, (const void*)fwd_kernel, NWAVES * 64, LDS_BYTES) != hipSuccess || per_cu < 1) fprintf(stderr, "kernel_launch: occupancy query reports %d\n", per_cu);
        (void)hipGetLastError();
        grid = cus;
    }
    if (grid < 0) return;
    if (hipMemsetAsync((char*)d_ws + WS_CTL, 0, CTL_ZERO_BYTES, stream) != hipSuccess) return;
    Args a{};
    for (int i = 0; i < N_IN; ++i) a.in[i] = (const float*)d_in[i];
    a.out = (float*)d_out; a.ws = (unsigned char*)d_ws;
#if MK_PER_PHASE
    for (int ph = 0; ph < N_PHASES; ++ph) { a.ph_lo = ph; a.ph_hi = ph + 1; hipLaunchKernelGGL(fwd_kernel, dim3(grid), dim3(NWAVES * 64), LDS_BYTES, stream, a); }
#else
    a.ph_lo = 0; a.ph_hi = N_PHASES;
    hipLaunchKernelGGL(fwd_kernel, dim3(grid), dim3(NWAVES * 64), LDS_BYTES, stream, a);
#endif
}
```

```cpp
#define MK_PER_PHASE 0

#include <hip/hip_runtime.h>
#include <cstdio>
#include <cstdint>
#include <cmath>
namespace pg8 {
#define PG8_LAS __attribute__((address_space(3)))
typedef unsigned short bf16_t;
typedef short bf16x8 __attribute__((ext_vector_type(8)));
typedef float f32x4 __attribute__((ext_vector_type(4)));
typedef unsigned u32x4 __attribute__((ext_vector_type(4)));
constexpr int BM = 256, BK = 64, HALF = 128, HTB = HALF * BK * 2  , STAGE_BYTES = 8 * HTB, NXCD = 8, WGM = 8;

__host__ __device__ __forceinline__ int lds_byte(int r, int c) { const int st = (r >> 4) * 2 + (c >> 5), rr = r & 15, cc = c & 31, ob = rr * 64 + cc * 2; return st * 1024 + (ob ^ (((ob >> 9) & 1) << 5)); }
__host__ __device__ __forceinline__ void stage_rc(int b, int& R, int& C) { const int st = b / 1024, sb = b % 1024, swz = sb ^ (((sb >> 9) & 1) << 5); R = (st >> 1) * 16 + swz / 64; C = (st & 1) * 32 + (swz % 64) / 2; }
__host__ __device__ __forceinline__ int perm32(int rho) { const int n = rho >> 4, i = rho & 15; return 8 * (i >> 2) + 4 * n + (i & 3); }

struct Unit { int pm, pn; };
struct Gemm { const bf16_t* A; const bf16_t* Bt; int M, N, K; };

struct StaticOrder {
    int nM, nN, nwg, G, c;
    __host__ __device__ void init(int M, int N, int G_, int c_) { nM = M / BM; nN = N / BM; nwg = nM * nN; G = G_; c = c_; }
    __host__ __device__ bool next(int i, Unit& u) const {
        const long L = (long)i * G + c; if (L >= nwg) return false;
        int wgid = (int)L; { const int q = nwg / NXCD, r = nwg % NXCD, xcd = wgid % NXCD, off = wgid / NXCD; wgid = (xcd < r ? xcd * (q + 1) : r * (q + 1) + (xcd - r) * q) + off; }
        const int nig = WGM * nN, gid = wgid / nig, fm = gid * WGM, gsz = (nM - fm) < WGM ? (nM - fm) : WGM;
        u.pm = fm + ((wgid % nig) % gsz); u.pn = (wgid % nig) / gsz; return true;
    }
    __device__ __forceinline__ void a_ready(const Unit&) const {}
    __device__ __forceinline__ void done(const Unit&) const {}
};

__device__ __forceinline__ unsigned cvt_pk_bf16(float lo, float hi) { unsigned r; asm volatile("v_cvt_pk_bf16_f32 %0, %1, %2" : "=v"(r) : "v"(lo), "v"(hi)); return r; }
template <int ACT  > struct EpiBf16 {
    static constexpr bool PERM = true, AFTER_DRAIN = false; static_assert(ACT == 0, "EpiBf16: ACT is 0 (none)");
    bf16_t* O; int ldc; const float* bias; int split_cols; size_t split_stride; float scale0;
    __device__ __forceinline__ void operator()(const f32x4 (&acc)[2][2][4][2], const Unit& u, int wr, int wc, int fr, int fq) const {
        const int row0 = u.pm * BM + wr * 64 + fr; int colt = u.pn * BM; bf16_t* base = O;
        float sc = 1.f; if (split_cols) { const int t = colt / split_cols; base += (size_t)t * split_stride; colt -= t * split_cols; if (t == 0) sc = scale0; }
        const int col0 = colt + wc * 32 + 8 * fq, bcol0 = u.pn * BM + wc * 32 + 8 * fq;
        f32x4 bv[2][2];
#pragma unroll
        for (int bj = 0; bj < 2; ++bj)
#pragma unroll
            for (int n = 0; n < 2; ++n) bv[bj][n] = bias ? *(const f32x4*)(bias + bcol0 + bj * HALF + 4 * n) : (f32x4){0.f, 0.f, 0.f, 0.f};
#pragma unroll
        for (int ai = 0; ai < 2; ++ai)
#pragma unroll
            for (int m = 0; m < 4; ++m) { bf16_t* rowp = base + (size_t)(row0 + ai * HALF + m * 16) * ldc + col0;
#pragma unroll
                for (int bj = 0; bj < 2; ++bj) { f32x4 v0 = acc[ai][bj][m][0] + bv[bj][0], v1 = acc[ai][bj][m][1] + bv[bj][1];
                    v0 = v0 * sc; v1 = v1 * sc; u32x4 w; w.x = cvt_pk_bf16(v0[0], v0[1]); w.y = cvt_pk_bf16(v0[2], v0[3]); w.z = cvt_pk_bf16(v1[0], v1[1]); w.w = cvt_pk_bf16(v1[2], v1[3]);
                    *(u32x4*)(rowp + bj * HALF) = w; } }
    }
};

template <class Epi, class Sched, bool ALIGN_EPI = false, bool SP2 = false>
__device__ __forceinline__ void gemm_phase(PG8_LAS unsigned char* lds, const Gemm g, const Sched& S, const Epi& E) {
    const int tid = threadIdx.x, wid = __builtin_amdgcn_readfirstlane(tid >> 6), lane = tid & 63, wr = wid >> 2, wc = wid & 3, fr = lane & 15, fq = lane >> 4;
    const int K = g.K, nt = K / BK;
    unsigned voffA[2], voffB[2];
#pragma unroll
    for (int i = 0; i < 2; ++i) { int R, C; stage_rc(tid * 16 + i * 8192, R, C); const int Rb = Epi::PERM ? ((R & ~31) + perm32(R & 31)) : R;
        voffA[i] = (unsigned)(R * K + C) * 2u; voffB[i] = (unsigned)(Rb * K + C) * 2u; }
    const size_t kstep = (size_t)(BK * 2);
    const size_t hstep = (size_t)HALF * K * 2;
    const size_t tstep = 2 * hstep;
    const unsigned ldsw = (unsigned)wid * 1024u;
    const int aoff = lds_byte(wr * 64 + fr, fq * 8), boff = lds_byte(wc * 32 + fr, fq * 8);
#define PG8_SA(b, h) (((b) * 2 + (h)) * HTB)
#define PG8_SB(b, h) ((4 + (b) * 2 + (h)) * HTB)
#define PG8_STAGE(bufoff, gbase, voff) do { _Pragma("unroll") for (int _i = 0; _i < 2; ++_i) \
        __builtin_amdgcn_global_load_lds((const unsigned*)((const char*)(gbase) + (voff)[_i]), (PG8_LAS unsigned*)(lds + (bufoff) + ldsw + _i * 8192), 16, 0, 0); } while (0)
#define PG8_LDA(dst, b, h) do { _Pragma("unroll") for (int m = 0; m < 4; ++m) _Pragma("unroll") for (int k = 0; k < 2; ++k) dst[m][k] = *(const PG8_LAS bf16x8*)(lds + PG8_SA(b, h) + aoff + m * 2048 + k * 1024); } while (0)
#define PG8_LDB(dst, b, h) do { _Pragma("unroll") for (int n = 0; n < 2; ++n) _Pragma("unroll") for (int k = 0; k < 2; ++k) dst[n][k] = *(const PG8_LAS bf16x8*)(lds + PG8_SB(b, h) + boff + n * 2048 + k * 1024); } while (0)
#define PG8_MMA(ai, bj, At, Bt) do { __builtin_amdgcn_s_setprio(1); _Pragma("unroll") for (int m = 0; m < 4; ++m) _Pragma("unroll") for (int n = 0; n < 2; ++n) _Pragma("unroll") for (int k = 0; k < 2; ++k) \
        acc[ai][bj][m][n] = __builtin_amdgcn_mfma_f32_16x16x32_bf16(Bt[n][k], At[m][k], acc[ai][bj][m][n], 0, 0, 0); __builtin_amdgcn_s_setprio(0); } while (0)
#define PG8_WAIT_V(n) asm volatile("s_waitcnt vmcnt(" #n ")" ::: "memory")
#define PG8_WAIT_L(n) asm volatile("s_waitcnt lgkmcnt(" #n ")" ::: "memory")
#define PG8_BAR __builtin_amdgcn_s_barrier()
#define PG8_SCHED __builtin_amdgcn_sched_barrier(0)
    Unit cur, nxt; int ui = 0;
    if (!S.next(0, cur)) return;
    f32x4 acc[2][2][4][2];
#pragma unroll
    for (int a = 0; a < 2; ++a)
#pragma unroll
        for (int b = 0; b < 2; ++b)
#pragma unroll
            for (int m = 0; m < 4; ++m)
#pragma unroll
                for (int n = 0; n < 2; ++n) acc[a][b][m][n] = (f32x4){0.f, 0.f, 0.f, 0.f};
    bf16x8 At[4][2], B0[2][2], B1[2][2];
    const char* cA = (const char*)g.A + (size_t)cur.pm * tstep; const char* cB = (const char*)g.Bt + (size_t)cur.pn * tstep;
    S.a_ready(cur);
    if constexpr (SP2) {
        PG8_STAGE(PG8_SB(0, 0), cB, voffB); PG8_STAGE(PG8_SB(0, 1), cB + hstep, voffB); PG8_STAGE(PG8_SA(0, 0), cA, voffA); PG8_STAGE(PG8_SA(0, 1), cA + hstep, voffA);
        if (wr == 1) PG8_BAR;
        PG8_WAIT_V(2); PG8_BAR;
        PG8_STAGE(PG8_SB(1, 0), cB + kstep, voffB); PG8_STAGE(PG8_SA(1, 0), cA + kstep, voffA); PG8_STAGE(PG8_SB(1, 1), cB + hstep + kstep, voffB);
        PG8_WAIT_V(6); PG8_BAR;
    } else {
        PG8_STAGE(PG8_SB(0, 0), cB, voffB); PG8_STAGE(PG8_SA(0, 0), cA, voffA); PG8_STAGE(PG8_SB(0, 1), cB + hstep, voffB); PG8_STAGE(PG8_SA(0, 1), cA + hstep, voffA);
        if (wr == 1) PG8_BAR;
        PG8_WAIT_V(4); PG8_BAR;
        PG8_STAGE(PG8_SB(1, 0), cB + kstep, voffB); PG8_STAGE(PG8_SA(1, 0), cA + kstep, voffA); PG8_STAGE(PG8_SB(1, 1), cB + hstep + kstep, voffB);
        PG8_WAIT_V(6); PG8_BAR;
    }
    for (;;) {
        const bool has_next = S.next(ui + 1, nxt);
        const char* nA = has_next ? (const char*)g.A + (size_t)nxt.pm * tstep : cA; const char* nB = has_next ? (const char*)g.Bt + (size_t)nxt.pn * tstep : cB;
        for (int t = 0; t < nt; t += 2) {
            const bool last = (t == nt - 2);
            const char* a1 = cA + (size_t)(t + 1) * kstep;
            const char* a2 = last ? nA : cA + (size_t)(t + 2) * kstep; const char* b2 = last ? nB : cB + (size_t)(t + 2) * kstep;
            const char* a3 = a2 + kstep; const char* b3 = b2 + kstep;
            if (last && has_next) S.a_ready(nxt);
            if constexpr (SP2) {
            PG8_LDB(B0, 0, 0); PG8_LDB(B1, 0, 1); PG8_SCHED; PG8_LDA(At, 0, 0); PG8_STAGE(PG8_SA(1, 1), a1 + hstep, voffA);
            PG8_WAIT_V(8); PG8_WAIT_L(0); PG8_BAR; PG8_MMA(0, 0, At, B0); PG8_MMA(0, 1, At, B1); PG8_BAR; PG8_SCHED;
            PG8_LDA(At, 0, 1); PG8_STAGE(PG8_SB(0, 0), b2, voffB); PG8_STAGE(PG8_SB(0, 1), b2 + hstep, voffB); PG8_STAGE(PG8_SA(0, 0), a2, voffA);
            PG8_WAIT_V(8); PG8_WAIT_L(0); PG8_BAR; PG8_MMA(1, 0, At, B0); PG8_MMA(1, 1, At, B1); PG8_BAR; PG8_SCHED;
            PG8_LDB(B0, 1, 0); PG8_LDB(B1, 1, 1); PG8_SCHED; PG8_LDA(At, 1, 0); PG8_STAGE(PG8_SA(0, 1), a2 + hstep, voffA);
            PG8_WAIT_V(8); PG8_WAIT_L(0); PG8_BAR; PG8_MMA(0, 0, At, B0); PG8_MMA(0, 1, At, B1); PG8_BAR; PG8_SCHED;
            PG8_LDA(At, 1, 1); PG8_STAGE(PG8_SB(1, 0), b3, voffB); PG8_STAGE(PG8_SB(1, 1), b3 + hstep, voffB); PG8_STAGE(PG8_SA(1, 0), a3, voffA);
            PG8_WAIT_V(8); PG8_WAIT_L(0); PG8_BAR; PG8_MMA(1, 0, At, B0); PG8_MMA(1, 1, At, B1); PG8_BAR; PG8_SCHED;
            } else {
            PG8_LDB(B0, 0, 0); PG8_SCHED; PG8_LDA(At, 0, 0); PG8_STAGE(PG8_SA(1, 1), a1 + hstep, voffA);
            PG8_WAIT_L(8); PG8_BAR; PG8_WAIT_L(0); PG8_MMA(0, 0, At, B0); PG8_BAR; PG8_SCHED;
            PG8_LDB(B1, 0, 1); PG8_STAGE(PG8_SB(0, 0), b2, voffB);
            PG8_BAR; PG8_WAIT_L(0); PG8_MMA(0, 1, At, B1); PG8_BAR;
            PG8_LDA(At, 0, 1); PG8_STAGE(PG8_SA(0, 0), a2, voffA);
            PG8_BAR; PG8_WAIT_L(0); PG8_MMA(1, 0, At, B0); PG8_BAR; PG8_SCHED;
            PG8_STAGE(PG8_SB(0, 1), b2 + hstep, voffB);
            PG8_WAIT_V(6); PG8_BAR; PG8_MMA(1, 1, At, B1); PG8_BAR;
            PG8_LDB(B0, 1, 0); PG8_SCHED; PG8_LDA(At, 1, 0); PG8_STAGE(PG8_SA(0, 1), a2 + hstep, voffA);
            PG8_WAIT_L(8); PG8_BAR; PG8_WAIT_L(0); PG8_MMA(0, 0, At, B0); PG8_BAR; PG8_SCHED;
            PG8_LDB(B1, 1, 1); PG8_STAGE(PG8_SB(1, 0), b3, voffB);
            PG8_BAR; PG8_WAIT_L(0); PG8_MMA(0, 1, At, B1); PG8_BAR;
            PG8_LDA(At, 1, 1); PG8_STAGE(PG8_SA(1, 0), a3, voffA);
            PG8_BAR; PG8_WAIT_L(0); PG8_MMA(1, 0, At, B0); PG8_BAR; PG8_SCHED;
            PG8_STAGE(PG8_SB(1, 1), b3 + hstep, voffB);
            PG8_WAIT_V(6); PG8_BAR; PG8_MMA(1, 1, At, B1); PG8_BAR;
            }
        }
        if constexpr (ALIGN_EPI) { if (wr == 0) PG8_BAR; }
        if constexpr (!Epi::AFTER_DRAIN) { E(acc, cur, wr, wc, fr, fq); S.done(cur); }
        if (!has_next) break;
#pragma unroll
        for (int a = 0; a < 2; ++a)
#pragma unroll
            for (int b = 0; b < 2; ++b)
#pragma unroll
                for (int m = 0; m < 4; ++m)
#pragma unroll
                    for (int n = 0; n < 2; ++n) acc[a][b][m][n] = (f32x4){0.f, 0.f, 0.f, 0.f};
        cur = nxt; cA = nA; cB = nB; ++ui;
        if constexpr (ALIGN_EPI) { if (wr == 1) PG8_BAR; }
    }
    PG8_WAIT_V(0);
    if constexpr (!ALIGN_EPI) { if (wr == 0) PG8_BAR; }
    PG8_BAR;
    if constexpr (Epi::AFTER_DRAIN) { E.fused(acc, cur, wr, wc, fr, fq, lds, wid, lane); S.done(cur); }
#undef PG8_SA
#undef PG8_SB
#undef PG8_STAGE
#undef PG8_LDA
#undef PG8_LDB
#undef PG8_MMA
#undef PG8_WAIT_V
#undef PG8_WAIT_L
#undef PG8_BAR
#undef PG8_SCHED
}
struct EpiSwiglu {
    static constexpr bool PERM = true, AFTER_DRAIN = false;
    bf16_t* H; int ldh;
    __device__ __forceinline__ void operator()(const f32x4 (&acc)[2][2][4][2], const Unit& u, int wr, int wc, int fr, int fq) const {
        const int row0 = u.pm * BM + wr * 64 + fr, col0 = u.pn * HALF + wc * 32 + 8 * fq;
#pragma unroll
        for (int ai = 0; ai < 2; ++ai)
#pragma unroll
            for (int m = 0; m < 4; ++m) {
                bf16_t* p = H + (size_t)(row0 + ai * HALF + m * 16) * ldh + col0;
                float h[8];
#pragma unroll
                for (int n = 0; n < 2; ++n)
#pragma unroll
                    for (int i = 0; i < 4; ++i) { const float g = acc[ai][0][m][n][i], up = acc[ai][1][m][n][i];
                        h[n * 4 + i] = g * __builtin_amdgcn_rcpf(1.0f + __expf(-g)) * up; }
                u32x4 w; w.x = cvt_pk_bf16(h[0], h[1]); w.y = cvt_pk_bf16(h[2], h[3]); w.z = cvt_pk_bf16(h[4], h[5]); w.w = cvt_pk_bf16(h[6], h[7]);
                *(u32x4*)p = w;
            }
    }
};
struct EpiResid {
    static constexpr bool PERM = false, AFTER_DRAIN = false;
    const float* xp; const float* xs; float* X; const float* gt; float alpha, gs;
    __device__ __forceinline__ void operator()(const f32x4 (&acc)[2][2][4][2], const Unit& u, int wr, int wc, int fr, int fq) const {
        const int col0 = u.pn * BM + wc * 32 + 4 * fq;
#pragma unroll
        for (int ai = 0; ai < 2; ++ai)
#pragma unroll
            for (int m = 0; m < 4; ++m) {
                const int row = u.pm * BM + ai * HALF + wr * 64 + m * 16 + fr;
                const bool smp = row >= 16384;
                const float* xr = smp ? xs + (size_t)(row - 16384) * 1024 : xp + (size_t)row * 1024;
                const int b = smp ? 2 + ((row - 16384) >> 3) : (row >> 13);
                const float* gr = gt + (size_t)b * 9216;
                float* xo = X + (size_t)row * 1024;
#pragma unroll
                for (int bj = 0; bj < 2; ++bj)
#pragma unroll
                    for (int n = 0; n < 2; ++n) { const int c = col0 + bj * HALF + n * 16;
                        const f32x4 xv = *(const f32x4*)(xr + c), gv = *(const f32x4*)(gr + c);
                        const f32x4 z = xv * alpha + (gv + 1.0f) * gs * acc[ai][bj][m][n];
                        *(f32x4*)(xo + c) = z; }
            }
    }
};
}
#define GAS __attribute__((address_space(1)))
#define LAS __attribute__((address_space(3)))
typedef unsigned short bf16;
typedef unsigned v4u __attribute__((ext_vector_type(4)));
typedef float f32x4 __attribute__((ext_vector_type(4)));
typedef short bf16x8 __attribute__((ext_vector_type(8)));
typedef GAS unsigned gu32;
typedef GAS unsigned long long gu64;
#define RLX_AGENT __ATOMIC_RELAXED, __HIP_MEMORY_SCOPE_AGENT
#define LDS_WAIT() asm volatile("s_waitcnt lgkmcnt(0)" ::: "memory")
#define VM_WAIT() asm volatile("s_waitcnt vmcnt(0)" ::: "memory")
__device__ __forceinline__ unsigned long long rt() { return __builtin_amdgcn_s_memrealtime(); }
__device__ __forceinline__ unsigned f2bf(float f) { unsigned u = __builtin_bit_cast(unsigned, f); return (u + 0x7fffu + ((u >> 16) & 1u)) >> 16; }
__device__ __forceinline__ unsigned pk2(float lo, float hi) { return f2bf(lo) | (f2bf(hi) << 16); }

#define XB_TMO      128
#define XB_XCNT(j)  (256  + 64 * (j))
#define XB_XSUB(j)  (1280 + 64 * (j))
#define XB_XGEN(j)  (2304 + 64 * (j))
#define XB_TOP      3328
#define XB_TOPGEN   3392
#define XCD_BAR_WORDS 3456
#define XB_SPIN_CAP (1u << 18)

__device__ __forceinline__ unsigned xb_ld(unsigned* p)              { return __hip_atomic_load(p, __ATOMIC_RELAXED, __HIP_MEMORY_SCOPE_AGENT); }
__device__ __forceinline__ unsigned xb_add(unsigned* p, unsigned v) { return __hip_atomic_fetch_add(p, v, __ATOMIC_RELAXED, __HIP_MEMORY_SCOPE_AGENT); }
__device__ __forceinline__ unsigned xb_xcc_id() { return (unsigned)__builtin_amdgcn_s_getreg((3 << 11) | 20) & 0xFu; }
#define XB_SPIN(cond, bar) do { unsigned _sp = 0; while (cond) { __builtin_amdgcn_s_sleep(1); \
    if ((++_sp & 255u) == 0u) { if (xb_ld(&(bar)[XB_TMO])) break; if (_sp > XB_SPIN_CAP) { atomicAdd(&(bar)[XB_TMO], 1u); break; } } } } while (0)

struct XcdBarrier {
    unsigned* bar; unsigned x;
    volatile LAS unsigned* st;
};

__device__ __forceinline__ XcdBarrier xcd_barrier_post(unsigned* bar, volatile LAS unsigned* st) {
    XcdBarrier b; b.bar = bar; b.x = xb_xcc_id(); b.st = st;
    if (threadIdx.x == 0) (void)xb_add(&bar[XB_XCNT(b.x)], 1u);
    return b;
}
__device__ __forceinline__ void xcd_barrier_complete(unsigned* bar, unsigned x, unsigned& nloc, unsigned& nx) {
    const unsigned G = gridDim.x * gridDim.y * gridDim.z;
    unsigned sum, cnt, mine, sp = 0u;
    for (;;) {
        sum = 0u; cnt = 0u; mine = 0u;
#pragma unroll
        for (unsigned j = 0; j < 16; ++j) { const unsigned c = xb_ld(&bar[XB_XCNT(j)]); sum += c; cnt += (c > 0u) ? 1u : 0u; mine = (j == x) ? c : mine; }
        if (sum == G) break;
        __builtin_amdgcn_s_sleep(1);
        if ((++sp & 255u) == 0u) { if (xb_ld(&bar[XB_TMO])) break; if (sp > XB_SPIN_CAP) { atomicAdd(&bar[XB_TMO], 1u); break; } }
    }
    nloc = mine > 0u ? mine : 1u; nx = cnt > 0u ? cnt : 1u;
}

__device__ __forceinline__ void xcd_barrier(const XcdBarrier& b) {
    asm volatile("s_waitcnt vmcnt(0)" ::: "memory");
    __syncthreads();
    if (threadIdx.x == 0) {
        unsigned* bar = b.bar;
        __builtin_amdgcn_s_waitcnt(0);
        unsigned nloc = b.st[0], nx = b.st[1];
        if (nloc == 0u) { xcd_barrier_complete(bar, b.x, nloc, nx); b.st[0] = nloc; b.st[1] = nx; }
        const unsigned old = xb_add(&bar[XB_XSUB(b.x)], 1u);
        const unsigned gen = old / nloc;
        if (old + 1u == (gen + 1u) * nloc) {
            __builtin_amdgcn_fence(__ATOMIC_RELEASE, "agent");
            asm volatile("s_waitcnt vmcnt(0)" ::: "memory");
            const unsigned og = xb_add(&bar[XB_TOP], 1u);
            const unsigned tg = og / nx;
            if (og + 1u == (tg + 1u) * nx) xb_add(&bar[XB_TOPGEN], 1u);
            else XB_SPIN(xb_ld(&bar[XB_TOPGEN]) == tg, bar);
            __builtin_amdgcn_fence(__ATOMIC_ACQUIRE, "agent");
            xb_add(&bar[XB_XGEN(b.x)], 1u);
            asm volatile("s_waitcnt vmcnt(0)" ::: "memory");
        } else {
            XB_SPIN(xb_ld(&bar[XB_XGEN(b.x)]) == gen, bar);
            __builtin_amdgcn_fence(__ATOMIC_ACQUIRE, "agent");
            asm volatile("s_waitcnt vmcnt(0)" ::: "memory");
        }
    }
    __syncthreads();
}

constexpr int D = 1024, FF = 2816, NFF = 2 * FF, NIN = 2560, RW = 512, RWP = 1792;
constexpr int MP = 16384, MS = 1024, M = MP + MS, TP = 8192, TS = 8, NBS = 128;
constexpr int MODW = 9216, NMOD = 130;
constexpr float ALPHA = 1.189207115002721f;
constexpr float LN_EPS = 1e-5f, GN_EPS = 64e-5f;
constexpr int NWAVES = 8;
enum { I_XP = 0, I_XS, I_SWKV, I_SSHIFT, I_CK, I_CV, I_CP, I_CS, I_RELB, I_WADA, I_BADA, I_LNG, I_LNB, I_W1IN, I_W1OUT, I_WIN, I_MU, I_W0, I_WDEC, I_A0, I_WICLR, I_WGATE,
       I_KK, I_KA, I_RK, I_GNW, I_GNB, I_SINKS, I_WOUT, I_W2IN, I_W2OUT, N_IN };
constexpr size_t O_Y = 0, O_WKV_P = (size_t)M * D, O_SHIFT_P = O_WKV_P + 65536, O_WINK_P = O_SHIFT_P + 3584, O_WINV_P = O_WINK_P + 32768,
                 O_WKV_S = O_WINV_P + 32768, O_SHIFT_S = O_WKV_S + 4194304, O_WINK_S = O_SHIFT_S + 229376, O_WINV_S = O_WINK_S + 2097152, O_END = O_WINV_S + 2097152;
static_assert(O_END == 26578432, "d_out size");
constexpr size_t MiB = 1u << 20;
constexpr size_t WS_CTL = 0, CTL_ZERO_BYTES = 1 * MiB;
constexpr size_t WS_W1IN = 2 * MiB, WS_W1OUT = 13 * MiB, WS_WIN = 19 * MiB, WS_WOUT = 24 * MiB, WS_W2IN = 26 * MiB, WS_W2OUT = 37 * MiB;
constexpr size_t WS_MOD = 43 * MiB;
constexpr size_t WS_U = 48 * MiB;
constexpr size_t WS_H = 82 * MiB;
constexpr size_t WS_WLOG = 176 * MiB, WS_A = 210 * MiB, WS_G = 227 * MiB, WS_INV = 244 * MiB, WS_LORA = 245 * MiB, WS_END = 246 * MiB;
constexpr size_t LORA_WI = 512 * 64 * 2, LORA_WG = 2 * 512 * 64 * 2;
static_assert(WS_W1IN + (size_t)NFF * D * 2 <= WS_W1OUT && WS_W1OUT + (size_t)D * FF * 2 <= WS_WIN && WS_WIN + (size_t)NIN * D * 2 <= WS_WOUT && WS_WOUT + (size_t)D * D * 2 <= WS_W2IN &&
              WS_W2IN + (size_t)NFF * D * 2 <= WS_W2OUT && WS_W2OUT + (size_t)D * FF * 2 <= WS_MOD && WS_MOD + (size_t)NMOD * MODW * 4 <= WS_U && WS_U + (size_t)M * D * 2 <= WS_H &&
              WS_H + (size_t)M * FF * 2 <= WS_WLOG && WS_WLOG + (size_t)M * RW * 4 <= WS_A && WS_A + (size_t)M * RW * 2 <= WS_G && WS_G + (size_t)M * RW * 2 <= WS_INV &&
              WS_INV + (size_t)M * 8 * 4 <= WS_LORA && WS_LORA + 4 * 512 * 64 * 2 <= WS_END && WS_END <= 256 * MiB, "d_ws map");
constexpr int CW_BAR = 4096;
constexpr int RING_OFF = 0, RING_BYTES = 151552;
constexpr int LDSCTL_OFF = RING_BYTES, MISC_OFF = LDSCTL_OFF + 320;
constexpr int LDS_BYTES = 155648;
static_assert(MISC_OFF + 128 <= LDS_BYTES, "LDS map");

__device__ __forceinline__ float bf2f(unsigned short h) { return __uint_as_float((unsigned)h << 16); }
__device__ __forceinline__ float bflo(unsigned u) { return __uint_as_float(u << 16); }
__device__ __forceinline__ float bfhi(unsigned u) { return __uint_as_float(u & 0xffff0000u); }
__device__ __forceinline__ unsigned long long pk4(f32x4 v) { return (unsigned long long)pk2(v[0], v[1]) | ((unsigned long long)pk2(v[2], v[3]) << 32); }
__device__ __forceinline__ f32x4 bf4_to_f32(unsigned long long w) { return (f32x4){bflo((unsigned)w), bfhi((unsigned)w), bflo((unsigned)(w >> 32)), bfhi((unsigned)(w >> 32))}; }
__device__ __forceinline__ float wave_sum(float v) {
#pragma unroll
    for (int o = 1; o < 64; o <<= 1) v += __shfl_xor(v, o);
    return v;
}
template <int CTRL> __device__ __forceinline__ float dppf(float x) { return __builtin_bit_cast(float, __builtin_amdgcn_update_dpp(0, __builtin_bit_cast(int, x), CTRL, 0xf, 0xf, true)); }
__device__ __forceinline__ float sum8(float x) {
    x += dppf<0xB1>(x);
    x += dppf<0x4E>(x);
    x += dppf<0x141>(x);
    return x;
}
__device__ __forceinline__ float wave_sum_dpp(float x) {
    x += dppf<0xB1>(x); x += dppf<0x4E>(x); x += dppf<0x141>(x);
    x += dppf<0x140>(x);
    const int xi = __builtin_bit_cast(int, x);
    return __builtin_bit_cast(float, __builtin_amdgcn_readlane(xi, 0)) + __builtin_bit_cast(float, __builtin_amdgcn_readlane(xi, 16)) +
           __builtin_bit_cast(float, __builtin_amdgcn_readlane(xi, 32)) + __builtin_bit_cast(float, __builtin_amdgcn_readlane(xi, 48));
}
__device__ __forceinline__ float sigmoidf_(float x) { return 1.0f / (1.0f + expf(-x)); }

struct Args { const float* in[N_IN]; float* out; unsigned char* ws; int ph_lo, ph_hi; };
static_assert(sizeof(Args) == N_IN * 8 + 24, "Args has no padding");
struct Frame {
    LAS unsigned char* lds;
    volatile LAS unsigned* MISC;
    gu32* ctl;
    int tid, lane, wave, vcu, G;
    const Args* a;
};
#define WSP(T, off) ((T*)(F.a->ws + (off)))

__device__ __forceinline__ void p0_transpose_item(const float* W, int K, int N, bf16* WT, int dst_row0, int k0, int n0, LAS float* scr, int lane) {
#pragma unroll 8
    for (int i = 0; i < 32; ++i) { const int kk = 2 * i + (lane >> 5); scr[kk * 33 + (lane & 31)] = W[(size_t)(k0 + kk) * N + n0 + (lane & 31)]; }
    LDS_WAIT(); asm volatile("" ::: "memory");
    const int c = lane & 7;
#pragma unroll
    for (int j = 0; j < 4; ++j) { const int n = (lane >> 3) + 8 * j; const LAS float* s = scr + (8 * c) * 33 + n;
        v4u o; o.x = pk2(s[0 * 33], s[1 * 33]); o.y = pk2(s[2 * 33], s[3 * 33]); o.z = pk2(s[4 * 33], s[5 * 33]); o.w = pk2(s[6 * 33], s[7 * 33]);
        *(GAS v4u*)(WT + (size_t)(dst_row0 + n) * K + k0 + 8 * c) = o; }
    LDS_WAIT(); asm volatile("" ::: "memory");
}
__device__ __forceinline__ void p0_ffin_item(const float* W, bf16* WT, int r, LAS float* scr, int lane) {
    const int kb = r / 176, nb = r % 176, n0 = 32 * nb; const bool up = n0 >= FF; const int j = up ? n0 - FF : n0;
    p0_transpose_item(W, D, NFF, WT, (j >> 7) * 256 + (up ? 128 : 0) + (j & 127), 64 * kb, n0, scr, lane);
}
__device__ __forceinline__ void p0_plain_item(const float* W, int K, int N, bf16* WT, int r, LAS float* scr, int lane) {
    const int nblk = N / 32, kb = r / nblk, nb = r % nblk;
    p0_transpose_item(W, K, N, WT, 32 * nb, 64 * kb, 32 * nb, scr, lane);
}
__device__ __forceinline__ void p0_weights(Frame& F) {
    LAS float* scr = (LAS float*)(F.lds + RING_OFF + F.wave * 16384);
    const int gw = F.vcu * NWAVES + F.wave, NGW = F.G * NWAVES;
    constexpr int I_FI = 16 * 176, I_FO = 44 * 32, I_IN = 16 * 80, I_O = 16 * 32, I_L = 16, NITEMS = 2 * I_FI + 2 * I_FO + I_IN + I_O + 4 * I_L;
    for (int it = gw; it < NITEMS; it += NGW) {
        int r = it;
        if (r < I_FI) { p0_ffin_item(F.a->in[I_W1IN], WSP(bf16, WS_W1IN), r, scr, F.lane); continue; } r -= I_FI;
        if (r < I_FI) { p0_ffin_item(F.a->in[I_W2IN], WSP(bf16, WS_W2IN), r, scr, F.lane); continue; } r -= I_FI;
        if (r < I_FO) { p0_plain_item(F.a->in[I_W1OUT], FF, D, WSP(bf16, WS_W1OUT), r, scr, F.lane); continue; } r -= I_FO;
        if (r < I_FO) { p0_plain_item(F.a->in[I_W2OUT], FF, D, WSP(bf16, WS_W2OUT), r, scr, F.lane); continue; } r -= I_FO;
        if (r < I_IN) { p0_plain_item(F.a->in[I_WIN], D, NIN, WSP(bf16, WS_WIN), r, scr, F.lane); continue; } r -= I_IN;
        if (r < I_O) { p0_plain_item(F.a->in[I_WOUT], D, D, WSP(bf16, WS_WOUT), r, scr, F.lane); continue; } r -= I_O;
        if (r < I_L) { p0_plain_item(F.a->in[I_WDEC], 64, RW, WSP(bf16, WS_LORA), r, scr, F.lane); continue; } r -= I_L;
        if (r < I_L) { p0_plain_item(F.a->in[I_WICLR], 64, RW, WSP(bf16, WS_LORA + LORA_WI), r, scr, F.lane); continue; } r -= I_L;
        p0_plain_item(F.a->in[I_WGATE], 128, RW, WSP(bf16, WS_LORA + LORA_WG), r, scr, F.lane);
    }
}
typedef float f32x16m __attribute__((ext_vector_type(16)));
__device__ __forceinline__ void p0_mod(Frame& F) {
    const float* wada = F.a->in[I_WADA]; const float* bada = F.a->in[I_BADA]; const float* cp = F.a->in[I_CP]; const float* cs = F.a->in[I_CS];
    float* mod = WSP(float, WS_MOD);
    LAS float* red = (LAS float*)F.lds;
    const int lane = F.lane, wave = F.wave, r = lane & 31, h = lane >> 5;
    for (int task = blockIdx.x; task < MODW / 32; task += F.G) {
        const int j0 = 32 * task;
        f32x16m acc[5];
#pragma unroll
        for (int bt = 0; bt < 5; ++bt)
#pragma unroll
            for (int e = 0; e < 16; ++e) acc[bt][e] = 0.f;
#pragma unroll 1
        for (int ks = 0; ks < 8; ++ks) {
            const int i0 = 128 * wave + 16 * ks + 8 * h;
            unsigned aw[4];
#pragma unroll
            for (int e = 0; e < 4; ++e) aw[e] = pk2(wada[(size_t)(i0 + 2 * e) * MODW + j0 + r], wada[(size_t)(i0 + 2 * e + 1) * MODW + j0 + r]);
            const bf16x8 af = __builtin_bit_cast(bf16x8, (v4u){aw[0], aw[1], aw[2], aw[3]});
#pragma unroll
            for (int bt = 0; bt < 5; ++bt) {
                const int b = 32 * bt + r;
                f32x4 c0 = (f32x4){0.f, 0.f, 0.f, 0.f}, c1 = c0;
                if (b < NMOD) { const float* cr = (b < 2 ? cp + (size_t)b * D : cs + (size_t)(b - 2) * D) + i0; c0 = *(const f32x4*)cr; c1 = *(const f32x4*)(cr + 4); }
                float sv[8];
#pragma unroll
                for (int e = 0; e < 4; ++e) { sv[e] = c0[e] * __builtin_amdgcn_rcpf(1.0f + __expf(-c0[e])); sv[4 + e] = c1[e] * __builtin_amdgcn_rcpf(1.0f + __expf(-c1[e])); }
                const bf16x8 bfm = __builtin_bit_cast(bf16x8, (v4u){pk2(sv[0], sv[1]), pk2(sv[2], sv[3]), pk2(sv[4], sv[5]), pk2(sv[6], sv[7])});
                acc[bt] = __builtin_amdgcn_mfma_f32_32x32x16_bf16(af, bfm, acc[bt], 0, 0, 0);
            }
        }
#pragma unroll
        for (int rd = 0; rd < 2; ++rd) {
            const int nv = rd == 0 ? 48 : 32, bt0 = rd == 0 ? 0 : 3;
            __syncthreads();
#pragma unroll
            for (int bt = 0; bt < 3; ++bt) if (bt0 + bt < 5)
#pragma unroll
                for (int e = 0; e < 16; ++e) red[(wave * 48 + bt * 16 + e) * 64 + lane] = acc[bt0 + bt][e];
            __syncthreads();
            for (int idx = F.tid; idx < nv * 64; idx += 512) {
                const int v = idx >> 6, ln = idx & 63, bt = bt0 + (v >> 4), e = v & 15;
                float s = 0.f;
#pragma unroll
                for (int w = 0; w < 8; ++w) s += red[(w * 48 + v) * 64 + ln];
                const int b = 32 * bt + (ln & 31), j = j0 + (e & 3) + 8 * (e >> 2) + 4 * (ln >> 5);
                if (b < NMOD) mod[(size_t)b * MODW + j] = s + bada[j];
            }
        }
    }
    __syncthreads();
}

__device__ __forceinline__ int mod_row_of(int m) { return m < MP ? (m >> 13) : 2 + ((m - MP) >> 3); }
__device__ __forceinline__ void p_modulate0(Frame& F) {
    const int gw = F.vcu * NWAVES + F.wave, NGW = F.G * NWAVES;
    const float* mod = WSP(float, WS_MOD); bf16* U = WSP(bf16, WS_U);
    for (int m = gw; m < M; m += NGW) {
        const float* xr = m < MP ? F.a->in[I_XP] + (size_t)m * D : F.a->in[I_XS] + (size_t)(m - MP) * D;
        const float* mr = mod + (size_t)mod_row_of(m) * MODW;
        unsigned long long* o8 = (unsigned long long*)(U + (size_t)m * D) + F.lane;
#pragma unroll
        for (int j = 0; j < 4; ++j) { const int c = 4 * F.lane + 256 * j;
            const f32x4 x = *(const f32x4*)(xr + c), sh = *(const f32x4*)(mr + c), sc = *(const f32x4*)(mr + D + c);
            const f32x4 u = x * (sc + 1.0f) + sh;
            o8[64 * j] = (unsigned long long)pk2(u[0], u[1]) | ((unsigned long long)pk2(u[2], u[3]) << 32); }
    }
}
__device__ __forceinline__ void p_layernorm(Frame& F, int lnidx, int koff) {
    const int gw = F.vcu * NWAVES + F.wave, NGW = F.G * NWAVES;
    const float* mod = WSP(float, WS_MOD); bf16* U = WSP(bf16, WS_U); float* X = F.a->out + O_Y;
    const float* lg = F.a->in[I_LNG] + lnidx * D; const float* lb = F.a->in[I_LNB] + lnidx * D;
    for (int m = gw; m < M; m += NGW) {
        float* xr = X + (size_t)m * D;
        f32x4 v[4]; float s = 0.f;
#pragma unroll
        for (int j = 0; j < 4; ++j) { v[j] = *(const f32x4*)(xr + 4 * F.lane + 256 * j); s += (v[j][0] + v[j][1]) + (v[j][2] + v[j][3]); }
        const float mean = wave_sum(s) * (1.f / D); float s2 = 0.f;
#pragma unroll
        for (int j = 0; j < 4; ++j) { v[j] = v[j] - mean; s2 += (v[j][0] * v[j][0] + v[j][1] * v[j][1]) + (v[j][2] * v[j][2] + v[j][3] * v[j][3]); }
        const float rstd = 1.f / sqrtf(wave_sum(s2) * (1.f / D) + LN_EPS);
        const float* mr = mod + (size_t)mod_row_of(m) * MODW + (koff >= 0 ? koff : 0);
        unsigned long long* o8 = (unsigned long long*)(U + (size_t)m * D) + F.lane;
#pragma unroll
        for (int j = 0; j < 4; ++j) { const int c = 4 * F.lane + 256 * j;
            const f32x4 x = v[j] * rstd * *(const f32x4*)(lg + c) + *(const f32x4*)(lb + c);
            *(f32x4*)(xr + c) = x;
            if (koff >= 0) { const f32x4 sh = *(const f32x4*)(mr + c), sc = *(const f32x4*)(mr + D + c); const f32x4 u = x * (sc + 1.0f) + sh;
                o8[64 * j] = (unsigned long long)pk2(u[0], u[1]) | ((unsigned long long)pk2(u[2], u[3]) << 32); } }
    }
}
__device__ __forceinline__ float prev_val(const bf16* P, const float* sshift, int m, int col) {
    if (m < MP) return (m & (TP - 1)) == 0 ? 0.f : bf2f(P[(size_t)(m - 1) * NIN + col]);
    const int ms = m - MP;
    return (ms & (TS - 1)) == 0 ? sshift[(size_t)(ms >> 3) * RWP + col] : bf2f(P[(size_t)(m - 1) * NIN + col]);
}
constexpr int PP_PITCH = 528;
__device__ __forceinline__ void p_prep(Frame& F) {
    LAS unsigned char* lds = F.lds;
    const bf16* P = WSP(bf16, WS_H); const float* sshift = F.a->in[I_SSHIFT]; const float* mu = F.a->in[I_MU];
    float* WLOG = WSP(float, WS_WLOG); bf16* AA = WSP(bf16, WS_A); bf16* GG = WSP(bf16, WS_G);
    const int tid = F.tid, lane = F.lane, wave = F.wave;
    const int tile_lo0 = (F.vcu * (M / 16)) / F.G, tile_hi0 = ((F.vcu + 1) * (M / 16)) / F.G;
    for (int tile_lo = tile_lo0; tile_lo < tile_hi0; tile_lo += 5) {
    const int ntile = (tile_hi0 - tile_lo) < 5 ? (tile_hi0 - tile_lo) : 5;
    const int m_lo = tile_lo * 16, ntok = ntile * 16;
    __syncthreads();
    {
        const int j = tid & 255, hf = tid >> 8, col = 1536 + j; const float muj = mu[col];
        const int ga = hf == 0 ? 0 : ntile, gb = hf == 0 ? ntile : 2 * ntile;
        float carry = 0.f;
        for (int gi = ga; gi < gb; ++gi) { const int mg = m_lo + 8 * gi;
            float p[8];
#pragma unroll
            for (int t = 0; t < 8; ++t) p[t] = bf2f(P[(size_t)(mg + t) * NIN + col]);
            float prev = (gi == ga || ((mg < MP) ? (mg & (TP - 1)) : ((mg - MP) & (TS - 1))) == 0) ? prev_val(P, sshift, mg, col) : carry;
#pragma unroll
            for (int t = 0; t < 8; ++t) { const float xs = p[t] + (prev - p[t]) * muj; prev = p[t];
                const float f = j < 64 ? tanhf(xs) : (j < 128 ? xs : sigmoidf_(xs));
                *(LAS unsigned short*)(lds + (8 * gi + t) * PP_PITCH + j * 2) = (unsigned short)f2bf(f); }
            carry = p[7]; }
    }
    __syncthreads();
    const int lr = lane & 15, lq = lane >> 4, c0 = 64 * wave;
#pragma unroll 1
    for (int lo = 0; lo < 3; ++lo) {
        const int kin = lo == 0 ? 0 : (lo == 1 ? 64 : 128), nks = lo == 2 ? 4 : 2, wpitch = lo == 2 ? 128 : 64;
        const bf16* Wt = WSP(bf16, WS_LORA) + (lo == 0 ? 0 : (lo == 1 ? 512 * 64 : 2 * 512 * 64));
        f32x4 acc[5][4];
#pragma unroll
        for (int tt = 0; tt < 5; ++tt)
#pragma unroll
            for (int ct = 0; ct < 4; ++ct) acc[tt][ct] = (f32x4){0.f, 0.f, 0.f, 0.f};
        for (int ks = 0; ks < nks; ++ks) {
            bf16x8 wf[4];
#pragma unroll
            for (int ct = 0; ct < 4; ++ct) wf[ct] = *(const bf16x8*)(Wt + (size_t)(c0 + 16 * ct + lr) * wpitch + ks * 32 + lq * 8);
#pragma unroll
            for (int tt = 0; tt < 5; ++tt) if (tt < ntile) {
                const bf16x8 af = *(const LAS bf16x8*)(lds + (16 * tt + lr) * PP_PITCH + (kin + ks * 32 + lq * 8) * 2);
#pragma unroll
                for (int ct = 0; ct < 4; ++ct) acc[tt][ct] = __builtin_amdgcn_mfma_f32_16x16x32_bf16(wf[ct], af, acc[tt][ct], 0, 0, 0);
            }
        }
#pragma unroll
        for (int tt = 0; tt < 5; ++tt) if (tt < ntile) { const int m = m_lo + 16 * tt + lr;
#pragma unroll
            for (int ct = 0; ct < 4; ++ct) { const int c = c0 + 16 * ct + 4 * lq; const f32x4 a = acc[tt][ct];
                if (lo == 0) { const f32x4 w0v = *(const f32x4*)(F.a->in[I_W0] + c); f32x4 o;
#pragma unroll
                    for (int e = 0; e < 4; ++e) { const float z = w0v[e] + a[e]; const float sp = fmaxf(-z, 0.f) + log1pf(expf(-fabsf(z))); o[e] = -expf(-sp - 0.5f); }
                    *(f32x4*)(WLOG + (size_t)m * RW + c) = o; }
                else if (lo == 1) { const f32x4 a0v = *(const f32x4*)(F.a->in[I_A0] + c); f32x4 o;
#pragma unroll
                    for (int e = 0; e < 4; ++e) o[e] = sigmoidf_(a0v[e] + a[e]);
                    *(unsigned long long*)(AA + (size_t)m * RW + c) = pk4(o); }
                else *(unsigned long long*)(GG + (size_t)m * RW + c) = pk4(a); }
        }
    }
    }
}

constexpr int NCOPY = 240;
__device__ __forceinline__ void copy_task(Frame& F, int task) {
    const bf16* P = WSP(bf16, WS_H);
    const int gt = task * 512 + F.tid, NT = NCOPY * 512;
    const float* ck = F.a->in[I_CK]; const float* cv = F.a->in[I_CV];
    for (int i = gt; i < 2 * RWP; i += NT) { const int b = i / RWP, col = i % RWP; F.a->out[O_SHIFT_P + i] = bf2f(P[(size_t)(b * TP + TP - 1) * NIN + col]); }
#pragma unroll 2
    for (int i = gt; i < NBS * RWP; i += NT) { const int b = i / RWP, col = i % RWP; F.a->out[O_SHIFT_S + i] = bf2f(P[(size_t)(MP + b * TS + TS - 1) * NIN + col]); }
    for (int i = gt; i < 2 * 128 * 128; i += NT) { const int b = i >> 14, j = (i >> 7) & 127, c2 = i & 127; const size_t row = (size_t)(b * TP + TP - 128 + j) * NIN;
        F.a->out[O_WINK_P + i] = bf2f(P[row + 2304 + c2]); F.a->out[O_WINV_P + i] = bf2f(P[row + 2432 + c2]); }
#pragma unroll 4
    for (int i = gt; i < NBS * 128 * 128; i += NT) { const int b = i >> 14, j = (i >> 7) & 127, c2 = i & 127;
        if (j < 120) { F.a->out[O_WINK_S + i] = ck[(size_t)(b * 128 + j + 8) * 128 + c2]; F.a->out[O_WINV_S + i] = cv[(size_t)(b * 128 + j + 8) * 128 + c2]; }
        else { const size_t row = (size_t)(MP + b * TS + (j - 120)) * NIN; F.a->out[O_WINK_S + i] = bf2f(P[row + 2304 + c2]); F.a->out[O_WINV_S + i] = bf2f(P[row + 2432 + c2]); } }
}
constexpr int SS_R = 0, SS_DEC = 1, SS_KM = 2, SS_KK = 3, SS_BB = 4, SS_V = 5;
__device__ __forceinline__ void sample_scan_unit(Frame& F, int b) {
    const int h = F.wave, lane = F.lane, chn = h * 64 + lane;
    LAS float* A = (LAS float*)F.lds + h * (6 * 8 * 64);
    const bf16* P = WSP(bf16, WS_H); const float* sshift = F.a->in[I_SSHIFT]; const float* mu = F.a->in[I_MU];
    const float* WLOG = WSP(float, WS_WLOG); const bf16* AA = WSP(bf16, WS_A); const bf16* GG = WSP(bf16, WS_G);
    bf16* MIX = WSP(bf16, WS_U);
    const float mur = mu[chn], muk = mu[RW + chn], muv = mu[2 * RW + chn], kkc = F.a->in[I_KK][chn], kac = F.a->in[I_KA][chn], rkc = F.a->in[I_RK][chn], gnw = F.a->in[I_GNW][chn], gnb = F.a->in[I_GNB][chn];
    __syncthreads();
    float q_r = sshift[(size_t)b * RWP + chn], q_k = sshift[(size_t)b * RWP + RW + chn], q_v = sshift[(size_t)b * RWP + 2 * RW + chn];
#pragma unroll
    for (int t = 0; t < TS; ++t) {
        const int m = MP + b * TS + t; const size_t pr = (size_t)m * NIN;
        const float p_r = bf2f(P[pr + chn]), p_k = bf2f(P[pr + RW + chn]), p_v = bf2f(P[pr + 2 * RW + chn]);
        const float xr = p_r + (q_r - p_r) * mur, xk = p_k + (q_k - p_k) * muk, xv = p_v + (q_v - p_v) * muv;
        q_r = p_r; q_k = p_k; q_v = p_v;
        const float a = bf2f(AA[(size_t)m * RW + chn]), wl = WLOG[(size_t)m * RW + chn];
        const float kq0 = xk * kkc, kk = kq0 * (1.0f / fmaxf(sqrtf(wave_sum_dpp(kq0 * kq0)), 1e-12f));
        A[(SS_R * 8 + t) * 64 + lane] = xr; A[(SS_DEC * 8 + t) * 64 + lane] = expf(wl); A[(SS_KM * 8 + t) * 64 + lane] = xk * (1.0f + (a - 1.0f) * kac);
        A[(SS_KK * 8 + t) * 64 + lane] = kk; A[(SS_BB * 8 + t) * 64 + lane] = kk * a; A[(SS_V * 8 + t) * 64 + lane] = xv;
    }
    f32x4 S[16];
    { const f32x4* sp = (const f32x4*)(F.a->in[I_SWKV] + ((size_t)(b * 8 + h) * 64 + lane) * 64);
#pragma unroll
      for (int q = 0; q < 16; ++q) S[q] = sp[q]; }
    LDS_WAIT(); asm volatile("" ::: "memory");
#pragma unroll 1
    for (int t = 0; t < TS; ++t) {
        const LAS f32x4* pk = (const LAS f32x4*)(A + (SS_KK * 8 + t) * 64); const LAS f32x4* pb = (const LAS f32x4*)(A + (SS_BB * 8 + t) * 64);
        const LAS f32x4* pd = (const LAS f32x4*)(A + (SS_DEC * 8 + t) * 64); const LAS f32x4* pm = (const LAS f32x4*)(A + (SS_KM * 8 + t) * 64);
        const LAS f32x4* pq = (const LAS f32x4*)(A + (SS_R * 8 + t) * 64);
        const float v = A[(SS_V * 8 + t) * 64 + lane];
        f32x4 sa4 = (f32x4){0.f, 0.f, 0.f, 0.f};
#pragma unroll
        for (int q = 0; q < 16; ++q) sa4 += S[q] * pk[q];
        const float sa = (sa4[0] + sa4[1]) + (sa4[2] + sa4[3]);
        f32x4 y4 = (f32x4){0.f, 0.f, 0.f, 0.f};
#pragma unroll
        for (int q = 0; q < 16; ++q) { S[q] = S[q] * pd[q] + (pm[q] * v - pb[q] * sa); y4 += S[q] * pq[q]; }
        const float y = (y4[0] + y4[1]) + (y4[2] + y4[3]);
        const float mean = wave_sum_dpp(y) * (1.f / 64.f), d = y - mean, var = wave_sum_dpp(d * d) * (1.f / 64.f);
        const float yn = d * (1.0f / sqrtf(var + GN_EPS));
        const float dot = wave_sum_dpp(A[(SS_R * 8 + t) * 64 + lane] * A[(SS_KM * 8 + t) * 64 + lane] * rkc);
        const int m = MP + b * TS + t;
        const float g = bf2f(GG[(size_t)m * RW + chn]);
        MIX[(size_t)m * D + chn] = (bf16)f2bf((yn * gnw + gnb + dot * v) * g);
    }
    { f32x4* so = (f32x4*)(F.a->out + O_WKV_S + ((size_t)(b * 8 + h) * 64 + lane) * 64);
#pragma unroll
      for (int q = 0; q < 16; ++q) so[q] = S[q]; }
}
constexpr int PB = 144, PF = 272;
constexpr int MB16 = 64 * PB, MF32 = 64 * PF;
constexpr size_t WS_GX = 2 * MiB;
constexpr size_t WS_S0 = 167 * MiB;
static_assert(WS_GX + 512 * 32768 <= WS_WIN && WS_H + (size_t)M * NIN * 2 <= WS_S0 && WS_S0 + 512 * 16384 <= WS_WLOG, "scan scratch map");
constexpr int CA_RHS = 0, CA_LB = 34816, CA_KQ = 52224, CA_KD = 61440, CA_BD = 70656, CA_VT = 79872, CA_KET = 89088, CA_BET = 98304, CA_LK = 107520, CA_SMALL = 116736;
constexpr int CC_RHS = 0, CC_LB = 17408, CC_KQ = 34816, CC_RQ = 44032, CC_KD = 53248, CC_BD = 62464, CC_VT = 71680, CC_KET = 80896, CC_BET = 90112, CC_LK = 99328, CC_MK = 108544, CC_MB = 117760,
              CC_SHI = 126976, CC_SLO = 136192, CC_SMALL = 145408;
constexpr int SM_GL = 0, SM_DOT = 256, SM_TOT = 512, SM_BYTES = 512 + 2048;

__device__ __forceinline__ void mm_nt(f32x4 (&acc)[2], const LAS unsigned char* X, const LAS unsigned char* Y, int wave, int lane) {
    const int tr = wave >> 1, tc0 = (wave & 1) * 2, lr = lane & 15, lq = lane >> 4;
#pragma unroll
    for (int ks = 0; ks < 2; ++ks) {
        const bf16x8 xa = *(const LAS bf16x8*)(X + (16 * tr + lr) * PB + ks * 64 + lq * 16);
#pragma unroll
        for (int j = 0; j < 2; ++j) {
            const bf16x8 yb = *(const LAS bf16x8*)(Y + (16 * (tc0 + j) + lr) * PB + ks * 64 + lq * 16);
            acc[j] = __builtin_amdgcn_mfma_f32_16x16x32_bf16(yb, xa, acc[j], 0, 0, 0);
        }
    }
}
#define ACC_ZERO(a) do { a[0] = (f32x4){0.f, 0.f, 0.f, 0.f}; a[1] = (f32x4){0.f, 0.f, 0.f, 0.f}; } while (0)
#define ACC_M(wave, lane) (16 * ((wave) >> 1) + ((lane) & 15))
#define ACC_N(wave, lane, j) (16 * (((wave) & 1) * 2 + (j)) + 4 * ((lane) >> 4))
__device__ __forceinline__ void store_hilo(const f32x4 (&a)[2], LAS unsigned char* HI, LAS unsigned char* LO, int wave, int lane) {
    const int m = ACC_M(wave, lane);
#pragma unroll
    for (int j = 0; j < 2; ++j) { const int n = ACC_N(wave, lane, j);
        const unsigned long long hi = pk4(a[j]); const f32x4 lo = a[j] - bf4_to_f32(hi);
        *(LAS unsigned long long*)(HI + m * PB + n * 2) = hi; *(LAS unsigned long long*)(LO + m * PB + n * 2) = pk4(lo); }
}
template <int NW> __device__ __forceinline__ void tri_solve(const LAS unsigned char* LBT, const LAS unsigned char* RHS, LAS unsigned char* UT, int wave, int lane) {
    if (wave < NW) {
        const int col = wave * 64 + lane;
        f32x4 u[16], lv[8];
#pragma unroll
        for (int q = 0; q < 16; ++q) u[q] = *(const LAS f32x4*)(RHS + col * PF + q * 16);
#define TS_SWEEP(I0, I1, QOFF, QLO)                                                                                                      \
        _Pragma("unroll") for (int q = 0; q < 8; ++q) lv[q] = *(const LAS f32x4*)(LBT + (I0) * PF + (QOFF + q) * 16);                  \
        _Pragma("unroll") for (int i = (I0); i < (I1); ++i) {                                                                            \
            f32x4 ln[8];                                                                                                                 \
            _Pragma("unroll") for (int q = 0; q < 8; ++q) if (i + 1 < (I1) && q >= QLO(i + 1)) ln[q] = *(const LAS f32x4*)(LBT + (i + 1) * PF + (QOFF + q) * 16); \
            asm volatile("" ::: "memory");                                                                                               \
            const float ui = u[i >> 2][i & 3];                                                                                           \
            _Pragma("unroll") for (int q = 0; q < 8; ++q) if (q >= QLO(i)) u[QOFF + q] -= lv[q] * ui;                                    \
            _Pragma("unroll") for (int q = 0; q < 8; ++q) if (i + 1 < (I1) && q >= QLO(i + 1)) lv[q] = ln[q];                            \
        }
#define TS_QLO_A(i) (((i) + 1) >> 2)
#define TS_QLO_B(i) 0
#define TS_QLO_C(i) ((((i) + 1) >> 2) - 8)
        TS_SWEEP(0, 31, 0, TS_QLO_A)
        TS_SWEEP(0, 32, 8, TS_QLO_B)
        TS_SWEEP(32, 63, 8, TS_QLO_C)
#undef TS_SWEEP
#pragma unroll
        for (int q = 0; q < 8; ++q) { v4u w; w.x = pk2(u[2 * q][0], u[2 * q][1]); w.y = pk2(u[2 * q][2], u[2 * q][3]); w.z = pk2(u[2 * q + 1][0], u[2 * q + 1][1]); w.w = pk2(u[2 * q + 1][2], u[2 * q + 1][3]);
            *(LAS v4u*)(UT + col * PB + q * 16) = w; }
    }
}
struct ChunkRaw { unsigned rk[9], vv[5], aa[4]; float wl[8]; };
__device__ __forceinline__ void chunk_load(Frame& F, int m0, int h, ChunkRaw& R) {
    const bf16* P = WSP(bf16, WS_H); const float* WLOG = WSP(float, WS_WLOG); const bf16* AA = WSP(bf16, WS_A);
    const int chn = h * 64 + F.lane, mg = m0 + 8 * F.wave;
    unsigned pv[10], av[8];
    if ((mg & (TP - 1)) == 0) { R.rk[0] = 0u; pv[0] = 0u; }
    else { const size_t o = (size_t)(mg - 1) * NIN; R.rk[0] = (unsigned)P[o + chn] | ((unsigned)P[o + RW + chn] << 16); pv[0] = P[o + 2 * RW + chn]; }
#pragma unroll
    for (int j = 0; j < 8; ++j) { const size_t o = (size_t)(mg + j) * NIN; R.rk[j + 1] = (unsigned)P[o + chn] | ((unsigned)P[o + RW + chn] << 16); pv[j + 1] = P[o + 2 * RW + chn];
        R.wl[j] = WLOG[(size_t)(mg + j) * RW + chn]; av[j] = AA[(size_t)(mg + j) * RW + chn]; }
    pv[9] = 0u;
#pragma unroll
    for (int j = 0; j < 5; ++j) R.vv[j] = pv[2 * j] | (pv[2 * j + 1] << 16);
#pragma unroll
    for (int j = 0; j < 4; ++j) R.aa[j] = av[2 * j] | (av[2 * j + 1] << 16);
}
template <bool PHC> __device__ __forceinline__ void chunk_stage(Frame& F, const ChunkRaw& R, int h, int oKQ, int oRQ, int oKD, int oBD, int oVT, int oKET, int oBET, int oRHS, int oSMALL) {
    LAS unsigned char* lds = F.lds;
    const float* mu = F.a->in[I_MU];
    const int e = F.lane, g = F.wave, chn = h * 64 + e;
    const float mur = mu[chn], muk = mu[RW + chn], muv = mu[2 * RW + chn], kkc = F.a->in[I_KK][chn], kac = F.a->in[I_KA][chn], rkc = F.a->in[I_RK][chn];
    float pr[9], pk[9], pv[9], av[8];
#pragma unroll
    for (int j = 0; j < 9; ++j) { pr[j] = bflo(R.rk[j]); pk[j] = bfhi(R.rk[j]); pv[j] = (j & 1) ? bfhi(R.vv[j >> 1]) : bflo(R.vv[j >> 1]); }
#pragma unroll
    for (int j = 0; j < 8; ++j) av[j] = (j & 1) ? bfhi(R.aa[j >> 1]) : bflo(R.aa[j >> 1]);
    const float (&wl)[8] = R.wl;
    float cw[8]; { float s = 0.f;
#pragma unroll
        for (int j = 0; j < 8; ++j) { s += wl[j]; cw[j] = s; } }
    LAS float* TOT = (LAS float*)(lds + oSMALL + SM_TOT);
    TOT[g * 64 + e] = cw[7];
    __syncthreads();
    float off = 0.f, cwL = 0.f;
#pragma unroll
    for (int gg = 0; gg < 8; ++gg) { const float tv = TOT[gg * 64 + e]; cwL += tv; if (gg < g) off += tv; }
    if (g == 0) ((LAS float*)(lds + oSMALL + SM_GL))[e] = expf(cwL);
    unsigned vt[8], ket[8], bet[8]; float kq[8];
#pragma unroll
    for (int j = 0; j < 8; ++j) {
        const int t = 8 * g + j;
        const float c = off + cw[j];
        const float xr = pr[j + 1] + (pr[j] - pr[j + 1]) * mur, xk = pk[j + 1] + (pk[j] - pk[j + 1]) * muk, xv = pv[j + 1] + (pv[j] - pv[j + 1]) * muv;
        const float kq0 = xk * kkc, kk = kq0 * (1.0f / fmaxf(sqrtf(wave_sum_dpp(kq0 * kq0)), 1e-12f)), km = xk * (1.0f + (av[j] - 1.0f) * kac), bb = kk * av[j];
        const float e1 = expf(c), e2 = 1.0f / e1, e3 = expf(c - wl[j]), e4 = expf(cwL - c);
        kq[j] = kk * e3;
        *(LAS unsigned short*)(lds + oKQ + t * PB + e * 2) = (unsigned short)f2bf(kq[j]);
        *(LAS unsigned short*)(lds + oKD + t * PB + e * 2) = (unsigned short)f2bf(km * e2);
        *(LAS unsigned short*)(lds + oBD + t * PB + e * 2) = (unsigned short)f2bf(bb * e2);
        if (PHC) { *(LAS unsigned short*)(lds + oRQ + t * PB + e * 2) = (unsigned short)f2bf(xr * e1);
            const float d = wave_sum_dpp(xr * km * rkc); if (e == 0) ((LAS float*)(lds + oSMALL + SM_DOT))[t] = d; }
        vt[j] = f2bf(xv); ket[j] = f2bf(km * e4); bet[j] = f2bf(bb * e4);
    }
    { v4u w; w.x = vt[0] | (vt[1] << 16); w.y = vt[2] | (vt[3] << 16); w.z = vt[4] | (vt[5] << 16); w.w = vt[6] | (vt[7] << 16); *(LAS v4u*)(lds + oVT + e * PB + g * 16) = w; }
    { v4u w; w.x = ket[0] | (ket[1] << 16); w.y = ket[2] | (ket[3] << 16); w.z = ket[4] | (ket[5] << 16); w.w = ket[6] | (ket[7] << 16); *(LAS v4u*)(lds + oKET + e * PB + g * 16) = w; }
    { v4u w; w.x = bet[0] | (bet[1] << 16); w.y = bet[2] | (bet[3] << 16); w.z = bet[4] | (bet[5] << 16); w.w = bet[6] | (bet[7] << 16); *(LAS v4u*)(lds + oBET + e * PB + g * 16) = w; }
    if (!PHC) { *(LAS f32x4*)(lds + oRHS + e * PF + g * 32) = (f32x4){kq[0], kq[1], kq[2], kq[3]}; *(LAS f32x4*)(lds + oRHS + e * PF + g * 32 + 16) = (f32x4){kq[4], kq[5], kq[6], kq[7]}; }
}
__device__ __forceinline__ void scanA_task(Frame& F, int task) {
    LAS unsigned char* lds = F.lds; const int wave = F.wave, lane = F.lane;
    const int sc = task & 31, bh = task >> 5, h = bh & 7, b = bh >> 3;
    const int m = ACC_M(wave, lane);
    f32x4 gacc[2], xacc[2];
#pragma unroll
    for (int j = 0; j < 2; ++j) { const int n = ACC_N(wave, lane, j);
#pragma unroll
        for (int r = 0; r < 4; ++r) { gacc[j][r] = (m == n + r) ? 1.f : 0.f; xacc[j][r] = 0.f; } }
    ChunkRaw raw; chunk_load(F, b * TP + sc * 256, h, raw);
    for (int c = 0; c < 4; ++c) {
        __syncthreads();
        chunk_stage<false>(F, raw, h, CA_KQ, 0, CA_KD, CA_BD, CA_VT, CA_KET, CA_BET, CA_RHS, CA_SMALL);
        __syncthreads();
        { f32x4 a[2]; ACC_ZERO(a); mm_nt(a, lds + CA_BD, lds + CA_KQ, wave, lane);
#pragma unroll
          for (int j = 0; j < 2; ++j) { const int n = ACC_N(wave, lane, j); f32x4 o;
#pragma unroll
              for (int r = 0; r < 4; ++r) o[r] = (n + r > m) ? a[j][r] : 0.f;
              *(LAS f32x4*)(lds + CA_LB + m * PF + n * 4) = o; } }
        { f32x4 a[2]; ACC_ZERO(a); mm_nt(a, lds + CA_KQ, lds + CA_KD, wave, lane);
#pragma unroll
          for (int j = 0; j < 2; ++j) { const int n = ACC_N(wave, lane, j); f32x4 o;
#pragma unroll
              for (int r = 0; r < 4; ++r) o[r] = (n + r < m) ? a[j][r] : 0.f;
              *(LAS unsigned long long*)(lds + CA_LK + m * PB + n * 2) = pk4(o); } }
        __syncthreads();
        { f32x4 a[2]; ACC_ZERO(a); mm_nt(a, lds + CA_VT, lds + CA_LK, wave, lane);
#pragma unroll
          for (int j = 0; j < 2; ++j) { const int n = ACC_N(wave, lane, j); *(LAS f32x4*)(lds + CA_RHS + (64 + m) * PF + n * 4) = a[j]; } }
        __syncthreads();
        if (c < 3) chunk_load(F, b * TP + sc * 256 + (c + 1) * 64, h, raw);
        tri_solve<2>(lds + CA_LB, lds + CA_RHS, lds + CA_KD, wave, lane);
        __syncthreads();
        f32x4 pt[2], xc[2];
        { f32x4 a[2]; ACC_ZERO(a); mm_nt(a, lds + CA_BET, lds + CA_KD, wave, lane);
          const LAS float* GL = (const LAS float*)(lds + CA_SMALL + SM_GL);
#pragma unroll
          for (int j = 0; j < 2; ++j) { const int n = ACC_N(wave, lane, j);
#pragma unroll
              for (int r = 0; r < 4; ++r) pt[j][r] = ((m == n + r) ? GL[n + r] : 0.f) - a[j][r]; } }
        { f32x4 a1[2], a2[2]; ACC_ZERO(a1); ACC_ZERO(a2);
          mm_nt(a1, lds + CA_VT, lds + CA_KET, wave, lane); mm_nt(a2, lds + CA_KD + 64 * PB, lds + CA_BET, wave, lane);
          xc[0] = a1[0] - a2[0]; xc[1] = a1[1] - a2[1]; }
        store_hilo(pt, lds + CA_KQ, lds + CA_LK, wave, lane);
        store_hilo(gacc, lds + 0, lds + MB16, wave, lane);
        store_hilo(xacc, lds + 2 * MB16, lds + 3 * MB16, wave, lane);
        __syncthreads();
        { f32x4 a[2]; ACC_ZERO(a);
          mm_nt(a, lds + 0, lds + CA_KQ, wave, lane); mm_nt(a, lds + 0, lds + CA_LK, wave, lane); mm_nt(a, lds + MB16, lds + CA_KQ, wave, lane);
          gacc[0] = a[0]; gacc[1] = a[1]; }
        { f32x4 a[2]; a[0] = xc[0]; a[1] = xc[1];
          mm_nt(a, lds + 2 * MB16, lds + CA_KQ, wave, lane); mm_nt(a, lds + 2 * MB16, lds + CA_LK, wave, lane); mm_nt(a, lds + 3 * MB16, lds + CA_KQ, wave, lane);
          xacc[0] = a[0]; xacc[1] = a[1]; }
    }
    float* GT = (float*)(F.a->ws + WS_GX + (size_t)task * 32768); float* XO = GT + 4096;
#pragma unroll
    for (int j = 0; j < 2; ++j) { const int n = ACC_N(wave, lane, j);
#pragma unroll
        for (int r = 0; r < 4; ++r) GT[(n + r) * 64 + m] = gacc[j][r];
        *(f32x4*)(XO + m * 64 + n) = xacc[j]; }
}
__device__ __forceinline__ void scanB_unit(Frame& F, int bh) {
    LAS unsigned char* lds = F.lds; const int wave = F.wave, lane = F.lane, tid = F.tid, lr = lane & 15, lq = lane >> 4;
    constexpr int GTB = 2 * MB16;
    LAS unsigned char* myS = lds + 2 * GTB + wave * (2 * 16 * PB);
    const int row = tid >> 3, c8 = (tid & 7) * 8;
    const float* G0 = (const float*)(F.a->ws + WS_GX + (size_t)(bh * 32) * 32768);
#define SB_PUT(buf, ga, gb) do { const unsigned long long h0_ = pk4(ga), h1_ = pk4(gb); const f32x4 l0_ = ga - bf4_to_f32(h0_), l1_ = gb - bf4_to_f32(h1_); const unsigned long long q0_ = pk4(l0_), q1_ = pk4(l1_); \
        *(LAS v4u*)(lds + (buf) * GTB + row * PB + c8 * 2) = (v4u){(unsigned)h0_, (unsigned)(h0_ >> 32), (unsigned)h1_, (unsigned)(h1_ >> 32)}; \
        *(LAS v4u*)(lds + (buf) * GTB + MB16 + row * PB + c8 * 2) = (v4u){(unsigned)q0_, (unsigned)(q0_ >> 32), (unsigned)q1_, (unsigned)(q1_ >> 32)}; } while (0)
    f32x4 g0 = *(const f32x4*)(G0 + row * 64 + c8), g1 = *(const f32x4*)(G0 + row * 64 + c8 + 4);
    __syncthreads();
    SB_PUT(0, g0, g1);
    g0 = *(const f32x4*)(G0 + 8192 + row * 64 + c8); g1 = *(const f32x4*)(G0 + 8192 + row * 64 + c8 + 4);
    f32x4 s[4], x[4];
#pragma unroll
    for (int tc = 0; tc < 4; ++tc) { s[tc] = (f32x4){0.f, 0.f, 0.f, 0.f}; x[tc] = s[tc]; }
    const int vrow = 16 * (wave & 3) + lr;
    if (wave < 4) {
#pragma unroll
        for (int tc = 0; tc < 4; ++tc) x[tc] = *(const f32x4*)(G0 + 4096 + vrow * 64 + 16 * tc + 4 * lq); }
    __syncthreads();
    for (int sc = 0; sc < 32; ++sc) {
        const int task = bh * 32 + sc;
        if (wave < 4) {
            float* S0 = (float*)(F.a->ws + WS_S0 + (size_t)task * 16384);
#pragma unroll
            for (int tc = 0; tc < 4; ++tc) { *(f32x4*)(S0 + vrow * 64 + 16 * tc + 4 * lq) = s[tc];
                const unsigned long long hi = pk4(s[tc]); const f32x4 lo = s[tc] - bf4_to_f32(hi);
                *(LAS unsigned long long*)(myS + lr * PB + (16 * tc + 4 * lq) * 2) = hi; *(LAS unsigned long long*)(myS + 16 * PB + lr * PB + (16 * tc + 4 * lq) * 2) = pk4(lo); }
            f32x4 a[4];
#pragma unroll
            for (int tc = 0; tc < 4; ++tc) a[tc] = x[tc];
            if (sc + 1 < 32) { const float* Xn = (const float*)(F.a->ws + WS_GX + (size_t)(task + 1) * 32768) + 4096;
#pragma unroll
                for (int tc = 0; tc < 4; ++tc) x[tc] = *(const f32x4*)(Xn + vrow * 64 + 16 * tc + 4 * lq); }
            LDS_WAIT(); asm volatile("" ::: "memory");
            const LAS unsigned char* gb = lds + (sc & 1) * GTB;
#pragma unroll
            for (int ks = 0; ks < 2; ++ks) {
                const bf16x8 xh = *(const LAS bf16x8*)(myS + lr * PB + ks * 64 + lq * 16), xl = *(const LAS bf16x8*)(myS + 16 * PB + lr * PB + ks * 64 + lq * 16);
#pragma unroll
                for (int tc = 0; tc < 4; ++tc) {
                    const bf16x8 yh = *(const LAS bf16x8*)(gb + (16 * tc + lr) * PB + ks * 64 + lq * 16), yl = *(const LAS bf16x8*)(gb + MB16 + (16 * tc + lr) * PB + ks * 64 + lq * 16);
                    a[tc] = __builtin_amdgcn_mfma_f32_16x16x32_bf16(yh, xh, a[tc], 0, 0, 0);
                    a[tc] = __builtin_amdgcn_mfma_f32_16x16x32_bf16(yl, xh, a[tc], 0, 0, 0);
                    a[tc] = __builtin_amdgcn_mfma_f32_16x16x32_bf16(yh, xl, a[tc], 0, 0, 0);
                }
            }
#pragma unroll
            for (int tc = 0; tc < 4; ++tc) s[tc] = a[tc];
        }
        if (sc + 1 < 32) SB_PUT((sc + 1) & 1, g0, g1);
        if (sc + 2 < 32) { const float* Gn = (const float*)(F.a->ws + WS_GX + (size_t)(task + 2) * 32768); g0 = *(const f32x4*)(Gn + row * 64 + c8); g1 = *(const f32x4*)(Gn + row * 64 + c8 + 4); }
        __syncthreads();
    }
#undef SB_PUT
}
__device__ __forceinline__ void scanC_task(Frame& F, int task) {
    LAS unsigned char* lds = F.lds; const int wave = F.wave, lane = F.lane;
    const int sc = task & 31, bh = task >> 5, h = bh & 7, b = bh >> 3;
    const int m = ACC_M(wave, lane);
    const bf16* GG = WSP(bf16, WS_G); bf16* MIX = WSP(bf16, WS_U);
    const int chn = h * 64 + lane; const float gnw = F.a->in[I_GNW][chn], gnb = F.a->in[I_GNB][chn];
    f32x4 s[2];
    { const float* S0 = (const float*)(F.a->ws + WS_S0 + (size_t)task * 16384);
#pragma unroll
      for (int j = 0; j < 2; ++j) { const int n = ACC_N(wave, lane, j); s[j] = *(const f32x4*)(S0 + m * 64 + n); } }
    ChunkRaw raw; chunk_load(F, b * TP + sc * 256, h, raw);
    for (int c = 0; c < 4; ++c) {
        const int m0 = b * TP + sc * 256 + c * 64;
        __syncthreads();
        chunk_stage<true>(F, raw, h, CC_KQ, CC_RQ, CC_KD, CC_BD, CC_VT, CC_KET, CC_BET, 0, CC_SMALL);
        store_hilo(s, lds + CC_SHI, lds + CC_SLO, wave, lane);
        __syncthreads();
        { f32x4 a[2]; ACC_ZERO(a); mm_nt(a, lds + CC_BD, lds + CC_KQ, wave, lane);
#pragma unroll
          for (int j = 0; j < 2; ++j) { const int n = ACC_N(wave, lane, j); f32x4 o;
#pragma unroll
              for (int r = 0; r < 4; ++r) o[r] = (n + r > m) ? a[j][r] : 0.f;
              *(LAS f32x4*)(lds + CC_LB + m * PF + n * 4) = o; } }
        { f32x4 a[2]; ACC_ZERO(a); mm_nt(a, lds + CC_KQ, lds + CC_KD, wave, lane);
#pragma unroll
          for (int j = 0; j < 2; ++j) { const int n = ACC_N(wave, lane, j); f32x4 o;
#pragma unroll
              for (int r = 0; r < 4; ++r) o[r] = (n + r < m) ? a[j][r] : 0.f;
              *(LAS unsigned long long*)(lds + CC_LK + m * PB + n * 2) = pk4(o); } }
        { f32x4 a[2], a2[2]; ACC_ZERO(a); ACC_ZERO(a2); mm_nt(a, lds + CC_RQ, lds + CC_KD, wave, lane); mm_nt(a2, lds + CC_RQ, lds + CC_BD, wave, lane);
#pragma unroll
          for (int j = 0; j < 2; ++j) { const int n = ACC_N(wave, lane, j); f32x4 o, o2;
#pragma unroll
              for (int r = 0; r < 4; ++r) { o[r] = (n + r <= m) ? a[j][r] : 0.f; o2[r] = (n + r <= m) ? a2[j][r] : 0.f; }
              *(LAS unsigned long long*)(lds + CC_MK + m * PB + n * 2) = pk4(o); *(LAS unsigned long long*)(lds + CC_MB + m * PB + n * 2) = pk4(o2); } }
        __syncthreads();
        { f32x4 a[2]; ACC_ZERO(a);
          mm_nt(a, lds + CC_SHI, lds + CC_KQ, wave, lane); mm_nt(a, lds + CC_SLO, lds + CC_KQ, wave, lane); mm_nt(a, lds + CC_VT, lds + CC_LK, wave, lane);
#pragma unroll
          for (int j = 0; j < 2; ++j) { const int n = ACC_N(wave, lane, j); *(LAS f32x4*)(lds + CC_RHS + m * PF + n * 4) = a[j]; } }
        __syncthreads();
        if (c < 3) chunk_load(F, m0 + 64, h, raw);
        tri_solve<1>(lds + CC_LB, lds + CC_RHS, lds + CC_KD, wave, lane);
        __syncthreads();
        { f32x4 a[2], a2[2]; ACC_ZERO(a); ACC_ZERO(a2);
          mm_nt(a, lds + CC_RQ, lds + CC_SHI, wave, lane); mm_nt(a, lds + CC_RQ, lds + CC_SLO, wave, lane); mm_nt(a, lds + CC_MK, lds + CC_VT, wave, lane);
          mm_nt(a2, lds + CC_MB, lds + CC_KD, wave, lane);
#pragma unroll
          for (int j = 0; j < 2; ++j) { const int n = ACC_N(wave, lane, j); *(LAS f32x4*)(lds + CC_LB + m * PF + n * 4) = a[j] - a2[j]; } }
        { f32x4 a1[2], a2[2]; ACC_ZERO(a1); ACC_ZERO(a2);
          mm_nt(a1, lds + CC_VT, lds + CC_KET, wave, lane); mm_nt(a2, lds + CC_KD, lds + CC_BET, wave, lane);
          const LAS float* GL = (const LAS float*)(lds + CC_SMALL + SM_GL);
#pragma unroll
          for (int j = 0; j < 2; ++j) { const int n = ACC_N(wave, lane, j); const f32x4 gl = *(const LAS f32x4*)(GL + n); s[j] = s[j] * gl + a1[j] - a2[j]; } }
        __syncthreads();
        for (int t = wave; t < 64; t += 8) {
            const int mm = m0 + t;
            const float y = *(const LAS float*)(lds + CC_LB + t * PF + lane * 4);
            const float mean = wave_sum_dpp(y) * (1.f / 64.f), d = y - mean, var = wave_sum_dpp(d * d) * (1.f / 64.f);
            const float yn = d * (1.0f / sqrtf(var + GN_EPS));
            const float dot = ((const LAS float*)(lds + CC_SMALL + SM_DOT))[t];
            const float v = bf2f(*(const LAS unsigned short*)(lds + CC_VT + lane * PB + t * 2));
            const float gg = bf2f(GG[(size_t)mm * RW + chn]);
            MIX[(size_t)mm * D + chn] = (bf16)f2bf((yn * gnw + gnb + dot * v) * gg);
        }
    }
    if (sc == 31) { float* so = F.a->out + O_WKV_P + (size_t)bh * 4096;
#pragma unroll
        for (int j = 0; j < 2; ++j) { const int n = ACC_N(wave, lane, j); *(f32x4*)(so + m * 64 + n) = s[j]; } }
}
__device__ __forceinline__ int rel_bucket(int n) {
    if (n < 16) return n;
    const int b = 16 + (int)(logf((float)n * (1.0f / 16.0f)) / 2.0794415416798357f * 16.0f);
    return b < 31 ? b : 31;
}
typedef float f32x16 __attribute__((ext_vector_type(16)));
typedef short s16x4 __attribute__((ext_vector_type(4)));
struct AttnLane { const bf16* qrow; int qrel; int rmin; const LAS float* btab; float sink; bf16* orow; };
__device__ __forceinline__ void attn_core32(const LAS unsigned char* Kl, const LAS unsigned char* Vt, int VTP, int kt0, const AttnLane L, int lane) {
    const int r = lane & 31, h = lane >> 5;
    bf16x8 qf[4];
#pragma unroll
    for (int ds = 0; ds < 4; ++ds) qf[ds] = *(const bf16x8*)(L.qrow + 16 * ds + 8 * h);
    f32x16 sc[5];
#pragma unroll
    for (int T = 0; T < 5; ++T) {
#pragma unroll
        for (int e = 0; e < 16; ++e) sc[T][e] = 0.f;
#pragma unroll
        for (int ds = 0; ds < 4; ++ds) { const bf16x8 kf = *(const LAS bf16x8*)(Kl + ((kt0 + T) * 32 + r) * 144 + (16 * ds + 8 * h) * 2);
            sc[T] = __builtin_amdgcn_mfma_f32_32x32x16_bf16(kf, qf[ds], sc[T], 0, 0, 0); }
    }
    float mx = L.sink;
#pragma unroll
    for (int T = 0; T < 5; ++T)
#pragma unroll
        for (int e = 0; e < 16; ++e) { const int rabs = (kt0 + T) * 32 + (e & 3) + 8 * (e >> 2) + 4 * h, dist = L.qrel - rabs;
            const bool valid = dist >= 0 && dist < 128 && rabs >= L.rmin;
            const float s = valid ? sc[T][e] * 0.125f + L.btab[dist & 127] : -1e30f;
            sc[T][e] = s; mx = fmaxf(mx, s); }
    mx = fmaxf(mx, __shfl_xor(mx, 32));
    float l = 0.f;
#pragma unroll
    for (int T = 0; T < 5; ++T)
#pragma unroll
        for (int e = 0; e < 16; ++e) { const float p = sc[T][e] > -1e29f ? __expf(sc[T][e] - mx) : 0.f; sc[T][e] = p; l += p; }
    l += __shfl_xor(l, 32);
    l += __expf(L.sink - mx);
    f32x16 o[2];
#pragma unroll
    for (int e = 0; e < 16; ++e) { o[0][e] = 0.f; o[1][e] = 0.f; }
#pragma unroll
    for (int T = 0; T < 5; ++T)
#pragma unroll
        for (int s2 = 0; s2 < 2; ++s2) {
            v4u pw; pw.x = pk2(sc[T][8 * s2], sc[T][8 * s2 + 1]); pw.y = pk2(sc[T][8 * s2 + 2], sc[T][8 * s2 + 3]); pw.z = pk2(sc[T][8 * s2 + 4], sc[T][8 * s2 + 5]); pw.w = pk2(sc[T][8 * s2 + 6], sc[T][8 * s2 + 7]);
            const bf16x8 pb = __builtin_bit_cast(bf16x8, pw);
#pragma unroll
            for (int dt = 0; dt < 2; ++dt) {
                const LAS unsigned char* vp = Vt + (32 * dt + r) * VTP + ((kt0 + T) * 32 + 16 * s2 + 4 * h) * 2;
                const s16x4 lo = *(const LAS s16x4*)vp, hi = *(const LAS s16x4*)(vp + 16);
                const bf16x8 va = (bf16x8){lo[0], lo[1], lo[2], lo[3], hi[0], hi[1], hi[2], hi[3]};
                o[dt] = __builtin_amdgcn_mfma_f32_32x32x16_bf16(va, pb, o[dt], 0, 0, 0);
            }
        }
    const float il = 1.0f / l;
#pragma unroll
    for (int dt = 0; dt < 2; ++dt)
#pragma unroll
        for (int gq = 0; gq < 4; ++gq) { const int d = 32 * dt + 8 * gq + 4 * h;
            const unsigned long long w = (unsigned long long)pk2(o[dt][4 * gq] * il, o[dt][4 * gq + 1] * il) | ((unsigned long long)pk2(o[dt][4 * gq + 2] * il, o[dt][4 * gq + 3] * il) << 32);
            *(unsigned long long*)(L.orow + d) = w; }
}
constexpr int AP_K = 0, AP_VTP = 528, AP_VT = 256 * 144, AP_BT = AP_VT + 64 * AP_VTP, AP_END = AP_BT + 4 * 128 * 4;
__device__ __forceinline__ void attn_prompt_unit(Frame& F, int b, int kvh, int qb) {
    LAS unsigned char* lds = F.lds;
    const bf16* P = WSP(bf16, WS_H); bf16* MIX = WSP(bf16, WS_U); const float* relb = F.a->in[I_RELB];
    const int t0 = qb * 128, tid = F.tid;
    __syncthreads();
    for (int idx = tid; idx < 256 * 8; idx += 512) {
        const int row = idx >> 3, part = idx & 7, pos = t0 - 128 + row;
        v4u val = (v4u){0u, 0u, 0u, 0u};
        if (pos >= 0) val = *(const v4u*)(P + (size_t)(b * TP + pos) * NIN + 2304 + kvh * 64 + part * 8);
        *(LAS v4u*)(lds + AP_K + row * 144 + part * 16) = val;
    }
    for (int idx = tid; idx < 256 * 8; idx += 512) {
        const int row = idx & 255, part = idx >> 8, pos = t0 - 128 + row;
        v4u val = (v4u){0u, 0u, 0u, 0u};
        if (pos >= 0) val = *(const v4u*)(P + (size_t)(b * TP + pos) * NIN + 2432 + kvh * 64 + part * 8);
#pragma unroll
        for (int e = 0; e < 4; ++e) { *(LAS unsigned short*)(lds + AP_VT + (part * 8 + 2 * e) * AP_VTP + row * 2) = (unsigned short)(val[e] & 0xffffu);
                                      *(LAS unsigned short*)(lds + AP_VT + (part * 8 + 2 * e + 1) * AP_VTP + row * 2) = (unsigned short)(val[e] >> 16); }
    }
    { const int g = tid >> 7, dist = tid & 127; ((LAS float*)(lds + AP_BT))[g * 128 + dist] = relb[rel_bucket(dist) * 8 + kvh * 4 + g]; }
    __syncthreads();
    const int g = F.wave & 3, qh = F.wave >> 2, hq = kvh * 4 + g;
#pragma unroll 1
    for (int bq = 0; bq < 2; ++bq) {
        const int i = 64 * qh + 32 * bq + (F.lane & 31), m = b * TP + t0 + i;
        AttnLane L; L.qrow = P + (size_t)m * NIN + RWP + hq * 64; L.qrel = i + 128; L.rmin = t0 == 0 ? 128 : 0;
        L.btab = (const LAS float*)(lds + AP_BT) + g * 128; L.sink = F.a->in[I_SINKS][hq]; L.orow = MIX + (size_t)m * D + RW + hq * 64;
        attn_core32(lds + AP_K, lds + AP_VT, AP_VTP, 2 * qh + bq, L, F.lane);
    }
}
static_assert(AP_END <= RING_BYTES && AP_VT % 16 == 0 && CC_SMALL + SM_BYTES <= RING_BYTES && CA_SMALL + SM_BYTES <= RING_BYTES, "LDS maps");
constexpr int AS_KB = 160 * 144, AS_VTP = 336, AS_VT = 2 * AS_KB, AS_VB = 64 * AS_VTP, AS_BT = AS_VT + 2 * AS_VB, AS_END = AS_BT + 8 * 128 * 4;
static_assert(AS_END <= RING_BYTES && AS_VT % 16 == 0 && AS_VB % 16 == 0, "LDS maps");
__device__ __forceinline__ void attn_sample_unit(Frame& F, int b) {
    LAS unsigned char* lds = F.lds;
    const bf16* P = WSP(bf16, WS_H); bf16* MIX = WSP(bf16, WS_U); const float* relb = F.a->in[I_RELB]; const float* ck = F.a->in[I_CK]; const float* cv = F.a->in[I_CV];
    const int tid = F.tid;
    __syncthreads();
    for (int idx = tid; idx < 160 * 32; idx += 512) {
        const int j = idx >> 5, c4 = (idx & 31) * 4, kvh = c4 >> 6, d = c4 & 63;
        f32x4 kx = (f32x4){0.f, 0.f, 0.f, 0.f}, vx = kx;
        if (j < 128) { kx = *(const f32x4*)(ck + (size_t)(b * 128 + j) * 128 + c4); vx = *(const f32x4*)(cv + (size_t)(b * 128 + j) * 128 + c4); }
        else if (j < 136) { const bf16* pr = P + (size_t)(MP + b * TS + (j - 128)) * NIN;
            const unsigned long long kw = *(const unsigned long long*)(pr + 2304 + c4), vw = *(const unsigned long long*)(pr + 2432 + c4); kx = bf4_to_f32(kw); vx = bf4_to_f32(vw); }
        *(LAS unsigned long long*)(lds + kvh * AS_KB + j * 144 + d * 2) = pk4(kx);
#pragma unroll
        for (int e = 0; e < 4; ++e) *(LAS unsigned short*)(lds + AS_VT + kvh * AS_VB + (d + e) * AS_VTP + j * 2) = (unsigned short)f2bf(vx[e]);
    }
    for (int idx = tid; idx < 1024; idx += 512) { const int hq = idx >> 7, dist = idx & 127; ((LAS float*)(lds + AS_BT))[idx] = relb[rel_bucket(dist) * 8 + hq]; }
    __syncthreads();
    if (F.wave < 2) {
        const int kvh = F.wave, rr = F.lane & 31, g = rr >> 3, t = rr & 7, hq = kvh * 4 + g, m = MP + b * TS + t;
        AttnLane L; L.qrow = P + (size_t)m * NIN + RWP + hq * 64; L.qrel = t + 128; L.rmin = 0;
        L.btab = (const LAS float*)(lds + AS_BT) + hq * 128; L.sink = F.a->in[I_SINKS][hq]; L.orow = MIX + (size_t)m * D + RW + hq * 64;
        attn_core32(lds + kvh * AS_KB, lds + AS_VT + kvh * AS_VB, AS_VTP, 0, L, F.lane);
    }
}
__device__ __forceinline__ void mixer_task(Frame& F0, int t) {
    Frame F = F0;
    { int t_ = threadIdx.x; asm volatile("" : "+v"(t_)); F.tid = t_; F.lane = t_ & 63; F.wave = __builtin_amdgcn_readfirstlane(t_ >> 6); }
    if (t < 16) scanB_unit(F, t);
    else if (t < 272) { const int u = t - 16; attn_prompt_unit(F, u >> 7, (u >> 6) & 1, u & 63); }
    else if (t < 400) sample_scan_unit(F, t - 272);
    else if (t < 528) attn_sample_unit(F, t - 400);
    else copy_task(F, t - 528);
}
__device__ __forceinline__ void p_mixer(Frame& F) {
    int t = F.vcu, step = F.G, end = 528 + NCOPY;
    if (F.G >= 32) { if (F.vcu < 16) { step = 1 << 20; end = 16; } else step = F.G - 16; }
    for (; t < end; t += step) mixer_task(F, t);
    __syncthreads();
}
__device__ __forceinline__ void p_scanA(Frame& F) { for (int t = F.vcu; t < 512; t += F.G) scanA_task(F, t); __syncthreads(); }
__device__ __forceinline__ void p_scanC(Frame& F) { for (int t = F.vcu; t < 512; t += F.G) scanC_task(F, t); __syncthreads(); }
#ifndef MK_PER_PHASE
#define MK_PER_PHASE 0
#endif
constexpr int N_PHASES = 15;
__global__ void __launch_bounds__(NWAVES * 64, 2) fwd_kernel(Args args) {
    extern __shared__ __attribute__((aligned(16))) unsigned char lds[];
    Frame F;
    F.lds = (LAS unsigned char*)lds;
    F.MISC = (volatile LAS unsigned*)(F.lds + MISC_OFF);
    F.tid = threadIdx.x; F.lane = F.tid & 63; F.wave = __builtin_amdgcn_readfirstlane(F.tid >> 6);
    F.G = gridDim.x; { const int bx = blockIdx.x; F.vcu = (F.G % 8 == 0) ? (bx % 8) * (F.G / 8) + bx / 8 : bx; }
    F.a = &args; F.ctl = (gu32*)(args.ws + WS_CTL);
    for (int u = F.tid; u < (LDS_BYTES - LDSCTL_OFF) / 4; u += NWAVES * 64) ((LAS unsigned*)(F.lds + LDSCTL_OFF))[u] = 0u;
    __syncthreads();
    const int lo = args.ph_lo, hi = args.ph_hi;
    XcdBarrier bar; bar.bar = (unsigned*)(F.ctl + CW_BAR); bar.x = 0; bar.st = nullptr;
    if (hi - lo > 1) bar = xcd_barrier_post((unsigned*)(F.ctl + CW_BAR), F.MISC + 8);
#ifdef ONLY_PHASE
#define IN(k) ((k) == ONLY_PHASE && lo <= (k) && (k) < hi)
#else
#define IN(k) (lo <= (k) && (k) < hi)
#endif
#ifndef REP_PHASE
#define REP_PHASE -1
#endif
#define SEAM(k) do { if ((k) + 1 < hi) xcd_barrier(bar); } while (0)
#define PH(k, BODY) if (IN(k)) { BODY; if ((k) == REP_PHASE) { xcd_barrier(bar); BODY; } SEAM(k); }
#define GEMM_SWIGLU(WOFF) { \
        pg8::Gemm g{WSP(bf16, WS_U), WSP(bf16, WOFF), M, NFF, D}; pg8::StaticOrder S; S.init(M, NFF, F.G, (int)blockIdx.x); \
        pg8::EpiSwiglu E{WSP(bf16, WS_H), FF}; \
        pg8::gemm_phase<pg8::EpiSwiglu, pg8::StaticOrder, true, true>(F.lds + RING_OFF, g, S, E); }
#define GEMM_RESID(AOFF, WOFF, KK, XP, XS, GTK, GS) { \
        pg8::Gemm g{WSP(bf16, AOFF), WSP(bf16, WOFF), M, D, KK}; pg8::StaticOrder S; S.init(M, D, F.G, (int)blockIdx.x); \
        pg8::EpiResid E{XP, XS, args.out + O_Y, WSP(float, WS_MOD) + (GTK) * D, ALPHA, GS}; \
        pg8::gemm_phase<pg8::EpiResid, pg8::StaticOrder, true, true>(F.lds + RING_OFF, g, S, E); }
#define GEMM_WIN() { \
        pg8::Gemm g{WSP(bf16, WS_U), WSP(bf16, WS_WIN), M, NIN, D}; pg8::StaticOrder S; S.init(M, NIN, F.G, (int)blockIdx.x); \
        pg8::EpiBf16<0> E{WSP(bf16, WS_H), NIN, nullptr, 0, 0, 1.f}; \
        pg8::gemm_phase<pg8::EpiBf16<0>, pg8::StaticOrder, true, true>(F.lds + RING_OFF, g, S, E); }
    PH(0, { p0_weights(F); if (REP_PHASE == 100) { __syncthreads(); p0_weights(F); } __syncthreads(); p0_mod(F); if (REP_PHASE == 101) { __syncthreads(); p0_mod(F); } })
    PH(1, p_modulate0(F))
    PH(2, GEMM_SWIGLU(WS_W1IN))
    PH(3, GEMM_RESID(WS_H, WS_W1OUT, FF, args.in[I_XP], args.in[I_XS], 2, 0.5f))
    PH(4, p_layernorm(F, 0, 3 * D))
    PH(5, GEMM_WIN())
    PH(6, p_prep(F))
    PH(7, p_scanA(F))
    PH(8, p_mixer(F))
    PH(9, p_scanC(F))
    PH(10, GEMM_RESID(WS_U, WS_WOUT, D, args.out + O_Y, args.out + O_Y + (size_t)MP * D, 5, 1.0f))
    PH(11, p_layernorm(F, 1, 6 * D))
    PH(12, GEMM_SWIGLU(WS_W2IN))
    PH(13, GEMM_RESID(WS_H, WS_W2OUT, FF, args.out + O_Y, args.out + O_Y + (size_t)MP * D, 8, 0.5f))
    PH(14, p_layernorm(F, 2, -1))
}

extern "C" void kernel_launch(void* const* d_in, const int* in_sizes, int n_in, void* d_out, int out_size, void* d_ws, size_t ws_size, hipStream_t stream) {
    static int grid = 0;
    if (grid == 0) {
        if (n_in != N_IN || in_sizes[0] != MP * D || out_size != (int)O_END || ws_size < WS_END) { fprintf(stderr, "kernel_launch: unexpected shapes (n_in %d, out %d, ws %zu); nothing launched\n", n_in, out_size, ws_size); grid = -1; return; }
        int dev = 0, cus = 0;
        if (hipGetDevice(&dev) != hipSuccess || hipDeviceGetAttribute(&cus, hipDeviceAttributeMultiprocessorCount, dev) != hipSuccess) { grid = -1; return; }
        if (hipFuncSetAttribute((const void*)fwd_kernel, hipFuncAttributeMaxDynamicSharedMemorySize, LDS_BYTES) != hipSuccess) { fprintf(stderr, "kernel_launch: hipFuncSetAttribute failed\n"); grid = -1; return; }
        int per_cu = 0;
        if (hipOccupancyMaxActiveBlocksPerMultiprocessor(&per_cu, (const void*)fwd_kernel, NWAVES * 64, LDS_BYTES) != hipSuccess || per_cu < 1) fprintf(stderr, "kernel_launch: occupancy query reports %d\n", per_cu);
        (void)hipGetLastError();
        grid = cus;
    }
    if (grid < 0) return;
    if (hipMemsetAsync((char*)d_ws + WS_CTL, 0, CTL_ZERO_BYTES, stream) != hipSuccess) return;
    Args a{};
    for (int i = 0; i < N_IN; ++i) a.in[i] = (const float*)d_in[i];
    a.out = (float*)d_out; a.ws = (unsigned char*)d_ws;
#if MK_PER_PHASE
    for (int ph = 0; ph < N_PHASES; ++ph) { a.ph_lo = ph; a.ph_hi = ph + 1; hipLaunchKernelGGL(fwd_kernel, dim3(grid), dim3(NWAVES * 64), LDS_BYTES, stream, a); }
#else
    a.ph_lo = 0; a.ph_hi = N_PHASES;
    hipLaunchKernelGGL(fwd_kernel, dim3(grid), dim3(NWAVES * 64), LDS_BYTES, stream, a);
#endif
}
```

```cpp
#define MK_PER_PHASE 0

#include <hip/hip_runtime.h>
#include <cstdio>
#include <cstdint>
#include <cmath>
namespace pg8 {
#define PG8_LAS __attribute__((address_space(3)))
typedef unsigned short bf16_t;
typedef short bf16x8 __attribute__((ext_vector_type(8)));
typedef float f32x4 __attribute__((ext_vector_type(4)));
typedef unsigned u32x4 __attribute__((ext_vector_type(4)));
constexpr int BM = 256, BK = 64, HALF = 128, HTB = HALF * BK * 2  , STAGE_BYTES = 8 * HTB, NXCD = 8, WGM = 8;

__host__ __device__ __forceinline__ int lds_byte(int r, int c) { const int st = (r >> 4) * 2 + (c >> 5), rr = r & 15, cc = c & 31, ob = rr * 64 + cc * 2; return st * 1024 + (ob ^ (((ob >> 9) & 1) << 5)); }
__host__ __device__ __forceinline__ void stage_rc(int b, int& R, int& C) { const int st = b / 1024, sb = b % 1024, swz = sb ^ (((sb >> 9) & 1) << 5); R = (st >> 1) * 16 + swz / 64; C = (st & 1) * 32 + (swz % 64) / 2; }
__host__ __device__ __forceinline__ int perm32(int rho) { const int n = rho >> 4, i = rho & 15; return 8 * (i >> 2) + 4 * n + (i & 3); }

struct Unit { int pm, pn, kt0, nt, ks; };
struct Gemm { const bf16_t* A; const bf16_t* Bt; int M, N, K; };

struct StaticOrder {
    int nM, nN, nwg, G, c;
    int ntk;
    __host__ __device__ void init(int M, int N, int G_, int c_, int K = 0) { nM = M / BM; nN = N / BM; nwg = nM * nN; G = G_; c = c_; ntk = K / BK; }
    __host__ __device__ bool next(int i, Unit& u) const {
        const long L = (long)i * G + c; if (L >= nwg) return false;
        int wgid = (int)L; { const int q = nwg / NXCD, r = nwg % NXCD, xcd = wgid % NXCD, off = wgid / NXCD; wgid = (xcd < r ? xcd * (q + 1) : r * (q + 1) + (xcd - r) * q) + off; }
        const int nig = WGM * nN, gid = wgid / nig, fm = gid * WGM, gsz = (nM - fm) < WGM ? (nM - fm) : WGM;
        u.pm = fm + ((wgid % nig) % gsz); u.pn = (wgid % nig) / gsz; u.kt0 = 0; u.nt = ntk; u.ks = -1; return true;
    }
    __device__ __forceinline__ void a_ready(const Unit&) const {}
    __device__ __forceinline__ void done(const Unit&) const {}
};

__device__ __forceinline__ unsigned cvt_pk_bf16(float lo, float hi) { unsigned r; asm volatile("v_cvt_pk_bf16_f32 %0, %1, %2" : "=v"(r) : "v"(lo), "v"(hi)); return r; }
template <int ACT  > struct EpiBf16 {
    static constexpr bool PERM = true, AFTER_DRAIN = false; static_assert(ACT == 0, "EpiBf16: ACT is 0 (none)");
    bf16_t* O; int ldc; const float* bias; int split_cols; size_t split_stride; float scale0;
    __device__ __forceinline__ void operator()(const f32x4 (&acc)[2][2][4][2], const Unit& u, int wr, int wc, int fr, int fq) const {
        const int row0 = u.pm * BM + wr * 64 + fr; int colt = u.pn * BM; bf16_t* base = O;
        float sc = 1.f; if (split_cols) { const int t = colt / split_cols; base += (size_t)t * split_stride; colt -= t * split_cols; if (t == 0) sc = scale0; }
        const int col0 = colt + wc * 32 + 8 * fq, bcol0 = u.pn * BM + wc * 32 + 8 * fq;
        f32x4 bv[2][2];
#pragma unroll
        for (int bj = 0; bj < 2; ++bj)
#pragma unroll
            for (int n = 0; n < 2; ++n) bv[bj][n] = bias ? *(const f32x4*)(bias + bcol0 + bj * HALF + 4 * n) : (f32x4){0.f, 0.f, 0.f, 0.f};
#pragma unroll
        for (int ai = 0; ai < 2; ++ai)
#pragma unroll
            for (int m = 0; m < 4; ++m) { bf16_t* rowp = base + (size_t)(row0 + ai * HALF + m * 16) * ldc + col0;
#pragma unroll
                for (int bj = 0; bj < 2; ++bj) { f32x4 v0 = acc[ai][bj][m][0] + bv[bj][0], v1 = acc[ai][bj][m][1] + bv[bj][1];
                    v0 = v0 * sc; v1 = v1 * sc; u32x4 w; w.x = cvt_pk_bf16(v0[0], v0[1]); w.y = cvt_pk_bf16(v0[2], v0[3]); w.z = cvt_pk_bf16(v1[0], v1[1]); w.w = cvt_pk_bf16(v1[2], v1[3]);
                    *(u32x4*)(rowp + bj * HALF) = w; } }
    }
};

template <class Epi, class Sched, bool ALIGN_EPI = false, bool SP2 = false>
__device__ __forceinline__ void gemm_phase(PG8_LAS unsigned char* lds, const Gemm g, const Sched& S, const Epi& E) {
    const int tid = threadIdx.x, wid = __builtin_amdgcn_readfirstlane(tid >> 6), lane = tid & 63, wr = wid >> 2, wc = wid & 3, fr = lane & 15, fq = lane >> 4;
    const int K = g.K;
    unsigned voffA[2], voffB[2];
#pragma unroll
    for (int i = 0; i < 2; ++i) { int R, C; stage_rc(tid * 16 + i * 8192, R, C); const int Rb = Epi::PERM ? ((R & ~31) + perm32(R & 31)) : R;
        voffA[i] = (unsigned)(R * K + C) * 2u; voffB[i] = (unsigned)(Rb * K + C) * 2u; }
    const size_t kstep = (size_t)(BK * 2);
    const size_t hstep = (size_t)HALF * K * 2;
    const size_t tstep = 2 * hstep;
    const unsigned ldsw = (unsigned)wid * 1024u;
    const int aoff = lds_byte(wr * 64 + fr, fq * 8), boff = lds_byte(wc * 32 + fr, fq * 8);
#define PG8_SA(b, h) (((b) * 2 + (h)) * HTB)
#define PG8_SB(b, h) ((4 + (b) * 2 + (h)) * HTB)
#define PG8_STAGE(bufoff, gbase, voff) do { _Pragma("unroll") for (int _i = 0; _i < 2; ++_i) \
        __builtin_amdgcn_global_load_lds((const unsigned*)((const char*)(gbase) + (voff)[_i]), (PG8_LAS unsigned*)(lds + (bufoff) + ldsw + _i * 8192), 16, 0, 0); } while (0)
#define PG8_LDA(dst, b, h) do { _Pragma("unroll") for (int m = 0; m < 4; ++m) _Pragma("unroll") for (int k = 0; k < 2; ++k) dst[m][k] = *(const PG8_LAS bf16x8*)(lds + PG8_SA(b, h) + aoff + m * 2048 + k * 1024); } while (0)
#define PG8_LDB(dst, b, h) do { _Pragma("unroll") for (int n = 0; n < 2; ++n) _Pragma("unroll") for (int k = 0; k < 2; ++k) dst[n][k] = *(const PG8_LAS bf16x8*)(lds + PG8_SB(b, h) + boff + n * 2048 + k * 1024); } while (0)
#define PG8_MMA(ai, bj, At, Bt) do { __builtin_amdgcn_s_setprio(1); _Pragma("unroll") for (int m = 0; m < 4; ++m) _Pragma("unroll") for (int n = 0; n < 2; ++n) _Pragma("unroll") for (int k = 0; k < 2; ++k) \
        acc[ai][bj][m][n] = __builtin_amdgcn_mfma_f32_16x16x32_bf16(Bt[n][k], At[m][k], acc[ai][bj][m][n], 0, 0, 0); __builtin_amdgcn_s_setprio(0); } while (0)
#define PG8_WAIT_V(n) asm volatile("s_waitcnt vmcnt(" #n ")" ::: "memory")
#define PG8_WAIT_L(n) asm volatile("s_waitcnt lgkmcnt(" #n ")" ::: "memory")
#define PG8_BAR __builtin_amdgcn_s_barrier()
#define PG8_SCHED __builtin_amdgcn_sched_barrier(0)
    Unit cur, nxt; int ui = 0;
    if (!S.next(0, cur)) return;
    f32x4 acc[2][2][4][2];
#pragma unroll
    for (int a = 0; a < 2; ++a)
#pragma unroll
        for (int b = 0; b < 2; ++b)
#pragma unroll
            for (int m = 0; m < 4; ++m)
#pragma unroll
                for (int n = 0; n < 2; ++n) acc[a][b][m][n] = (f32x4){0.f, 0.f, 0.f, 0.f};
    bf16x8 At[4][2], B0[2][2], B1[2][2];
    const char* cA = (const char*)g.A + (size_t)cur.pm * tstep + (size_t)cur.kt0 * kstep; const char* cB = (const char*)g.Bt + (size_t)cur.pn * tstep + (size_t)cur.kt0 * kstep;
    S.a_ready(cur);
    if constexpr (SP2) {
        PG8_STAGE(PG8_SB(0, 0), cB, voffB); PG8_STAGE(PG8_SB(0, 1), cB + hstep, voffB); PG8_STAGE(PG8_SA(0, 0), cA, voffA); PG8_STAGE(PG8_SA(0, 1), cA + hstep, voffA);
        if (wr == 1) PG8_BAR;
        PG8_WAIT_V(2); PG8_BAR;
        PG8_STAGE(PG8_SB(1, 0), cB + kstep, voffB); PG8_STAGE(PG8_SA(1, 0), cA + kstep, voffA); PG8_STAGE(PG8_SB(1, 1), cB + hstep + kstep, voffB);
        PG8_WAIT_V(6); PG8_BAR;
    } else {
        PG8_STAGE(PG8_SB(0, 0), cB, voffB); PG8_STAGE(PG8_SA(0, 0), cA, voffA); PG8_STAGE(PG8_SB(0, 1), cB + hstep, voffB); PG8_STAGE(PG8_SA(0, 1), cA + hstep, voffA);
        if (wr == 1) PG8_BAR;
        PG8_WAIT_V(4); PG8_BAR;
        PG8_STAGE(PG8_SB(1, 0), cB + kstep, voffB); PG8_STAGE(PG8_SA(1, 0), cA + kstep, voffA); PG8_STAGE(PG8_SB(1, 1), cB + hstep + kstep, voffB);
        PG8_WAIT_V(6); PG8_BAR;
    }
    for (;;) {
        const bool has_next = S.next(ui + 1, nxt);
        const char* nA = has_next ? (const char*)g.A + (size_t)nxt.pm * tstep + (size_t)nxt.kt0 * kstep : cA; const char* nB = has_next ? (const char*)g.Bt + (size_t)nxt.pn * tstep + (size_t)nxt.kt0 * kstep : cB;
        const int nt = cur.nt;
        for (int t = 0; t < nt; t += 2) {
            const bool last = (t == nt - 2);
            const char* a1 = cA + (size_t)(t + 1) * kstep;
            const char* a2 = last ? nA : cA + (size_t)(t + 2) * kstep; const char* b2 = last ? nB : cB + (size_t)(t + 2) * kstep;
            const char* a3 = a2 + kstep; const char* b3 = b2 + kstep;
            if (last && has_next) S.a_ready(nxt);
            if constexpr (SP2) {
            PG8_LDB(B0, 0, 0); PG8_LDB(B1, 0, 1); PG8_SCHED; PG8_LDA(At, 0, 0); PG8_STAGE(PG8_SA(1, 1), a1 + hstep, voffA);
            PG8_WAIT_V(8); PG8_WAIT_L(0); PG8_BAR; PG8_MMA(0, 0, At, B0); PG8_MMA(0, 1, At, B1); PG8_BAR; PG8_SCHED;
            PG8_LDA(At, 0, 1); PG8_STAGE(PG8_SB(0, 0), b2, voffB); PG8_STAGE(PG8_SB(0, 1), b2 + hstep, voffB); PG8_STAGE(PG8_SA(0, 0), a2, voffA);
            PG8_WAIT_V(8); PG8_WAIT_L(0); PG8_BAR; PG8_MMA(1, 0, At, B0); PG8_MMA(1, 1, At, B1); PG8_BAR; PG8_SCHED;
            PG8_LDB(B0, 1, 0); PG8_LDB(B1, 1, 1); PG8_SCHED; PG8_LDA(At, 1, 0); PG8_STAGE(PG8_SA(0, 1), a2 + hstep, voffA);
            PG8_WAIT_V(8); PG8_WAIT_L(0); PG8_BAR; PG8_MMA(0, 0, At, B0); PG8_MMA(0, 1, At, B1); PG8_BAR; PG8_SCHED;
            PG8_LDA(At, 1, 1); PG8_STAGE(PG8_SB(1, 0), b3, voffB); PG8_STAGE(PG8_SB(1, 1), b3 + hstep, voffB); PG8_STAGE(PG8_SA(1, 0), a3, voffA);
            PG8_WAIT_V(8); PG8_WAIT_L(0); PG8_BAR; PG8_MMA(1, 0, At, B0); PG8_MMA(1, 1, At, B1); PG8_BAR; PG8_SCHED;
            } else {
            PG8_LDB(B0, 0, 0); PG8_SCHED; PG8_LDA(At, 0, 0); PG8_STAGE(PG8_SA(1, 1), a1 + hstep, voffA);
            PG8_WAIT_L(8); PG8_BAR; PG8_WAIT_L(0); PG8_MMA(0, 0, At, B0); PG8_BAR; PG8_SCHED;
            PG8_LDB(B1, 0, 1); PG8_STAGE(PG8_SB(0, 0), b2, voffB);
            PG8_BAR; PG8_WAIT_L(0); PG8_MMA(0, 1, At, B1); PG8_BAR;
            PG8_LDA(At, 0, 1); PG8_STAGE(PG8_SA(0, 0), a2, voffA);
            PG8_BAR; PG8_WAIT_L(0); PG8_MMA(1, 0, At, B0); PG8_BAR; PG8_SCHED;
            PG8_STAGE(PG8_SB(0, 1), b2 + hstep, voffB);
            PG8_WAIT_V(6); PG8_BAR; PG8_MMA(1, 1, At, B1); PG8_BAR;
            PG8_LDB(B0, 1, 0); PG8_SCHED; PG8_LDA(At, 1, 0); PG8_STAGE(PG8_SA(0, 1), a2 + hstep, voffA);
            PG8_WAIT_L(8); PG8_BAR; PG8_WAIT_L(0); PG8_MMA(0, 0, At, B0); PG8_BAR; PG8_SCHED;
            PG8_LDB(B1, 1, 1); PG8_STAGE(PG8_SB(1, 0), b3, voffB);
            PG8_BAR; PG8_WAIT_L(0); PG8_MMA(0, 1, At, B1); PG8_BAR;
            PG8_LDA(At, 1, 1); PG8_STAGE(PG8_SA(1, 0), a3, voffA);
            PG8_BAR; PG8_WAIT_L(0); PG8_MMA(1, 0, At, B0); PG8_BAR; PG8_SCHED;
            PG8_STAGE(PG8_SB(1, 1), b3 + hstep, voffB);
            PG8_WAIT_V(6); PG8_BAR; PG8_MMA(1, 1, At, B1); PG8_BAR;
            }
        }
        if constexpr (ALIGN_EPI) { if (wr == 0) PG8_BAR; }
        if constexpr (!Epi::AFTER_DRAIN) { E(acc, cur, wr, wc, fr, fq); S.done(cur); }
        if (!has_next) break;
#pragma unroll
        for (int a = 0; a < 2; ++a)
#pragma unroll
            for (int b = 0; b < 2; ++b)
#pragma unroll
                for (int m = 0; m < 4; ++m)
#pragma unroll
                    for (int n = 0; n < 2; ++n) acc[a][b][m][n] = (f32x4){0.f, 0.f, 0.f, 0.f};
        cur = nxt; cA = nA; cB = nB; ++ui;
        if constexpr (ALIGN_EPI) { if (wr == 1) PG8_BAR; }
    }
    PG8_WAIT_V(0);
    if constexpr (!ALIGN_EPI) { if (wr == 0) PG8_BAR; }
    PG8_BAR;
    if constexpr (Epi::AFTER_DRAIN) { E.fused(acc, cur, wr, wc, fr, fq, lds, wid, lane); S.done(cur); }
#undef PG8_SA
#undef PG8_SB
#undef PG8_STAGE
#undef PG8_LDA
#undef PG8_LDB
#undef PG8_MMA
#undef PG8_WAIT_V
#undef PG8_WAIT_L
#undef PG8_BAR
#undef PG8_SCHED
}
struct EpiSwiglu {
    static constexpr bool PERM = true, AFTER_DRAIN = false;
    bf16_t* H; int ldh;
    __device__ __forceinline__ void operator()(const f32x4 (&acc)[2][2][4][2], const Unit& u, int wr, int wc, int fr, int fq) const {
        const int row0 = u.pm * BM + wr * 64 + fr, col0 = u.pn * HALF + wc * 32 + 8 * fq;
#pragma unroll
        for (int ai = 0; ai < 2; ++ai)
#pragma unroll
            for (int m = 0; m < 4; ++m) {
                bf16_t* p = H + (size_t)(row0 + ai * HALF + m * 16) * ldh + col0;
                float h[8];
#pragma unroll
                for (int n = 0; n < 2; ++n)
#pragma unroll
                    for (int i = 0; i < 4; ++i) { const float g = acc[ai][0][m][n][i], up = acc[ai][1][m][n][i];
                        h[n * 4 + i] = g * __builtin_amdgcn_rcpf(1.0f + __expf(-g)) * up; }
                u32x4 w; w.x = cvt_pk_bf16(h[0], h[1]); w.y = cvt_pk_bf16(h[2], h[3]); w.z = cvt_pk_bf16(h[4], h[5]); w.w = cvt_pk_bf16(h[6], h[7]);
                *(u32x4*)p = w;
            }
    }
};
template <int GS2  > struct EpiResid {
    static constexpr bool PERM = false, AFTER_DRAIN = false;
    static constexpr float alpha = 1.189207115002721f, gs = 0.5f * GS2;
    const float* xp; const float* xs; float* X; const float* gt; float* part;
    __device__ __forceinline__ void operator()(const f32x4 (&acc)[2][2][4][2], const Unit& u, int wr, int wc, int fr, int fq) const {
        const int col0 = u.pn * BM + wc * 32 + 4 * fq;
        if (u.ks >= 0) {
#pragma unroll
            for (int ai = 0; ai < 2; ++ai)
#pragma unroll
                for (int m = 0; m < 4; ++m) { float* po = part + ((size_t)u.ks * 1024 + (size_t)(u.pm * BM + ai * HALF + wr * 64 + m * 16 + fr - 16384)) * 1024;
#pragma unroll
                    for (int bj = 0; bj < 2; ++bj)
#pragma unroll
                        for (int n = 0; n < 2; ++n) *(f32x4*)(po + col0 + bj * HALF + n * 16) = acc[ai][bj][m][n]; }
            return;
        }
#pragma unroll
        for (int ai = 0; ai < 2; ++ai)
#pragma unroll
            for (int m = 0; m < 4; ++m) {
                const int row = u.pm * BM + ai * HALF + wr * 64 + m * 16 + fr;
                const bool smp = row >= 16384;
                const float* xr = smp ? xs + (size_t)(row - 16384) * 1024 : xp + (size_t)row * 1024;
                const int b = smp ? 2 + ((row - 16384) >> 3) : (row >> 13);
                const float* gr = gt + (size_t)b * 9216;
                float* xo = X + (size_t)row * 1024;
#pragma unroll
                for (int bj = 0; bj < 2; ++bj)
#pragma unroll
                    for (int n = 0; n < 2; ++n) { const int c = col0 + bj * HALF + n * 16;
                        const f32x4 xv = *(const f32x4*)(xr + c), gv = *(const f32x4*)(gr + c);
                        const f32x4 z = xv * alpha + (gv + 1.0f) * gs * acc[ai][bj][m][n];
                        *(f32x4*)(xo + c) = z; }
            }
    }
};
struct SliceOrder {
    StaticOrder so; int nsl, G, c;
    __host__ __device__ void init(int K, int G_, int c_) { so.init(16384, 1024, G_, c_, K); nsl = K / (4 * BK); G = G_; c = c_; }
    __host__ __device__ bool next(int i, Unit& u) const {
        if (so.next(i, u)) return true;
        const long L = (long)i * G + c - so.nwg; if (L < 0 || L >= 16 * nsl) return false;
        const int t16 = (int)L / nsl, ks = (int)L % nsl;
        u.pm = 64 + (t16 >> 2); u.pn = t16 & 3; u.kt0 = 4 * ks; u.nt = 4; u.ks = ks; return true;
    }
    __device__ __forceinline__ void a_ready(const Unit&) const {}
    __device__ __forceinline__ void done(const Unit&) const {}
};
}
#define GAS __attribute__((address_space(1)))
#define LAS __attribute__((address_space(3)))
typedef unsigned short bf16;
typedef unsigned v4u __attribute__((ext_vector_type(4)));
typedef float f32x4 __attribute__((ext_vector_type(4)));
typedef short bf16x8 __attribute__((ext_vector_type(8)));
typedef GAS unsigned gu32;
typedef GAS unsigned long long gu64;
#define RLX_AGENT __ATOMIC_RELAXED, __HIP_MEMORY_SCOPE_AGENT
#define LDS_WAIT() asm volatile("s_waitcnt lgkmcnt(0)" ::: "memory")
#define VM_WAIT() asm volatile("s_waitcnt vmcnt(0)" ::: "memory")
__device__ __forceinline__ unsigned long long rt() { return __builtin_amdgcn_s_memrealtime(); }
__device__ __forceinline__ unsigned f2bf(float f) { unsigned u = __builtin_bit_cast(unsigned, f); return (u + 0x7fffu + ((u >> 16) & 1u)) >> 16; }
__device__ __forceinline__ unsigned pk2(float lo, float hi) { return f2bf(lo) | (f2bf(hi) << 16); }

#define XB_TMO      128
#define XB_XCNT(j)  (256  + 64 * (j))
#define XB_XSUB(j)  (1280 + 64 * (j))
#define XB_XGEN(j)  (2304 + 64 * (j))
#define XB_TOP      3328
#define XB_TOPGEN   3392
#define XCD_BAR_WORDS 3456
#define XB_SPIN_CAP (1u << 18)

__device__ __forceinline__ unsigned xb_ld(unsigned* p)              { return __hip_atomic_load(p, __ATOMIC_RELAXED, __HIP_MEMORY_SCOPE_AGENT); }
__device__ __forceinline__ unsigned xb_add(unsigned* p, unsigned v) { return __hip_atomic_fetch_add(p, v, __ATOMIC_RELAXED, __HIP_MEMORY_SCOPE_AGENT); }
__device__ __forceinline__ unsigned xb_xcc_id() { return (unsigned)__builtin_amdgcn_s_getreg((3 << 11) | 20) & 0xFu; }
#define XB_SPIN(cond, bar) do { unsigned _sp = 0; while (cond) { __builtin_amdgcn_s_sleep(1); \
    if ((++_sp & 255u) == 0u) { if (xb_ld(&(bar)[XB_TMO])) break; if (_sp > XB_SPIN_CAP) { atomicAdd(&(bar)[XB_TMO], 1u); break; } } } } while (0)

struct XcdBarrier {
    unsigned* bar; unsigned x;
    volatile LAS unsigned* st;
};

__device__ __forceinline__ XcdBarrier xcd_barrier_post(unsigned* bar, volatile LAS unsigned* st) {
    XcdBarrier b; b.bar = bar; b.x = xb_xcc_id(); b.st = st;
    if (threadIdx.x == 0) (void)xb_add(&bar[XB_XCNT(b.x)], 1u);
    return b;
}
__device__ __forceinline__ void xcd_barrier_complete(unsigned* bar, unsigned x, unsigned& nloc, unsigned& nx) {
    const unsigned G = gridDim.x * gridDim.y * gridDim.z;
    unsigned sum, cnt, mine, sp = 0u;
    for (;;) {
        sum = 0u; cnt = 0u; mine = 0u;
#pragma unroll
        for (unsigned j = 0; j < 16; ++j) { const unsigned c = xb_ld(&bar[XB_XCNT(j)]); sum += c; cnt += (c > 0u) ? 1u : 0u; mine = (j == x) ? c : mine; }
        if (sum == G) break;
        __builtin_amdgcn_s_sleep(1);
        if ((++sp & 255u) == 0u) { if (xb_ld(&bar[XB_TMO])) break; if (sp > XB_SPIN_CAP) { atomicAdd(&bar[XB_TMO], 1u); break; } }
    }
    nloc = mine > 0u ? mine : 1u; nx = cnt > 0u ? cnt : 1u;
}

__device__ __forceinline__ void xcd_barrier(const XcdBarrier& b) {
    asm volatile("s_waitcnt vmcnt(0)" ::: "memory");
    __syncthreads();
    if (threadIdx.x == 0) {
        unsigned* bar = b.bar;
        __builtin_amdgcn_s_waitcnt(0);
        unsigned nloc = b.st[0], nx = b.st[1];
        if (nloc == 0u) { xcd_barrier_complete(bar, b.x, nloc, nx); b.st[0] = nloc; b.st[1] = nx; }
        const unsigned old = xb_add(&bar[XB_XSUB(b.x)], 1u);
        const unsigned gen = old / nloc;
        if (old + 1u == (gen + 1u) * nloc) {
            __builtin_amdgcn_fence(__ATOMIC_RELEASE, "agent");
            asm volatile("s_waitcnt vmcnt(0)" ::: "memory");
            const unsigned og = xb_add(&bar[XB_TOP], 1u);
            const unsigned tg = og / nx;
            if (og + 1u == (tg + 1u) * nx) xb_add(&bar[XB_TOPGEN], 1u);
            else XB_SPIN(xb_ld(&bar[XB_TOPGEN]) == tg, bar);
            __builtin_amdgcn_fence(__ATOMIC_ACQUIRE, "agent");
            xb_add(&bar[XB_XGEN(b.x)], 1u);
            asm volatile("s_waitcnt vmcnt(0)" ::: "memory");
        } else {
            XB_SPIN(xb_ld(&bar[XB_XGEN(b.x)]) == gen, bar);
            __builtin_amdgcn_fence(__ATOMIC_ACQUIRE, "agent");
            asm volatile("s_waitcnt vmcnt(0)" ::: "memory");
        }
    }
    __syncthreads();
}

constexpr int D = 1024, FF = 2816, NFF = 2 * FF, NIN = 2560, RW = 512, RWP = 1792;
constexpr int MP = 16384, MS = 1024, M = MP + MS, TP = 8192, TS = 8, NBS = 128;
constexpr int MODW = 9216, NMOD = 130;
constexpr float ALPHA = 1.189207115002721f;
constexpr float LN_EPS = 1e-5f, GN_EPS = 64e-5f;
constexpr int NWAVES = 8;
enum { I_XP = 0, I_XS, I_SWKV, I_SSHIFT, I_CK, I_CV, I_CP, I_CS, I_RELB, I_WADA, I_BADA, I_LNG, I_LNB, I_W1IN, I_W1OUT, I_WIN, I_MU, I_W0, I_WDEC, I_A0, I_WICLR, I_WGATE,
       I_KK, I_KA, I_RK, I_GNW, I_GNB, I_SINKS, I_WOUT, I_W2IN, I_W2OUT, N_IN };
constexpr size_t O_Y = 0, O_WKV_P = (size_t)M * D, O_SHIFT_P = O_WKV_P + 65536, O_WINK_P = O_SHIFT_P + 3584, O_WINV_P = O_WINK_P + 32768,
                 O_WKV_S = O_WINV_P + 32768, O_SHIFT_S = O_WKV_S + 4194304, O_WINK_S = O_SHIFT_S + 229376, O_WINV_S = O_WINK_S + 2097152, O_END = O_WINV_S + 2097152;
static_assert(O_END == 26578432, "d_out size");
constexpr size_t MiB = 1u << 20;
constexpr size_t WS_CTL = 0, CTL_ZERO_BYTES = 1 * MiB;
constexpr size_t WS_W1IN = 2 * MiB, WS_W1OUT = 13 * MiB, WS_WIN = 19 * MiB, WS_WOUT = 24 * MiB, WS_W2IN = 26 * MiB, WS_W2OUT = 37 * MiB;
constexpr size_t WS_MOD = 43 * MiB;
constexpr size_t WS_U = 48 * MiB;
constexpr size_t WS_H = 82 * MiB;
constexpr size_t WS_WLOG = 176 * MiB, WS_A = 210 * MiB, WS_G = 227 * MiB, WS_INV = 244 * MiB, WS_LORA = 245 * MiB, WS_END = 246 * MiB;
constexpr size_t LORA_WI = 512 * 64 * 2, LORA_WG = 2 * 512 * 64 * 2;
static_assert(WS_W1IN + (size_t)NFF * D * 2 <= WS_W1OUT && WS_W1OUT + (size_t)D * FF * 2 <= WS_WIN && WS_WIN + (size_t)NIN * D * 2 <= WS_WOUT && WS_WOUT + (size_t)D * D * 2 <= WS_W2IN &&
              WS_W2IN + (size_t)NFF * D * 2 <= WS_W2OUT && WS_W2OUT + (size_t)D * FF * 2 <= WS_MOD && WS_MOD + (size_t)NMOD * MODW * 4 <= WS_U && WS_U + (size_t)M * D * 2 <= WS_H &&
              WS_H + (size_t)M * FF * 2 <= WS_WLOG && WS_WLOG + (size_t)M * RW * 4 <= WS_A && WS_A + (size_t)M * RW * 2 <= WS_G && WS_G + (size_t)M * RW * 2 <= WS_INV &&
              WS_INV + (size_t)M * 8 * 4 <= WS_LORA && WS_LORA + 4 * 512 * 64 * 2 <= WS_END && WS_END <= 256 * MiB, "d_ws map");
constexpr int CW_BAR = 4096;
constexpr int RING_OFF = 0, RING_BYTES = 151552;
constexpr int LDSCTL_OFF = RING_BYTES, MISC_OFF = LDSCTL_OFF + 320;
constexpr int LDS_BYTES = 155648;
static_assert(MISC_OFF + 128 <= LDS_BYTES, "LDS map");

__device__ __forceinline__ float bf2f(unsigned short h) { return __uint_as_float((unsigned)h << 16); }
__device__ __forceinline__ float bflo(unsigned u) { return __uint_as_float(u << 16); }
__device__ __forceinline__ float bfhi(unsigned u) { return __uint_as_float(u & 0xffff0000u); }
__device__ __forceinline__ unsigned long long pk4(f32x4 v) { return (unsigned long long)pk2(v[0], v[1]) | ((unsigned long long)pk2(v[2], v[3]) << 32); }
__device__ __forceinline__ f32x4 bf4_to_f32(unsigned long long w) { return (f32x4){bflo((unsigned)w), bfhi((unsigned)w), bflo((unsigned)(w >> 32)), bfhi((unsigned)(w >> 32))}; }
__device__ __forceinline__ float wave_sum(float v) {
#pragma unroll
    for (int o = 1; o < 64; o <<= 1) v += __shfl_xor(v, o);
    return v;
}
template <int CTRL> __device__ __forceinline__ float dppf(float x) { return __builtin_bit_cast(float, __builtin_amdgcn_update_dpp(0, __builtin_bit_cast(int, x), CTRL, 0xf, 0xf, true)); }
__device__ __forceinline__ float sum8(float x) {
    x += dppf<0xB1>(x);
    x += dppf<0x4E>(x);
    x += dppf<0x141>(x);
    return x;
}
__device__ __forceinline__ float wave_sum_dpp(float x) {
    x += dppf<0xB1>(x); x += dppf<0x4E>(x); x += dppf<0x141>(x);
    x += dppf<0x140>(x);
    const int xi = __builtin_bit_cast(int, x);
    return __builtin_bit_cast(float, __builtin_amdgcn_readlane(xi, 0)) + __builtin_bit_cast(float, __builtin_amdgcn_readlane(xi, 16)) +
           __builtin_bit_cast(float, __builtin_amdgcn_readlane(xi, 32)) + __builtin_bit_cast(float, __builtin_amdgcn_readlane(xi, 48));
}
__device__ __forceinline__ float sigmoidf_(float x) { return 1.0f / (1.0f + expf(-x)); }

struct Args { const float* in[N_IN]; float* out; unsigned char* ws; int ph_lo, ph_hi; };
static_assert(sizeof(Args) == N_IN * 8 + 24, "Args has no padding");
struct Frame {
    LAS unsigned char* lds;
    volatile LAS unsigned* MISC;
    gu32* ctl;
    int tid, lane, wave, vcu, G;
    const Args* a;
};
#define WSP(T, off) ((T*)(F.a->ws + (off)))

__device__ __forceinline__ void p0_transpose_item(const float* W, int K, int N, bf16* WT, int dst_row0, int k0, int n0, LAS float* scr, int lane) {
#pragma unroll 8
    for (int i = 0; i < 32; ++i) { const int kk = 2 * i + (lane >> 5); scr[kk * 33 + (lane & 31)] = W[(size_t)(k0 + kk) * N + n0 + (lane & 31)]; }
    LDS_WAIT(); asm volatile("" ::: "memory");
    const int c = lane & 7;
#pragma unroll
    for (int j = 0; j < 4; ++j) { const int n = (lane >> 3) + 8 * j; const LAS float* s = scr + (8 * c) * 33 + n;
        v4u o; o.x = pk2(s[0 * 33], s[1 * 33]); o.y = pk2(s[2 * 33], s[3 * 33]); o.z = pk2(s[4 * 33], s[5 * 33]); o.w = pk2(s[6 * 33], s[7 * 33]);
        *(GAS v4u*)(WT + (size_t)(dst_row0 + n) * K + k0 + 8 * c) = o; }
    LDS_WAIT(); asm volatile("" ::: "memory");
}
__device__ __forceinline__ void p0_ffin_item(const float* W, bf16* WT, int r, LAS float* scr, int lane) {
    const int kb = r / 176, nb = r % 176, n0 = 32 * nb; const bool up = n0 >= FF; const int j = up ? n0 - FF : n0;
    p0_transpose_item(W, D, NFF, WT, (j >> 7) * 256 + (up ? 128 : 0) + (j & 127), 64 * kb, n0, scr, lane);
}
__device__ __forceinline__ void p0_plain_item(const float* W, int K, int N, bf16* WT, int r, LAS float* scr, int lane) {
    const int nblk = N / 32, kb = r / nblk, nb = r % nblk;
    p0_transpose_item(W, K, N, WT, 32 * nb, 64 * kb, 32 * nb, scr, lane);
}
__device__ __forceinline__ void p0_weights(Frame& F) {
    LAS float* scr = (LAS float*)(F.lds + RING_OFF + F.wave * 16384);
    const int gw = F.vcu * NWAVES + F.wave, NGW = F.G * NWAVES;
    constexpr int I_FI = 16 * 176, I_FO = 44 * 32, I_IN = 16 * 80, I_O = 16 * 32, I_L = 16, NITEMS = 2 * I_FI + 2 * I_FO + I_IN + I_O + 4 * I_L;
    for (int it = gw; it < NITEMS; it += NGW) {
        int r = it;
        if (r < I_FI) { p0_ffin_item(F.a->in[I_W1IN], WSP(bf16, WS_W1IN), r, scr, F.lane); continue; } r -= I_FI;
        if (r < I_FI) { p0_ffin_item(F.a->in[I_W2IN], WSP(bf16, WS_W2IN), r, scr, F.lane); continue; } r -= I_FI;
        if (r < I_FO) { p0_plain_item(F.a->in[I_W1OUT], FF, D, WSP(bf16, WS_W1OUT), r, scr, F.lane); continue; } r -= I_FO;
        if (r < I_FO) { p0_plain_item(F.a->in[I_W2OUT], FF, D, WSP(bf16, WS_W2OUT), r, scr, F.lane); continue; } r -= I_FO;
        if (r < I_IN) { p0_plain_item(F.a->in[I_WIN], D, NIN, WSP(bf16, WS_WIN), r, scr, F.lane); continue; } r -= I_IN;
        if (r < I_O) { p0_plain_item(F.a->in[I_WOUT], D, D, WSP(bf16, WS_WOUT), r, scr, F.lane); continue; } r -= I_O;
        if (r < I_L) { p0_plain_item(F.a->in[I_WDEC], 64, RW, WSP(bf16, WS_LORA), r, scr, F.lane); continue; } r -= I_L;
        if (r < I_L) { p0_plain_item(F.a->in[I_WICLR], 64, RW, WSP(bf16, WS_LORA + LORA_WI), r, scr, F.lane); continue; } r -= I_L;
        p0_plain_item(F.a->in[I_WGATE], 128, RW, WSP(bf16, WS_LORA + LORA_WG), r, scr, F.lane);
    }
}
typedef float f32x16m __attribute__((ext_vector_type(16)));
__device__ __forceinline__ void p0_mod(Frame& F) {
    const float* wada = F.a->in[I_WADA]; const float* bada = F.a->in[I_BADA]; const float* cp = F.a->in[I_CP]; const float* cs = F.a->in[I_CS];
    float* mod = WSP(float, WS_MOD);
    LAS float* red = (LAS float*)F.lds;
    const int lane = F.lane, wave = F.wave, r = lane & 31, h = lane >> 5;
    for (int task = blockIdx.x; task < MODW / 32; task += F.G) {
        const int j0 = 32 * task;
        f32x16m acc[5];
#pragma unroll
        for (int bt = 0; bt < 5; ++bt)
#pragma unroll
            for (int e = 0; e < 16; ++e) acc[bt][e] = 0.f;
#pragma unroll 1
        for (int ks = 0; ks < 8; ++ks) {
            const int i0 = 128 * wave + 16 * ks + 8 * h;
            unsigned aw[4];
#pragma unroll
            for (int e = 0; e < 4; ++e) aw[e] = pk2(wada[(size_t)(i0 + 2 * e) * MODW + j0 + r], wada[(size_t)(i0 + 2 * e + 1) * MODW + j0 + r]);
            const bf16x8 af = __builtin_bit_cast(bf16x8, (v4u){aw[0], aw[1], aw[2], aw[3]});
#pragma unroll
            for (int bt = 0; bt < 5; ++bt) {
                const int b = 32 * bt + r;
                f32x4 c0 = (f32x4){0.f, 0.f, 0.f, 0.f}, c1 = c0;
                if (b < NMOD) { const float* cr = (b < 2 ? cp + (size_t)b * D : cs + (size_t)(b - 2) * D) + i0; c0 = *(const f32x4*)cr; c1 = *(const f32x4*)(cr + 4); }
                float sv[8];
#pragma unroll
                for (int e = 0; e < 4; ++e) { sv[e] = c0[e] * __builtin_amdgcn_rcpf(1.0f + __expf(-c0[e])); sv[4 + e] = c1[e] * __builtin_amdgcn_rcpf(1.0f + __expf(-c1[e])); }
                const bf16x8 bfm = __builtin_bit_cast(bf16x8, (v4u){pk2(sv[0], sv[1]), pk2(sv[2], sv[3]), pk2(sv[4], sv[5]), pk2(sv[6], sv[7])});
                acc[bt] = __builtin_amdgcn_mfma_f32_32x32x16_bf16(af, bfm, acc[bt], 0, 0, 0);
            }
        }
#pragma unroll
        for (int rd = 0; rd < 2; ++rd) {
            const int nv = rd == 0 ? 48 : 32, bt0 = rd == 0 ? 0 : 3;
            __syncthreads();
#pragma unroll
            for (int bt = 0; bt < 3; ++bt) if (bt0 + bt < 5)
#pragma unroll
                for (int e = 0; e < 16; ++e) red[(wave * 48 + bt * 16 + e) * 64 + lane] = acc[bt0 + bt][e];
            __syncthreads();
            for (int idx = F.tid; idx < nv * 64; idx += 512) {
                const int v = idx >> 6, ln = idx & 63, bt = bt0 + (v >> 4), e = v & 15;
                float s = 0.f;
#pragma unroll
                for (int w = 0; w < 8; ++w) s += red[(w * 48 + v) * 64 + ln];
                const int b = 32 * bt + (ln & 31), j = j0 + (e & 3) + 8 * (e >> 2) + 4 * (ln >> 5);
                if (b < NMOD) mod[(size_t)b * MODW + j] = s + bada[j];
            }
        }
    }
    __syncthreads();
}

__device__ __forceinline__ int mod_row_of(int m) { return m < MP ? (m >> 13) : 2 + ((m - MP) >> 3); }
__device__ __forceinline__ void p_modulate0(Frame& F) {
    const int gw = F.vcu * NWAVES + F.wave, NGW = F.G * NWAVES;
    const float* mod = WSP(float, WS_MOD); bf16* U = WSP(bf16, WS_U);
    for (int m = gw; m < M; m += NGW) {
        const float* xr = m < MP ? F.a->in[I_XP] + (size_t)m * D : F.a->in[I_XS] + (size_t)(m - MP) * D;
        const float* mr = mod + (size_t)mod_row_of(m) * MODW;
        unsigned long long* o8 = (unsigned long long*)(U + (size_t)m * D) + F.lane;
#pragma unroll
        for (int j = 0; j < 4; ++j) { const int c = 4 * F.lane + 256 * j;
            const f32x4 x = *(const f32x4*)(xr + c), sh = *(const f32x4*)(mr + c), sc = *(const f32x4*)(mr + D + c);
            const f32x4 u = x * (sc + 1.0f) + sh;
            o8[64 * j] = (unsigned long long)pk2(u[0], u[1]) | ((unsigned long long)pk2(u[2], u[3]) << 32); }
    }
}
__device__ __forceinline__ void p_layernorm(Frame& F, int lnidx, int koff, int nsl, const float* xs_old, int gtk, float gs) {
    const int gw = F.vcu * NWAVES + F.wave, NGW = F.G * NWAVES;
    const float* mod = WSP(float, WS_MOD); bf16* U = WSP(bf16, WS_U); float* X = F.a->out + O_Y;
    const float* lg = F.a->in[I_LNG] + lnidx * D; const float* lb = F.a->in[I_LNB] + lnidx * D;
    for (int m = gw; m < M; m += NGW) {
        float* xr = X + (size_t)m * D;
        f32x4 v[4]; float s = 0.f;
#pragma unroll
        for (int j = 0; j < 4; ++j) { const int c = 4 * F.lane + 256 * j;
            if (m < MP) v[j] = *(const f32x4*)(xr + c);
            else { const float* pp = WSP(float, WS_WLOG) + (size_t)(m - MP) * D + c; f32x4 a = *(const f32x4*)pp;
                for (int ks = 1; ks < nsl; ++ks) a += *(const f32x4*)(pp + (size_t)ks * MS * D);
                const f32x4 xo = *(const f32x4*)(xs_old + (size_t)(m - MP) * D + c), gv = *(const f32x4*)(mod + (size_t)mod_row_of(m) * MODW + gtk * D + c);
                v[j] = xo * ALPHA + (gv + 1.0f) * gs * a; }
            s += (v[j][0] + v[j][1]) + (v[j][2] + v[j][3]); }
        const float mean = wave_sum(s) * (1.f / D); float s2 = 0.f;
#pragma unroll
        for (int j = 0; j < 4; ++j) { v[j] = v[j] - mean; s2 += (v[j][0] * v[j][0] + v[j][1] * v[j][1]) + (v[j][2] * v[j][2] + v[j][3] * v[j][3]); }
        const float rstd = 1.f / sqrtf(wave_sum(s2) * (1.f / D) + LN_EPS);
        const float* mr = mod + (size_t)mod_row_of(m) * MODW + (koff >= 0 ? koff : 0);
        unsigned long long* o8 = (unsigned long long*)(U + (size_t)m * D) + F.lane;
#pragma unroll
        for (int j = 0; j < 4; ++j) { const int c = 4 * F.lane + 256 * j;
            const f32x4 x = v[j] * rstd * *(const f32x4*)(lg + c) + *(const f32x4*)(lb + c);
            *(f32x4*)(xr + c) = x;
            if (koff >= 0) { const f32x4 sh = *(const f32x4*)(mr + c), sc = *(const f32x4*)(mr + D + c); const f32x4 u = x * (sc + 1.0f) + sh;
                o8[64 * j] = (unsigned long long)pk2(u[0], u[1]) | ((unsigned long long)pk2(u[2], u[3]) << 32); } }
    }
}
__device__ __forceinline__ float prev_val(const bf16* P, const float* sshift, int m, int col) {
    if (m < MP) return (m & (TP - 1)) == 0 ? 0.f : bf2f(P[(size_t)(m - 1) * NIN + col]);
    const int ms = m - MP;
    return (ms & (TS - 1)) == 0 ? sshift[(size_t)(ms >> 3) * RWP + col] : bf2f(P[(size_t)(m - 1) * NIN + col]);
}
constexpr int PP_PITCH = 528;
__device__ __forceinline__ void p_prep(Frame& F) {
    LAS unsigned char* lds = F.lds;
    const bf16* P = WSP(bf16, WS_H); const float* sshift = F.a->in[I_SSHIFT]; const float* mu = F.a->in[I_MU];
    float* WLOG = WSP(float, WS_WLOG); bf16* AA = WSP(bf16, WS_A); bf16* GG = WSP(bf16, WS_G);
    const int tid = F.tid, lane = F.lane, wave = F.wave;
    const int tile_lo0 = (F.vcu * (M / 16)) / F.G, tile_hi0 = ((F.vcu + 1) * (M / 16)) / F.G;
    for (int tile_lo = tile_lo0; tile_lo < tile_hi0; tile_lo += 5) {
    const int ntile = (tile_hi0 - tile_lo) < 5 ? (tile_hi0 - tile_lo) : 5;
    const int m_lo = tile_lo * 16, ntok = ntile * 16;
    __syncthreads();
    {
        const int j = tid & 255, hf = tid >> 8, col = 1536 + j; const float muj = mu[col];
        const int ga = hf == 0 ? 0 : ntile, gb = hf == 0 ? ntile : 2 * ntile;
        float carry = 0.f;
        for (int gi = ga; gi < gb; ++gi) { const int mg = m_lo + 8 * gi;
            float p[8];
#pragma unroll
            for (int t = 0; t < 8; ++t) p[t] = bf2f(P[(size_t)(mg + t) * NIN + col]);
            float prev = (gi == ga || ((mg < MP) ? (mg & (TP - 1)) : ((mg - MP) & (TS - 1))) == 0) ? prev_val(P, sshift, mg, col) : carry;
#pragma unroll
            for (int t = 0; t < 8; ++t) { const float xs = p[t] + (prev - p[t]) * muj; prev = p[t];
                const float f = j < 64 ? tanhf(xs) : (j < 128 ? xs : sigmoidf_(xs));
                *(LAS unsigned short*)(lds + (8 * gi + t) * PP_PITCH + j * 2) = (unsigned short)f2bf(f); }
            carry = p[7]; }
    }
    __syncthreads();
    const int lr = lane & 15, lq = lane >> 4, c0 = 64 * wave;
#pragma unroll 1
    for (int lo = 0; lo < 3; ++lo) {
        const int kin = lo == 0 ? 0 : (lo == 1 ? 64 : 128), nks = lo == 2 ? 4 : 2, wpitch = lo == 2 ? 128 : 64;
        const bf16* Wt = WSP(bf16, WS_LORA) + (lo == 0 ? 0 : (lo == 1 ? 512 * 64 : 2 * 512 * 64));
        f32x4 acc[5][4];
#pragma unroll
        for (int tt = 0; tt < 5; ++tt)
#pragma unroll
            for (int ct = 0; ct < 4; ++ct) acc[tt][ct] = (f32x4){0.f, 0.f, 0.f, 0.f};
        for (int ks = 0; ks < nks; ++ks) {
            bf16x8 wf[4];
#pragma unroll
            for (int ct = 0; ct < 4; ++ct) wf[ct] = *(const bf16x8*)(Wt + (size_t)(c0 + 16 * ct + lr) * wpitch + ks * 32 + lq * 8);
#pragma unroll
            for (int tt = 0; tt < 5; ++tt) if (tt < ntile) {
                const bf16x8 af = *(const LAS bf16x8*)(lds + (16 * tt + lr) * PP_PITCH + (kin + ks * 32 + lq * 8) * 2);
#pragma unroll
                for (int ct = 0; ct < 4; ++ct) acc[tt][ct] = __builtin_amdgcn_mfma_f32_16x16x32_bf16(wf[ct], af, acc[tt][ct], 0, 0, 0);
            }
        }
#pragma unroll
        for (int tt = 0; tt < 5; ++tt) if (tt < ntile) { const int m = m_lo + 16 * tt + lr;
#pragma unroll
            for (int ct = 0; ct < 4; ++ct) { const int c = c0 + 16 * ct + 4 * lq; const f32x4 a = acc[tt][ct];
                if (lo == 0) { const f32x4 w0v = *(const f32x4*)(F.a->in[I_W0] + c); f32x4 o;
#pragma unroll
                    for (int e = 0; e < 4; ++e) { const float z = w0v[e] + a[e]; const float sp = fmaxf(-z, 0.f) + log1pf(expf(-fabsf(z))); o[e] = -expf(-sp - 0.5f); }
                    *(f32x4*)(WLOG + (size_t)m * RW + c) = o; }
                else if (lo == 1) { const f32x4 a0v = *(const f32x4*)(F.a->in[I_A0] + c); f32x4 o;
#pragma unroll
                    for (int e = 0; e < 4; ++e) o[e] = sigmoidf_(a0v[e] + a[e]);
                    *(unsigned long long*)(AA + (size_t)m * RW + c) = pk4(o); }
                else *(unsigned long long*)(GG + (size_t)m * RW + c) = pk4(a); }
        }
    }
    }
}

constexpr int NCOPY = 240;
__device__ __forceinline__ void copy_task(Frame& F, int task) {
    const bf16* P = WSP(bf16, WS_H);
    const int gt = task * 512 + F.tid, NT = NCOPY * 512;
    const float* ck = F.a->in[I_CK]; const float* cv = F.a->in[I_CV];
    for (int i = gt; i < 2 * RWP; i += NT) { const int b = i / RWP, col = i % RWP; F.a->out[O_SHIFT_P + i] = bf2f(P[(size_t)(b * TP + TP - 1) * NIN + col]); }
#pragma unroll 2
    for (int i = gt; i < NBS * RWP; i += NT) { const int b = i / RWP, col = i % RWP; F.a->out[O_SHIFT_S + i] = bf2f(P[(size_t)(MP + b * TS + TS - 1) * NIN + col]); }
    for (int i = gt; i < 2 * 128 * 128; i += NT) { const int b = i >> 14, j = (i >> 7) & 127, c2 = i & 127; const size_t row = (size_t)(b * TP + TP - 128 + j) * NIN;
        F.a->out[O_WINK_P + i] = bf2f(P[row + 2304 + c2]); F.a->out[O_WINV_P + i] = bf2f(P[row + 2432 + c2]); }
#pragma unroll 4
    for (int i = gt; i < NBS * 128 * 128; i += NT) { const int b = i >> 14, j = (i >> 7) & 127, c2 = i & 127;
        if (j < 120) { F.a->out[O_WINK_S + i] = ck[(size_t)(b * 128 + j + 8) * 128 + c2]; F.a->out[O_WINV_S + i] = cv[(size_t)(b * 128 + j + 8) * 128 + c2]; }
        else { const size_t row = (size_t)(MP + b * TS + (j - 120)) * NIN; F.a->out[O_WINK_S + i] = bf2f(P[row + 2304 + c2]); F.a->out[O_WINV_S + i] = bf2f(P[row + 2432 + c2]); } }
}
constexpr int SS_R = 0, SS_DEC = 1, SS_KM = 2, SS_KK = 3, SS_BB = 4, SS_V = 5;
__device__ __forceinline__ void sample_scan_unit(Frame& F, int b) {
    const int h = F.wave, lane = F.lane, chn = h * 64 + lane;
    LAS float* A = (LAS float*)F.lds + h * (6 * 8 * 64);
    const bf16* P = WSP(bf16, WS_H); const float* sshift = F.a->in[I_SSHIFT]; const float* mu = F.a->in[I_MU];
    const float* WLOG = WSP(float, WS_WLOG); const bf16* AA = WSP(bf16, WS_A); const bf16* GG = WSP(bf16, WS_G);
    bf16* MIX = WSP(bf16, WS_U);
    const float mur = mu[chn], muk = mu[RW + chn], muv = mu[2 * RW + chn], kkc = F.a->in[I_KK][chn], kac = F.a->in[I_KA][chn], rkc = F.a->in[I_RK][chn], gnw = F.a->in[I_GNW][chn], gnb = F.a->in[I_GNB][chn];
    __syncthreads();
    float q_r = sshift[(size_t)b * RWP + chn], q_k = sshift[(size_t)b * RWP + RW + chn], q_v = sshift[(size_t)b * RWP + 2 * RW + chn];
#pragma unroll
    for (int t = 0; t < TS; ++t) {
        const int m = MP + b * TS + t; const size_t pr = (size_t)m * NIN;
        const float p_r = bf2f(P[pr + chn]), p_k = bf2f(P[pr + RW + chn]), p_v = bf2f(P[pr + 2 * RW + chn]);
        const float xr = p_r + (q_r - p_r) * mur, xk = p_k + (q_k - p_k) * muk, xv = p_v + (q_v - p_v) * muv;
        q_r = p_r; q_k = p_k; q_v = p_v;
        const float a = bf2f(AA[(size_t)m * RW + chn]), wl = WLOG[(size_t)m * RW + chn];
        const float kq0 = xk * kkc, kk = kq0 * (1.0f / fmaxf(sqrtf(wave_sum_dpp(kq0 * kq0)), 1e-12f));
        A[(SS_R * 8 + t) * 64 + lane] = xr; A[(SS_DEC * 8 + t) * 64 + lane] = expf(wl); A[(SS_KM * 8 + t) * 64 + lane] = xk * (1.0f + (a - 1.0f) * kac);
        A[(SS_KK * 8 + t) * 64 + lane] = kk; A[(SS_BB * 8 + t) * 64 + lane] = kk * a; A[(SS_V * 8 + t) * 64 + lane] = xv;
    }
    f32x4 S[16];
    { const f32x4* sp = (const f32x4*)(F.a->in[I_SWKV] + ((size_t)(b * 8 + h) * 64 + lane) * 64);
#pragma unroll
      for (int q = 0; q < 16; ++q) S[q] = sp[q]; }
    float gate[TS];
#pragma unroll
    for (int t = 0; t < TS; ++t) gate[t] = bf2f(GG[(size_t)(MP + b * TS + t) * RW + chn]);
    LDS_WAIT(); asm volatile("" ::: "memory");
#pragma unroll
    for (int t = 0; t < TS; ++t) {
        const LAS f32x4* pk = (const LAS f32x4*)(A + (SS_KK * 8 + t) * 64); const LAS f32x4* pb = (const LAS f32x4*)(A + (SS_BB * 8 + t) * 64);
        const LAS f32x4* pd = (const LAS f32x4*)(A + (SS_DEC * 8 + t) * 64); const LAS f32x4* pm = (const LAS f32x4*)(A + (SS_KM * 8 + t) * 64);
        const LAS f32x4* pq = (const LAS f32x4*)(A + (SS_R * 8 + t) * 64);
        const float v = A[(SS_V * 8 + t) * 64 + lane];
        f32x4 sa4 = (f32x4){0.f, 0.f, 0.f, 0.f};
#pragma unroll
        for (int q = 0; q < 16; ++q) sa4 += S[q] * pk[q];
        const float sa = (sa4[0] + sa4[1]) + (sa4[2] + sa4[3]);
        f32x4 y4 = (f32x4){0.f, 0.f, 0.f, 0.f};
#pragma unroll
        for (int q = 0; q < 16; ++q) { S[q] = S[q] * pd[q] + (pm[q] * v - pb[q] * sa); y4 += S[q] * pq[q]; }
        const float y = (y4[0] + y4[1]) + (y4[2] + y4[3]);
        const float mean = wave_sum_dpp(y) * (1.f / 64.f), d = y - mean, var = wave_sum_dpp(d * d) * (1.f / 64.f);
        const float yn = d * (1.0f / sqrtf(var + GN_EPS));
        const float dot = wave_sum_dpp(A[(SS_R * 8 + t) * 64 + lane] * A[(SS_KM * 8 + t) * 64 + lane] * rkc);
        const int m = MP + b * TS + t;
        MIX[(size_t)m * D + chn] = (bf16)f2bf((yn * gnw + gnb + dot * v) * gate[t]);
        asm volatile("" ::: "memory");
    }
    { f32x4* so = (f32x4*)(F.a->out + O_WKV_S + ((size_t)(b * 8 + h) * 64 + lane) * 64);
#pragma unroll
      for (int q = 0; q < 16; ++q) so[q] = S[q]; }
}
constexpr int PB = 144, PF = 272;
constexpr int MB16 = 64 * PB, MF32 = 64 * PF;
constexpr size_t WS_GX = 2 * MiB;
constexpr size_t WS_S0 = 167 * MiB;
static_assert(WS_GX + 512 * 32768 <= WS_WIN && WS_H + (size_t)M * NIN * 2 <= WS_S0 && WS_S0 + 512 * 16384 <= WS_WLOG, "scan scratch map");
constexpr int CA_RHS = 0, CA_LB = 34816, CA_KQ = 52224, CA_KD = 61440, CA_BD = 70656, CA_VT = 79872, CA_KET = 89088, CA_BET = 98304, CA_LK = 107520, CA_SMALL = 116736;
constexpr int CC_RHS = 0, CC_LB = 17408, CC_KQ = 34816, CC_RQ = 44032, CC_KD = 53248, CC_BD = 62464, CC_VT = 71680, CC_KET = 80896, CC_BET = 90112, CC_LK = 99328, CC_MK = 108544, CC_MB = 117760,
              CC_SHI = 126976, CC_SLO = 136192, CC_SMALL = 145408;
constexpr int SM_GL = 0, SM_DOT = 256, SM_TOT = 512, SM_BYTES = 512 + 2048;

__device__ __forceinline__ void mm_nt(f32x4 (&acc)[2], const LAS unsigned char* X, const LAS unsigned char* Y, int wave, int lane) {
    const int tr = wave >> 1, tc0 = (wave & 1) * 2, lr = lane & 15, lq = lane >> 4;
#pragma unroll
    for (int ks = 0; ks < 2; ++ks) {
        const bf16x8 xa = *(const LAS bf16x8*)(X + (16 * tr + lr) * PB + ks * 64 + lq * 16);
#pragma unroll
        for (int j = 0; j < 2; ++j) {
            const bf16x8 yb = *(const LAS bf16x8*)(Y + (16 * (tc0 + j) + lr) * PB + ks * 64 + lq * 16);
            acc[j] = __builtin_amdgcn_mfma_f32_16x16x32_bf16(yb, xa, acc[j], 0, 0, 0);
        }
    }
}
#define ACC_ZERO(a) do { a[0] = (f32x4){0.f, 0.f, 0.f, 0.f}; a[1] = (f32x4){0.f, 0.f, 0.f, 0.f}; } while (0)
#define ACC_M(wave, lane) (16 * ((wave) >> 1) + ((lane) & 15))
#define ACC_N(wave, lane, j) (16 * (((wave) & 1) * 2 + (j)) + 4 * ((lane) >> 4))
__device__ __forceinline__ void store_hilo(const f32x4 (&a)[2], LAS unsigned char* HI, LAS unsigned char* LO, int wave, int lane) {
    const int m = ACC_M(wave, lane);
#pragma unroll
    for (int j = 0; j < 2; ++j) { const int n = ACC_N(wave, lane, j);
        const unsigned long long hi = pk4(a[j]); const f32x4 lo = a[j] - bf4_to_f32(hi);
        *(LAS unsigned long long*)(HI + m * PB + n * 2) = hi; *(LAS unsigned long long*)(LO + m * PB + n * 2) = pk4(lo); }
}
template <int NW> __device__ __forceinline__ void tri_solve(const LAS unsigned char* LBT, const LAS unsigned char* RHS, LAS unsigned char* UT, int wave, int lane) {
    if (wave < NW) {
        const int col = wave * 64 + lane;
        f32x4 u[16], lv[8];
#pragma unroll
        for (int q = 0; q < 16; ++q) u[q] = *(const LAS f32x4*)(RHS + col * PF + q * 16);
#define TS_SWEEP(I0, I1, QOFF, QLO)                                                                                                      \
        _Pragma("unroll") for (int q = 0; q < 8; ++q) lv[q] = *(const LAS f32x4*)(LBT + (I0) * PF + (QOFF + q) * 16);                  \
        _Pragma("unroll") for (int i = (I0); i < (I1); ++i) {                                                                            \
            f32x4 ln[8];                                                                                                                 \
            _Pragma("unroll") for (int q = 0; q < 8; ++q) if (i + 1 < (I1) && q >= QLO(i + 1)) ln[q] = *(const LAS f32x4*)(LBT + (i + 1) * PF + (QOFF + q) * 16); \
            asm volatile("" ::: "memory");                                                                                               \
            const float ui = u[i >> 2][i & 3];                                                                                           \
            _Pragma("unroll") for (int q = 0; q < 8; ++q) if (q >= QLO(i)) u[QOFF + q] -= lv[q] * ui;                                    \
            _Pragma("unroll") for (int q = 0; q < 8; ++q) if (i + 1 < (I1) && q >= QLO(i + 1)) lv[q] = ln[q];                            \
        }
#define TS_QLO_A(i) (((i) + 1) >> 2)
#define TS_QLO_B(i) 0
#define TS_QLO_C(i) ((((i) + 1) >> 2) - 8)
        TS_SWEEP(0, 31, 0, TS_QLO_A)
        TS_SWEEP(0, 32, 8, TS_QLO_B)
        TS_SWEEP(32, 63, 8, TS_QLO_C)
#undef TS_SWEEP
#pragma unroll
        for (int q = 0; q < 8; ++q) { v4u w; w.x = pk2(u[2 * q][0], u[2 * q][1]); w.y = pk2(u[2 * q][2], u[2 * q][3]); w.z = pk2(u[2 * q + 1][0], u[2 * q + 1][1]); w.w = pk2(u[2 * q + 1][2], u[2 * q + 1][3]);
            *(LAS v4u*)(UT + col * PB + q * 16) = w; }
    }
}
struct ChunkRaw { unsigned rk[9], vv[5], aa[4]; float wl[8]; };
__device__ __forceinline__ void chunk_load(Frame& F, int m0, int h, ChunkRaw& R) {
    const bf16* P = WSP(bf16, WS_H); const float* WLOG = WSP(float, WS_WLOG); const bf16* AA = WSP(bf16, WS_A);
    const int chn = h * 64 + F.lane, mg = m0 + 8 * F.wave;
    unsigned pv[10], av[8];
    if ((mg & (TP - 1)) == 0) { R.rk[0] = 0u; pv[0] = 0u; }
    else { const size_t o = (size_t)(mg - 1) * NIN; R.rk[0] = (unsigned)P[o + chn] | ((unsigned)P[o + RW + chn] << 16); pv[0] = P[o + 2 * RW + chn]; }
#pragma unroll
    for (int j = 0; j < 8; ++j) { const size_t o = (size_t)(mg + j) * NIN; R.rk[j + 1] = (unsigned)P[o + chn] | ((unsigned)P[o + RW + chn] << 16); pv[j + 1] = P[o + 2 * RW + chn];
        R.wl[j] = WLOG[(size_t)(mg + j) * RW + chn]; av[j] = AA[(size_t)(mg + j) * RW + chn]; }
    pv[9] = 0u;
#pragma unroll
    for (int j = 0; j < 5; ++j) R.vv[j] = pv[2 * j] | (pv[2 * j + 1] << 16);
#pragma unroll
    for (int j = 0; j < 4; ++j) R.aa[j] = av[2 * j] | (av[2 * j + 1] << 16);
}
template <bool PHC> __device__ __forceinline__ void chunk_stage(Frame& F, const ChunkRaw& R, int h, int oKQ, int oRQ, int oKD, int oBD, int oVT, int oKET, int oBET, int oRHS, int oSMALL) {
    LAS unsigned char* lds = F.lds;
    const float* mu = F.a->in[I_MU];
    const int e = F.lane, g = F.wave, chn = h * 64 + e;
    const float mur = mu[chn], muk = mu[RW + chn], muv = mu[2 * RW + chn], kkc = F.a->in[I_KK][chn], kac = F.a->in[I_KA][chn], rkc = F.a->in[I_RK][chn];
    float pr[9], pk[9], pv[9], av[8];
#pragma unroll
    for (int j = 0; j < 9; ++j) { pr[j] = bflo(R.rk[j]); pk[j] = bfhi(R.rk[j]); pv[j] = (j & 1) ? bfhi(R.vv[j >> 1]) : bflo(R.vv[j >> 1]); }
#pragma unroll
    for (int j = 0; j < 8; ++j) av[j] = (j & 1) ? bfhi(R.aa[j >> 1]) : bflo(R.aa[j >> 1]);
    const float (&wl)[8] = R.wl;
    float cw[8]; { float s = 0.f;
#pragma unroll
        for (int j = 0; j < 8; ++j) { s += wl[j]; cw[j] = s; } }
    LAS float* TOT = (LAS float*)(lds + oSMALL + SM_TOT);
    TOT[g * 64 + e] = cw[7];
    __syncthreads();
    float off = 0.f, cwL = 0.f;
#pragma unroll
    for (int gg = 0; gg < 8; ++gg) { const float tv = TOT[gg * 64 + e]; cwL += tv; if (gg < g) off += tv; }
    if (g == 0) ((LAS float*)(lds + oSMALL + SM_GL))[e] = expf(cwL);
    unsigned vt[8], ket[8], bet[8]; float kq[8];
#pragma unroll
    for (int j = 0; j < 8; ++j) {
        const int t = 8 * g + j;
        const float c = off + cw[j];
        const float xr = pr[j + 1] + (pr[j] - pr[j + 1]) * mur, xk = pk[j + 1] + (pk[j] - pk[j + 1]) * muk, xv = pv[j + 1] + (pv[j] - pv[j + 1]) * muv;
        const float kq0 = xk * kkc, kk = kq0 * (1.0f / fmaxf(sqrtf(wave_sum_dpp(kq0 * kq0)), 1e-12f)), km = xk * (1.0f + (av[j] - 1.0f) * kac), bb = kk * av[j];
        const float e1 = expf(c), e2 = 1.0f / e1, e3 = expf(c - wl[j]), e4 = expf(cwL - c);
        kq[j] = kk * e3;
        *(LAS unsigned short*)(lds + oKQ + t * PB + e * 2) = (unsigned short)f2bf(kq[j]);
        *(LAS unsigned short*)(lds + oKD + t * PB + e * 2) = (unsigned short)f2bf(km * e2);
        *(LAS unsigned short*)(lds + oBD + t * PB + e * 2) = (unsigned short)f2bf(bb * e2);
        if (PHC) { *(LAS unsigned short*)(lds + oRQ + t * PB + e * 2) = (unsigned short)f2bf(xr * e1);
            const float d = wave_sum_dpp(xr * km * rkc); if (e == 0) ((LAS float*)(lds + oSMALL + SM_DOT))[t] = d; }
        vt[j] = f2bf(xv); ket[j] = f2bf(km * e4); bet[j] = f2bf(bb * e4);
    }
    { v4u w; w.x = vt[0] | (vt[1] << 16); w.y = vt[2] | (vt[3] << 16); w.z = vt[4] | (vt[5] << 16); w.w = vt[6] | (vt[7] << 16); *(LAS v4u*)(lds + oVT + e * PB + g * 16) = w; }
    { v4u w; w.x = ket[0] | (ket[1] << 16); w.y = ket[2] | (ket[3] << 16); w.z = ket[4] | (ket[5] << 16); w.w = ket[6] | (ket[7] << 16); *(LAS v4u*)(lds + oKET + e * PB + g * 16) = w; }
    { v4u w; w.x = bet[0] | (bet[1] << 16); w.y = bet[2] | (bet[3] << 16); w.z = bet[4] | (bet[5] << 16); w.w = bet[6] | (bet[7] << 16); *(LAS v4u*)(lds + oBET + e * PB + g * 16) = w; }
    if (!PHC) { *(LAS f32x4*)(lds + oRHS + e * PF + g * 32) = (f32x4){kq[0], kq[1], kq[2], kq[3]}; *(LAS f32x4*)(lds + oRHS + e * PF + g * 32 + 16) = (f32x4){kq[4], kq[5], kq[6], kq[7]}; }
}
__device__ __forceinline__ void scanA_task(Frame& F, int task) {
    LAS unsigned char* lds = F.lds; const int wave = F.wave, lane = F.lane;
    const int sc = task & 31, bh = task >> 5, h = bh & 7, b = bh >> 3;
    const int m = ACC_M(wave, lane);
    f32x4 gacc[2], xacc[2];
#pragma unroll
    for (int j = 0; j < 2; ++j) { const int n = ACC_N(wave, lane, j);
#pragma unroll
        for (int r = 0; r < 4; ++r) { gacc[j][r] = (m == n + r) ? 1.f : 0.f; xacc[j][r] = 0.f; } }
    ChunkRaw raw; chunk_load(F, b * TP + sc * 256, h, raw);
    for (int c = 0; c < 4; ++c) {
        __syncthreads();
        chunk_stage<false>(F, raw, h, CA_KQ, 0, CA_KD, CA_BD, CA_VT, CA_KET, CA_BET, CA_RHS, CA_SMALL);
        __syncthreads();
        { f32x4 a[2]; ACC_ZERO(a); mm_nt(a, lds + CA_BD, lds + CA_KQ, wave, lane);
#pragma unroll
          for (int j = 0; j < 2; ++j) { const int n = ACC_N(wave, lane, j); f32x4 o;
#pragma unroll
              for (int r = 0; r < 4; ++r) o[r] = (n + r > m) ? a[j][r] : 0.f;
              *(LAS f32x4*)(lds + CA_LB + m * PF + n * 4) = o; } }
        { f32x4 a[2]; ACC_ZERO(a); mm_nt(a, lds + CA_KQ, lds + CA_KD, wave, lane);
#pragma unroll
          for (int j = 0; j < 2; ++j) { const int n = ACC_N(wave, lane, j); f32x4 o;
#pragma unroll
              for (int r = 0; r < 4; ++r) o[r] = (n + r < m) ? a[j][r] : 0.f;
              *(LAS unsigned long long*)(lds + CA_LK + m * PB + n * 2) = pk4(o); } }
        __syncthreads();
        { f32x4 a[2]; ACC_ZERO(a); mm_nt(a, lds + CA_VT, lds + CA_LK, wave, lane);
#pragma unroll
          for (int j = 0; j < 2; ++j) { const int n = ACC_N(wave, lane, j); *(LAS f32x4*)(lds + CA_RHS + (64 + m) * PF + n * 4) = a[j]; } }
        __syncthreads();
        if (c < 3) chunk_load(F, b * TP + sc * 256 + (c + 1) * 64, h, raw);
        tri_solve<2>(lds + CA_LB, lds + CA_RHS, lds + CA_KD, wave, lane);
        __syncthreads();
        f32x4 pt[2], xc[2];
        { f32x4 a[2]; ACC_ZERO(a); mm_nt(a, lds + CA_BET, lds + CA_KD, wave, lane);
          const LAS float* GL = (const LAS float*)(lds + CA_SMALL + SM_GL);
#pragma unroll
          for (int j = 0; j < 2; ++j) { const int n = ACC_N(wave, lane, j);
#pragma unroll
              for (int r = 0; r < 4; ++r) pt[j][r] = ((m == n + r) ? GL[n + r] : 0.f) - a[j][r]; } }
        { f32x4 a1[2], a2[2]; ACC_ZERO(a1); ACC_ZERO(a2);
          mm_nt(a1, lds + CA_VT, lds + CA_KET, wave, lane); mm_nt(a2, lds + CA_KD + 64 * PB, lds + CA_BET, wave, lane);
          xc[0] = a1[0] - a2[0]; xc[1] = a1[1] - a2[1]; }
        store_hilo(pt, lds + CA_KQ, lds + CA_LK, wave, lane);
        store_hilo(gacc, lds + 0, lds + MB16, wave, lane);
        store_hilo(xacc, lds + 2 * MB16, lds + 3 * MB16, wave, lane);
        __syncthreads();
        { f32x4 a[2]; ACC_ZERO(a);
          mm_nt(a, lds + 0, lds + CA_KQ, wave, lane); mm_nt(a, lds + 0, lds + CA_LK, wave, lane); mm_nt(a, lds + MB16, lds + CA_KQ, wave, lane);
          gacc[0] = a[0]; gacc[1] = a[1]; }
        { f32x4 a[2]; a[0] = xc[0]; a[1] = xc[1];
          mm_nt(a, lds + 2 * MB16, lds + CA_KQ, wave, lane); mm_nt(a, lds + 2 * MB16, lds + CA_LK, wave, lane); mm_nt(a, lds + 3 * MB16, lds + CA_KQ, wave, lane);
          xacc[0] = a[0]; xacc[1] = a[1]; }
    }
    float* GT = (float*)(F.a->ws + WS_GX + (size_t)task * 32768); float* XO = GT + 4096;
#pragma unroll
    for (int j = 0; j < 2; ++j) { const int n = ACC_N(wave, lane, j);
#pragma unroll
        for (int r = 0; r < 4; ++r) GT[(n + r) * 64 + m] = gacc[j][r];
        *(f32x4*)(XO + m * 64 + n) = xacc[j]; }
}
__device__ __forceinline__ void scanB_unit(Frame& F, int bh) {
    LAS unsigned char* lds = F.lds; const int wave = F.wave, lane = F.lane, tid = F.tid, lr = lane & 15, lq = lane >> 4;
    constexpr int GTB = 2 * MB16;
    LAS unsigned char* myS = lds + 2 * GTB + wave * (2 * 16 * PB);
    const int row = tid >> 3, c8 = (tid & 7) * 8;
    const float* G0 = (const float*)(F.a->ws + WS_GX + (size_t)(bh * 32) * 32768);
#define SB_PUT(buf, ga, gb) do { const unsigned long long h0_ = pk4(ga), h1_ = pk4(gb); const f32x4 l0_ = ga - bf4_to_f32(h0_), l1_ = gb - bf4_to_f32(h1_); const unsigned long long q0_ = pk4(l0_), q1_ = pk4(l1_); \
        *(LAS v4u*)(lds + (buf) * GTB + row * PB + c8 * 2) = (v4u){(unsigned)h0_, (unsigned)(h0_ >> 32), (unsigned)h1_, (unsigned)(h1_ >> 32)}; \
        *(LAS v4u*)(lds + (buf) * GTB + MB16 + row * PB + c8 * 2) = (v4u){(unsigned)q0_, (unsigned)(q0_ >> 32), (unsigned)q1_, (unsigned)(q1_ >> 32)}; } while (0)
    f32x4 g0 = *(const f32x4*)(G0 + row * 64 + c8), g1 = *(const f32x4*)(G0 + row * 64 + c8 + 4);
    __syncthreads();
    SB_PUT(0, g0, g1);
    g0 = *(const f32x4*)(G0 + 8192 + row * 64 + c8); g1 = *(const f32x4*)(G0 + 8192 + row * 64 + c8 + 4);
    f32x4 s[4], x[4];
#pragma unroll
    for (int tc = 0; tc < 4; ++tc) { s[tc] = (f32x4){0.f, 0.f, 0.f, 0.f}; x[tc] = s[tc]; }
    const int vrow = 16 * (wave & 3) + lr;
    if (wave < 4) {
#pragma unroll
        for (int tc = 0; tc < 4; ++tc) x[tc] = *(const f32x4*)(G0 + 4096 + vrow * 64 + 16 * tc + 4 * lq); }
    __syncthreads();
    for (int sc = 0; sc < 32; ++sc) {
        const int task = bh * 32 + sc;
        if (wave < 4) {
            float* S0 = (float*)(F.a->ws + WS_S0 + (size_t)task * 16384);
#pragma unroll
            for (int tc = 0; tc < 4; ++tc) { *(f32x4*)(S0 + vrow * 64 + 16 * tc + 4 * lq) = s[tc];
                const unsigned long long hi = pk4(s[tc]); const f32x4 lo = s[tc] - bf4_to_f32(hi);
                *(LAS unsigned long long*)(myS + lr * PB + (16 * tc + 4 * lq) * 2) = hi; *(LAS unsigned long long*)(myS + 16 * PB + lr * PB + (16 * tc + 4 * lq) * 2) = pk4(lo); }
            f32x4 a[4];
#pragma unroll
            for (int tc = 0; tc < 4; ++tc) a[tc] = x[tc];
            if (sc + 1 < 32) { const float* Xn = (const float*)(F.a->ws + WS_GX + (size_t)(task + 1) * 32768) + 4096;
#pragma unroll
                for (int tc = 0; tc < 4; ++tc) x[tc] = *(const f32x4*)(Xn + vrow * 64 + 16 * tc + 4 * lq); }
            LDS_WAIT(); asm volatile("" ::: "memory");
            const LAS unsigned char* gb = lds + (sc & 1) * GTB;
#pragma unroll
            for (int ks = 0; ks < 2; ++ks) {
                const bf16x8 xh = *(const LAS bf16x8*)(myS + lr * PB + ks * 64 + lq * 16), xl = *(const LAS bf16x8*)(myS + 16 * PB + lr * PB + ks * 64 + lq * 16);
#pragma unroll
                for (int tc = 0; tc < 4; ++tc) {
                    const bf16x8 yh = *(const LAS bf16x8*)(gb + (16 * tc + lr) * PB + ks * 64 + lq * 16), yl = *(const LAS bf16x8*)(gb + MB16 + (16 * tc + lr) * PB + ks * 64 + lq * 16);
                    a[tc] = __builtin_amdgcn_mfma_f32_16x16x32_bf16(yh, xh, a[tc], 0, 0, 0);
                    a[tc] = __builtin_amdgcn_mfma_f32_16x16x32_bf16(yl, xh, a[tc], 0, 0, 0);
                    a[tc] = __builtin_amdgcn_mfma_f32_16x16x32_bf16(yh, xl, a[tc], 0, 0, 0);
                }
            }
#pragma unroll
            for (int tc = 0; tc < 4; ++tc) s[tc] = a[tc];
        }
        if (sc + 1 < 32) SB_PUT((sc + 1) & 1, g0, g1);
        if (sc + 2 < 32) { const float* Gn = (const float*)(F.a->ws + WS_GX + (size_t)(task + 2) * 32768); g0 = *(const f32x4*)(Gn + row * 64 + c8); g1 = *(const f32x4*)(Gn + row * 64 + c8 + 4); }
        __syncthreads();
    }
#undef SB_PUT
}
__device__ __forceinline__ void scanC_task(Frame& F, int task) {
    LAS unsigned char* lds = F.lds; const int wave = F.wave, lane = F.lane;
    const int sc = task & 31, bh = task >> 5, h = bh & 7, b = bh >> 3;
    const int m = ACC_M(wave, lane);
    const bf16* GG = WSP(bf16, WS_G); bf16* MIX = WSP(bf16, WS_U);
    const int chn = h * 64 + lane; const float gnw = F.a->in[I_GNW][chn], gnb = F.a->in[I_GNB][chn];
    f32x4 s[2];
    { const float* S0 = (const float*)(F.a->ws + WS_S0 + (size_t)task * 16384);
#pragma unroll
      for (int j = 0; j < 2; ++j) { const int n = ACC_N(wave, lane, j); s[j] = *(const f32x4*)(S0 + m * 64 + n); } }
    ChunkRaw raw; chunk_load(F, b * TP + sc * 256, h, raw);
    for (int c = 0; c < 4; ++c) {
        const int m0 = b * TP + sc * 256 + c * 64;
        __syncthreads();
        chunk_stage<true>(F, raw, h, CC_KQ, CC_RQ, CC_KD, CC_BD, CC_VT, CC_KET, CC_BET, 0, CC_SMALL);
        store_hilo(s, lds + CC_SHI, lds + CC_SLO, wave, lane);
        __syncthreads();
        { f32x4 a[2]; ACC_ZERO(a); mm_nt(a, lds + CC_BD, lds + CC_KQ, wave, lane);
#pragma unroll
          for (int j = 0; j < 2; ++j) { const int n = ACC_N(wave, lane, j); f32x4 o;
#pragma unroll
              for (int r = 0; r < 4; ++r) o[r] = (n + r > m) ? a[j][r] : 0.f;
              *(LAS f32x4*)(lds + CC_LB + m * PF + n * 4) = o; } }
        { f32x4 a[2]; ACC_ZERO(a); mm_nt(a, lds + CC_KQ, lds + CC_KD, wave, lane);
#pragma unroll
          for (int j = 0; j < 2; ++j) { const int n = ACC_N(wave, lane, j); f32x4 o;
#pragma unroll
              for (int r = 0; r < 4; ++r) o[r] = (n + r < m) ? a[j][r] : 0.f;
              *(LAS unsigned long long*)(lds + CC_LK + m * PB + n * 2) = pk4(o); } }
        { f32x4 a[2], a2[2]; ACC_ZERO(a); ACC_ZERO(a2); mm_nt(a, lds + CC_RQ, lds + CC_KD, wave, lane); mm_nt(a2, lds + CC_RQ, lds + CC_BD, wave, lane);
#pragma unroll
          for (int j = 0; j < 2; ++j) { const int n = ACC_N(wave, lane, j); f32x4 o, o2;
#pragma unroll
              for (int r = 0; r < 4; ++r) { o[r] = (n + r <= m) ? a[j][r] : 0.f; o2[r] = (n + r <= m) ? a2[j][r] : 0.f; }
              *(LAS unsigned long long*)(lds + CC_MK + m * PB + n * 2) = pk4(o); *(LAS unsigned long long*)(lds + CC_MB + m * PB + n * 2) = pk4(o2); } }
        __syncthreads();
        { f32x4 a[2]; ACC_ZERO(a);
          mm_nt(a, lds + CC_SHI, lds + CC_KQ, wave, lane); mm_nt(a, lds + CC_SLO, lds + CC_KQ, wave, lane); mm_nt(a, lds + CC_VT, lds + CC_LK, wave, lane);
#pragma unroll
          for (int j = 0; j < 2; ++j) { const int n = ACC_N(wave, lane, j); *(LAS f32x4*)(lds + CC_RHS + m * PF + n * 4) = a[j]; } }
        __syncthreads();
        unsigned gq[8];
#pragma unroll
        for (int i8 = 0; i8 < 8; ++i8) gq[i8] = GG[(size_t)(m0 + wave + 8 * i8) * RW + chn];
        if (c < 3) chunk_load(F, m0 + 64, h, raw);
        tri_solve<1>(lds + CC_LB, lds + CC_RHS, lds + CC_KD, wave, lane);
        __syncthreads();
        { f32x4 a[2], a2[2]; ACC_ZERO(a); ACC_ZERO(a2);
          mm_nt(a, lds + CC_RQ, lds + CC_SHI, wave, lane); mm_nt(a, lds + CC_RQ, lds + CC_SLO, wave, lane); mm_nt(a, lds + CC_MK, lds + CC_VT, wave, lane);
          mm_nt(a2, lds + CC_MB, lds + CC_KD, wave, lane);
#pragma unroll
          for (int j = 0; j < 2; ++j) { const int n = ACC_N(wave, lane, j); *(LAS f32x4*)(lds + CC_LB + m * PF + n * 4) = a[j] - a2[j]; } }
        { f32x4 a1[2], a2[2]; ACC_ZERO(a1); ACC_ZERO(a2);
          mm_nt(a1, lds + CC_VT, lds + CC_KET, wave, lane); mm_nt(a2, lds + CC_KD, lds + CC_BET, wave, lane);
          const LAS float* GL = (const LAS float*)(lds + CC_SMALL + SM_GL);
#pragma unroll
          for (int j = 0; j < 2; ++j) { const int n = ACC_N(wave, lane, j); const f32x4 gl = *(const LAS f32x4*)(GL + n); s[j] = s[j] * gl + a1[j] - a2[j]; } }
        __syncthreads();
#pragma unroll
        for (int i8 = 0; i8 < 8; ++i8) {
            const int t = wave + 8 * i8, mm = m0 + t;
            const float y = *(const LAS float*)(lds + CC_LB + t * PF + lane * 4);
            const float mean = wave_sum_dpp(y) * (1.f / 64.f), d = y - mean, var = wave_sum_dpp(d * d) * (1.f / 64.f);
            const float yn = d * (1.0f / sqrtf(var + GN_EPS));
            const float dot = ((const LAS float*)(lds + CC_SMALL + SM_DOT))[t];
            const float v = bf2f(*(const LAS unsigned short*)(lds + CC_VT + lane * PB + t * 2));
            const float gg = bf2f((unsigned short)gq[i8]);
            MIX[(size_t)mm * D + chn] = (bf16)f2bf((yn * gnw + gnb + dot * v) * gg);
        }
    }
    if (sc == 31) { float* so = F.a->out + O_WKV_P + (size_t)bh * 4096;
#pragma unroll
        for (int j = 0; j < 2; ++j) { const int n = ACC_N(wave, lane, j); *(f32x4*)(so + m * 64 + n) = s[j]; } }
}
__device__ __forceinline__ int rel_bucket(int n) {
    if (n < 16) return n;
    const int b = 16 + (int)(logf((float)n * (1.0f / 16.0f)) / 2.0794415416798357f * 16.0f);
    return b < 31 ? b : 31;
}
typedef float f32x16 __attribute__((ext_vector_type(16)));
typedef short s16x4 __attribute__((ext_vector_type(4)));
struct AttnLane { const bf16* qrow; int qrel; int rmin; const LAS float* btab; float sink; bf16* orow; };
__device__ __forceinline__ void attn_core32(const LAS unsigned char* Kl, const LAS unsigned char* Vt, int VTP, int kt0, const AttnLane L, int lane) {
    const int r = lane & 31, h = lane >> 5;
    bf16x8 qf[4];
#pragma unroll
    for (int ds = 0; ds < 4; ++ds) qf[ds] = *(const bf16x8*)(L.qrow + 16 * ds + 8 * h);
    f32x16 sc[5];
#pragma unroll
    for (int T = 0; T < 5; ++T) {
#pragma unroll
        for (int e = 0; e < 16; ++e) sc[T][e] = 0.f;
#pragma unroll
        for (int ds = 0; ds < 4; ++ds) { const bf16x8 kf = *(const LAS bf16x8*)(Kl + ((kt0 + T) * 32 + r) * 144 + (16 * ds + 8 * h) * 2);
            sc[T] = __builtin_amdgcn_mfma_f32_32x32x16_bf16(kf, qf[ds], sc[T], 0, 0, 0); }
    }
    float mx = L.sink;
#pragma unroll
    for (int T = 0; T < 5; ++T)
#pragma unroll
        for (int e = 0; e < 16; ++e) { const int rabs = (kt0 + T) * 32 + (e & 3) + 8 * (e >> 2) + 4 * h, dist = L.qrel - rabs;
            const bool valid = dist >= 0 && dist < 128 && rabs >= L.rmin;
            const float s = valid ? sc[T][e] * 0.125f + L.btab[dist & 127] : -1e30f;
            sc[T][e] = s; mx = fmaxf(mx, s); }
    mx = fmaxf(mx, __shfl_xor(mx, 32));
    float l = 0.f;
#pragma unroll
    for (int T = 0; T < 5; ++T)
#pragma unroll
        for (int e = 0; e < 16; ++e) { const float p = sc[T][e] > -1e29f ? __expf(sc[T][e] - mx) : 0.f; sc[T][e] = p; l += p; }
    l += __shfl_xor(l, 32);
    l += __expf(L.sink - mx);
    f32x16 o[2];
#pragma unroll
    for (int e = 0; e < 16; ++e) { o[0][e] = 0.f; o[1][e] = 0.f; }
#pragma unroll
    for (int T = 0; T < 5; ++T)
#pragma unroll
        for (int s2 = 0; s2 < 2; ++s2) {
            v4u pw; pw.x = pk2(sc[T][8 * s2], sc[T][8 * s2 + 1]); pw.y = pk2(sc[T][8 * s2 + 2], sc[T][8 * s2 + 3]); pw.z = pk2(sc[T][8 * s2 + 4], sc[T][8 * s2 + 5]); pw.w = pk2(sc[T][8 * s2 + 6], sc[T][8 * s2 + 7]);
            const bf16x8 pb = __builtin_bit_cast(bf16x8, pw);
#pragma unroll
            for (int dt = 0; dt < 2; ++dt) {
                const LAS unsigned char* vp = Vt + (32 * dt + r) * VTP + ((kt0 + T) * 32 + 16 * s2 + 4 * h) * 2;
                const s16x4 lo = *(const LAS s16x4*)vp, hi = *(const LAS s16x4*)(vp + 16);
                const bf16x8 va = (bf16x8){lo[0], lo[1], lo[2], lo[3], hi[0], hi[1], hi[2], hi[3]};
                o[dt] = __builtin_amdgcn_mfma_f32_32x32x16_bf16(va, pb, o[dt], 0, 0, 0);
            }
        }
    const float il = 1.0f / l;
#pragma unroll
    for (int dt = 0; dt < 2; ++dt)
#pragma unroll
        for (int gq = 0; gq < 4; ++gq) { const int d = 32 * dt + 8 * gq + 4 * h;
            const unsigned long long w = (unsigned long long)pk2(o[dt][4 * gq] * il, o[dt][4 * gq + 1] * il) | ((unsigned long long)pk2(o[dt][4 * gq + 2] * il, o[dt][4 * gq + 3] * il) << 32);
            *(unsigned long long*)(L.orow + d) = w; }
}
constexpr int AP_K = 0, AP_VTP = 528, AP_VT = 256 * 144, AP_BT = AP_VT + 64 * AP_VTP, AP_END = AP_BT + 4 * 128 * 4;
__device__ __forceinline__ void attn_prompt_unit(Frame& F, int b, int kvh, int qb) {
    LAS unsigned char* lds = F.lds;
    const bf16* P = WSP(bf16, WS_H); bf16* MIX = WSP(bf16, WS_U); const float* relb = F.a->in[I_RELB];
    const int t0 = qb * 128, tid = F.tid;
    __syncthreads();
    for (int idx = tid; idx < 256 * 8; idx += 512) {
        const int row = idx >> 3, part = idx & 7, pos = t0 - 128 + row;
        v4u val = (v4u){0u, 0u, 0u, 0u};
        if (pos >= 0) val = *(const v4u*)(P + (size_t)(b * TP + pos) * NIN + 2304 + kvh * 64 + part * 8);
        *(LAS v4u*)(lds + AP_K + row * 144 + part * 16) = val;
    }
    for (int idx = tid; idx < 256 * 8; idx += 512) {
        const int row = idx & 255, part = idx >> 8, pos = t0 - 128 + row;
        v4u val = (v4u){0u, 0u, 0u, 0u};
        if (pos >= 0) val = *(const v4u*)(P + (size_t)(b * TP + pos) * NIN + 2432 + kvh * 64 + part * 8);
#pragma unroll
        for (int e = 0; e < 4; ++e) { *(LAS unsigned short*)(lds + AP_VT + (part * 8 + 2 * e) * AP_VTP + row * 2) = (unsigned short)(val[e] & 0xffffu);
                                      *(LAS unsigned short*)(lds + AP_VT + (part * 8 + 2 * e + 1) * AP_VTP + row * 2) = (unsigned short)(val[e] >> 16); }
    }
    { const int g = tid >> 7, dist = tid & 127; ((LAS float*)(lds + AP_BT))[g * 128 + dist] = relb[rel_bucket(dist) * 8 + kvh * 4 + g]; }
    __syncthreads();
    const int g = F.wave & 3, qh = F.wave >> 2, hq = kvh * 4 + g;
#pragma unroll 1
    for (int bq = 0; bq < 2; ++bq) {
        const int i = 64 * qh + 32 * bq + (F.lane & 31), m = b * TP + t0 + i;
        AttnLane L; L.qrow = P + (size_t)m * NIN + RWP + hq * 64; L.qrel = i + 128; L.rmin = t0 == 0 ? 128 : 0;
        L.btab = (const LAS float*)(lds + AP_BT) + g * 128; L.sink = F.a->in[I_SINKS][hq]; L.orow = MIX + (size_t)m * D + RW + hq * 64;
        attn_core32(lds + AP_K, lds + AP_VT, AP_VTP, 2 * qh + bq, L, F.lane);
    }
}
static_assert(AP_END <= RING_BYTES && AP_VT % 16 == 0 && CC_SMALL + SM_BYTES <= RING_BYTES && CA_SMALL + SM_BYTES <= RING_BYTES, "LDS maps");
constexpr int AS_KB = 160 * 144, AS_VTP = 336, AS_VT = 2 * AS_KB, AS_VB = 64 * AS_VTP, AS_BT = AS_VT + 2 * AS_VB, AS_END = AS_BT + 8 * 128 * 4;
static_assert(AS_END <= RING_BYTES && AS_VT % 16 == 0 && AS_VB % 16 == 0, "LDS maps");
__device__ __forceinline__ void attn_sample_unit(Frame& F, int b) {
    LAS unsigned char* lds = F.lds;
    const bf16* P = WSP(bf16, WS_H); bf16* MIX = WSP(bf16, WS_U); const float* relb = F.a->in[I_RELB]; const float* ck = F.a->in[I_CK]; const float* cv = F.a->in[I_CV];
    const int tid = F.tid;
    __syncthreads();
    for (int idx = tid; idx < 160 * 32; idx += 512) {
        const int j = idx >> 5, c4 = (idx & 31) * 4, kvh = c4 >> 6, d = c4 & 63;
        f32x4 kx = (f32x4){0.f, 0.f, 0.f, 0.f}, vx = kx;
        if (j < 128) { kx = *(const f32x4*)(ck + (size_t)(b * 128 + j) * 128 + c4); vx = *(const f32x4*)(cv + (size_t)(b * 128 + j) * 128 + c4); }
        else if (j < 136) { const bf16* pr = P + (size_t)(MP + b * TS + (j - 128)) * NIN;
            const unsigned long long kw = *(const unsigned long long*)(pr + 2304 + c4), vw = *(const unsigned long long*)(pr + 2432 + c4); kx = bf4_to_f32(kw); vx = bf4_to_f32(vw); }
        *(LAS unsigned long long*)(lds + kvh * AS_KB + j * 144 + d * 2) = pk4(kx);
#pragma unroll
        for (int e = 0; e < 4; ++e) *(LAS unsigned short*)(lds + AS_VT + kvh * AS_VB + (d + e) * AS_VTP + j * 2) = (unsigned short)f2bf(vx[e]);
    }
    for (int idx = tid; idx < 1024; idx += 512) { const int hq = idx >> 7, dist = idx & 127; ((LAS float*)(lds + AS_BT))[idx] = relb[rel_bucket(dist) * 8 + hq]; }
    __syncthreads();
    if (F.wave < 2) {
        const int kvh = F.wave, rr = F.lane & 31, g = rr >> 3, t = rr & 7, hq = kvh * 4 + g, m = MP + b * TS + t;
        AttnLane L; L.qrow = P + (size_t)m * NIN + RWP + hq * 64; L.qrel = t + 128; L.rmin = 0;
        L.btab = (const LAS float*)(lds + AS_BT) + hq * 128; L.sink = F.a->in[I_SINKS][hq]; L.orow = MIX + (size_t)m * D + RW + hq * 64;
        attn_core32(lds + kvh * AS_KB, lds + AS_VT + kvh * AS_VB, AS_VTP, 0, L, F.lane);
    }
}
__device__ __forceinline__ void mixer_task(Frame& F0, int t) {
    Frame F = F0;
    { int t_ = threadIdx.x; asm volatile("" : "+v"(t_)); F.tid = t_; F.lane = t_ & 63; F.wave = __builtin_amdgcn_readfirstlane(t_ >> 6); }
#ifndef REP_PHASE
#define REP_PHASE -1
#endif
    if (t < 16) { scanB_unit(F, t); if (REP_PHASE == 108) scanB_unit(F, t); }
    else if (t < 272) { const int u = t - 16; attn_prompt_unit(F, u >> 7, (u >> 6) & 1, u & 63); if (REP_PHASE == 208) attn_prompt_unit(F, u >> 7, (u >> 6) & 1, u & 63); }
    else if (t < 400) { sample_scan_unit(F, t - 272); if (REP_PHASE == 308) sample_scan_unit(F, t - 272); }
    else if (t < 528) { attn_sample_unit(F, t - 400); if (REP_PHASE == 408) attn_sample_unit(F, t - 400); }
    else { copy_task(F, t - 528); if (REP_PHASE == 508) copy_task(F, t - 528); }
}
__device__ __forceinline__ void p_mixer(Frame& F) {
    int t = F.vcu, step = F.G, end = 528 + NCOPY;
    if (F.G >= 32) { if (F.vcu < 16) { step = 1 << 20; end = 16; } else step = F.G - 16; }
    for (; t < end; t += step) mixer_task(F, t);
    __syncthreads();
}
__device__ __forceinline__ void p_scanA(Frame& F) { for (int t = F.vcu; t < 512; t += F.G) scanA_task(F, t); __syncthreads(); }
__device__ __forceinline__ void p_scanC(Frame& F) { for (int t = F.vcu; t < 512; t += F.G) scanC_task(F, t); __syncthreads(); }
#ifndef MK_PER_PHASE
#define MK_PER_PHASE 0
#endif
constexpr int N_PHASES = 15;
__global__ void __launch_bounds__(NWAVES * 64, 2) fwd_kernel(Args args) {
    extern __shared__ __attribute__((aligned(16))) unsigned char lds[];
    Frame F;
    F.lds = (LAS unsigned char*)lds;
    F.MISC = (volatile LAS unsigned*)(F.lds + MISC_OFF);
    F.tid = threadIdx.x; F.lane = F.tid & 63; F.wave = __builtin_amdgcn_readfirstlane(F.tid >> 6);
    F.G = gridDim.x; { const int bx = blockIdx.x; F.vcu = (F.G % 8 == 0) ? (bx % 8) * (F.G / 8) + bx / 8 : bx; }
    F.a = &args; F.ctl = (gu32*)(args.ws + WS_CTL);
    for (int u = F.tid; u < (LDS_BYTES - LDSCTL_OFF) / 4; u += NWAVES * 64) ((LAS unsigned*)(F.lds + LDSCTL_OFF))[u] = 0u;
    __syncthreads();
    const int lo = args.ph_lo, hi = args.ph_hi;
    XcdBarrier bar; bar.bar = (unsigned*)(F.ctl + CW_BAR); bar.x = 0; bar.st = nullptr;
    if (hi - lo > 1) bar = xcd_barrier_post((unsigned*)(F.ctl + CW_BAR), F.MISC + 8);
#ifdef ONLY_PHASE
#define IN(k) ((k) == ONLY_PHASE && lo <= (k) && (k) < hi)
#else
#define IN(k) (lo <= (k) && (k) < hi)
#endif
#ifndef REP_PHASE
#define REP_PHASE -1
#endif
#define SEAM(k) do { if ((k) + 1 < hi) xcd_barrier(bar); } while (0)
#define PH(k, BODY) if (IN(k)) { BODY; if ((k) == REP_PHASE) { xcd_barrier(bar); BODY; } SEAM(k); }
#define GEMM_SWIGLU(WOFF) { \
        pg8::Gemm g{WSP(bf16, WS_U), WSP(bf16, WOFF), M, NFF, D}; pg8::StaticOrder S; S.init(M, NFF, F.G, (int)blockIdx.x, D); \
        pg8::EpiSwiglu E{WSP(bf16, WS_H), FF}; \
        pg8::gemm_phase<pg8::EpiSwiglu, pg8::StaticOrder, true, true>(F.lds + RING_OFF, g, S, E); }
#define GEMM_RESID(AOFF, WOFF, KK, XP, XS, GTK, GS) { \
        pg8::Gemm g{WSP(bf16, AOFF), WSP(bf16, WOFF), M, D, KK}; pg8::SliceOrder S; S.init(KK, F.G, (int)blockIdx.x); \
        pg8::EpiResid<GS> E{XP, XS, args.out + O_Y, WSP(float, WS_MOD) + (GTK) * D, WSP(float, WS_WLOG)}; \
        pg8::gemm_phase<pg8::EpiResid<GS>, pg8::SliceOrder, true, true>(F.lds + RING_OFF, g, S, E); }
#define GEMM_WIN() { \
        pg8::Gemm g{WSP(bf16, WS_U), WSP(bf16, WS_WIN), M, NIN, D}; pg8::StaticOrder S; S.init(M, NIN, F.G, (int)blockIdx.x, D); \
        pg8::EpiBf16<0> E{WSP(bf16, WS_H), NIN, nullptr, 0, 0, 1.f}; \
        pg8::gemm_phase<pg8::EpiBf16<0>, pg8::StaticOrder, true, true>(F.lds + RING_OFF, g, S, E); }
    PH(0, { p0_weights(F); if (REP_PHASE == 100) { __syncthreads(); p0_weights(F); } __syncthreads(); p0_mod(F); if (REP_PHASE == 101) { __syncthreads(); p0_mod(F); } })
    PH(1, p_modulate0(F))
    PH(2, GEMM_SWIGLU(WS_W1IN))
    PH(3, GEMM_RESID(WS_H, WS_W1OUT, FF, args.in[I_XP], args.in[I_XS], 2, 1))
    PH(4, p_layernorm(F, 0, 3 * D, FF / 256, args.in[I_XS], 2, 0.5f))
    PH(5, GEMM_WIN())
    PH(6, p_prep(F))
    PH(7, p_scanA(F))
    PH(8, p_mixer(F))
    PH(9, p_scanC(F))
    PH(10, GEMM_RESID(WS_U, WS_WOUT, D, args.out + O_Y, args.out + O_Y + (size_t)MP * D, 5, 2))
    PH(11, p_layernorm(F, 1, 6 * D, D / 256, args.out + O_Y + (size_t)MP * D, 5, 1.0f))
    PH(12, GEMM_SWIGLU(WS_W2IN))
    PH(13, GEMM_RESID(WS_H, WS_W2OUT, FF, args.out + O_Y, args.out + O_Y + (size_t)MP * D, 8, 1))
    PH(14, p_layernorm(F, 2, -1, FF / 256, args.out + O_Y + (size_t)MP * D, 8, 0.5f))
}

extern "C" void kernel_launch(void* const* d_in, const int* in_sizes, int n_in, void* d_out, int out_size, void* d_ws, size_t ws_size, hipStream_t stream) {
    static int grid = 0;
    if (grid == 0) {
        if (n_in != N_IN || in_sizes[0] != MP * D || out_size != (int)O_END || ws_size < WS_END) { fprintf(stderr, "kernel_launch: unexpected shapes (n_in %d, out %d, ws %zu); nothing launched\n", n_in, out_size, ws_size); grid = -1; return; }
        int dev = 0, cus = 0;
        if (hipGetDevice(&dev) != hipSuccess || hipDeviceGetAttribute(&cus, hipDeviceAttributeMultiprocessorCount, dev) != hipSuccess) { grid = -1; return; }
        if (hipFuncSetAttribute((const void*)fwd_kernel, hipFuncAttributeMaxDynamicSharedMemorySize, LDS_BYTES) != hipSuccess) { fprintf(stderr, "kernel_launch: hipFuncSetAttribute failed\n"); grid = -1; return; }
        int per_cu = 0;
        if (hipOccupancyMaxActiveBlocksPerMultiprocessor(&per_cu, (const void*)fwd_kernel, NWAVES * 64, LDS_BYTES) != hipSuccess || per_cu < 1) fprintf(stderr, "kernel_launch: occupancy query reports %d\n", per_cu);
        (void)hipGetLastError();
        grid = cus;
    }
    if (grid < 0) return;
    if (hipMemsetAsync((char*)d_ws + WS_CTL, 0, CTL_ZERO_BYTES, stream) != hipSuccess) return;
    Args a{};
    for (int i = 0; i < N_IN; ++i) a.in[i] = (const float*)d_in[i];
    a.out = (float*)d_out; a.ws = (unsigned char*)d_ws;
#if MK_PER_PHASE
    for (int ph = 0; ph < N_PHASES; ++ph) { a.ph_lo = ph; a.ph_hi = ph + 1; hipLaunchKernelGGL(fwd_kernel, dim3(grid), dim3(NWAVES * 64), LDS_BYTES, stream, a); }
#else
    a.ph_lo = 0; a.ph_hi = N_PHASES;
    hipLaunchKernelGGL(fwd_kernel, dim3(grid), dim3(NWAVES * 64), LDS_BYTES, stream, a);
#endif
}
```

```cpp
#define MK_PER_PHASE 0

#include <hip/hip_runtime.h>
#include <cstdio>
#include <cstdint>
#include <cmath>
namespace pg8 {
#define PG8_LAS __attribute__((address_space(3)))
typedef unsigned short bf16_t;
typedef short bf16x8 __attribute__((ext_vector_type(8)));
typedef float f32x4 __attribute__((ext_vector_type(4)));
typedef unsigned u32x4 __attribute__((ext_vector_type(4)));
constexpr int BM = 256, BK = 64, HALF = 128, HTB = HALF * BK * 2  , STAGE_BYTES = 8 * HTB, NXCD = 8, WGM = 8;

__host__ __device__ __forceinline__ int lds_byte(int r, int c) { const int st = (r >> 4) * 2 + (c >> 5), rr = r & 15, cc = c & 31, ob = rr * 64 + cc * 2; return st * 1024 + (ob ^ (((ob >> 9) & 1) << 5)); }
__host__ __device__ __forceinline__ void stage_rc(int b, int& R, int& C) { const int st = b / 1024, sb = b % 1024, swz = sb ^ (((sb >> 9) & 1) << 5); R = (st >> 1) * 16 + swz / 64; C = (st & 1) * 32 + (swz % 64) / 2; }
__host__ __device__ __forceinline__ int perm32(int rho) { const int n = rho >> 4, i = rho & 15; return 8 * (i >> 2) + 4 * n + (i & 3); }

struct Unit { int pm, pn, kt0, nt, ks; };
struct Gemm { const bf16_t* A; const bf16_t* Bt; int M, N, K; };

struct StaticOrder {
    int nM, nN, nwg, G, c;
    int ntk;
    __host__ __device__ void init(int M, int N, int G_, int c_, int K = 0) { nM = M / BM; nN = N / BM; nwg = nM * nN; G = G_; c = c_; ntk = K / BK; }
    __host__ __device__ bool next(int i, Unit& u) const {
        const long L = (long)i * G + c; if (L >= nwg) return false;
        int wgid = (int)L; { const int q = nwg / NXCD, r = nwg % NXCD, xcd = wgid % NXCD, off = wgid / NXCD; wgid = (xcd < r ? xcd * (q + 1) : r * (q + 1) + (xcd - r) * q) + off; }
        const int nig = WGM * nN, gid = wgid / nig, fm = gid * WGM, gsz = (nM - fm) < WGM ? (nM - fm) : WGM;
        u.pm = fm + ((wgid % nig) % gsz); u.pn = (wgid % nig) / gsz; u.kt0 = 0; u.nt = ntk; u.ks = -1; return true;
    }
    __device__ __forceinline__ void a_ready(const Unit&) const {}
    __device__ __forceinline__ void done(const Unit&) const {}
};

__device__ __forceinline__ unsigned cvt_pk_bf16(float lo, float hi) { unsigned r; asm volatile("v_cvt_pk_bf16_f32 %0, %1, %2" : "=v"(r) : "v"(lo), "v"(hi)); return r; }
template <int ACT  > struct EpiBf16 {
    static constexpr bool PERM = true, AFTER_DRAIN = false; static_assert(ACT == 0, "EpiBf16: ACT is 0 (none)");
    bf16_t* O; int ldc; const float* bias; int split_cols; size_t split_stride; float scale0;
    __device__ __forceinline__ void operator()(const f32x4 (&acc)[2][2][4][2], const Unit& u, int wr, int wc, int fr, int fq) const {
        const int row0 = u.pm * BM + wr * 64 + fr; int colt = u.pn * BM; bf16_t* base = O;
        float sc = 1.f; if (split_cols) { const int t = colt / split_cols; base += (size_t)t * split_stride; colt -= t * split_cols; if (t == 0) sc = scale0; }
        const int col0 = colt + wc * 32 + 8 * fq, bcol0 = u.pn * BM + wc * 32 + 8 * fq;
        f32x4 bv[2][2];
#pragma unroll
        for (int bj = 0; bj < 2; ++bj)
#pragma unroll
            for (int n = 0; n < 2; ++n) bv[bj][n] = bias ? *(const f32x4*)(bias + bcol0 + bj * HALF + 4 * n) : (f32x4){0.f, 0.f, 0.f, 0.f};
#pragma unroll
        for (int ai = 0; ai < 2; ++ai)
#pragma unroll
            for (int m = 0; m < 4; ++m) { bf16_t* rowp = base + (size_t)(row0 + ai * HALF + m * 16) * ldc + col0;
#pragma unroll
                for (int bj = 0; bj < 2; ++bj) { f32x4 v0 = acc[ai][bj][m][0] + bv[bj][0], v1 = acc[ai][bj][m][1] + bv[bj][1];
                    v0 = v0 * sc; v1 = v1 * sc; u32x4 w; w.x = cvt_pk_bf16(v0[0], v0[1]); w.y = cvt_pk_bf16(v0[2], v0[3]); w.z = cvt_pk_bf16(v1[0], v1[1]); w.w = cvt_pk_bf16(v1[2], v1[3]);
                    *(u32x4*)(rowp + bj * HALF) = w; } }
    }
};

template <class Epi, class Sched, bool ALIGN_EPI = false, bool SP2 = false>
__device__ __forceinline__ void gemm_phase(PG8_LAS unsigned char* lds, const Gemm g, const Sched& S, const Epi& E) {
    const int tid = threadIdx.x, wid = __builtin_amdgcn_readfirstlane(tid >> 6), lane = tid & 63, wr = wid >> 2, wc = wid & 3, fr = lane & 15, fq = lane >> 4;
    const int K = g.K;
    unsigned voffA[2], voffB[2];
#pragma unroll
    for (int i = 0; i < 2; ++i) { int R, C; stage_rc(tid * 16 + i * 8192, R, C); const int Rb = Epi::PERM ? ((R & ~31) + perm32(R & 31)) : R;
        voffA[i] = (unsigned)(R * K + C) * 2u; voffB[i] = (unsigned)(Rb * K + C) * 2u; }
    const size_t kstep = (size_t)(BK * 2);
    const size_t hstep = (size_t)HALF * K * 2;
    const size_t tstep = 2 * hstep;
    const unsigned ldsw = (unsigned)wid * 1024u;
    const int aoff = lds_byte(wr * 64 + fr, fq * 8), boff = lds_byte(wc * 32 + fr, fq * 8);
#define PG8_SA(b, h) (((b) * 2 + (h)) * HTB)
#define PG8_SB(b, h) ((4 + (b) * 2 + (h)) * HTB)
#define PG8_STAGE(bufoff, gbase, voff) do { _Pragma("unroll") for (int _i = 0; _i < 2; ++_i) \
        __builtin_amdgcn_global_load_lds((const unsigned*)((const char*)(gbase) + (voff)[_i]), (PG8_LAS unsigned*)(lds + (bufoff) + ldsw + _i * 8192), 16, 0, 0); } while (0)
#define PG8_LDA(dst, b, h) do { _Pragma("unroll") for (int m = 0; m < 4; ++m) _Pragma("unroll") for (int k = 0; k < 2; ++k) dst[m][k] = *(const PG8_LAS bf16x8*)(lds + PG8_SA(b, h) + aoff + m * 2048 + k * 1024); } while (0)
#define PG8_LDB(dst, b, h) do { _Pragma("unroll") for (int n = 0; n < 2; ++n) _Pragma("unroll") for (int k = 0; k < 2; ++k) dst[n][k] = *(const PG8_LAS bf16x8*)(lds + PG8_SB(b, h) + boff + n * 2048 + k * 1024); } while (0)
#define PG8_MMA(ai, bj, At, Bt) do { __builtin_amdgcn_s_setprio(1); _Pragma("unroll") for (int m = 0; m < 4; ++m) _Pragma("unroll") for (int n = 0; n < 2; ++n) _Pragma("unroll") for (int k = 0; k < 2; ++k) \
        acc[ai][bj][m][n] = __builtin_amdgcn_mfma_f32_16x16x32_bf16(Bt[n][k], At[m][k], acc[ai][bj][m][n], 0, 0, 0); __builtin_amdgcn_s_setprio(0); } while (0)
#define PG8_WAIT_V(n) asm volatile("s_waitcnt vmcnt(" #n ")" ::: "memory")
#define PG8_WAIT_L(n) asm volatile("s_waitcnt lgkmcnt(" #n ")" ::: "memory")
#define PG8_BAR __builtin_amdgcn_s_barrier()
#define PG8_SCHED __builtin_amdgcn_sched_barrier(0)
    Unit cur, nxt; int ui = 0;
    if (!S.next(0, cur)) return;
    f32x4 acc[2][2][4][2];
#pragma unroll
    for (int a = 0; a < 2; ++a)
#pragma unroll
        for (int b = 0; b < 2; ++b)
#pragma unroll
            for (int m = 0; m < 4; ++m)
#pragma unroll
                for (int n = 0; n < 2; ++n) acc[a][b][m][n] = (f32x4){0.f, 0.f, 0.f, 0.f};
    bf16x8 At[4][2], B0[2][2], B1[2][2];
    const char* cA = (const char*)g.A + (size_t)cur.pm * tstep + (size_t)cur.kt0 * kstep; const char* cB = (const char*)g.Bt + (size_t)cur.pn * tstep + (size_t)cur.kt0 * kstep;
    S.a_ready(cur);
    if constexpr (SP2) {
        PG8_STAGE(PG8_SB(0, 0), cB, voffB); PG8_STAGE(PG8_SB(0, 1), cB + hstep, voffB); PG8_STAGE(PG8_SA(0, 0), cA, voffA); PG8_STAGE(PG8_SA(0, 1), cA + hstep, voffA);
        if (wr == 1) PG8_BAR;
        PG8_WAIT_V(2); PG8_BAR;
        PG8_STAGE(PG8_SB(1, 0), cB + kstep, voffB); PG8_STAGE(PG8_SA(1, 0), cA + kstep, voffA); PG8_STAGE(PG8_SB(1, 1), cB + hstep + kstep, voffB);
        PG8_WAIT_V(6); PG8_BAR;
    } else {
        PG8_STAGE(PG8_SB(0, 0), cB, voffB); PG8_STAGE(PG8_SA(0, 0), cA, voffA); PG8_STAGE(PG8_SB(0, 1), cB + hstep, voffB); PG8_STAGE(PG8_SA(0, 1), cA + hstep, voffA);
        if (wr == 1) PG8_BAR;
        PG8_WAIT_V(4); PG8_BAR;
        PG8_STAGE(PG8_SB(1, 0), cB + kstep, voffB); PG8_STAGE(PG8_SA(1, 0), cA + kstep, voffA); PG8_STAGE(PG8_SB(1, 1), cB + hstep + kstep, voffB);
        PG8_WAIT_V(6); PG8_BAR;
    }
    for (;;) {
        const bool has_next = S.next(ui + 1, nxt);
        const char* nA = has_next ? (const char*)g.A + (size_t)nxt.pm * tstep + (size_t)nxt.kt0 * kstep : cA; const char* nB = has_next ? (const char*)g.Bt + (size_t)nxt.pn * tstep + (size_t)nxt.kt0 * kstep : cB;
        const int nt = cur.nt;
        for (int t = 0; t < nt; t += 2) {
            const bool last = (t == nt - 2);
            const char* a1 = cA + (size_t)(t + 1) * kstep;
            const char* a2 = last ? nA : cA + (size_t)(t + 2) * kstep; const char* b2 = last ? nB : cB + (size_t)(t + 2) * kstep;
            const char* a3 = a2 + kstep; const char* b3 = b2 + kstep;
            if (last && has_next) S.a_ready(nxt);
            if constexpr (SP2) {
            PG8_LDB(B0, 0, 0); PG8_LDB(B1, 0, 1); PG8_SCHED; PG8_LDA(At, 0, 0); PG8_STAGE(PG8_SA(1, 1), a1 + hstep, voffA);
            PG8_WAIT_V(8); PG8_WAIT_L(0); PG8_BAR; PG8_MMA(0, 0, At, B0); PG8_MMA(0, 1, At, B1); PG8_BAR; PG8_SCHED;
            PG8_LDA(At, 0, 1); PG8_STAGE(PG8_SB(0, 0), b2, voffB); PG8_STAGE(PG8_SB(0, 1), b2 + hstep, voffB); PG8_STAGE(PG8_SA(0, 0), a2, voffA);
            PG8_WAIT_V(8); PG8_WAIT_L(0); PG8_BAR; PG8_MMA(1, 0, At, B0); PG8_MMA(1, 1, At, B1); PG8_BAR; PG8_SCHED;
            PG8_LDB(B0, 1, 0); PG8_LDB(B1, 1, 1); PG8_SCHED; PG8_LDA(At, 1, 0); PG8_STAGE(PG8_SA(0, 1), a2 + hstep, voffA);
            PG8_WAIT_V(8); PG8_WAIT_L(0); PG8_BAR; PG8_MMA(0, 0, At, B0); PG8_MMA(0, 1, At, B1); PG8_BAR; PG8_SCHED;
            PG8_LDA(At, 1, 1); PG8_STAGE(PG8_SB(1, 0), b3, voffB); PG8_STAGE(PG8_SB(1, 1), b3 + hstep, voffB); PG8_STAGE(PG8_SA(1, 0), a3, voffA);
            PG8_WAIT_V(8); PG8_WAIT_L(0); PG8_BAR; PG8_MMA(1, 0, At, B0); PG8_MMA(1, 1, At, B1); PG8_BAR; PG8_SCHED;
            } else {
            PG8_LDB(B0, 0, 0); PG8_SCHED; PG8_LDA(At, 0, 0); PG8_STAGE(PG8_SA(1, 1), a1 + hstep, voffA);
            PG8_WAIT_L(8); PG8_BAR; PG8_WAIT_L(0); PG8_MMA(0, 0, At, B0); PG8_BAR; PG8_SCHED;
            PG8_LDB(B1, 0, 1); PG8_STAGE(PG8_SB(0, 0), b2, voffB);
            PG8_BAR; PG8_WAIT_L(0); PG8_MMA(0, 1, At, B1); PG8_BAR;
            PG8_LDA(At, 0, 1); PG8_STAGE(PG8_SA(0, 0), a2, voffA);
            PG8_BAR; PG8_WAIT_L(0); PG8_MMA(1, 0, At, B0); PG8_BAR; PG8_SCHED;
            PG8_STAGE(PG8_SB(0, 1), b2 + hstep, voffB);
            PG8_WAIT_V(6); PG8_BAR; PG8_MMA(1, 1, At, B1); PG8_BAR;
            PG8_LDB(B0, 1, 0); PG8_SCHED; PG8_LDA(At, 1, 0); PG8_STAGE(PG8_SA(0, 1), a2 + hstep, voffA);
            PG8_WAIT_L(8); PG8_BAR; PG8_WAIT_L(0); PG8_MMA(0, 0, At, B0); PG8_BAR; PG8_SCHED;
            PG8_LDB(B1, 1, 1); PG8_STAGE(PG8_SB(1, 0), b3, voffB);
            PG8_BAR; PG8_WAIT_L(0); PG8_MMA(0, 1, At, B1); PG8_BAR;
            PG8_LDA(At, 1, 1); PG8_STAGE(PG8_SA(1, 0), a3, voffA);
            PG8_BAR; PG8_WAIT_L(0); PG8_MMA(1, 0, At, B0); PG8_BAR; PG8_SCHED;
            PG8_STAGE(PG8_SB(1, 1), b3 + hstep, voffB);
            PG8_WAIT_V(6); PG8_BAR; PG8_MMA(1, 1, At, B1); PG8_BAR;
            }
        }
        if constexpr (ALIGN_EPI) { if (wr == 0) PG8_BAR; }
        if constexpr (!Epi::AFTER_DRAIN) { E(acc, cur, wr, wc, fr, fq); S.done(cur); }
        if (!has_next) break;
#pragma unroll
        for (int a = 0; a < 2; ++a)
#pragma unroll
            for (int b = 0; b < 2; ++b)
#pragma unroll
                for (int m = 0; m < 4; ++m)
#pragma unroll
                    for (int n = 0; n < 2; ++n) acc[a][b][m][n] = (f32x4){0.f, 0.f, 0.f, 0.f};
        cur = nxt; cA = nA; cB = nB; ++ui;
        if constexpr (ALIGN_EPI) { if (wr == 1) PG8_BAR; }
    }
    PG8_WAIT_V(0);
    if constexpr (!ALIGN_EPI) { if (wr == 0) PG8_BAR; }
    PG8_BAR;
    if constexpr (Epi::AFTER_DRAIN) { E.fused(acc, cur, wr, wc, fr, fq, lds, wid, lane); S.done(cur); }
#undef PG8_SA
#undef PG8_SB
#undef PG8_STAGE
#undef PG8_LDA
#undef PG8_LDB
#undef PG8_MMA
#undef PG8_WAIT_V
#undef PG8_WAIT_L
#undef PG8_BAR
#undef PG8_SCHED
}
struct EpiSwiglu {
    static constexpr bool PERM = true, AFTER_DRAIN = false;
    bf16_t* H; int ldh;
    __device__ __forceinline__ void operator()(const f32x4 (&acc)[2][2][4][2], const Unit& u, int wr, int wc, int fr, int fq) const {
        const int row0 = u.pm * BM + wr * 64 + fr, col0 = u.pn * HALF + wc * 32 + 8 * fq;
#pragma unroll
        for (int ai = 0; ai < 2; ++ai)
#pragma unroll
            for (int m = 0; m < 4; ++m) {
                bf16_t* p = H + (size_t)(row0 + ai * HALF + m * 16) * ldh + col0;
                float h[8];
#pragma unroll
                for (int n = 0; n < 2; ++n)
#pragma unroll
                    for (int i = 0; i < 4; ++i) { const float g = acc[ai][0][m][n][i], up = acc[ai][1][m][n][i];
                        h[n * 4 + i] = g * __builtin_amdgcn_rcpf(1.0f + __expf(-g)) * up; }
                u32x4 w; w.x = cvt_pk_bf16(h[0], h[1]); w.y = cvt_pk_bf16(h[2], h[3]); w.z = cvt_pk_bf16(h[4], h[5]); w.w = cvt_pk_bf16(h[6], h[7]);
                *(u32x4*)p = w;
            }
    }
};
template <int GS2  > struct EpiResid {
    static constexpr bool PERM = false, AFTER_DRAIN = false;
    static constexpr float alpha = 1.189207115002721f, gs = 0.5f * GS2;
    const float* xp; const float* xs; float* X; const float* gt; float* part;
    __device__ __forceinline__ void operator()(const f32x4 (&acc)[2][2][4][2], const Unit& u, int wr, int wc, int fr, int fq) const {
        const int col0 = u.pn * BM + wc * 32 + 4 * fq;
        if (u.ks >= 0) {
#pragma unroll
            for (int ai = 0; ai < 2; ++ai)
#pragma unroll
                for (int m = 0; m < 4; ++m) { float* po = part + ((size_t)u.ks * 1024 + (size_t)(u.pm * BM + ai * HALF + wr * 64 + m * 16 + fr - 16384)) * 1024;
#pragma unroll
                    for (int bj = 0; bj < 2; ++bj)
#pragma unroll
                        for (int n = 0; n < 2; ++n) *(f32x4*)(po + col0 + bj * HALF + n * 16) = acc[ai][bj][m][n]; }
            return;
        }
#pragma unroll
        for (int ai = 0; ai < 2; ++ai)
#pragma unroll
            for (int m = 0; m < 4; ++m) {
                const int row = u.pm * BM + ai * HALF + wr * 64 + m * 16 + fr;
                const bool smp = row >= 16384;
                const float* xr = smp ? xs + (size_t)(row - 16384) * 1024 : xp + (size_t)row * 1024;
                const int b = smp ? 2 + ((row - 16384) >> 3) : (row >> 13);
                const float* gr = gt + (size_t)b * 9216;
                float* xo = X + (size_t)row * 1024;
#pragma unroll
                for (int bj = 0; bj < 2; ++bj)
#pragma unroll
                    for (int n = 0; n < 2; ++n) { const int c = col0 + bj * HALF + n * 16;
                        const f32x4 xv = *(const f32x4*)(xr + c), gv = *(const f32x4*)(gr + c);
                        const f32x4 z = xv * alpha + (gv + 1.0f) * gs * acc[ai][bj][m][n];
                        *(f32x4*)(xo + c) = z; }
            }
    }
};
struct SliceOrder {
    StaticOrder so; int nsl, G, c;
    __host__ __device__ void init(int K, int G_, int c_) { so.init(16384, 1024, G_, c_, K); nsl = K / (4 * BK); G = G_; c = c_; }
    __host__ __device__ bool next(int i, Unit& u) const {
        if (so.next(i, u)) return true;
        const long L = (long)i * G + c - so.nwg; if (L < 0 || L >= 16 * nsl) return false;
        const int t16 = (int)L / nsl, ks = (int)L % nsl;
        u.pm = 64 + (t16 >> 2); u.pn = t16 & 3; u.kt0 = 4 * ks; u.nt = 4; u.ks = ks; return true;
    }
    __device__ __forceinline__ void a_ready(const Unit&) const {}
    __device__ __forceinline__ void done(const Unit&) const {}
};
}
#define GAS __attribute__((address_space(1)))
#define LAS __attribute__((address_space(3)))
typedef unsigned short bf16;
typedef unsigned v4u __attribute__((ext_vector_type(4)));
typedef float f32x4 __attribute__((ext_vector_type(4)));
typedef short bf16x8 __attribute__((ext_vector_type(8)));
typedef GAS unsigned gu32;
typedef GAS unsigned long long gu64;
#define RLX_AGENT __ATOMIC_RELAXED, __HIP_MEMORY_SCOPE_AGENT
#define LDS_WAIT() asm volatile("s_waitcnt lgkmcnt(0)" ::: "memory")
#define VM_WAIT() asm volatile("s_waitcnt vmcnt(0)" ::: "memory")
__device__ __forceinline__ unsigned long long rt() { return __builtin_amdgcn_s_memrealtime(); }
__device__ __forceinline__ unsigned f2bf(float f) { unsigned u = __builtin_bit_cast(unsigned, f); return (u + 0x7fffu + ((u >> 16) & 1u)) >> 16; }
__device__ __forceinline__ unsigned pk2(float lo, float hi) { return f2bf(lo) | (f2bf(hi) << 16); }

#define XB_TMO      128
#define XB_XCNT(j)  (256  + 64 * (j))
#define XB_XSUB(j)  (1280 + 64 * (j))
#define XB_XGEN(j)  (2304 + 64 * (j))
#define XB_TOP      3328
#define XB_TOPGEN   3392
#define XCD_BAR_WORDS 3456
#define XB_SPIN_CAP (1u << 18)

__device__ __forceinline__ unsigned xb_ld(unsigned* p)              { return __hip_atomic_load(p, __ATOMIC_RELAXED, __HIP_MEMORY_SCOPE_AGENT); }
__device__ __forceinline__ unsigned xb_add(unsigned* p, unsigned v) { return __hip_atomic_fetch_add(p, v, __ATOMIC_RELAXED, __HIP_MEMORY_SCOPE_AGENT); }
__device__ __forceinline__ unsigned xb_xcc_id() { return (unsigned)__builtin_amdgcn_s_getreg((3 << 11) | 20) & 0xFu; }
#define XB_SPIN(cond, bar) do { unsigned _sp = 0; while (cond) { __builtin_amdgcn_s_sleep(1); \
    if ((++_sp & 255u) == 0u) { if (xb_ld(&(bar)[XB_TMO])) break; if (_sp > XB_SPIN_CAP) { atomicAdd(&(bar)[XB_TMO], 1u); break; } } } } while (0)

struct XcdBarrier {
    unsigned* bar; unsigned x;
    volatile LAS unsigned* st;
};

__device__ __forceinline__ XcdBarrier xcd_barrier_post(unsigned* bar, volatile LAS unsigned* st) {
    XcdBarrier b; b.bar = bar; b.x = xb_xcc_id(); b.st = st;
    if (threadIdx.x == 0) (void)xb_add(&bar[XB_XCNT(b.x)], 1u);
    return b;
}
__device__ __forceinline__ void xcd_barrier_complete(unsigned* bar, unsigned x, unsigned& nloc, unsigned& nx) {
    const unsigned G = gridDim.x * gridDim.y * gridDim.z;
    unsigned sum, cnt, mine, sp = 0u;
    for (;;) {
        sum = 0u; cnt = 0u; mine = 0u;
#pragma unroll
        for (unsigned j = 0; j < 16; ++j) { const unsigned c = xb_ld(&bar[XB_XCNT(j)]); sum += c; cnt += (c > 0u) ? 1u : 0u; mine = (j == x) ? c : mine; }
        if (sum == G) break;
        __builtin_amdgcn_s_sleep(1);
        if ((++sp & 255u) == 0u) { if (xb_ld(&bar[XB_TMO])) break; if (sp > XB_SPIN_CAP) { atomicAdd(&bar[XB_TMO], 1u); break; } }
    }
    nloc = mine > 0u ? mine : 1u; nx = cnt > 0u ? cnt : 1u;
}

__device__ __forceinline__ void xcd_barrier(const XcdBarrier& b) {
    asm volatile("s_waitcnt vmcnt(0)" ::: "memory");
    __syncthreads();
    if (threadIdx.x == 0) {
        unsigned* bar = b.bar;
        __builtin_amdgcn_s_waitcnt(0);
        unsigned nloc = b.st[0], nx = b.st[1];
        if (nloc == 0u) { xcd_barrier_complete(bar, b.x, nloc, nx); b.st[0] = nloc; b.st[1] = nx; }
        const unsigned old = xb_add(&bar[XB_XSUB(b.x)], 1u);
        const unsigned gen = old / nloc;
        if (old + 1u == (gen + 1u) * nloc) {
            __builtin_amdgcn_fence(__ATOMIC_RELEASE, "agent");
            asm volatile("s_waitcnt vmcnt(0)" ::: "memory");
            const unsigned og = xb_add(&bar[XB_TOP], 1u);
            const unsigned tg = og / nx;
            if (og + 1u == (tg + 1u) * nx) xb_add(&bar[XB_TOPGEN], 1u);
            else XB_SPIN(xb_ld(&bar[XB_TOPGEN]) == tg, bar);
            __builtin_amdgcn_fence(__ATOMIC_ACQUIRE, "agent");
            xb_add(&bar[XB_XGEN(b.x)], 1u);
            asm volatile("s_waitcnt vmcnt(0)" ::: "memory");
        } else {
            XB_SPIN(xb_ld(&bar[XB_XGEN(b.x)]) == gen, bar);
            __builtin_amdgcn_fence(__ATOMIC_ACQUIRE, "agent");
            asm volatile("s_waitcnt vmcnt(0)" ::: "memory");
        }
    }
    __syncthreads();
}

constexpr int D = 1024, FF = 2816, NFF = 2 * FF, NIN = 2560, RW = 512, RWP = 1792;
constexpr int MP = 16384, MS = 1024, M = MP + MS, TP = 8192, TS = 8, NBS = 128;
constexpr int MODW = 9216, NMOD = 130;
constexpr float ALPHA = 1.189207115002721f;
constexpr float LN_EPS = 1e-5f, GN_EPS = 64e-5f;
constexpr int NWAVES = 8;
enum { I_XP = 0, I_XS, I_SWKV, I_SSHIFT, I_CK, I_CV, I_CP, I_CS, I_RELB, I_WADA, I_BADA, I_LNG, I_LNB, I_W1IN, I_W1OUT, I_WIN, I_MU, I_W0, I_WDEC, I_A0, I_WICLR, I_WGATE,
       I_KK, I_KA, I_RK, I_GNW, I_GNB, I_SINKS, I_WOUT, I_W2IN, I_W2OUT, N_IN };
constexpr size_t O_Y = 0, O_WKV_P = (size_t)M * D, O_SHIFT_P = O_WKV_P + 65536, O_WINK_P = O_SHIFT_P + 3584, O_WINV_P = O_WINK_P + 32768,
                 O_WKV_S = O_WINV_P + 32768, O_SHIFT_S = O_WKV_S + 4194304, O_WINK_S = O_SHIFT_S + 229376, O_WINV_S = O_WINK_S + 2097152, O_END = O_WINV_S + 2097152;
static_assert(O_END == 26578432, "d_out size");
constexpr size_t MiB = 1u << 20;
constexpr size_t WS_CTL = 0, CTL_ZERO_BYTES = 1 * MiB;
constexpr size_t WS_W1IN = 2 * MiB, WS_W1OUT = 13 * MiB, WS_WIN = 19 * MiB, WS_WOUT = 24 * MiB, WS_W2IN = 26 * MiB, WS_W2OUT = 37 * MiB;
constexpr size_t WS_MOD = 43 * MiB;
constexpr size_t WS_U = 48 * MiB;
constexpr size_t WS_H = 82 * MiB;
constexpr size_t WS_WLOG = 176 * MiB, WS_A = 210 * MiB, WS_G = 227 * MiB, WS_INV = 244 * MiB, WS_LORA = 245 * MiB, WS_END = 246 * MiB;
constexpr size_t LORA_WI = 512 * 64 * 2, LORA_WG = 2 * 512 * 64 * 2;
static_assert(WS_W1IN + (size_t)NFF * D * 2 <= WS_W1OUT && WS_W1OUT + (size_t)D * FF * 2 <= WS_WIN && WS_WIN + (size_t)NIN * D * 2 <= WS_WOUT && WS_WOUT + (size_t)D * D * 2 <= WS_W2IN &&
              WS_W2IN + (size_t)NFF * D * 2 <= WS_W2OUT && WS_W2OUT + (size_t)D * FF * 2 <= WS_MOD && WS_MOD + (size_t)NMOD * MODW * 4 <= WS_U && WS_U + (size_t)M * D * 2 <= WS_H &&
              WS_H + (size_t)M * FF * 2 <= WS_WLOG && WS_WLOG + (size_t)M * RW * 4 <= WS_A && WS_A + (size_t)M * RW * 2 <= WS_G && WS_G + (size_t)M * RW * 2 <= WS_INV &&
              WS_INV + (size_t)M * 8 * 4 <= WS_LORA && WS_LORA + 4 * 512 * 64 * 2 <= WS_END && WS_END <= 256 * MiB, "d_ws map");
constexpr int CW_BAR = 4096;
constexpr int RING_OFF = 0, RING_BYTES = 151552;
constexpr int LDSCTL_OFF = RING_BYTES, MISC_OFF = LDSCTL_OFF + 320;
constexpr int LDS_BYTES = 155648;
static_assert(MISC_OFF + 128 <= LDS_BYTES, "LDS map");

__device__ __forceinline__ float bf2f(unsigned short h) { return __uint_as_float((unsigned)h << 16); }
__device__ __forceinline__ float bflo(unsigned u) { return __uint_as_float(u << 16); }
__device__ __forceinline__ float bfhi(unsigned u) { return __uint_as_float(u & 0xffff0000u); }
__device__ __forceinline__ unsigned long long pk4(f32x4 v) { return (unsigned long long)pk2(v[0], v[1]) | ((unsigned long long)pk2(v[2], v[3]) << 32); }
__device__ __forceinline__ f32x4 bf4_to_f32(unsigned long long w) { return (f32x4){bflo((unsigned)w), bfhi((unsigned)w), bflo((unsigned)(w >> 32)), bfhi((unsigned)(w >> 32))}; }
__device__ __forceinline__ float wave_sum(float v) {
#pragma unroll
    for (int o = 1; o < 64; o <<= 1) v += __shfl_xor(v, o);
    return v;
}
template <int CTRL> __device__ __forceinline__ float dppf(float x) { return __builtin_bit_cast(float, __builtin_amdgcn_update_dpp(0, __builtin_bit_cast(int, x), CTRL, 0xf, 0xf, true)); }
__device__ __forceinline__ float sum8(float x) {
    x += dppf<0xB1>(x);
    x += dppf<0x4E>(x);
    x += dppf<0x141>(x);
    return x;
}
__device__ __forceinline__ float wave_sum_dpp(float x) {
    x += dppf<0xB1>(x); x += dppf<0x4E>(x); x += dppf<0x141>(x);
    x += dppf<0x140>(x);
    const int xi = __builtin_bit_cast(int, x);
    return __builtin_bit_cast(float, __builtin_amdgcn_readlane(xi, 0)) + __builtin_bit_cast(float, __builtin_amdgcn_readlane(xi, 16)) +
           __builtin_bit_cast(float, __builtin_amdgcn_readlane(xi, 32)) + __builtin_bit_cast(float, __builtin_amdgcn_readlane(xi, 48));
}
__device__ __forceinline__ float sigmoidf_(float x) { return __builtin_amdgcn_rcpf(1.0f + __expf(-x)); }
__device__ __forceinline__ float tanhf_(float x) { return 1.0f - 2.0f * __builtin_amdgcn_rcpf(1.0f + __expf(2.0f * x)); }
__device__ __forceinline__ unsigned cvtpk(float lo, float hi) { unsigned r; asm volatile("v_cvt_pk_bf16_f32 %0, %1, %2" : "=v"(r) : "v"(lo), "v"(hi)); return r; }

struct Args { const float* in[N_IN]; float* out; unsigned char* ws; int ph_lo, ph_hi; };
static_assert(sizeof(Args) == N_IN * 8 + 24, "Args has no padding");
struct Frame {
    LAS unsigned char* lds;
    volatile LAS unsigned* MISC;
    gu32* ctl;
    int tid, lane, wave, vcu, G;
    const Args* a;
};
#define WSP(T, off) ((T*)(F.a->ws + (off)))

__device__ __forceinline__ void p0_transpose_item(const float* W, int K, int N, bf16* WT, int dst_row0, int k0, int n0, LAS float* scr, int lane) {
#pragma unroll 8
    for (int i = 0; i < 32; ++i) { const int kk = 2 * i + (lane >> 5); scr[kk * 33 + (lane & 31)] = W[(size_t)(k0 + kk) * N + n0 + (lane & 31)]; }
    LDS_WAIT(); asm volatile("" ::: "memory");
    const int c = lane & 7;
#pragma unroll
    for (int j = 0; j < 4; ++j) { const int n = (lane >> 3) + 8 * j; const LAS float* s = scr + (8 * c) * 33 + n;
        v4u o; o.x = pk2(s[0 * 33], s[1 * 33]); o.y = pk2(s[2 * 33], s[3 * 33]); o.z = pk2(s[4 * 33], s[5 * 33]); o.w = pk2(s[6 * 33], s[7 * 33]);
        *(GAS v4u*)(WT + (size_t)(dst_row0 + n) * K + k0 + 8 * c) = o; }
    LDS_WAIT(); asm volatile("" ::: "memory");
}
__device__ __forceinline__ void p0_ffin_item(const float* W, bf16* WT, int r, LAS float* scr, int lane) {
    const int kb = r / 176, nb = r % 176, n0 = 32 * nb; const bool up = n0 >= FF; const int j = up ? n0 - FF : n0;
    p0_transpose_item(W, D, NFF, WT, (j >> 7) * 256 + (up ? 128 : 0) + (j & 127), 64 * kb, n0, scr, lane);
}
__device__ __forceinline__ void p0_plain_item(const float* W, int K, int N, bf16* WT, int r, LAS float* scr, int lane) {
    const int nblk = N / 32, kb = r / nblk, nb = r % nblk;
    p0_transpose_item(W, K, N, WT, 32 * nb, 64 * kb, 32 * nb, scr, lane);
}
__device__ __forceinline__ void p0_weights(Frame& F) {
    LAS float* scr = (LAS float*)(F.lds + RING_OFF + F.wave * 16384);
    const int gw = F.vcu * NWAVES + F.wave, NGW = F.G * NWAVES;
    constexpr int I_FI = 16 * 176, I_FO = 44 * 32, I_IN = 16 * 80, I_O = 16 * 32, I_L = 16, NITEMS = 2 * I_FI + 2 * I_FO + I_IN + I_O + 4 * I_L;
    for (int it = gw; it < NITEMS; it += NGW) {
        int r = it;
        if (r < I_FI) { p0_ffin_item(F.a->in[I_W1IN], WSP(bf16, WS_W1IN), r, scr, F.lane); continue; } r -= I_FI;
        if (r < I_FI) { p0_ffin_item(F.a->in[I_W2IN], WSP(bf16, WS_W2IN), r, scr, F.lane); continue; } r -= I_FI;
        if (r < I_FO) { p0_plain_item(F.a->in[I_W1OUT], FF, D, WSP(bf16, WS_W1OUT), r, scr, F.lane); continue; } r -= I_FO;
        if (r < I_FO) { p0_plain_item(F.a->in[I_W2OUT], FF, D, WSP(bf16, WS_W2OUT), r, scr, F.lane); continue; } r -= I_FO;
        if (r < I_IN) { p0_plain_item(F.a->in[I_WIN], D, NIN, WSP(bf16, WS_WIN), r, scr, F.lane); continue; } r -= I_IN;
        if (r < I_O) { p0_plain_item(F.a->in[I_WOUT], D, D, WSP(bf16, WS_WOUT), r, scr, F.lane); continue; } r -= I_O;
        if (r < I_L) { p0_plain_item(F.a->in[I_WDEC], 64, RW, WSP(bf16, WS_LORA), r, scr, F.lane); continue; } r -= I_L;
        if (r < I_L) { p0_plain_item(F.a->in[I_WICLR], 64, RW, WSP(bf16, WS_LORA + LORA_WI), r, scr, F.lane); continue; } r -= I_L;
        p0_plain_item(F.a->in[I_WGATE], 128, RW, WSP(bf16, WS_LORA + LORA_WG), r, scr, F.lane);
    }
}
typedef float f32x16m __attribute__((ext_vector_type(16)));
__device__ __forceinline__ void p0_mod(Frame& F) {
    const float* wada = F.a->in[I_WADA]; const float* bada = F.a->in[I_BADA]; const float* cp = F.a->in[I_CP]; const float* cs = F.a->in[I_CS];
    float* mod = WSP(float, WS_MOD);
    LAS float* red = (LAS float*)F.lds;
    const int lane = F.lane, wave = F.wave, r = lane & 31, h = lane >> 5;
    for (int task = blockIdx.x; task < MODW / 32; task += F.G) {
        const int j0 = 32 * task;
        f32x16m acc[5];
#pragma unroll
        for (int bt = 0; bt < 5; ++bt)
#pragma unroll
            for (int e = 0; e < 16; ++e) acc[bt][e] = 0.f;
#pragma unroll 1
        for (int ks = 0; ks < 8; ++ks) {
            const int i0 = 128 * wave + 16 * ks + 8 * h;
            unsigned aw[4];
#pragma unroll
            for (int e = 0; e < 4; ++e) aw[e] = pk2(wada[(size_t)(i0 + 2 * e) * MODW + j0 + r], wada[(size_t)(i0 + 2 * e + 1) * MODW + j0 + r]);
            const bf16x8 af = __builtin_bit_cast(bf16x8, (v4u){aw[0], aw[1], aw[2], aw[3]});
#pragma unroll
            for (int bt = 0; bt < 5; ++bt) {
                const int b = 32 * bt + r;
                f32x4 c0 = (f32x4){0.f, 0.f, 0.f, 0.f}, c1 = c0;
                if (b < NMOD) { const float* cr = (b < 2 ? cp + (size_t)b * D : cs + (size_t)(b - 2) * D) + i0; c0 = *(const f32x4*)cr; c1 = *(const f32x4*)(cr + 4); }
                float sv[8];
#pragma unroll
                for (int e = 0; e < 4; ++e) { sv[e] = c0[e] * __builtin_amdgcn_rcpf(1.0f + __expf(-c0[e])); sv[4 + e] = c1[e] * __builtin_amdgcn_rcpf(1.0f + __expf(-c1[e])); }
                const bf16x8 bfm = __builtin_bit_cast(bf16x8, (v4u){pk2(sv[0], sv[1]), pk2(sv[2], sv[3]), pk2(sv[4], sv[5]), pk2(sv[6], sv[7])});
                acc[bt] = __builtin_amdgcn_mfma_f32_32x32x16_bf16(af, bfm, acc[bt], 0, 0, 0);
            }
        }
#pragma unroll
        for (int rd = 0; rd < 2; ++rd) {
            const int nv = rd == 0 ? 48 : 32, bt0 = rd == 0 ? 0 : 3;
            __syncthreads();
#pragma unroll
            for (int bt = 0; bt < 3; ++bt) if (bt0 + bt < 5)
#pragma unroll
                for (int e = 0; e < 16; ++e) red[(wave * 48 + bt * 16 + e) * 64 + lane] = acc[bt0 + bt][e];
            __syncthreads();
            for (int idx = F.tid; idx < nv * 64; idx += 512) {
                const int v = idx >> 6, ln = idx & 63, bt = bt0 + (v >> 4), e = v & 15;
                float s = 0.f;
#pragma unroll
                for (int w = 0; w < 8; ++w) s += red[(w * 48 + v) * 64 + ln];
                const int b = 32 * bt + (ln & 31), j = j0 + (e & 3) + 8 * (e >> 2) + 4 * (ln >> 5);
                if (b < NMOD) mod[(size_t)b * MODW + j] = s + bada[j];
            }
        }
    }
    __syncthreads();
}

__device__ __forceinline__ int mod_row_of(int m) { return m < MP ? (m >> 13) : 2 + ((m - MP) >> 3); }
__device__ __forceinline__ void p_modulate0(Frame& F) {
    const int gw = F.vcu * NWAVES + F.wave, NGW = F.G * NWAVES;
    const float* mod = WSP(float, WS_MOD); bf16* U = WSP(bf16, WS_U);
    for (int m = gw; m < M; m += NGW) {
        const float* xr = m < MP ? F.a->in[I_XP] + (size_t)m * D : F.a->in[I_XS] + (size_t)(m - MP) * D;
        const float* mr = mod + (size_t)mod_row_of(m) * MODW;
        unsigned long long* o8 = (unsigned long long*)(U + (size_t)m * D) + F.lane;
#pragma unroll
        for (int j = 0; j < 4; ++j) { const int c = 4 * F.lane + 256 * j;
            const f32x4 x = *(const f32x4*)(xr + c), sh = *(const f32x4*)(mr + c), sc = *(const f32x4*)(mr + D + c);
            const f32x4 u = x * (sc + 1.0f) + sh;
            o8[64 * j] = (unsigned long long)pk2(u[0], u[1]) | ((unsigned long long)pk2(u[2], u[3]) << 32); }
    }
}
__device__ __forceinline__ void p_layernorm(Frame& F, int lnidx, int koff, int nsl, const float* xs_old, int gtk, float gs) {
    const int gw = F.vcu * NWAVES + F.wave, NGW = F.G * NWAVES;
    const float* mod = WSP(float, WS_MOD); bf16* U = WSP(bf16, WS_U); float* X = F.a->out + O_Y;
    const float* lg = F.a->in[I_LNG] + lnidx * D; const float* lb = F.a->in[I_LNB] + lnidx * D;
    for (int m = gw; m < M; m += NGW) {
        float* xr = X + (size_t)m * D;
        f32x4 v[4]; float s = 0.f;
#pragma unroll
        for (int j = 0; j < 4; ++j) { const int c = 4 * F.lane + 256 * j;
            if (m < MP) v[j] = *(const f32x4*)(xr + c);
            else { const float* pp = WSP(float, WS_WLOG) + (size_t)(m - MP) * D + c; f32x4 a = *(const f32x4*)pp;
                for (int ks = 1; ks < nsl; ++ks) a += *(const f32x4*)(pp + (size_t)ks * MS * D);
                const f32x4 xo = *(const f32x4*)(xs_old + (size_t)(m - MP) * D + c), gv = *(const f32x4*)(mod + (size_t)mod_row_of(m) * MODW + gtk * D + c);
                v[j] = xo * ALPHA + (gv + 1.0f) * gs * a; }
            s += (v[j][0] + v[j][1]) + (v[j][2] + v[j][3]); }
        const float mean = wave_sum(s) * (1.f / D); float s2 = 0.f;
#pragma unroll
        for (int j = 0; j < 4; ++j) { v[j] = v[j] - mean; s2 += (v[j][0] * v[j][0] + v[j][1] * v[j][1]) + (v[j][2] * v[j][2] + v[j][3] * v[j][3]); }
        const float rstd = 1.f / sqrtf(wave_sum(s2) * (1.f / D) + LN_EPS);
        const float* mr = mod + (size_t)mod_row_of(m) * MODW + (koff >= 0 ? koff : 0);
        unsigned long long* o8 = (unsigned long long*)(U + (size_t)m * D) + F.lane;
#pragma unroll
        for (int j = 0; j < 4; ++j) { const int c = 4 * F.lane + 256 * j;
            const f32x4 x = v[j] * rstd * *(const f32x4*)(lg + c) + *(const f32x4*)(lb + c);
            *(f32x4*)(xr + c) = x;
            if (koff >= 0) { const f32x4 sh = *(const f32x4*)(mr + c), sc = *(const f32x4*)(mr + D + c); const f32x4 u = x * (sc + 1.0f) + sh;
                o8[64 * j] = (unsigned long long)pk2(u[0], u[1]) | ((unsigned long long)pk2(u[2], u[3]) << 32); } }
    }
}
__device__ __forceinline__ float prev_val(const bf16* P, const float* sshift, int m, int col) {
    if (m < MP) return (m & (TP - 1)) == 0 ? 0.f : bf2f(P[(size_t)(m - 1) * NIN + col]);
    const int ms = m - MP;
    return (ms & (TS - 1)) == 0 ? sshift[(size_t)(ms >> 3) * RWP + col] : bf2f(P[(size_t)(m - 1) * NIN + col]);
}
constexpr int PP_PITCH = 528;
__device__ __forceinline__ void p_prep(Frame& F) {
    LAS unsigned char* lds = F.lds;
    const bf16* P = WSP(bf16, WS_H); const float* sshift = F.a->in[I_SSHIFT]; const float* mu = F.a->in[I_MU];
    float* WLOG = WSP(float, WS_WLOG); bf16* AA = WSP(bf16, WS_A); bf16* GG = WSP(bf16, WS_G);
    const int tid = F.tid, lane = F.lane, wave = F.wave;
    const int tile_lo0 = (F.vcu * (M / 16)) / F.G, tile_hi0 = ((F.vcu + 1) * (M / 16)) / F.G;
    for (int tile_lo = tile_lo0; tile_lo < tile_hi0; tile_lo += 5) {
    const int ntile = (tile_hi0 - tile_lo) < 5 ? (tile_hi0 - tile_lo) : 5;
    const int m_lo = tile_lo * 16, ntok = ntile * 16;
    __syncthreads();
    {
        const int j = tid & 255, hf = tid >> 8, col = 1536 + j; const float muj = mu[col];
        const int ga = hf == 0 ? 0 : ntile, gb = hf == 0 ? ntile : 2 * ntile;
        float carry = 0.f;
        for (int gi = ga; gi < gb; ++gi) { const int mg = m_lo + 8 * gi;
            float p[8];
#pragma unroll
            for (int t = 0; t < 8; ++t) p[t] = bf2f(P[(size_t)(mg + t) * NIN + col]);
            float prev = (gi == ga || ((mg < MP) ? (mg & (TP - 1)) : ((mg - MP) & (TS - 1))) == 0) ? prev_val(P, sshift, mg, col) : carry;
#pragma unroll
            for (int t = 0; t < 8; ++t) { const float xs = p[t] + (prev - p[t]) * muj; prev = p[t];
                const float f = j < 64 ? tanhf_(xs) : (j < 128 ? xs : sigmoidf_(xs));
                *(LAS unsigned short*)(lds + (8 * gi + t) * PP_PITCH + j * 2) = (unsigned short)f2bf(f); }
            carry = p[7]; }
    }
    __syncthreads();
    const int lr = lane & 15, lq = lane >> 4, c0 = 64 * wave;
#pragma unroll 1
    for (int lo = 0; lo < 3; ++lo) {
        const int kin = lo == 0 ? 0 : (lo == 1 ? 64 : 128), nks = lo == 2 ? 4 : 2, wpitch = lo == 2 ? 128 : 64;
        const bf16* Wt = WSP(bf16, WS_LORA) + (lo == 0 ? 0 : (lo == 1 ? 512 * 64 : 2 * 512 * 64));
        f32x4 acc[5][4];
#pragma unroll
        for (int tt = 0; tt < 5; ++tt)
#pragma unroll
            for (int ct = 0; ct < 4; ++ct) acc[tt][ct] = (f32x4){0.f, 0.f, 0.f, 0.f};
        for (int ks = 0; ks < nks; ++ks) {
            bf16x8 wf[4];
#pragma unroll
            for (int ct = 0; ct < 4; ++ct) wf[ct] = *(const bf16x8*)(Wt + (size_t)(c0 + 16 * ct + lr) * wpitch + ks * 32 + lq * 8);
#pragma unroll
            for (int tt = 0; tt < 5; ++tt) if (tt < ntile) {
                const bf16x8 af = *(const LAS bf16x8*)(lds + (16 * tt + lr) * PP_PITCH + (kin + ks * 32 + lq * 8) * 2);
#pragma unroll
                for (int ct = 0; ct < 4; ++ct) acc[tt][ct] = __builtin_amdgcn_mfma_f32_16x16x32_bf16(wf[ct], af, acc[tt][ct], 0, 0, 0);
            }
        }
#pragma unroll
        for (int tt = 0; tt < 5; ++tt) if (tt < ntile) { const int m = m_lo + 16 * tt + lr;
#pragma unroll
            for (int ct = 0; ct < 4; ++ct) { const int c = c0 + 16 * ct + 4 * lq; const f32x4 a = acc[tt][ct];
                if (lo == 0) { const f32x4 w0v = *(const f32x4*)(F.a->in[I_W0] + c); f32x4 o;
#pragma unroll
                    for (int e = 0; e < 4; ++e) { const float z = w0v[e] + a[e]; const float sp = fmaxf(-z, 0.f) + __logf(1.0f + __expf(-fabsf(z))); o[e] = -__expf(-sp - 0.5f); }
                    *(f32x4*)(WLOG + (size_t)m * RW + c) = o; }
                else if (lo == 1) { const f32x4 a0v = *(const f32x4*)(F.a->in[I_A0] + c); f32x4 o;
#pragma unroll
                    for (int e = 0; e < 4; ++e) o[e] = sigmoidf_(a0v[e] + a[e]);
                    *(unsigned long long*)(AA + (size_t)m * RW + c) = pk4(o); }
                else *(unsigned long long*)(GG + (size_t)m * RW + c) = pk4(a); }
        }
    }
    }
}

constexpr int NCOPY = 96;
__device__ __forceinline__ void copy_task(Frame& F, int task) {
    const bf16* P = WSP(bf16, WS_H);
    const int gt = task * 512 + F.tid, NT = NCOPY * 512;
    const float* ck = F.a->in[I_CK]; const float* cv = F.a->in[I_CV]; float* out = F.a->out;
#pragma unroll 4
    for (int i = gt; i < NBS * 120 * 32; i += NT) {
        const int b = i / 3840, rem = i - b * 3840, j = rem >> 5, c4 = (rem & 31) * 4; const size_t d = (size_t)(b * 128 + j) * 128 + c4, s = d + 8 * 128;
        *(f32x4*)(out + O_WINK_S + d) = *(const f32x4*)(ck + s); *(f32x4*)(out + O_WINV_S + d) = *(const f32x4*)(cv + s); }
    for (int i = gt; i < NBS * 8 * 128; i += NT) {
        const int b = i >> 10, t = (i >> 7) & 7, c2 = i & 127; const size_t row = (size_t)(MP + b * TS + t) * NIN, d = (size_t)(b * 128 + 120 + t) * 128 + c2;
        out[O_WINK_S + d] = bf2f(P[row + 2304 + c2]); out[O_WINV_S + d] = bf2f(P[row + 2432 + c2]); }
    for (int i = gt; i < 2 * RWP; i += NT) { const int b = i / RWP, col = i % RWP; out[O_SHIFT_P + i] = bf2f(P[(size_t)(b * TP + TP - 1) * NIN + col]); }
#pragma unroll 2
    for (int i = gt; i < NBS * RWP; i += NT) { const int b = i / RWP, col = i % RWP; out[O_SHIFT_S + i] = bf2f(P[(size_t)(MP + b * TS + TS - 1) * NIN + col]); }
    for (int i = gt; i < 2 * 128 * 128; i += NT) { const int b = i >> 14, j = (i >> 7) & 127, c2 = i & 127; const size_t row = (size_t)(b * TP + TP - 128 + j) * NIN;
        out[O_WINK_P + i] = bf2f(P[row + 2304 + c2]); out[O_WINV_P + i] = bf2f(P[row + 2432 + c2]); }
}
constexpr int SS_R = 0, SS_DEC = 1, SS_KM = 2, SS_KK = 3, SS_BB = 4, SS_V = 5;
__device__ __forceinline__ void sample_scan_unit(Frame& F, int b) {
    const int h = F.wave, lane = F.lane, chn = h * 64 + lane;
    LAS float* A = (LAS float*)F.lds + h * (6 * 8 * 64);
    const bf16* P = WSP(bf16, WS_H); const float* sshift = F.a->in[I_SSHIFT]; const float* mu = F.a->in[I_MU];
    const float* WLOG = WSP(float, WS_WLOG); const bf16* AA = WSP(bf16, WS_A); const bf16* GG = WSP(bf16, WS_G);
    bf16* MIX = WSP(bf16, WS_U);
    const float mur = mu[chn], muk = mu[RW + chn], muv = mu[2 * RW + chn], kkc = F.a->in[I_KK][chn], kac = F.a->in[I_KA][chn], rkc = F.a->in[I_RK][chn], gnw = F.a->in[I_GNW][chn], gnb = F.a->in[I_GNB][chn];
    __syncthreads();
    float q_r = sshift[(size_t)b * RWP + chn], q_k = sshift[(size_t)b * RWP + RW + chn], q_v = sshift[(size_t)b * RWP + 2 * RW + chn];
#pragma unroll
    for (int t = 0; t < TS; ++t) {
        const int m = MP + b * TS + t; const size_t pr = (size_t)m * NIN;
        const float p_r = bf2f(P[pr + chn]), p_k = bf2f(P[pr + RW + chn]), p_v = bf2f(P[pr + 2 * RW + chn]);
        const float xr = p_r + (q_r - p_r) * mur, xk = p_k + (q_k - p_k) * muk, xv = p_v + (q_v - p_v) * muv;
        q_r = p_r; q_k = p_k; q_v = p_v;
        const float a = bf2f(AA[(size_t)m * RW + chn]), wl = WLOG[(size_t)m * RW + chn];
        const float kq0 = xk * kkc, kk = kq0 * (1.0f / fmaxf(sqrtf(wave_sum_dpp(kq0 * kq0)), 1e-12f));
        A[(SS_R * 8 + t) * 64 + lane] = xr; A[(SS_DEC * 8 + t) * 64 + lane] = __expf(wl); A[(SS_KM * 8 + t) * 64 + lane] = xk * (1.0f + (a - 1.0f) * kac);
        A[(SS_KK * 8 + t) * 64 + lane] = kk; A[(SS_BB * 8 + t) * 64 + lane] = kk * a; A[(SS_V * 8 + t) * 64 + lane] = xv;
    }
    f32x4 S[16];
    { const f32x4* sp = (const f32x4*)(F.a->in[I_SWKV] + ((size_t)(b * 8 + h) * 64 + lane) * 64);
#pragma unroll
      for (int q = 0; q < 16; ++q) S[q] = sp[q]; }
    float gate[TS];
#pragma unroll
    for (int t = 0; t < TS; ++t) gate[t] = bf2f(GG[(size_t)(MP + b * TS + t) * RW + chn]);
    LDS_WAIT(); asm volatile("" ::: "memory");
#pragma unroll
    for (int t = 0; t < TS; ++t) {
        const LAS f32x4* pk = (const LAS f32x4*)(A + (SS_KK * 8 + t) * 64); const LAS f32x4* pb = (const LAS f32x4*)(A + (SS_BB * 8 + t) * 64);
        const LAS f32x4* pd = (const LAS f32x4*)(A + (SS_DEC * 8 + t) * 64); const LAS f32x4* pm = (const LAS f32x4*)(A + (SS_KM * 8 + t) * 64);
        const LAS f32x4* pq = (const LAS f32x4*)(A + (SS_R * 8 + t) * 64);
        const float v = A[(SS_V * 8 + t) * 64 + lane];
        f32x4 sa4 = (f32x4){0.f, 0.f, 0.f, 0.f};
#pragma unroll
        for (int q = 0; q < 16; ++q) sa4 += S[q] * pk[q];
        const float sa = (sa4[0] + sa4[1]) + (sa4[2] + sa4[3]);
        f32x4 y4 = (f32x4){0.f, 0.f, 0.f, 0.f};
#pragma unroll
        for (int q = 0; q < 16; ++q) { S[q] = S[q] * pd[q] + (pm[q] * v - pb[q] * sa); y4 += S[q] * pq[q]; }
        const float y = (y4[0] + y4[1]) + (y4[2] + y4[3]);
        const float mean = wave_sum_dpp(y) * (1.f / 64.f), d = y - mean, var = wave_sum_dpp(d * d) * (1.f / 64.f);
        const float yn = d * (1.0f / sqrtf(var + GN_EPS));
        const float dot = wave_sum_dpp(A[(SS_R * 8 + t) * 64 + lane] * A[(SS_KM * 8 + t) * 64 + lane] * rkc);
        const int m = MP + b * TS + t;
        MIX[(size_t)m * D + chn] = (bf16)f2bf((yn * gnw + gnb + dot * v) * gate[t]);
        asm volatile("" ::: "memory");
    }
    { f32x4* so = (f32x4*)(F.a->out + O_WKV_S + ((size_t)(b * 8 + h) * 64 + lane) * 64);
#pragma unroll
      for (int q = 0; q < 16; ++q) so[q] = S[q]; }
}
constexpr int PB = 144, PF = 272;
constexpr int MB16 = 64 * PB, MF32 = 64 * PF;
constexpr size_t WS_GX = 2 * MiB;
constexpr size_t WS_S0 = 167 * MiB;
static_assert(WS_GX + 512 * 32768 <= WS_WIN && WS_H + (size_t)M * NIN * 2 <= WS_S0 && WS_S0 + 512 * 16384 <= WS_WLOG, "scan scratch map");
constexpr int CA_RHS = 0, CA_LB = 34816, CA_KQ = 52224, CA_KD = 61440, CA_BD = 70656, CA_VT = 79872, CA_KET = 89088, CA_BET = 98304, CA_LK = 107520, CA_SMALL = 116736;
constexpr int CC_RHS = 0, CC_LB = 17408, CC_KQ = 34816, CC_RQ = 44032, CC_KD = 53248, CC_BD = 62464, CC_VT = 71680, CC_KET = 80896, CC_BET = 90112, CC_LK = 99328, CC_MK = 108544, CC_MB = 117760,
              CC_SHI = 126976, CC_SLO = 136192, CC_SMALL = 145408;
constexpr int SM_GL = 0, SM_DOT = 256, SM_TOT = 512, SM_BYTES = 512 + 2048;

__device__ __forceinline__ void mm_nt(f32x4 (&acc)[2], const LAS unsigned char* X, const LAS unsigned char* Y, int wave, int lane) {
    const int tr = wave >> 1, tc0 = (wave & 1) * 2, lr = lane & 15, lq = lane >> 4;
#pragma unroll
    for (int ks = 0; ks < 2; ++ks) {
        const bf16x8 xa = *(const LAS bf16x8*)(X + (16 * tr + lr) * PB + ks * 64 + lq * 16);
#pragma unroll
        for (int j = 0; j < 2; ++j) {
            const bf16x8 yb = *(const LAS bf16x8*)(Y + (16 * (tc0 + j) + lr) * PB + ks * 64 + lq * 16);
            acc[j] = __builtin_amdgcn_mfma_f32_16x16x32_bf16(yb, xa, acc[j], 0, 0, 0);
        }
    }
}
#ifndef REP_PHASE
#define REP_PHASE -1
#endif
#define ACC_ZERO(a) do { a[0] = (f32x4){0.f, 0.f, 0.f, 0.f}; a[1] = (f32x4){0.f, 0.f, 0.f, 0.f}; } while (0)
#define ACC_M(wave, lane) (16 * ((wave) >> 1) + ((lane) & 15))
#define ACC_N(wave, lane, j) (16 * (((wave) & 1) * 2 + (j)) + 4 * ((lane) >> 4))
__device__ __forceinline__ void store_hilo(const f32x4 (&a)[2], LAS unsigned char* HI, LAS unsigned char* LO, int wave, int lane) {
    const int m = ACC_M(wave, lane);
#pragma unroll
    for (int j = 0; j < 2; ++j) { const int n = ACC_N(wave, lane, j);
        const unsigned long long hi = pk4(a[j]); const f32x4 lo = a[j] - bf4_to_f32(hi);
        *(LAS unsigned long long*)(HI + m * PB + n * 2) = hi; *(LAS unsigned long long*)(LO + m * PB + n * 2) = pk4(lo); }
}
template <int NW> __device__ __forceinline__ void tri_solve(const LAS unsigned char* LBT, const LAS unsigned char* RHS, LAS unsigned char* UT, int wave, int lane) {
    if (wave < NW) {
        const int col = wave * 64 + lane;
        f32x4 u[16], lv[8];
#pragma unroll
        for (int q = 0; q < 16; ++q) u[q] = *(const LAS f32x4*)(RHS + col * PF + q * 16);
#define TS_SWEEP(I0, I1, QOFF, QLO)                                                                                                      \
        _Pragma("unroll") for (int q = 0; q < 8; ++q) lv[q] = *(const LAS f32x4*)(LBT + (I0) * PF + (QOFF + q) * 16);                  \
        _Pragma("unroll") for (int i = (I0); i < (I1); ++i) {                                                                            \
            f32x4 ln[8];                                                                                                                 \
            _Pragma("unroll") for (int q = 0; q < 8; ++q) if (i + 1 < (I1) && q >= QLO(i + 1)) ln[q] = *(const LAS f32x4*)(LBT + (i + 1) * PF + (QOFF + q) * 16); \
            asm volatile("" ::: "memory");                                                                                               \
            const float ui = u[i >> 2][i & 3];                                                                                           \
            _Pragma("unroll") for (int q = 0; q < 8; ++q) if (q >= QLO(i)) u[QOFF + q] -= lv[q] * ui;                                    \
            _Pragma("unroll") for (int q = 0; q < 8; ++q) if (i + 1 < (I1) && q >= QLO(i + 1)) lv[q] = ln[q];                            \
        }
#define TS_QLO_A(i) (((i) + 1) >> 2)
#define TS_QLO_B(i) 0
#define TS_QLO_C(i) ((((i) + 1) >> 2) - 8)
        TS_SWEEP(0, 31, 0, TS_QLO_A)
        TS_SWEEP(0, 32, 8, TS_QLO_B)
        TS_SWEEP(32, 63, 8, TS_QLO_C)
#undef TS_SWEEP
#pragma unroll
        for (int q = 0; q < 8; ++q) { v4u w; w.x = pk2(u[2 * q][0], u[2 * q][1]); w.y = pk2(u[2 * q][2], u[2 * q][3]); w.z = pk2(u[2 * q + 1][0], u[2 * q + 1][1]); w.w = pk2(u[2 * q + 1][2], u[2 * q + 1][3]);
            *(LAS v4u*)(UT + col * PB + q * 16) = w; }
    }
}
struct ChunkRaw { unsigned rk[9], vv[5], aa[4]; float wl[8]; };
__device__ __forceinline__ void chunk_load(Frame& F, int m0, int h, ChunkRaw& R) {
    const bf16* P = WSP(bf16, WS_H); const float* WLOG = WSP(float, WS_WLOG); const bf16* AA = WSP(bf16, WS_A);
    const int chn = h * 64 + F.lane, mg = m0 + 8 * F.wave;
    unsigned pv[10], av[8];
    if ((mg & (TP - 1)) == 0) { R.rk[0] = 0u; pv[0] = 0u; }
    else { const size_t o = (size_t)(mg - 1) * NIN; R.rk[0] = (unsigned)P[o + chn] | ((unsigned)P[o + RW + chn] << 16); pv[0] = P[o + 2 * RW + chn]; }
#pragma unroll
    for (int j = 0; j < 8; ++j) { const size_t o = (size_t)(mg + j) * NIN; R.rk[j + 1] = (unsigned)P[o + chn] | ((unsigned)P[o + RW + chn] << 16); pv[j + 1] = P[o + 2 * RW + chn];
        R.wl[j] = WLOG[(size_t)(mg + j) * RW + chn]; av[j] = AA[(size_t)(mg + j) * RW + chn]; }
    pv[9] = 0u;
#pragma unroll
    for (int j = 0; j < 5; ++j) R.vv[j] = pv[2 * j] | (pv[2 * j + 1] << 16);
#pragma unroll
    for (int j = 0; j < 4; ++j) R.aa[j] = av[2 * j] | (av[2 * j + 1] << 16);
}
template <bool PHC> __device__ __forceinline__ void chunk_stage(Frame& F, const ChunkRaw& R, int h, int oKQ, int oRQ, int oKD, int oBD, int oVT, int oKET, int oBET, int oRHS, int oSMALL) {
    LAS unsigned char* lds = F.lds;
    const float* mu = F.a->in[I_MU];
    const int e = F.lane, g = F.wave, chn = h * 64 + e;
    const float mur = mu[chn], muk = mu[RW + chn], muv = mu[2 * RW + chn], kkc = F.a->in[I_KK][chn], kac = F.a->in[I_KA][chn], rkc = F.a->in[I_RK][chn];
    float pr[9], pk[9], pv[9], av[8];
#pragma unroll
    for (int j = 0; j < 9; ++j) { pr[j] = bflo(R.rk[j]); pk[j] = bfhi(R.rk[j]); pv[j] = (j & 1) ? bfhi(R.vv[j >> 1]) : bflo(R.vv[j >> 1]); }
#pragma unroll
    for (int j = 0; j < 8; ++j) av[j] = (j & 1) ? bfhi(R.aa[j >> 1]) : bflo(R.aa[j >> 1]);
    const float (&wl)[8] = R.wl;
    float cw[8]; { float s = 0.f;
#pragma unroll
        for (int j = 0; j < 8; ++j) { s += wl[j]; cw[j] = s; } }
    LAS float* TOT = (LAS float*)(lds + oSMALL + SM_TOT);
    TOT[g * 64 + e] = cw[7];
    __syncthreads();
    float off = 0.f, cwL = 0.f;
#pragma unroll
    for (int gg = 0; gg < 8; ++gg) { const float tv = TOT[gg * 64 + e]; cwL += tv; if (gg < g) off += tv; }
    if (g == 0) ((LAS float*)(lds + oSMALL + SM_GL))[e] = __expf(cwL);
    unsigned vt[8], ket[8], bet[8]; float kq[8];
#pragma unroll
    for (int j = 0; j < 8; ++j) {
        const int t = 8 * g + j;
        const float c = off + cw[j];
        const float xr = pr[j + 1] + (pr[j] - pr[j + 1]) * mur, xk = pk[j + 1] + (pk[j] - pk[j + 1]) * muk, xv = pv[j + 1] + (pv[j] - pv[j + 1]) * muv;
        const float kq0 = xk * kkc, kk = kq0 * (1.0f / fmaxf(sqrtf(wave_sum_dpp(kq0 * kq0)), 1e-12f)), km = xk * (1.0f + (av[j] - 1.0f) * kac), bb = kk * av[j];
        const float e1 = __expf(c), e2 = __builtin_amdgcn_rcpf(e1), e3 = __expf(c - wl[j]), e4 = __expf(cwL - c);
        kq[j] = kk * e3;
        { const unsigned w1 = cvtpk(km * e2, bb * e2), w2 = cvtpk(kq[j], xr * e1);
          *(LAS unsigned short*)(lds + oKD + t * PB + e * 2) = (unsigned short)w1; *(LAS unsigned short*)(lds + oBD + t * PB + e * 2) = (unsigned short)(w1 >> 16);
          *(LAS unsigned short*)(lds + oKQ + t * PB + e * 2) = (unsigned short)w2; if (PHC) *(LAS unsigned short*)(lds + oRQ + t * PB + e * 2) = (unsigned short)(w2 >> 16); }
        if (PHC) {
            const float d = wave_sum_dpp(xr * km * rkc); if (e == 0) ((LAS float*)(lds + oSMALL + SM_DOT))[t] = d; }
        { const unsigned w3 = cvtpk(km * e4, bb * e4); ket[j] = w3 & 0xffffu; bet[j] = w3 >> 16; vt[j] = f2bf(xv); }
    }
    { v4u w; w.x = vt[0] | (vt[1] << 16); w.y = vt[2] | (vt[3] << 16); w.z = vt[4] | (vt[5] << 16); w.w = vt[6] | (vt[7] << 16); *(LAS v4u*)(lds + oVT + e * PB + g * 16) = w; }
    { v4u w; w.x = ket[0] | (ket[1] << 16); w.y = ket[2] | (ket[3] << 16); w.z = ket[4] | (ket[5] << 16); w.w = ket[6] | (ket[7] << 16); *(LAS v4u*)(lds + oKET + e * PB + g * 16) = w; }
    { v4u w; w.x = bet[0] | (bet[1] << 16); w.y = bet[2] | (bet[3] << 16); w.z = bet[4] | (bet[5] << 16); w.w = bet[6] | (bet[7] << 16); *(LAS v4u*)(lds + oBET + e * PB + g * 16) = w; }
    if (!PHC) { *(LAS f32x4*)(lds + oRHS + e * PF + g * 32) = (f32x4){kq[0], kq[1], kq[2], kq[3]}; *(LAS f32x4*)(lds + oRHS + e * PF + g * 32 + 16) = (f32x4){kq[4], kq[5], kq[6], kq[7]}; }
}
__device__ __forceinline__ void scanA_task(Frame& F, int task) {
    LAS unsigned char* lds = F.lds; const int wave = F.wave, lane = F.lane;
    const int sc = task & 31, bh = task >> 5, h = bh & 7, b = bh >> 3;
    const int m = ACC_M(wave, lane);
    f32x4 gacc[2], xacc[2];
#pragma unroll
    for (int j = 0; j < 2; ++j) { const int n = ACC_N(wave, lane, j);
#pragma unroll
        for (int r = 0; r < 4; ++r) { gacc[j][r] = (m == n + r) ? 1.f : 0.f; xacc[j][r] = 0.f; } }
    ChunkRaw raw; chunk_load(F, b * TP + sc * 256, h, raw);
    for (int c = 0; c < 4; ++c) {
        __syncthreads();
        chunk_stage<false>(F, raw, h, CA_KQ, 0, CA_KD, CA_BD, CA_VT, CA_KET, CA_BET, CA_RHS, CA_SMALL);
        if (REP_PHASE == 702) { __syncthreads(); chunk_stage<false>(F, raw, h, CA_KQ, 0, CA_KD, CA_BD, CA_VT, CA_KET, CA_BET, CA_RHS, CA_SMALL); }
        __syncthreads();
        { f32x4 a[2]; ACC_ZERO(a); mm_nt(a, lds + CA_BD, lds + CA_KQ, wave, lane);
#pragma unroll
          for (int j = 0; j < 2; ++j) { const int n = ACC_N(wave, lane, j); f32x4 o;
#pragma unroll
              for (int r = 0; r < 4; ++r) o[r] = (n + r > m) ? a[j][r] : 0.f;
              *(LAS f32x4*)(lds + CA_LB + m * PF + n * 4) = o; } }
        { f32x4 a[2]; ACC_ZERO(a); mm_nt(a, lds + CA_KQ, lds + CA_KD, wave, lane);
#pragma unroll
          for (int j = 0; j < 2; ++j) { const int n = ACC_N(wave, lane, j); f32x4 o;
#pragma unroll
              for (int r = 0; r < 4; ++r) o[r] = (n + r < m) ? a[j][r] : 0.f;
              *(LAS unsigned long long*)(lds + CA_LK + m * PB + n * 2) = pk4(o); } }
        __syncthreads();
        { f32x4 a[2]; ACC_ZERO(a); mm_nt(a, lds + CA_VT, lds + CA_LK, wave, lane);
#pragma unroll
          for (int j = 0; j < 2; ++j) { const int n = ACC_N(wave, lane, j); *(LAS f32x4*)(lds + CA_RHS + (64 + m) * PF + n * 4) = a[j]; } }
        __syncthreads();
        if (c < 3) chunk_load(F, b * TP + sc * 256 + (c + 1) * 64, h, raw);
        tri_solve<2>(lds + CA_LB, lds + CA_RHS, lds + CA_KD, wave, lane);
        if (REP_PHASE == 701) { __syncthreads(); tri_solve<2>(lds + CA_LB, lds + CA_RHS, lds + CA_KD, wave, lane); }
        __syncthreads();
        f32x4 pt[2], xc[2];
        { f32x4 a[2]; ACC_ZERO(a); mm_nt(a, lds + CA_BET, lds + CA_KD, wave, lane);
          const LAS float* GL = (const LAS float*)(lds + CA_SMALL + SM_GL);
#pragma unroll
          for (int j = 0; j < 2; ++j) { const int n = ACC_N(wave, lane, j);
#pragma unroll
              for (int r = 0; r < 4; ++r) pt[j][r] = ((m == n + r) ? GL[n + r] : 0.f) - a[j][r]; } }
        { f32x4 a1[2], a2[2]; ACC_ZERO(a1); ACC_ZERO(a2);
          mm_nt(a1, lds + CA_VT, lds + CA_KET, wave, lane); mm_nt(a2, lds + CA_KD + 64 * PB, lds + CA_BET, wave, lane);
          xc[0] = a1[0] - a2[0]; xc[1] = a1[1] - a2[1]; }
        store_hilo(pt, lds + CA_KQ, lds + CA_LK, wave, lane);
        store_hilo(gacc, lds + 0, lds + MB16, wave, lane);
        store_hilo(xacc, lds + 2 * MB16, lds + 3 * MB16, wave, lane);
        __syncthreads();
        { f32x4 a[2]; ACC_ZERO(a);
          mm_nt(a, lds + 0, lds + CA_KQ, wave, lane); mm_nt(a, lds + 0, lds + CA_LK, wave, lane); mm_nt(a, lds + MB16, lds + CA_KQ, wave, lane);
          gacc[0] = a[0]; gacc[1] = a[1]; }
        { f32x4 a[2]; a[0] = xc[0]; a[1] = xc[1];
          mm_nt(a, lds + 2 * MB16, lds + CA_KQ, wave, lane); mm_nt(a, lds + 2 * MB16, lds + CA_LK, wave, lane); mm_nt(a, lds + 3 * MB16, lds + CA_KQ, wave, lane);
          xacc[0] = a[0]; xacc[1] = a[1]; }
    }
    float* GT = (float*)(F.a->ws + WS_GX + (size_t)task * 32768); float* XO = GT + 4096;
#pragma unroll
    for (int j = 0; j < 2; ++j) { const int n = ACC_N(wave, lane, j);
#pragma unroll
        for (int r = 0; r < 4; ++r) GT[(n + r) * 64 + m] = gacc[j][r];
        *(f32x4*)(XO + m * 64 + n) = xacc[j]; }
}
__device__ __forceinline__ void scanB_unit(Frame& F, int bh) {
    LAS unsigned char* lds = F.lds; const int wave = F.wave, lane = F.lane, tid = F.tid, lr = lane & 15, lq = lane >> 4;
    constexpr int GTB = 2 * MB16;
    LAS unsigned char* myS = lds + 2 * GTB + wave * (2 * 16 * PB);
    const int row = tid >> 3, c8 = (tid & 7) * 8;
    const float* G0 = (const float*)(F.a->ws + WS_GX + (size_t)(bh * 32) * 32768);
#define SB_PUT(buf, ga, gb) do { const unsigned long long h0_ = pk4(ga), h1_ = pk4(gb); const f32x4 l0_ = ga - bf4_to_f32(h0_), l1_ = gb - bf4_to_f32(h1_); const unsigned long long q0_ = pk4(l0_), q1_ = pk4(l1_); \
        *(LAS v4u*)(lds + (buf) * GTB + row * PB + c8 * 2) = (v4u){(unsigned)h0_, (unsigned)(h0_ >> 32), (unsigned)h1_, (unsigned)(h1_ >> 32)}; \
        *(LAS v4u*)(lds + (buf) * GTB + MB16 + row * PB + c8 * 2) = (v4u){(unsigned)q0_, (unsigned)(q0_ >> 32), (unsigned)q1_, (unsigned)(q1_ >> 32)}; } while (0)
    f32x4 g0 = *(const f32x4*)(G0 + row * 64 + c8), g1 = *(const f32x4*)(G0 + row * 64 + c8 + 4);
    __syncthreads();
    SB_PUT(0, g0, g1);
    g0 = *(const f32x4*)(G0 + 8192 + row * 64 + c8); g1 = *(const f32x4*)(G0 + 8192 + row * 64 + c8 + 4);
    f32x4 s[4], x[4];
#pragma unroll
    for (int tc = 0; tc < 4; ++tc) { s[tc] = (f32x4){0.f, 0.f, 0.f, 0.f}; x[tc] = s[tc]; }
    const int vrow = 16 * (wave & 3) + lr;
    if (wave < 4) {
#pragma unroll
        for (int tc = 0; tc < 4; ++tc) x[tc] = *(const f32x4*)(G0 + 4096 + vrow * 64 + 16 * tc + 4 * lq); }
    __syncthreads();
    for (int sc = 0; sc < 32; ++sc) {
        const int task = bh * 32 + sc;
        if (wave < 4) {
            float* S0 = (float*)(F.a->ws + WS_S0 + (size_t)task * 16384);
#pragma unroll
            for (int tc = 0; tc < 4; ++tc) { *(f32x4*)(S0 + vrow * 64 + 16 * tc + 4 * lq) = s[tc];
                const unsigned long long hi = pk4(s[tc]); const f32x4 lo = s[tc] - bf4_to_f32(hi);
                *(LAS unsigned long long*)(myS + lr * PB + (16 * tc + 4 * lq) * 2) = hi; *(LAS unsigned long long*)(myS + 16 * PB + lr * PB + (16 * tc + 4 * lq) * 2) = pk4(lo); }
            f32x4 a[4];
#pragma unroll
            for (int tc = 0; tc < 4; ++tc) a[tc] = x[tc];
            if (sc + 1 < 32) { const float* Xn = (const float*)(F.a->ws + WS_GX + (size_t)(task + 1) * 32768) + 4096;
#pragma unroll
                for (int tc = 0; tc < 4; ++tc) x[tc] = *(const f32x4*)(Xn + vrow * 64 + 16 * tc + 4 * lq); }
            LDS_WAIT(); asm volatile("" ::: "memory");
            const LAS unsigned char* gb = lds + (sc & 1) * GTB;
#pragma unroll
            for (int ks = 0; ks < 2; ++ks) {
                const bf16x8 xh = *(const LAS bf16x8*)(myS + lr * PB + ks * 64 + lq * 16), xl = *(const LAS bf16x8*)(myS + 16 * PB + lr * PB + ks * 64 + lq * 16);
#pragma unroll
                for (int tc = 0; tc < 4; ++tc) {
                    const bf16x8 yh = *(const LAS bf16x8*)(gb + (16 * tc + lr) * PB + ks * 64 + lq * 16), yl = *(const LAS bf16x8*)(gb + MB16 + (16 * tc + lr) * PB + ks * 64 + lq * 16);
                    a[tc] = __builtin_amdgcn_mfma_f32_16x16x32_bf16(yh, xh, a[tc], 0, 0, 0);
                    a[tc] = __builtin_amdgcn_mfma_f32_16x16x32_bf16(yl, xh, a[tc], 0, 0, 0);
                    a[tc] = __builtin_amdgcn_mfma_f32_16x16x32_bf16(yh, xl, a[tc], 0, 0, 0);
                }
            }
#pragma unroll
            for (int tc = 0; tc < 4; ++tc) s[tc] = a[tc];
        }
        if (sc + 1 < 32) SB_PUT((sc + 1) & 1, g0, g1);
        if (sc + 2 < 32) { const float* Gn = (const float*)(F.a->ws + WS_GX + (size_t)(task + 2) * 32768); g0 = *(const f32x4*)(Gn + row * 64 + c8); g1 = *(const f32x4*)(Gn + row * 64 + c8 + 4); }
        __syncthreads();
    }
#undef SB_PUT
}
__device__ __forceinline__ void scanC_task(Frame& F, int task) {
    LAS unsigned char* lds = F.lds; const int wave = F.wave, lane = F.lane;
    const int sc = task & 31, bh = task >> 5, h = bh & 7, b = bh >> 3;
    const int m = ACC_M(wave, lane);
    const bf16* GG = WSP(bf16, WS_G); bf16* MIX = WSP(bf16, WS_U);
    const int chn = h * 64 + lane; const float gnw = F.a->in[I_GNW][chn], gnb = F.a->in[I_GNB][chn];
    f32x4 s[2];
    { const float* S0 = (const float*)(F.a->ws + WS_S0 + (size_t)task * 16384);
#pragma unroll
      for (int j = 0; j < 2; ++j) { const int n = ACC_N(wave, lane, j); s[j] = *(const f32x4*)(S0 + m * 64 + n); } }
    ChunkRaw raw; chunk_load(F, b * TP + sc * 256, h, raw);
    for (int c = 0; c < 4; ++c) {
        const int m0 = b * TP + sc * 256 + c * 64;
        __syncthreads();
        chunk_stage<true>(F, raw, h, CC_KQ, CC_RQ, CC_KD, CC_BD, CC_VT, CC_KET, CC_BET, 0, CC_SMALL);
        store_hilo(s, lds + CC_SHI, lds + CC_SLO, wave, lane);
        __syncthreads();
        { f32x4 a[2]; ACC_ZERO(a); mm_nt(a, lds + CC_BD, lds + CC_KQ, wave, lane);
#pragma unroll
          for (int j = 0; j < 2; ++j) { const int n = ACC_N(wave, lane, j); f32x4 o;
#pragma unroll
              for (int r = 0; r < 4; ++r) o[r] = (n + r > m) ? a[j][r] : 0.f;
              *(LAS f32x4*)(lds + CC_LB + m * PF + n * 4) = o; } }
        { f32x4 a[2]; ACC_ZERO(a); mm_nt(a, lds + CC_KQ, lds + CC_KD, wave, lane);
#pragma unroll
          for (int j = 0; j < 2; ++j) { const int n = ACC_N(wave, lane, j); f32x4 o;
#pragma unroll
              for (int r = 0; r < 4; ++r) o[r] = (n + r < m) ? a[j][r] : 0.f;
              *(LAS unsigned long long*)(lds + CC_LK + m * PB + n * 2) = pk4(o); } }
        { f32x4 a[2], a2[2]; ACC_ZERO(a); ACC_ZERO(a2); mm_nt(a, lds + CC_RQ, lds + CC_KD, wave, lane); mm_nt(a2, lds + CC_RQ, lds + CC_BD, wave, lane);
#pragma unroll
          for (int j = 0; j < 2; ++j) { const int n = ACC_N(wave, lane, j); f32x4 o, o2;
#pragma unroll
              for (int r = 0; r < 4; ++r) { o[r] = (n + r <= m) ? a[j][r] : 0.f; o2[r] = (n + r <= m) ? a2[j][r] : 0.f; }
              *(LAS unsigned long long*)(lds + CC_MK + m * PB + n * 2) = pk4(o); *(LAS unsigned long long*)(lds + CC_MB + m * PB + n * 2) = pk4(o2); } }
        __syncthreads();
        { f32x4 a[2]; ACC_ZERO(a);
          mm_nt(a, lds + CC_SHI, lds + CC_KQ, wave, lane); mm_nt(a, lds + CC_SLO, lds + CC_KQ, wave, lane); mm_nt(a, lds + CC_VT, lds + CC_LK, wave, lane);
#pragma unroll
          for (int j = 0; j < 2; ++j) { const int n = ACC_N(wave, lane, j); *(LAS f32x4*)(lds + CC_RHS + m * PF + n * 4) = a[j]; } }
        __syncthreads();
        unsigned gq[8];
#pragma unroll
        for (int i8 = 0; i8 < 8; ++i8) gq[i8] = GG[(size_t)(m0 + wave + 8 * i8) * RW + chn];
        if (c < 3) chunk_load(F, m0 + 64, h, raw);
        tri_solve<1>(lds + CC_LB, lds + CC_RHS, lds + CC_KD, wave, lane);
        __syncthreads();
        { f32x4 a[2], a2[2]; ACC_ZERO(a); ACC_ZERO(a2);
          mm_nt(a, lds + CC_RQ, lds + CC_SHI, wave, lane); mm_nt(a, lds + CC_RQ, lds + CC_SLO, wave, lane); mm_nt(a, lds + CC_MK, lds + CC_VT, wave, lane);
          mm_nt(a2, lds + CC_MB, lds + CC_KD, wave, lane);
#pragma unroll
          for (int j = 0; j < 2; ++j) { const int n = ACC_N(wave, lane, j); *(LAS f32x4*)(lds + CC_LB + m * PF + n * 4) = a[j] - a2[j]; } }
        { f32x4 a1[2], a2[2]; ACC_ZERO(a1); ACC_ZERO(a2);
          mm_nt(a1, lds + CC_VT, lds + CC_KET, wave, lane); mm_nt(a2, lds + CC_KD, lds + CC_BET, wave, lane);
          const LAS float* GL = (const LAS float*)(lds + CC_SMALL + SM_GL);
#pragma unroll
          for (int j = 0; j < 2; ++j) { const int n = ACC_N(wave, lane, j); const f32x4 gl = *(const LAS f32x4*)(GL + n); s[j] = s[j] * gl + a1[j] - a2[j]; } }
        __syncthreads();
#pragma unroll
        for (int i8 = 0; i8 < 8; ++i8) {
            const int t = wave + 8 * i8, mm = m0 + t;
            const float y = *(const LAS float*)(lds + CC_LB + t * PF + lane * 4);
            const float mean = wave_sum_dpp(y) * (1.f / 64.f), d = y - mean, var = wave_sum_dpp(d * d) * (1.f / 64.f);
            const float yn = d * (1.0f / sqrtf(var + GN_EPS));
            const float dot = ((const LAS float*)(lds + CC_SMALL + SM_DOT))[t];
            const float v = bf2f(*(const LAS unsigned short*)(lds + CC_VT + lane * PB + t * 2));
            const float gg = bf2f((unsigned short)gq[i8]);
            MIX[(size_t)mm * D + chn] = (bf16)f2bf((yn * gnw + gnb + dot * v) * gg);
        }
    }
    if (sc == 31) { float* so = F.a->out + O_WKV_P + (size_t)bh * 4096;
#pragma unroll
        for (int j = 0; j < 2; ++j) { const int n = ACC_N(wave, lane, j); *(f32x4*)(so + m * 64 + n) = s[j]; } }
}
__device__ __forceinline__ int rel_bucket(int n) {
    if (n < 16) return n;
    const int b = 16 + (int)(logf((float)n * (1.0f / 16.0f)) / 2.0794415416798357f * 16.0f);
    return b < 31 ? b : 31;
}
typedef float f32x16 __attribute__((ext_vector_type(16)));
typedef short s16x4 __attribute__((ext_vector_type(4)));
struct AttnLane { const bf16* qrow; int qrel; int rmin; const LAS float* btab; float sink; bf16* orow; };
__device__ __forceinline__ void attn_core32(const LAS unsigned char* Kl, const LAS unsigned char* Vt, int VTP, int kt0, const AttnLane L, int lane) {
    const int r = lane & 31, h = lane >> 5;
    bf16x8 qf[4];
#pragma unroll
    for (int ds = 0; ds < 4; ++ds) qf[ds] = *(const bf16x8*)(L.qrow + 16 * ds + 8 * h);
    f32x16 sc[5];
#pragma unroll
    for (int T = 0; T < 5; ++T) {
#pragma unroll
        for (int e = 0; e < 16; ++e) sc[T][e] = 0.f;
#pragma unroll
        for (int ds = 0; ds < 4; ++ds) { const bf16x8 kf = *(const LAS bf16x8*)(Kl + ((kt0 + T) * 32 + r) * 144 + (16 * ds + 8 * h) * 2);
            sc[T] = __builtin_amdgcn_mfma_f32_32x32x16_bf16(kf, qf[ds], sc[T], 0, 0, 0); }
    }
    float mx = L.sink;
#pragma unroll
    for (int T = 0; T < 5; ++T)
#pragma unroll
        for (int e = 0; e < 16; ++e) { const int rabs = (kt0 + T) * 32 + (e & 3) + 8 * (e >> 2) + 4 * h, dist = L.qrel - rabs;
            const bool valid = dist >= 0 && dist < 128 && rabs >= L.rmin;
            const float s = valid ? sc[T][e] * 0.125f + L.btab[dist & 127] : -1e30f;
            sc[T][e] = s; mx = fmaxf(mx, s); }
    mx = fmaxf(mx, __shfl_xor(mx, 32));
    float l = 0.f;
#pragma unroll
    for (int T = 0; T < 5; ++T)
#pragma unroll
        for (int e = 0; e < 16; ++e) { const float p = sc[T][e] > -1e29f ? __expf(sc[T][e] - mx) : 0.f; sc[T][e] = p; l += p; }
    l += __shfl_xor(l, 32);
    l += __expf(L.sink - mx);
    f32x16 o[2];
#pragma unroll
    for (int e = 0; e < 16; ++e) { o[0][e] = 0.f; o[1][e] = 0.f; }
#pragma unroll
    for (int T = 0; T < 5; ++T)
#pragma unroll
        for (int s2 = 0; s2 < 2; ++s2) {
            v4u pw; pw.x = pk2(sc[T][8 * s2], sc[T][8 * s2 + 1]); pw.y = pk2(sc[T][8 * s2 + 2], sc[T][8 * s2 + 3]); pw.z = pk2(sc[T][8 * s2 + 4], sc[T][8 * s2 + 5]); pw.w = pk2(sc[T][8 * s2 + 6], sc[T][8 * s2 + 7]);
            const bf16x8 pb = __builtin_bit_cast(bf16x8, pw);
#pragma unroll
            for (int dt = 0; dt < 2; ++dt) {
                const LAS unsigned char* vp = Vt + (32 * dt + r) * VTP + ((kt0 + T) * 32 + 16 * s2 + 4 * h) * 2;
                const s16x4 lo = *(const LAS s16x4*)vp, hi = *(const LAS s16x4*)(vp + 16);
                const bf16x8 va = (bf16x8){lo[0], lo[1], lo[2], lo[3], hi[0], hi[1], hi[2], hi[3]};
                o[dt] = __builtin_amdgcn_mfma_f32_32x32x16_bf16(va, pb, o[dt], 0, 0, 0);
            }
        }
    const float il = 1.0f / l;
#pragma unroll
    for (int dt = 0; dt < 2; ++dt)
#pragma unroll
        for (int gq = 0; gq < 4; ++gq) { const int d = 32 * dt + 8 * gq + 4 * h;
            const unsigned long long w = (unsigned long long)pk2(o[dt][4 * gq] * il, o[dt][4 * gq + 1] * il) | ((unsigned long long)pk2(o[dt][4 * gq + 2] * il, o[dt][4 * gq + 3] * il) << 32);
            *(unsigned long long*)(L.orow + d) = w; }
}
constexpr int AP_K = 0, AP_VTP = 528, AP_VT = 256 * 144, AP_BT = AP_VT + 64 * AP_VTP, AP_END = AP_BT + 4 * 128 * 4;
__device__ __forceinline__ void attn_prompt_unit(Frame& F, int b, int kvh, int qb) {
    LAS unsigned char* lds = F.lds;
    const bf16* P = WSP(bf16, WS_H); bf16* MIX = WSP(bf16, WS_U); const float* relb = F.a->in[I_RELB];
    const int t0 = qb * 128, tid = F.tid;
    __syncthreads();
    for (int idx = tid; idx < 256 * 8; idx += 512) {
        const int row = idx >> 3, part = idx & 7, pos = t0 - 128 + row;
        v4u val = (v4u){0u, 0u, 0u, 0u};
        if (pos >= 0) val = *(const v4u*)(P + (size_t)(b * TP + pos) * NIN + 2304 + kvh * 64 + part * 8);
        *(LAS v4u*)(lds + AP_K + row * 144 + part * 16) = val;
    }
    for (int idx = tid; idx < 256 * 8; idx += 512) {
        const int row = idx & 255, part = idx >> 8, pos = t0 - 128 + row;
        v4u val = (v4u){0u, 0u, 0u, 0u};
        if (pos >= 0) val = *(const v4u*)(P + (size_t)(b * TP + pos) * NIN + 2432 + kvh * 64 + part * 8);
#pragma unroll
        for (int e = 0; e < 4; ++e) { *(LAS unsigned short*)(lds + AP_VT + (part * 8 + 2 * e) * AP_VTP + row * 2) = (unsigned short)(val[e] & 0xffffu);
                                      *(LAS unsigned short*)(lds + AP_VT + (part * 8 + 2 * e + 1) * AP_VTP + row * 2) = (unsigned short)(val[e] >> 16); }
    }
    { const int g = tid >> 7, dist = tid & 127; ((LAS float*)(lds + AP_BT))[g * 128 + dist] = relb[rel_bucket(dist) * 8 + kvh * 4 + g]; }
    __syncthreads();
    const int g = F.wave & 3, qh = F.wave >> 2, hq = kvh * 4 + g;
#pragma unroll 1
    for (int bq = 0; bq < 2; ++bq) {
        const int i = 64 * qh + 32 * bq + (F.lane & 31), m = b * TP + t0 + i;
        AttnLane L; L.qrow = P + (size_t)m * NIN + RWP + hq * 64; L.qrel = i + 128; L.rmin = t0 == 0 ? 128 : 0;
        L.btab = (const LAS float*)(lds + AP_BT) + g * 128; L.sink = F.a->in[I_SINKS][hq]; L.orow = MIX + (size_t)m * D + RW + hq * 64;
        attn_core32(lds + AP_K, lds + AP_VT, AP_VTP, 2 * qh + bq, L, F.lane);
    }
}
static_assert(AP_END <= RING_BYTES && AP_VT % 16 == 0 && CC_SMALL + SM_BYTES <= RING_BYTES && CA_SMALL + SM_BYTES <= RING_BYTES, "LDS maps");
constexpr int AS_KB = 160 * 144, AS_VTP = 336, AS_VT = 2 * AS_KB, AS_VB = 64 * AS_VTP, AS_BT = AS_VT + 2 * AS_VB, AS_END = AS_BT + 8 * 128 * 4;
static_assert(AS_END <= RING_BYTES && AS_VT % 16 == 0 && AS_VB % 16 == 0, "LDS maps");
__device__ __forceinline__ void attn_sample_unit(Frame& F, int b) {
    LAS unsigned char* lds = F.lds;
    const bf16* P = WSP(bf16, WS_H); bf16* MIX = WSP(bf16, WS_U); const float* relb = F.a->in[I_RELB]; const float* ck = F.a->in[I_CK]; const float* cv = F.a->in[I_CV];
    const int tid = F.tid;
    __syncthreads();
    for (int idx = tid; idx < 160 * 32; idx += 512) {
        const int j = idx >> 5, c4 = (idx & 31) * 4, kvh = c4 >> 6, d = c4 & 63;
        f32x4 kx = (f32x4){0.f, 0.f, 0.f, 0.f}, vx = kx;
        if (j < 128) { kx = *(const f32x4*)(ck + (size_t)(b * 128 + j) * 128 + c4); vx = *(const f32x4*)(cv + (size_t)(b * 128 + j) * 128 + c4); }
        else if (j < 136) { const bf16* pr = P + (size_t)(MP + b * TS + (j - 128)) * NIN;
            const unsigned long long kw = *(const unsigned long long*)(pr + 2304 + c4), vw = *(const unsigned long long*)(pr + 2432 + c4); kx = bf4_to_f32(kw); vx = bf4_to_f32(vw); }
        *(LAS unsigned long long*)(lds + kvh * AS_KB + j * 144 + d * 2) = pk4(kx);
#pragma unroll
        for (int e = 0; e < 4; ++e) *(LAS unsigned short*)(lds + AS_VT + kvh * AS_VB + (d + e) * AS_VTP + j * 2) = (unsigned short)f2bf(vx[e]);
    }
    for (int idx = tid; idx < 1024; idx += 512) { const int hq = idx >> 7, dist = idx & 127; ((LAS float*)(lds + AS_BT))[idx] = relb[rel_bucket(dist) * 8 + hq]; }
    __syncthreads();
    if (F.wave < 2) {
        const int kvh = F.wave, rr = F.lane & 31, g = rr >> 3, t = rr & 7, hq = kvh * 4 + g, m = MP + b * TS + t;
        AttnLane L; L.qrow = P + (size_t)m * NIN + RWP + hq * 64; L.qrel = t + 128; L.rmin = 0;
        L.btab = (const LAS float*)(lds + AS_BT) + hq * 128; L.sink = F.a->in[I_SINKS][hq]; L.orow = MIX + (size_t)m * D + RW + hq * 64;
        attn_core32(lds + kvh * AS_KB, lds + AS_VT + kvh * AS_VB, AS_VTP, 0, L, F.lane);
    }
}
enum { MT_SCANB = 0, MT_ATTN = 1, MT_SSCAN = 2, MT_SATTN = 3, MT_COPY = 4 };
__device__ __forceinline__ void mixer_task(Frame& F0, int kind, int idx) {
    Frame F = F0;
    { int t_ = threadIdx.x; asm volatile("" : "+v"(t_)); F.tid = t_; F.lane = t_ & 63; F.wave = __builtin_amdgcn_readfirstlane(t_ >> 6); }
#ifndef REP_PHASE
#define REP_PHASE -1
#endif
    if (kind == MT_SCANB) { scanB_unit(F, idx); if (REP_PHASE == 108) scanB_unit(F, idx); }
    else if (kind == MT_ATTN) { attn_prompt_unit(F, idx >> 7, (idx >> 6) & 1, idx & 63); if (REP_PHASE == 208) attn_prompt_unit(F, idx >> 7, (idx >> 6) & 1, idx & 63); }
    else if (kind == MT_SSCAN) { sample_scan_unit(F, idx); if (REP_PHASE == 308) sample_scan_unit(F, idx); }
    else if (kind == MT_SATTN) { attn_sample_unit(F, idx); if (REP_PHASE == 408) attn_sample_unit(F, idx); }
    else { copy_task(F, idx); if (REP_PHASE == 508) copy_task(F, idx); }
}
__device__ __forceinline__ void p_mixer(Frame& F) {
    if (F.G == 256) {
        if (F.vcu < 16) mixer_task(F, MT_SCANB, F.vcu);
        else { const int o = F.vcu - 16;
            if (o < 128) { mixer_task(F, MT_SSCAN, o); mixer_task(F, MT_ATTN, o); }
            else { const int p = o - 128;
                mixer_task(F, MT_ATTN, 128 + p);
                if (p < 16) mixer_task(F, MT_ATTN, 240 + p);
                else { const int q = p - 16;
                    mixer_task(F, MT_SATTN, q); if (q < 32) mixer_task(F, MT_SATTN, 96 + q);
                    mixer_task(F, MT_COPY, q); } } }
    } else {
        for (int t = F.vcu; t < 16 + 256 + 128 + 128 + NCOPY; t += F.G) {
            if (t < 16) mixer_task(F, MT_SCANB, t); else if (t < 272) mixer_task(F, MT_ATTN, t - 16); else if (t < 400) mixer_task(F, MT_SSCAN, t - 272);
            else if (t < 528) mixer_task(F, MT_SATTN, t - 400); else mixer_task(F, MT_COPY, t - 528); }
    }
    __syncthreads();
}
__device__ __forceinline__ void p_scanA(Frame& F) { for (int t = F.vcu; t < 512; t += F.G) scanA_task(F, t); __syncthreads(); }
__device__ __forceinline__ void p_scanC(Frame& F) { for (int t = F.vcu; t < 512; t += F.G) scanC_task(F, t); __syncthreads(); }
#ifndef MK_PER_PHASE
#define MK_PER_PHASE 0
#endif
constexpr int N_PHASES = 15;
__global__ void __launch_bounds__(NWAVES * 64, 2) fwd_kernel(Args args) {
    extern __shared__ __attribute__((aligned(16))) unsigned char lds[];
    Frame F;
    F.lds = (LAS unsigned char*)lds;
    F.MISC = (volatile LAS unsigned*)(F.lds + MISC_OFF);
    F.tid = threadIdx.x; F.lane = F.tid & 63; F.wave = __builtin_amdgcn_readfirstlane(F.tid >> 6);
    F.G = gridDim.x; { const int bx = blockIdx.x; F.vcu = (F.G % 8 == 0) ? (bx % 8) * (F.G / 8) + bx / 8 : bx; }
    F.a = &args; F.ctl = (gu32*)(args.ws + WS_CTL);
    for (int u = F.tid; u < (LDS_BYTES - LDSCTL_OFF) / 4; u += NWAVES * 64) ((LAS unsigned*)(F.lds + LDSCTL_OFF))[u] = 0u;
    __syncthreads();
    const int lo = args.ph_lo, hi = args.ph_hi;
    XcdBarrier bar; bar.bar = (unsigned*)(F.ctl + CW_BAR); bar.x = 0; bar.st = nullptr;
    if (hi - lo > 1) bar = xcd_barrier_post((unsigned*)(F.ctl + CW_BAR), F.MISC + 8);
#ifdef ONLY_PHASE
#define IN(k) ((k) == ONLY_PHASE && lo <= (k) && (k) < hi)
#else
#define IN(k) (lo <= (k) && (k) < hi)
#endif
#ifndef REP_PHASE
#define REP_PHASE -1
#endif
#define SEAM(k) do { if ((k) + 1 < hi) xcd_barrier(bar); } while (0)
#define PH(k, BODY) if (IN(k)) { BODY; if ((k) == REP_PHASE) { xcd_barrier(bar); BODY; } SEAM(k); }
#define GEMM_SWIGLU(WOFF) { \
        pg8::Gemm g{WSP(bf16, WS_U), WSP(bf16, WOFF), M, NFF, D}; pg8::StaticOrder S; S.init(M, NFF, F.G, (int)blockIdx.x, D); \
        pg8::EpiSwiglu E{WSP(bf16, WS_H), FF}; \
        pg8::gemm_phase<pg8::EpiSwiglu, pg8::StaticOrder, true, true>(F.lds + RING_OFF, g, S, E); }
#define GEMM_RESID(AOFF, WOFF, KK, XP, XS, GTK, GS) { \
        pg8::Gemm g{WSP(bf16, AOFF), WSP(bf16, WOFF), M, D, KK}; pg8::SliceOrder S; S.init(KK, F.G, (int)blockIdx.x); \
        pg8::EpiResid<GS> E{XP, XS, args.out + O_Y, WSP(float, WS_MOD) + (GTK) * D, WSP(float, WS_WLOG)}; \
        pg8::gemm_phase<pg8::EpiResid<GS>, pg8::SliceOrder, true, true>(F.lds + RING_OFF, g, S, E); }
#define GEMM_WIN() { \
        pg8::Gemm g{WSP(bf16, WS_U), WSP(bf16, WS_WIN), M, NIN, D}; pg8::StaticOrder S; S.init(M, NIN, F.G, (int)blockIdx.x, D); \
        pg8::EpiBf16<0> E{WSP(bf16, WS_H), NIN, nullptr, 0, 0, 1.f}; \
        pg8::gemm_phase<pg8::EpiBf16<0>, pg8::StaticOrder, true, true>(F.lds + RING_OFF, g, S, E); }
    PH(0, { p0_weights(F); if (REP_PHASE == 100) { __syncthreads(); p0_weights(F); } __syncthreads(); p0_mod(F); if (REP_PHASE == 101) { __syncthreads(); p0_mod(F); } })
    PH(1, p_modulate0(F))
    PH(2, GEMM_SWIGLU(WS_W1IN))
    PH(3, GEMM_RESID(WS_H, WS_W1OUT, FF, args.in[I_XP], args.in[I_XS], 2, 1))
    PH(4, p_layernorm(F, 0, 3 * D, FF / 256, args.in[I_XS], 2, 0.5f))
    PH(5, GEMM_WIN())
    PH(6, p_prep(F))
    PH(7, p_scanA(F))
    PH(8, p_mixer(F))
    PH(9, p_scanC(F))
    PH(10, GEMM_RESID(WS_U, WS_WOUT, D, args.out + O_Y, args.out + O_Y + (size_t)MP * D, 5, 2))
    PH(11, p_layernorm(F, 1, 6 * D, D / 256, args.out + O_Y + (size_t)MP * D, 5, 1.0f))
    PH(12, GEMM_SWIGLU(WS_W2IN))
    PH(13, GEMM_RESID(WS_H, WS_W2OUT, FF, args.out + O_Y, args.out + O_Y + (size_t)MP * D, 8, 1))
    PH(14, p_layernorm(F, 2, -1, FF / 256, args.out + O_Y + (size_t)MP * D, 8, 0.5f))
}

extern "C" void kernel_launch(void* const* d_in, const int* in_sizes, int n_in, void* d_out, int out_size, void* d_ws, size_t ws_size, hipStream_t stream) {
    static int grid = 0;
    if (grid == 0) {
        if (n_in != N_IN || in_sizes[0] != MP * D || out_size != (int)O_END || ws_size < WS_END) { fprintf(stderr, "kernel_launch: unexpected shapes (n_in %d, out %d, ws %zu); nothing launched\n", n_in, out_size, ws_size); grid = -1; return; }
        int dev = 0, cus = 0;
        if (hipGetDevice(&dev) != hipSuccess || hipDeviceGetAttribute(&cus, hipDeviceAttributeMultiprocessorCount, dev) != hipSuccess) { grid = -1; return; }
        if (hipFuncSetAttribute((const void*)fwd_kernel, hipFuncAttributeMaxDynamicSharedMemorySize, LDS_BYTES) != hipSuccess) { fprintf(stderr, "kernel_launch: hipFuncSetAttribute failed\n"); grid = -1; return; }
        int per_cu = 0;
        if (hipOccupancyMaxActiveBlocksPerMultiprocessor(&per_cu, (const void*)fwd_kernel, NWAVES * 64, LDS_BYTES) != hipSuccess || per_cu < 1) fprintf(stderr, "kernel_launch: occupancy query reports %d\n", per_cu);
        (void)hipGetLastError();
        grid = cus;
    }
    if (grid < 0) return;
    if (hipMemsetAsync((char*)d_ws + WS_CTL, 0, CTL_ZERO_BYTES, stream) != hipSuccess) return;
    Args a{};
    for (int i = 0; i < N_IN; ++i) a.in[i] = (const float*)d_in[i];
    a.out = (float*)d_out; a.ws = (unsigned char*)d_ws;
#if MK_PER_PHASE
    for (int ph = 0; ph < N_PHASES; ++ph) { a.ph_lo = ph; a.ph_hi = ph + 1; hipLaunchKernelGGL(fwd_kernel, dim3(grid), dim3(NWAVES * 64), LDS_BYTES, stream, a); }
#else
    a.ph_lo = 0; a.ph_hi = N_PHASES;
    hipLaunchKernelGGL(fwd_kernel, dim3(grid), dim3(NWAVES * 64), LDS_BYTES, stream, a);
#endif
}
```

```cpp
#define MK_PER_PHASE 0

#include <hip/hip_runtime.h>
#include <cstdio>
#include <cstdint>
#include <cmath>
namespace pg8 {
#define PG8_LAS __attribute__((address_space(3)))
typedef unsigned short bf16_t;
typedef short bf16x8 __attribute__((ext_vector_type(8)));
typedef float f32x4 __attribute__((ext_vector_type(4)));
typedef unsigned u32x4 __attribute__((ext_vector_type(4)));
constexpr int BM = 256, BK = 64, HALF = 128, HTB = HALF * BK * 2  , STAGE_BYTES = 8 * HTB, NXCD = 8, WGM = 8;

__host__ __device__ __forceinline__ int lds_byte(int r, int c) { const int st = (r >> 4) * 2 + (c >> 5), rr = r & 15, cc = c & 31, ob = rr * 64 + cc * 2; return st * 1024 + (ob ^ (((ob >> 9) & 1) << 5)); }
__host__ __device__ __forceinline__ void stage_rc(int b, int& R, int& C) { const int st = b / 1024, sb = b % 1024, swz = sb ^ (((sb >> 9) & 1) << 5); R = (st >> 1) * 16 + swz / 64; C = (st & 1) * 32 + (swz % 64) / 2; }
__host__ __device__ __forceinline__ int perm32(int rho) { const int n = rho >> 4, i = rho & 15; return 8 * (i >> 2) + 4 * n + (i & 3); }

struct Unit { int pm, pn, kt0, nt, ks; };
struct Gemm { const bf16_t* A; const bf16_t* Bt; int M, N, K; };

struct StaticOrder {
    int nM, nN, nwg, G, c;
    int ntk;
    __host__ __device__ void init(int M, int N, int G_, int c_, int K = 0) { nM = M / BM; nN = N / BM; nwg = nM * nN; G = G_; c = c_; ntk = K / BK; }
    __host__ __device__ bool next(int i, Unit& u) const {
        const long L = (long)i * G + c; if (L >= nwg) return false;
        int wgid = (int)L; { const int q = nwg / NXCD, r = nwg % NXCD, xcd = wgid % NXCD, off = wgid / NXCD; wgid = (xcd < r ? xcd * (q + 1) : r * (q + 1) + (xcd - r) * q) + off; }
        const int nig = WGM * nN, gid = wgid / nig, fm = gid * WGM, gsz = (nM - fm) < WGM ? (nM - fm) : WGM;
        u.pm = fm + ((wgid % nig) % gsz); u.pn = (wgid % nig) / gsz; u.kt0 = 0; u.nt = ntk; u.ks = -1; return true;
    }
    __device__ __forceinline__ void a_ready(const Unit&) const {}
    __device__ __forceinline__ void done(const Unit&) const {}
};

__device__ __forceinline__ unsigned cvt_pk_bf16(float lo, float hi) { unsigned r; asm volatile("v_cvt_pk_bf16_f32 %0, %1, %2" : "=v"(r) : "v"(lo), "v"(hi)); return r; }
template <int ACT  > struct EpiBf16 {
    static constexpr bool PERM = true, AFTER_DRAIN = false; static_assert(ACT == 0, "EpiBf16: ACT is 0 (none)");
    bf16_t* O; int ldc; const float* bias; int split_cols; size_t split_stride; float scale0;
    __device__ __forceinline__ void operator()(const f32x4 (&acc)[2][2][4][2], const Unit& u, int wr, int wc, int fr, int fq) const {
        const int row0 = u.pm * BM + wr * 64 + fr; int colt = u.pn * BM; bf16_t* base = O;
        float sc = 1.f; if (split_cols) { const int t = colt / split_cols; base += (size_t)t * split_stride; colt -= t * split_cols; if (t == 0) sc = scale0; }
        const int col0 = colt + wc * 32 + 8 * fq, bcol0 = u.pn * BM + wc * 32 + 8 * fq;
        f32x4 bv[2][2];
#pragma unroll
        for (int bj = 0; bj < 2; ++bj)
#pragma unroll
            for (int n = 0; n < 2; ++n) bv[bj][n] = bias ? *(const f32x4*)(bias + bcol0 + bj * HALF + 4 * n) : (f32x4){0.f, 0.f, 0.f, 0.f};
#pragma unroll
        for (int ai = 0; ai < 2; ++ai)
#pragma unroll
            for (int m = 0; m < 4; ++m) { bf16_t* rowp = base + (size_t)(row0 + ai * HALF + m * 16) * ldc + col0;
#pragma unroll
                for (int bj = 0; bj < 2; ++bj) { f32x4 v0 = acc[ai][bj][m][0] + bv[bj][0], v1 = acc[ai][bj][m][1] + bv[bj][1];
                    v0 = v0 * sc; v1 = v1 * sc; u32x4 w; w.x = cvt_pk_bf16(v0[0], v0[1]); w.y = cvt_pk_bf16(v0[2], v0[3]); w.z = cvt_pk_bf16(v1[0], v1[1]); w.w = cvt_pk_bf16(v1[2], v1[3]);
                    *(u32x4*)(rowp + bj * HALF) = w; } }
    }
};

template <class Epi, class Sched, bool ALIGN_EPI = false, bool SP2 = false>
__device__ __forceinline__ void gemm_phase(PG8_LAS unsigned char* lds, const Gemm g, const Sched& S, const Epi& E) {
    const int tid = threadIdx.x, wid = __builtin_amdgcn_readfirstlane(tid >> 6), lane = tid & 63, wr = wid >> 2, wc = wid & 3, fr = lane & 15, fq = lane >> 4;
    const int K = g.K;
    unsigned voffA[2], voffB[2];
#pragma unroll
    for (int i = 0; i < 2; ++i) { int R, C; stage_rc(tid * 16 + i * 8192, R, C); const int Rb = Epi::PERM ? ((R & ~31) + perm32(R & 31)) : R;
        voffA[i] = (unsigned)(R * K + C) * 2u; voffB[i] = (unsigned)(Rb * K + C) * 2u; }
    const size_t kstep = (size_t)(BK * 2);
    const size_t hstep = (size_t)HALF * K * 2;
    const size_t tstep = 2 * hstep;
    const unsigned ldsw = (unsigned)wid * 1024u;
    const int aoff = lds_byte(wr * 64 + fr, fq * 8), boff = lds_byte(wc * 32 + fr, fq * 8);
#define PG8_SA(b, h) (((b) * 2 + (h)) * HTB)
#define PG8_SB(b, h) ((4 + (b) * 2 + (h)) * HTB)
#define PG8_STAGE(bufoff, gbase, voff) do { _Pragma("unroll") for (int _i = 0; _i < 2; ++_i) \
        __builtin_amdgcn_global_load_lds((const unsigned*)((const char*)(gbase) + (voff)[_i]), (PG8_LAS unsigned*)(lds + (bufoff) + ldsw + _i * 8192), 16, 0, 0); } while (0)
#define PG8_LDA(dst, b, h) do { _Pragma("unroll") for (int m = 0; m < 4; ++m) _Pragma("unroll") for (int k = 0; k < 2; ++k) dst[m][k] = *(const PG8_LAS bf16x8*)(lds + PG8_SA(b, h) + aoff + m * 2048 + k * 1024); } while (0)
#define PG8_LDB(dst, b, h) do { _Pragma("unroll") for (int n = 0; n < 2; ++n) _Pragma("unroll") for (int k = 0; k < 2; ++k) dst[n][k] = *(const PG8_LAS bf16x8*)(lds + PG8_SB(b, h) + boff + n * 2048 + k * 1024); } while (0)
#define PG8_MMA(ai, bj, At, Bt) do { __builtin_amdgcn_s_setprio(1); _Pragma("unroll") for (int m = 0; m < 4; ++m) _Pragma("unroll") for (int n = 0; n < 2; ++n) _Pragma("unroll") for (int k = 0; k < 2; ++k) \
        acc[ai][bj][m][n] = __builtin_amdgcn_mfma_f32_16x16x32_bf16(Bt[n][k], At[m][k], acc[ai][bj][m][n], 0, 0, 0); __builtin_amdgcn_s_setprio(0); } while (0)
#define PG8_WAIT_V(n) asm volatile("s_waitcnt vmcnt(" #n ")" ::: "memory")
#define PG8_WAIT_L(n) asm volatile("s_waitcnt lgkmcnt(" #n ")" ::: "memory")
#define PG8_BAR __builtin_amdgcn_s_barrier()
#define PG8_SCHED __builtin_amdgcn_sched_barrier(0)
    Unit cur, nxt; int ui = 0;
    if (!S.next(0, cur)) return;
    f32x4 acc[2][2][4][2];
#pragma unroll
    for (int a = 0; a < 2; ++a)
#pragma unroll
        for (int b = 0; b < 2; ++b)
#pragma unroll
            for (int m = 0; m < 4; ++m)
#pragma unroll
                for (int n = 0; n < 2; ++n) acc[a][b][m][n] = (f32x4){0.f, 0.f, 0.f, 0.f};
    bf16x8 At[4][2], B0[2][2], B1[2][2];
    const char* cA = (const char*)g.A + (size_t)cur.pm * tstep + (size_t)cur.kt0 * kstep; const char* cB = (const char*)g.Bt + (size_t)cur.pn * tstep + (size_t)cur.kt0 * kstep;
    S.a_ready(cur);
    if constexpr (SP2) {
        PG8_STAGE(PG8_SB(0, 0), cB, voffB); PG8_STAGE(PG8_SB(0, 1), cB + hstep, voffB); PG8_STAGE(PG8_SA(0, 0), cA, voffA); PG8_STAGE(PG8_SA(0, 1), cA + hstep, voffA);
        if (wr == 1) PG8_BAR;
        PG8_WAIT_V(2); PG8_BAR;
        PG8_STAGE(PG8_SB(1, 0), cB + kstep, voffB); PG8_STAGE(PG8_SA(1, 0), cA + kstep, voffA); PG8_STAGE(PG8_SB(1, 1), cB + hstep + kstep, voffB);
        PG8_WAIT_V(6); PG8_BAR;
    } else {
        PG8_STAGE(PG8_SB(0, 0), cB, voffB); PG8_STAGE(PG8_SA(0, 0), cA, voffA); PG8_STAGE(PG8_SB(0, 1), cB + hstep, voffB); PG8_STAGE(PG8_SA(0, 1), cA + hstep, voffA);
        if (wr == 1) PG8_BAR;
        PG8_WAIT_V(4); PG8_BAR;
        PG8_STAGE(PG8_SB(1, 0), cB + kstep, voffB); PG8_STAGE(PG8_SA(1, 0), cA + kstep, voffA); PG8_STAGE(PG8_SB(1, 1), cB + hstep + kstep, voffB);
        PG8_WAIT_V(6); PG8_BAR;
    }
    for (;;) {
        const bool has_next = S.next(ui + 1, nxt);
        const char* nA = has_next ? (const char*)g.A + (size_t)nxt.pm * tstep + (size_t)nxt.kt0 * kstep : cA; const char* nB = has_next ? (const char*)g.Bt + (size_t)nxt.pn * tstep + (size_t)nxt.kt0 * kstep : cB;
        const int nt = cur.nt;
        for (int t = 0; t < nt; t += 2) {
            const bool last = (t == nt - 2);
            const char* a1 = cA + (size_t)(t + 1) * kstep;
            const char* a2 = last ? nA : cA + (size_t)(t + 2) * kstep; const char* b2 = last ? nB : cB + (size_t)(t + 2) * kstep;
            const char* a3 = a2 + kstep; const char* b3 = b2 + kstep;
            if (last && has_next) S.a_ready(nxt);
            if constexpr (SP2) {
            PG8_LDB(B0, 0, 0); PG8_LDB(B1, 0, 1); PG8_SCHED; PG8_LDA(At, 0, 0); PG8_STAGE(PG8_SA(1, 1), a1 + hstep, voffA);
            PG8_WAIT_V(8); PG8_WAIT_L(0); PG8_BAR; PG8_MMA(0, 0, At, B0); PG8_MMA(0, 1, At, B1); PG8_BAR; PG8_SCHED;
            PG8_LDA(At, 0, 1); PG8_STAGE(PG8_SB(0, 0), b2, voffB); PG8_STAGE(PG8_SB(0, 1), b2 + hstep, voffB); PG8_STAGE(PG8_SA(0, 0), a2, voffA);
            PG8_WAIT_V(8); PG8_WAIT_L(0); PG8_BAR; PG8_MMA(1, 0, At, B0); PG8_MMA(1, 1, At, B1); PG8_BAR; PG8_SCHED;
            PG8_LDB(B0, 1, 0); PG8_LDB(B1, 1, 1); PG8_SCHED; PG8_LDA(At, 1, 0); PG8_STAGE(PG8_SA(0, 1), a2 + hstep, voffA);
            PG8_WAIT_V(8); PG8_WAIT_L(0); PG8_BAR; PG8_MMA(0, 0, At, B0); PG8_MMA(0, 1, At, B1); PG8_BAR; PG8_SCHED;
            PG8_LDA(At, 1, 1); PG8_STAGE(PG8_SB(1, 0), b3, voffB); PG8_STAGE(PG8_SB(1, 1), b3 + hstep, voffB); PG8_STAGE(PG8_SA(1, 0), a3, voffA);
            PG8_WAIT_V(8); PG8_WAIT_L(0); PG8_BAR; PG8_MMA(1, 0, At, B0); PG8_MMA(1, 1, At, B1); PG8_BAR; PG8_SCHED;
            } else {
            PG8_LDB(B0, 0, 0); PG8_SCHED; PG8_LDA(At, 0, 0); PG8_STAGE(PG8_SA(1, 1), a1 + hstep, voffA);
            PG8_WAIT_L(8); PG8_BAR; PG8_WAIT_L(0); PG8_MMA(0, 0, At, B0); PG8_BAR; PG8_SCHED;
            PG8_LDB(B1, 0, 1); PG8_STAGE(PG8_SB(0, 0), b2, voffB);
            PG8_BAR; PG8_WAIT_L(0); PG8_MMA(0, 1, At, B1); PG8_BAR;
            PG8_LDA(At, 0, 1); PG8_STAGE(PG8_SA(0, 0), a2, voffA);
            PG8_BAR; PG8_WAIT_L(0); PG8_MMA(1, 0, At, B0); PG8_BAR; PG8_SCHED;
            PG8_STAGE(PG8_SB(0, 1), b2 + hstep, voffB);
            PG8_WAIT_V(6); PG8_BAR; PG8_MMA(1, 1, At, B1); PG8_BAR;
            PG8_LDB(B0, 1, 0); PG8_SCHED; PG8_LDA(At, 1, 0); PG8_STAGE(PG8_SA(0, 1), a2 + hstep, voffA);
            PG8_WAIT_L(8); PG8_BAR; PG8_WAIT_L(0); PG8_MMA(0, 0, At, B0); PG8_BAR; PG8_SCHED;
            PG8_LDB(B1, 1, 1); PG8_STAGE(PG8_SB(1, 0), b3, voffB);
            PG8_BAR; PG8_WAIT_L(0); PG8_MMA(0, 1, At, B1); PG8_BAR;
            PG8_LDA(At, 1, 1); PG8_STAGE(PG8_SA(1, 0), a3, voffA);
            PG8_BAR; PG8_WAIT_L(0); PG8_MMA(1, 0, At, B0); PG8_BAR; PG8_SCHED;
            PG8_STAGE(PG8_SB(1, 1), b3 + hstep, voffB);
            PG8_WAIT_V(6); PG8_BAR; PG8_MMA(1, 1, At, B1); PG8_BAR;
            }
        }
        if constexpr (ALIGN_EPI) { if (wr == 0) PG8_BAR; }
        if constexpr (!Epi::AFTER_DRAIN) { E(acc, cur, wr, wc, fr, fq); S.done(cur); }
        if (!has_next) break;
#pragma unroll
        for (int a = 0; a < 2; ++a)
#pragma unroll
            for (int b = 0; b < 2; ++b)
#pragma unroll
                for (int m = 0; m < 4; ++m)
#pragma unroll
                    for (int n = 0; n < 2; ++n) acc[a][b][m][n] = (f32x4){0.f, 0.f, 0.f, 0.f};
        cur = nxt; cA = nA; cB = nB; ++ui;
        if constexpr (ALIGN_EPI) { if (wr == 1) PG8_BAR; }
    }
    PG8_WAIT_V(0);
    if constexpr (!ALIGN_EPI) { if (wr == 0) PG8_BAR; }
    PG8_BAR;
    if constexpr (Epi::AFTER_DRAIN) { E.fused(acc, cur, wr, wc, fr, fq, lds, wid, lane); S.done(cur); }
#undef PG8_SA
#undef PG8_SB
#undef PG8_STAGE
#undef PG8_LDA
#undef PG8_LDB
#undef PG8_MMA
#undef PG8_WAIT_V
#undef PG8_WAIT_L
#undef PG8_BAR
#undef PG8_SCHED
}
struct EpiSwiglu {
    static constexpr bool PERM = true, AFTER_DRAIN = false;
    bf16_t* H; int ldh;
    __device__ __forceinline__ void operator()(const f32x4 (&acc)[2][2][4][2], const Unit& u, int wr, int wc, int fr, int fq) const {
        const int row0 = u.pm * BM + wr * 64 + fr, col0 = u.pn * HALF + wc * 32 + 8 * fq;
#pragma unroll
        for (int ai = 0; ai < 2; ++ai)
#pragma unroll
            for (int m = 0; m < 4; ++m) {
                bf16_t* p = H + (size_t)(row0 + ai * HALF + m * 16) * ldh + col0;
                float h[8];
#pragma unroll
                for (int n = 0; n < 2; ++n)
#pragma unroll
                    for (int i = 0; i < 4; ++i) { const float g = acc[ai][0][m][n][i], up = acc[ai][1][m][n][i];
                        h[n * 4 + i] = g * __builtin_amdgcn_rcpf(1.0f + __expf(-g)) * up; }
                u32x4 w; w.x = cvt_pk_bf16(h[0], h[1]); w.y = cvt_pk_bf16(h[2], h[3]); w.z = cvt_pk_bf16(h[4], h[5]); w.w = cvt_pk_bf16(h[6], h[7]);
                *(u32x4*)p = w;
            }
    }
};
template <int GS2  > struct EpiResid {
    static constexpr bool PERM = false, AFTER_DRAIN = false;
    static constexpr float alpha = 1.189207115002721f, gs = 0.5f * GS2;
    const float* xp; const float* xs; float* X; const float* gt; float* part;
    __device__ __forceinline__ void operator()(const f32x4 (&acc)[2][2][4][2], const Unit& u, int wr, int wc, int fr, int fq) const {
        const int col0 = u.pn * BM + wc * 32 + 4 * fq;
        if (u.ks >= 0) {
#pragma unroll
            for (int ai = 0; ai < 2; ++ai)
#pragma unroll
                for (int m = 0; m < 4; ++m) { float* po = part + ((size_t)u.ks * 1024 + (size_t)(u.pm * BM + ai * HALF + wr * 64 + m * 16 + fr - 16384)) * 1024;
#pragma unroll
                    for (int bj = 0; bj < 2; ++bj)
#pragma unroll
                        for (int n = 0; n < 2; ++n) *(f32x4*)(po + col0 + bj * HALF + n * 16) = acc[ai][bj][m][n]; }
            return;
        }
#pragma unroll
        for (int ai = 0; ai < 2; ++ai)
#pragma unroll
            for (int m = 0; m < 4; ++m) {
                const int row = u.pm * BM + ai * HALF + wr * 64 + m * 16 + fr;
                const bool smp = row >= 16384;
                const float* xr = smp ? xs + (size_t)(row - 16384) * 1024 : xp + (size_t)row * 1024;
                const int b = smp ? 2 + ((row - 16384) >> 3) : (row >> 13);
                const float* gr = gt + (size_t)b * 9216;
                float* xo = X + (size_t)row * 1024;
#pragma unroll
                for (int bj = 0; bj < 2; ++bj)
#pragma unroll
                    for (int n = 0; n < 2; ++n) { const int c = col0 + bj * HALF + n * 16;
                        const f32x4 xv = *(const f32x4*)(xr + c), gv = *(const f32x4*)(gr + c);
                        const f32x4 z = xv * alpha + (gv + 1.0f) * gs * acc[ai][bj][m][n];
                        *(f32x4*)(xo + c) = z; }
            }
    }
};
struct SliceOrder {
    StaticOrder so; int nsl, G, c;
    __host__ __device__ void init(int K, int G_, int c_) { so.init(16384, 1024, G_, c_, K); nsl = K / (4 * BK); G = G_; c = c_; }
    __host__ __device__ bool next(int i, Unit& u) const {
        if (so.next(i, u)) return true;
        const long L = (long)i * G + c - so.nwg; if (L < 0 || L >= 16 * nsl) return false;
        const int t16 = (int)L / nsl, ks = (int)L % nsl;
        u.pm = 64 + (t16 >> 2); u.pn = t16 & 3; u.kt0 = 4 * ks; u.nt = 4; u.ks = ks; return true;
    }
    __device__ __forceinline__ void a_ready(const Unit&) const {}
    __device__ __forceinline__ void done(const Unit&) const {}
};
}
#define GAS __attribute__((address_space(1)))
#define LAS __attribute__((address_space(3)))
typedef unsigned short bf16;
typedef unsigned v4u __attribute__((ext_vector_type(4)));
typedef float f32x4 __attribute__((ext_vector_type(4)));
typedef short bf16x8 __attribute__((ext_vector_type(8)));
typedef GAS unsigned gu32;
typedef GAS unsigned long long gu64;
#define RLX_AGENT __ATOMIC_RELAXED, __HIP_MEMORY_SCOPE_AGENT
#define LDS_WAIT() asm volatile("s_waitcnt lgkmcnt(0)" ::: "memory")
#define VM_WAIT() asm volatile("s_waitcnt vmcnt(0)" ::: "memory")
__device__ __forceinline__ unsigned long long rt() { return __builtin_amdgcn_s_memrealtime(); }
__device__ __forceinline__ unsigned f2bf(float f) { unsigned u = __builtin_bit_cast(unsigned, f); return (u + 0x7fffu + ((u >> 16) & 1u)) >> 16; }
__device__ __forceinline__ unsigned pk2(float lo, float hi) { return f2bf(lo) | (f2bf(hi) << 16); }

#define XB_TMO      128
#define XB_XCNT(j)  (256  + 64 * (j))
#define XB_XSUB(j)  (1280 + 64 * (j))
#define XB_XGEN(j)  (2304 + 64 * (j))
#define XB_TOP      3328
#define XB_TOPGEN   3392
#define XCD_BAR_WORDS 3456
#define XB_SPIN_CAP (1u << 18)

__device__ __forceinline__ unsigned xb_ld(unsigned* p)              { return __hip_atomic_load(p, __ATOMIC_RELAXED, __HIP_MEMORY_SCOPE_AGENT); }
__device__ __forceinline__ unsigned xb_add(unsigned* p, unsigned v) { return __hip_atomic_fetch_add(p, v, __ATOMIC_RELAXED, __HIP_MEMORY_SCOPE_AGENT); }
__device__ __forceinline__ unsigned xb_xcc_id() { return (unsigned)__builtin_amdgcn_s_getreg((3 << 11) | 20) & 0xFu; }
#define XB_SPIN(cond, bar) do { unsigned _sp = 0; while (cond) { __builtin_amdgcn_s_sleep(1); \
    if ((++_sp & 255u) == 0u) { if (xb_ld(&(bar)[XB_TMO])) break; if (_sp > XB_SPIN_CAP) { atomicAdd(&(bar)[XB_TMO], 1u); break; } } } } while (0)

struct XcdBarrier {
    unsigned* bar; unsigned x;
    volatile LAS unsigned* st;
};

__device__ __forceinline__ XcdBarrier xcd_barrier_post(unsigned* bar, volatile LAS unsigned* st) {
    XcdBarrier b; b.bar = bar; b.x = xb_xcc_id(); b.st = st;
    if (threadIdx.x == 0) (void)xb_add(&bar[XB_XCNT(b.x)], 1u);
    return b;
}
__device__ __forceinline__ void xcd_barrier_complete(unsigned* bar, unsigned x, unsigned& nloc, unsigned& nx) {
    const unsigned G = gridDim.x * gridDim.y * gridDim.z;
    unsigned sum, cnt, mine, sp = 0u;
    for (;;) {
        sum = 0u; cnt = 0u; mine = 0u;
#pragma unroll
        for (unsigned j = 0; j < 16; ++j) { const unsigned c = xb_ld(&bar[XB_XCNT(j)]); sum += c; cnt += (c > 0u) ? 1u : 0u; mine = (j == x) ? c : mine; }
        if (sum == G) break;
        __builtin_amdgcn_s_sleep(1);
        if ((++sp & 255u) == 0u) { if (xb_ld(&bar[XB_TMO])) break; if (sp > XB_SPIN_CAP) { atomicAdd(&bar[XB_TMO], 1u); break; } }
    }
    nloc = mine > 0u ? mine : 1u; nx = cnt > 0u ? cnt : 1u;
}

__device__ __forceinline__ void xcd_barrier(const XcdBarrier& b) {
    asm volatile("s_waitcnt vmcnt(0)" ::: "memory");
    __syncthreads();
    if (threadIdx.x == 0) {
        unsigned* bar = b.bar;
        __builtin_amdgcn_s_waitcnt(0);
        unsigned nloc = b.st[0], nx = b.st[1];
        if (nloc == 0u) { xcd_barrier_complete(bar, b.x, nloc, nx); b.st[0] = nloc; b.st[1] = nx; }
        const unsigned old = xb_add(&bar[XB_XSUB(b.x)], 1u);
        const unsigned gen = old / nloc;
        if (old + 1u == (gen + 1u) * nloc) {
            __builtin_amdgcn_fence(__ATOMIC_RELEASE, "agent");
            asm volatile("s_waitcnt vmcnt(0)" ::: "memory");
            const unsigned og = xb_add(&bar[XB_TOP], 1u);
            const unsigned tg = og / nx;
            if (og + 1u == (tg + 1u) * nx) xb_add(&bar[XB_TOPGEN], 1u);
            else XB_SPIN(xb_ld(&bar[XB_TOPGEN]) == tg, bar);
            __builtin_amdgcn_fence(__ATOMIC_ACQUIRE, "agent");
            xb_add(&bar[XB_XGEN(b.x)], 1u);
            asm volatile("s_waitcnt vmcnt(0)" ::: "memory");
        } else {
            XB_SPIN(xb_ld(&bar[XB_XGEN(b.x)]) == gen, bar);
            __builtin_amdgcn_fence(__ATOMIC_ACQUIRE, "agent");
            asm volatile("s_waitcnt vmcnt(0)" ::: "memory");
        }
    }
    __syncthreads();
}

constexpr int D = 1024, FF = 2816, NFF = 2 * FF, NIN = 2560, RW = 512, RWP = 1792;
constexpr int MP = 16384, MS = 1024, M = MP + MS, TP = 8192, TS = 8, NBS = 128;
constexpr int MODW = 9216, NMOD = 130;
constexpr float ALPHA = 1.189207115002721f;
constexpr float LN_EPS = 1e-5f, GN_EPS = 64e-5f;
constexpr int NWAVES = 8;
enum { I_XP = 0, I_XS, I_SWKV, I_SSHIFT, I_CK, I_CV, I_CP, I_CS, I_RELB, I_WADA, I_BADA, I_LNG, I_LNB, I_W1IN, I_W1OUT, I_WIN, I_MU, I_W0, I_WDEC, I_A0, I_WICLR, I_WGATE,
       I_KK, I_KA, I_RK, I_GNW, I_GNB, I_SINKS, I_WOUT, I_W2IN, I_W2OUT, N_IN };
constexpr size_t O_Y = 0, O_WKV_P = (size_t)M * D, O_SHIFT_P = O_WKV_P + 65536, O_WINK_P = O_SHIFT_P + 3584, O_WINV_P = O_WINK_P + 32768,
                 O_WKV_S = O_WINV_P + 32768, O_SHIFT_S = O_WKV_S + 4194304, O_WINK_S = O_SHIFT_S + 229376, O_WINV_S = O_WINK_S + 2097152, O_END = O_WINV_S + 2097152;
static_assert(O_END == 26578432, "d_out size");
constexpr size_t MiB = 1u << 20;
constexpr size_t WS_CTL = 0, CTL_ZERO_BYTES = 1 * MiB;
constexpr size_t WS_W1IN = 2 * MiB, WS_W1OUT = 13 * MiB, WS_WIN = 19 * MiB, WS_WOUT = 24 * MiB, WS_W2IN = 26 * MiB, WS_W2OUT = 37 * MiB;
constexpr size_t WS_MOD = 43 * MiB;
constexpr size_t WS_U = 48 * MiB;
constexpr size_t WS_H = 82 * MiB;
constexpr size_t WS_WLOG = 176 * MiB, WS_A = 210 * MiB, WS_G = 227 * MiB, WS_INV = 244 * MiB, WS_LORA = 245 * MiB, WS_END = 246 * MiB;
constexpr size_t LORA_WI = 512 * 64 * 2, LORA_WG = 2 * 512 * 64 * 2;
static_assert(WS_W1IN + (size_t)NFF * D * 2 <= WS_W1OUT && WS_W1OUT + (size_t)D * FF * 2 <= WS_WIN && WS_WIN + (size_t)NIN * D * 2 <= WS_WOUT && WS_WOUT + (size_t)D * D * 2 <= WS_W2IN &&
              WS_W2IN + (size_t)NFF * D * 2 <= WS_W2OUT && WS_W2OUT + (size_t)D * FF * 2 <= WS_MOD && WS_MOD + (size_t)NMOD * MODW * 4 <= WS_U && WS_U + (size_t)M * D * 2 <= WS_H &&
              WS_H + (size_t)M * FF * 2 <= WS_WLOG && WS_WLOG + (size_t)M * RW * 4 <= WS_A && WS_A + (size_t)M * RW * 2 <= WS_G && WS_G + (size_t)M * RW * 2 <= WS_INV &&
              WS_INV + (size_t)M * 8 * 4 <= WS_LORA && WS_LORA + 4 * 512 * 64 * 2 <= WS_END && WS_END <= 256 * MiB, "d_ws map");
constexpr int CW_BAR = 4096;
constexpr int RING_OFF = 0, RING_BYTES = 160768;
constexpr int LDSCTL_OFF = RING_BYTES, MISC_OFF = LDSCTL_OFF + 320;
constexpr int LDS_BYTES = 161792;
static_assert(MISC_OFF + 128 <= LDS_BYTES, "LDS map");

__device__ __forceinline__ float bf2f(unsigned short h) { return __uint_as_float((unsigned)h << 16); }
__device__ __forceinline__ float bflo(unsigned u) { return __uint_as_float(u << 16); }
__device__ __forceinline__ float bfhi(unsigned u) { return __uint_as_float(u & 0xffff0000u); }
__device__ __forceinline__ unsigned long long pk4(f32x4 v) { return (unsigned long long)pk2(v[0], v[1]) | ((unsigned long long)pk2(v[2], v[3]) << 32); }
__device__ __forceinline__ f32x4 bf4_to_f32(unsigned long long w) { return (f32x4){bflo((unsigned)w), bfhi((unsigned)w), bflo((unsigned)(w >> 32)), bfhi((unsigned)(w >> 32))}; }
__device__ __forceinline__ float wave_sum(float v) {
#pragma unroll
    for (int o = 1; o < 64; o <<= 1) v += __shfl_xor(v, o);
    return v;
}
template <int CTRL> __device__ __forceinline__ float dppf(float x) { return __builtin_bit_cast(float, __builtin_amdgcn_update_dpp(0, __builtin_bit_cast(int, x), CTRL, 0xf, 0xf, true)); }
__device__ __forceinline__ float sum8(float x) {
    x += dppf<0xB1>(x);
    x += dppf<0x4E>(x);
    x += dppf<0x141>(x);
    return x;
}
__device__ __forceinline__ float wave_sum_dpp(float x) {
    x += dppf<0xB1>(x); x += dppf<0x4E>(x); x += dppf<0x141>(x);
    x += dppf<0x140>(x);
    const int xi = __builtin_bit_cast(int, x);
    return __builtin_bit_cast(float, __builtin_amdgcn_readlane(xi, 0)) + __builtin_bit_cast(float, __builtin_amdgcn_readlane(xi, 16)) +
           __builtin_bit_cast(float, __builtin_amdgcn_readlane(xi, 32)) + __builtin_bit_cast(float, __builtin_amdgcn_readlane(xi, 48));
}
__device__ __forceinline__ float sigmoidf_(float x) { return __builtin_amdgcn_rcpf(1.0f + __expf(-x)); }
__device__ __forceinline__ float tanhf_(float x) { return 1.0f - 2.0f * __builtin_amdgcn_rcpf(1.0f + __expf(2.0f * x)); }
__device__ __forceinline__ unsigned cvtpk(float lo, float hi) { unsigned r; asm volatile("v_cvt_pk_bf16_f32 %0, %1, %2" : "=v"(r) : "v"(lo), "v"(hi)); return r; }

struct Args { const float* in[N_IN]; float* out; unsigned char* ws; int ph_lo, ph_hi; };
static_assert(sizeof(Args) == N_IN * 8 + 24, "Args has no padding");
struct Frame {
    LAS unsigned char* lds;
    volatile LAS unsigned* MISC;
    gu32* ctl;
    int tid, lane, wave, vcu, G;
    const __attribute__((address_space(4))) Args* a;
    unsigned char* ws;
};
#define WSP(T, off) ((T*)(F.ws + (off)))
#define GIN(k) ((const float*)(const GAS float*)(F.a->in[k]))
#define GOUT() ((float*)(GAS float*)(F.a->out))

__device__ __forceinline__ void p0_transpose_item(const float* W, int K, int N, bf16* WT, int dst_row0, int k0, int n0, LAS float* scr, int lane) {
#pragma unroll 8
    for (int i = 0; i < 32; ++i) { const int kk = 2 * i + (lane >> 5); scr[kk * 33 + (lane & 31)] = W[(size_t)(k0 + kk) * N + n0 + (lane & 31)]; }
    LDS_WAIT(); asm volatile("" ::: "memory");
    const int c = lane & 7;
#pragma unroll
    for (int j = 0; j < 4; ++j) { const int n = (lane >> 3) + 8 * j; const LAS float* s = scr + (8 * c) * 33 + n;
        v4u o; o.x = pk2(s[0 * 33], s[1 * 33]); o.y = pk2(s[2 * 33], s[3 * 33]); o.z = pk2(s[4 * 33], s[5 * 33]); o.w = pk2(s[6 * 33], s[7 * 33]);
        *(GAS v4u*)(WT + (size_t)(dst_row0 + n) * K + k0 + 8 * c) = o; }
    LDS_WAIT(); asm volatile("" ::: "memory");
}
__device__ __forceinline__ void p0_ffin_item(const float* W, bf16* WT, int r, LAS float* scr, int lane) {
    const int kb = r / 176, nb = r % 176, n0 = 32 * nb; const bool up = n0 >= FF; const int j = up ? n0 - FF : n0;
    p0_transpose_item(W, D, NFF, WT, (j >> 7) * 256 + (up ? 128 : 0) + (j & 127), 64 * kb, n0, scr, lane);
}
__device__ __forceinline__ void p0_plain_item(const float* W, int K, int N, bf16* WT, int r, LAS float* scr, int lane) {
    const int nblk = N / 32, kb = r / nblk, nb = r % nblk;
    p0_transpose_item(W, K, N, WT, 32 * nb, 64 * kb, 32 * nb, scr, lane);
}
__device__ __forceinline__ void p0_weights(Frame& F) {
    LAS float* scr = (LAS float*)(F.lds + RING_OFF + F.wave * 16384);
    const int gw = F.vcu * NWAVES + F.wave, NGW = F.G * NWAVES;
    constexpr int I_FI = 16 * 176, I_FO = 44 * 32, I_IN = 16 * 80, I_O = 16 * 32, I_L = 16, NITEMS = 2 * I_FI + 2 * I_FO + I_IN + I_O + 4 * I_L;
    for (int it = gw; it < NITEMS; it += NGW) {
        int r = it;
        if (r < I_FI) { p0_ffin_item(GIN(I_W1IN), WSP(bf16, WS_W1IN), r, scr, F.lane); continue; } r -= I_FI;
        if (r < I_FI) { p0_ffin_item(GIN(I_W2IN), WSP(bf16, WS_W2IN), r, scr, F.lane); continue; } r -= I_FI;
        if (r < I_FO) { p0_plain_item(GIN(I_W1OUT), FF, D, WSP(bf16, WS_W1OUT), r, scr, F.lane); continue; } r -= I_FO;
        if (r < I_FO) { p0_plain_item(GIN(I_W2OUT), FF, D, WSP(bf16, WS_W2OUT), r, scr, F.lane); continue; } r -= I_FO;
        if (r < I_IN) { p0_plain_item(GIN(I_WIN), D, NIN, WSP(bf16, WS_WIN), r, scr, F.lane); continue; } r -= I_IN;
        if (r < I_O) { p0_plain_item(GIN(I_WOUT), D, D, WSP(bf16, WS_WOUT), r, scr, F.lane); continue; } r -= I_O;
        if (r < I_L) { p0_plain_item(GIN(I_WDEC), 64, RW, WSP(bf16, WS_LORA), r, scr, F.lane); continue; } r -= I_L;
        if (r < I_L) { p0_plain_item(GIN(I_WICLR), 64, RW, WSP(bf16, WS_LORA + LORA_WI), r, scr, F.lane); continue; } r -= I_L;
        p0_plain_item(GIN(I_WGATE), 128, RW, WSP(bf16, WS_LORA + LORA_WG), r, scr, F.lane);
    }
}
typedef float f32x16m __attribute__((ext_vector_type(16)));
__device__ __forceinline__ void p0_mod(Frame& F) {
    const float* wada = GIN(I_WADA); const float* bada = GIN(I_BADA); const float* cp = GIN(I_CP); const float* cs = GIN(I_CS);
    float* mod = WSP(float, WS_MOD);
    LAS float* red = (LAS float*)F.lds;
    const int lane = F.lane, wave = F.wave, r = lane & 31, h = lane >> 5;
    for (int task = blockIdx.x; task < MODW / 32; task += F.G) {
        const int j0 = 32 * task;
        f32x16m acc[5];
#pragma unroll
        for (int bt = 0; bt < 5; ++bt)
#pragma unroll
            for (int e = 0; e < 16; ++e) acc[bt][e] = 0.f;
#pragma unroll 1
        for (int ks = 0; ks < 8; ++ks) {
            const int i0 = 128 * wave + 16 * ks + 8 * h;
            unsigned aw[4];
#pragma unroll
            for (int e = 0; e < 4; ++e) aw[e] = pk2(wada[(size_t)(i0 + 2 * e) * MODW + j0 + r], wada[(size_t)(i0 + 2 * e + 1) * MODW + j0 + r]);
            const bf16x8 af = __builtin_bit_cast(bf16x8, (v4u){aw[0], aw[1], aw[2], aw[3]});
#pragma unroll
            for (int bt = 0; bt < 5; ++bt) {
                const int b = 32 * bt + r;
                f32x4 c0 = (f32x4){0.f, 0.f, 0.f, 0.f}, c1 = c0;
                if (b < NMOD) { const float* cr = (b < 2 ? cp + (size_t)b * D : cs + (size_t)(b - 2) * D) + i0; c0 = *(const f32x4*)cr; c1 = *(const f32x4*)(cr + 4); }
                float sv[8];
#pragma unroll
                for (int e = 0; e < 4; ++e) { sv[e] = c0[e] * __builtin_amdgcn_rcpf(1.0f + __expf(-c0[e])); sv[4 + e] = c1[e] * __builtin_amdgcn_rcpf(1.0f + __expf(-c1[e])); }
                const bf16x8 bfm = __builtin_bit_cast(bf16x8, (v4u){pk2(sv[0], sv[1]), pk2(sv[2], sv[3]), pk2(sv[4], sv[5]), pk2(sv[6], sv[7])});
                acc[bt] = __builtin_amdgcn_mfma_f32_32x32x16_bf16(af, bfm, acc[bt], 0, 0, 0);
            }
        }
#pragma unroll
        for (int rd = 0; rd < 2; ++rd) {
            const int nv = rd == 0 ? 48 : 32, bt0 = rd == 0 ? 0 : 3;
            __syncthreads();
#pragma unroll
            for (int bt = 0; bt < 3; ++bt) if (bt0 + bt < 5)
#pragma unroll
                for (int e = 0; e < 16; ++e) red[(wave * 48 + bt * 16 + e) * 64 + lane] = acc[bt0 + bt][e];
            __syncthreads();
            for (int idx = F.tid; idx < nv * 64; idx += 512) {
                const int v = idx >> 6, ln = idx & 63, bt = bt0 + (v >> 4), e = v & 15;
                float s = 0.f;
#pragma unroll
                for (int w = 0; w < 8; ++w) s += red[(w * 48 + v) * 64 + ln];
                const int b = 32 * bt + (ln & 31), j = j0 + (e & 3) + 8 * (e >> 2) + 4 * (ln >> 5);
                if (b < NMOD) mod[(size_t)b * MODW + j] = s + bada[j];
            }
        }
    }
    __syncthreads();
}

__device__ __forceinline__ int mod_row_of(int m) { return m < MP ? (m >> 13) : 2 + ((m - MP) >> 3); }
__device__ __forceinline__ void p_modulate0(Frame& F) {
    const int gw = F.vcu * NWAVES + F.wave, NGW = F.G * NWAVES;
    const float* mod = WSP(float, WS_MOD); bf16* U = WSP(bf16, WS_U);
    for (int m = gw; m < M; m += NGW) {
        const float* xr = m < MP ? GIN(I_XP) + (size_t)m * D : GIN(I_XS) + (size_t)(m - MP) * D;
        const float* mr = mod + (size_t)mod_row_of(m) * MODW;
        unsigned long long* o8 = (unsigned long long*)(U + (size_t)m * D) + F.lane;
#pragma unroll
        for (int j = 0; j < 4; ++j) { const int c = 4 * F.lane + 256 * j;
            const f32x4 x = *(const f32x4*)(xr + c), sh = *(const f32x4*)(mr + c), sc = *(const f32x4*)(mr + D + c);
            const f32x4 u = x * (sc + 1.0f) + sh;
            o8[64 * j] = (unsigned long long)pk2(u[0], u[1]) | ((unsigned long long)pk2(u[2], u[3]) << 32); }
    }
}
__device__ __forceinline__ void p_layernorm(Frame& F, int lnidx, int koff, int nsl, const float* xs_old, int gtk, float gs) {
    const int gw = F.vcu * NWAVES + F.wave, NGW = F.G * NWAVES;
    const float* mod = WSP(float, WS_MOD); bf16* U = WSP(bf16, WS_U); float* X = GOUT() + O_Y;
    const float* lg = GIN(I_LNG) + lnidx * D; const float* lb = GIN(I_LNB) + lnidx * D;
    for (int m = gw; m < M; m += NGW) {
        float* xr = X + (size_t)m * D;
        f32x4 v[4]; float s = 0.f;
#pragma unroll
        for (int j = 0; j < 4; ++j) { const int c = 4 * F.lane + 256 * j;
            if (m < MP) v[j] = *(const f32x4*)(xr + c);
            else { const float* pp = WSP(float, WS_WLOG) + (size_t)(m - MP) * D + c; f32x4 a = *(const f32x4*)pp;
                for (int ks = 1; ks < nsl; ++ks) a += *(const f32x4*)(pp + (size_t)ks * MS * D);
                const f32x4 xo = *(const f32x4*)(xs_old + (size_t)(m - MP) * D + c), gv = *(const f32x4*)(mod + (size_t)mod_row_of(m) * MODW + gtk * D + c);
                v[j] = xo * ALPHA + (gv + 1.0f) * gs * a; }
            s += (v[j][0] + v[j][1]) + (v[j][2] + v[j][3]); }
        const float mean = wave_sum(s) * (1.f / D); float s2 = 0.f;
#pragma unroll
        for (int j = 0; j < 4; ++j) { v[j] = v[j] - mean; s2 += (v[j][0] * v[j][0] + v[j][1] * v[j][1]) + (v[j][2] * v[j][2] + v[j][3] * v[j][3]); }
        const float rstd = 1.f / sqrtf(wave_sum(s2) * (1.f / D) + LN_EPS);
        const float* mr = mod + (size_t)mod_row_of(m) * MODW + (koff >= 0 ? koff : 0);
        unsigned long long* o8 = (unsigned long long*)(U + (size_t)m * D) + F.lane;
#pragma unroll
        for (int j = 0; j < 4; ++j) { const int c = 4 * F.lane + 256 * j;
            const f32x4 x = v[j] * rstd * *(const f32x4*)(lg + c) + *(const f32x4*)(lb + c);
            *(f32x4*)(xr + c) = x;
            if (koff >= 0) { const f32x4 sh = *(const f32x4*)(mr + c), sc = *(const f32x4*)(mr + D + c); const f32x4 u = x * (sc + 1.0f) + sh;
                o8[64 * j] = (unsigned long long)pk2(u[0], u[1]) | ((unsigned long long)pk2(u[2], u[3]) << 32); } }
    }
}
__device__ __forceinline__ float prev_val(const bf16* P, const float* sshift, int m, int col) {
    if (m < MP) return (m & (TP - 1)) == 0 ? 0.f : bf2f(P[(size_t)(m - 1) * NIN + col]);
    const int ms = m - MP;
    return (ms & (TS - 1)) == 0 ? sshift[(size_t)(ms >> 3) * RWP + col] : bf2f(P[(size_t)(m - 1) * NIN + col]);
}
constexpr int PP_PITCH = 528;
__device__ __forceinline__ void p_prep(Frame& F) {
    LAS unsigned char* lds = F.lds;
    const bf16* P = WSP(bf16, WS_H); const float* sshift = GIN(I_SSHIFT); const float* mu = GIN(I_MU);
    float* WLOG = WSP(float, WS_WLOG); bf16* AA = WSP(bf16, WS_A); bf16* GG = WSP(bf16, WS_G);
    const int tid = F.tid, lane = F.lane, wave = F.wave;
    const int tile_lo0 = (F.vcu * (M / 16)) / F.G, tile_hi0 = ((F.vcu + 1) * (M / 16)) / F.G;
    for (int tile_lo = tile_lo0; tile_lo < tile_hi0; tile_lo += 5) {
    const int ntile = (tile_hi0 - tile_lo) < 5 ? (tile_hi0 - tile_lo) : 5;
    const int m_lo = tile_lo * 16, ntok = ntile * 16;
    __syncthreads();
    {
        const int j = tid & 255, hf = tid >> 8, col = 1536 + j; const float muj = mu[col];
        const int ga = hf == 0 ? 0 : ntile, gb = hf == 0 ? ntile : 2 * ntile;
        float carry = 0.f;
        for (int gi = ga; gi < gb; ++gi) { const int mg = m_lo + 8 * gi;
            float p[8];
#pragma unroll
            for (int t = 0; t < 8; ++t) p[t] = bf2f(P[(size_t)(mg + t) * NIN + col]);
            float prev = (gi == ga || ((mg < MP) ? (mg & (TP - 1)) : ((mg - MP) & (TS - 1))) == 0) ? prev_val(P, sshift, mg, col) : carry;
#pragma unroll
            for (int t = 0; t < 8; ++t) { const float xs = p[t] + (prev - p[t]) * muj; prev = p[t];
                const float f = j < 64 ? tanhf_(xs) : (j < 128 ? xs : sigmoidf_(xs));
                *(LAS unsigned short*)(lds + (8 * gi + t) * PP_PITCH + j * 2) = (unsigned short)f2bf(f); }
            carry = p[7]; }
    }
    __syncthreads();
    const int lr = lane & 15, lq = lane >> 4, c0 = 64 * wave;
#pragma unroll 1
    for (int lo = 0; lo < 3; ++lo) {
        const int kin = lo == 0 ? 0 : (lo == 1 ? 64 : 128), nks = lo == 2 ? 4 : 2, wpitch = lo == 2 ? 128 : 64;
        const bf16* Wt = WSP(bf16, WS_LORA) + (lo == 0 ? 0 : (lo == 1 ? 512 * 64 : 2 * 512 * 64));
        f32x4 acc[5][4];
#pragma unroll
        for (int tt = 0; tt < 5; ++tt)
#pragma unroll
            for (int ct = 0; ct < 4; ++ct) acc[tt][ct] = (f32x4){0.f, 0.f, 0.f, 0.f};
        for (int ks = 0; ks < nks; ++ks) {
            bf16x8 wf[4];
#pragma unroll
            for (int ct = 0; ct < 4; ++ct) wf[ct] = *(const bf16x8*)(Wt + (size_t)(c0 + 16 * ct + lr) * wpitch + ks * 32 + lq * 8);
#pragma unroll
            for (int tt = 0; tt < 5; ++tt) if (tt < ntile) {
                const bf16x8 af = *(const LAS bf16x8*)(lds + (16 * tt + lr) * PP_PITCH + (kin + ks * 32 + lq * 8) * 2);
#pragma unroll
                for (int ct = 0; ct < 4; ++ct) acc[tt][ct] = __builtin_amdgcn_mfma_f32_16x16x32_bf16(wf[ct], af, acc[tt][ct], 0, 0, 0);
            }
        }
#pragma unroll
        for (int tt = 0; tt < 5; ++tt) if (tt < ntile) { const int m = m_lo + 16 * tt + lr;
#pragma unroll
            for (int ct = 0; ct < 4; ++ct) { const int c = c0 + 16 * ct + 4 * lq; const f32x4 a = acc[tt][ct];
                if (lo == 0) { const f32x4 w0v = *(const f32x4*)(GIN(I_W0) + c); f32x4 o;
#pragma unroll
                    for (int e = 0; e < 4; ++e) { const float z = w0v[e] + a[e]; const float sp = fmaxf(-z, 0.f) + __logf(1.0f + __expf(-fabsf(z))); o[e] = -__expf(-sp - 0.5f); }
                    *(f32x4*)(WLOG + (size_t)m * RW + c) = o; }
                else if (lo == 1) { const f32x4 a0v = *(const f32x4*)(GIN(I_A0) + c); f32x4 o;
#pragma unroll
                    for (int e = 0; e < 4; ++e) o[e] = sigmoidf_(a0v[e] + a[e]);
                    *(unsigned long long*)(AA + (size_t)m * RW + c) = pk4(o); }
                else *(unsigned long long*)(GG + (size_t)m * RW + c) = pk4(a); }
        }
    }
    }
}

constexpr int NCOPY = 96;
__device__ __forceinline__ void copy_task(Frame& F, int task) {
    const bf16* P = WSP(bf16, WS_H);
    const int gt = task * 512 + F.tid, NT = NCOPY * 512;
    const float* ck = GIN(I_CK); const float* cv = GIN(I_CV); float* out = GOUT();
#pragma unroll 4
    for (int i = gt; i < NBS * 120 * 32; i += NT) {
        const int b = i / 3840, rem = i - b * 3840, j = rem >> 5, c4 = (rem & 31) * 4; const size_t d = (size_t)(b * 128 + j) * 128 + c4, s = d + 8 * 128;
        *(f32x4*)(out + O_WINK_S + d) = *(const f32x4*)(ck + s); *(f32x4*)(out + O_WINV_S + d) = *(const f32x4*)(cv + s); }
    for (int i = gt; i < NBS * 8 * 128; i += NT) {
        const int b = i >> 10, t = (i >> 7) & 7, c2 = i & 127; const size_t row = (size_t)(MP + b * TS + t) * NIN, d = (size_t)(b * 128 + 120 + t) * 128 + c2;
        out[O_WINK_S + d] = bf2f(P[row + 2304 + c2]); out[O_WINV_S + d] = bf2f(P[row + 2432 + c2]); }
    for (int i = gt; i < 2 * RWP; i += NT) { const int b = i / RWP, col = i % RWP; out[O_SHIFT_P + i] = bf2f(P[(size_t)(b * TP + TP - 1) * NIN + col]); }
#pragma unroll 2
    for (int i = gt; i < NBS * RWP; i += NT) { const int b = i / RWP, col = i % RWP; out[O_SHIFT_S + i] = bf2f(P[(size_t)(MP + b * TS + TS - 1) * NIN + col]); }
    for (int i = gt; i < 2 * 128 * 128; i += NT) { const int b = i >> 14, j = (i >> 7) & 127, c2 = i & 127; const size_t row = (size_t)(b * TP + TP - 128 + j) * NIN;
        out[O_WINK_P + i] = bf2f(P[row + 2304 + c2]); out[O_WINV_P + i] = bf2f(P[row + 2432 + c2]); }
}
constexpr int SS_R = 0, SS_DEC = 1, SS_KM = 2, SS_KK = 3, SS_BB = 4, SS_V = 5;
__device__ __forceinline__ void sample_scan_unit(Frame& F, int b) {
    const int h = F.wave, lane = F.lane, chn = h * 64 + lane;
    LAS float* A = (LAS float*)F.lds + h * (6 * 8 * 64);
    const bf16* P = WSP(bf16, WS_H); const float* sshift = GIN(I_SSHIFT); const float* mu = GIN(I_MU);
    const float* WLOG = WSP(float, WS_WLOG); const bf16* AA = WSP(bf16, WS_A); const bf16* GG = WSP(bf16, WS_G);
    bf16* MIX = WSP(bf16, WS_U);
    const float mur = mu[chn], muk = mu[RW + chn], muv = mu[2 * RW + chn], kkc = GIN(I_KK)[chn], kac = GIN(I_KA)[chn], rkc = GIN(I_RK)[chn], gnw = GIN(I_GNW)[chn], gnb = GIN(I_GNB)[chn];
    __syncthreads();
    float q_r = sshift[(size_t)b * RWP + chn], q_k = sshift[(size_t)b * RWP + RW + chn], q_v = sshift[(size_t)b * RWP + 2 * RW + chn];
#pragma unroll
    for (int t = 0; t < TS; ++t) {
        const int m = MP + b * TS + t; const size_t pr = (size_t)m * NIN;
        const float p_r = bf2f(P[pr + chn]), p_k = bf2f(P[pr + RW + chn]), p_v = bf2f(P[pr + 2 * RW + chn]);
        const float xr = p_r + (q_r - p_r) * mur, xk = p_k + (q_k - p_k) * muk, xv = p_v + (q_v - p_v) * muv;
        q_r = p_r; q_k = p_k; q_v = p_v;
        const float a = bf2f(AA[(size_t)m * RW + chn]), wl = WLOG[(size_t)m * RW + chn];
        const float kq0 = xk * kkc, kk = kq0 * (1.0f / fmaxf(sqrtf(wave_sum_dpp(kq0 * kq0)), 1e-12f));
        A[(SS_R * 8 + t) * 64 + lane] = xr; A[(SS_DEC * 8 + t) * 64 + lane] = __expf(wl); A[(SS_KM * 8 + t) * 64 + lane] = xk * (1.0f + (a - 1.0f) * kac);
        A[(SS_KK * 8 + t) * 64 + lane] = kk; A[(SS_BB * 8 + t) * 64 + lane] = kk * a; A[(SS_V * 8 + t) * 64 + lane] = xv;
    }
    f32x4 S[16];
    { const f32x4* sp = (const f32x4*)(GIN(I_SWKV) + ((size_t)(b * 8 + h) * 64 + lane) * 64);
#pragma unroll
      for (int q = 0; q < 16; ++q) S[q] = sp[q]; }
    float gate[TS];
#pragma unroll
    for (int t = 0; t < TS; ++t) gate[t] = bf2f(GG[(size_t)(MP + b * TS + t) * RW + chn]);
    LDS_WAIT(); asm volatile("" ::: "memory");
#pragma unroll
    for (int t = 0; t < TS; ++t) {
        const LAS f32x4* pk = (const LAS f32x4*)(A + (SS_KK * 8 + t) * 64); const LAS f32x4* pb = (const LAS f32x4*)(A + (SS_BB * 8 + t) * 64);
        const LAS f32x4* pd = (const LAS f32x4*)(A + (SS_DEC * 8 + t) * 64); const LAS f32x4* pm = (const LAS f32x4*)(A + (SS_KM * 8 + t) * 64);
        const LAS f32x4* pq = (const LAS f32x4*)(A + (SS_R * 8 + t) * 64);
        const float v = A[(SS_V * 8 + t) * 64 + lane];
        f32x4 sa4 = (f32x4){0.f, 0.f, 0.f, 0.f};
#pragma unroll
        for (int q = 0; q < 16; ++q) sa4 += S[q] * pk[q];
        const float sa = (sa4[0] + sa4[1]) + (sa4[2] + sa4[3]);
        f32x4 y4 = (f32x4){0.f, 0.f, 0.f, 0.f};
#pragma unroll
        for (int q = 0; q < 16; ++q) { S[q] = S[q] * pd[q] + (pm[q] * v - pb[q] * sa); y4 += S[q] * pq[q]; }
        const float y = (y4[0] + y4[1]) + (y4[2] + y4[3]);
        const float mean = wave_sum_dpp(y) * (1.f / 64.f), d = y - mean, var = wave_sum_dpp(d * d) * (1.f / 64.f);
        const float yn = d * (1.0f / sqrtf(var + GN_EPS));
        const float dot = wave_sum_dpp(A[(SS_R * 8 + t) * 64 + lane] * A[(SS_KM * 8 + t) * 64 + lane] * rkc);
        const int m = MP + b * TS + t;
        MIX[(size_t)m * D + chn] = (bf16)f2bf((yn * gnw + gnb + dot * v) * gate[t]);
        asm volatile("" ::: "memory");
    }
    { f32x4* so = (f32x4*)(GOUT() + O_WKV_S + ((size_t)(b * 8 + h) * 64 + lane) * 64);
#pragma unroll
      for (int q = 0; q < 16; ++q) so[q] = S[q]; }
}
constexpr int PB = 144, PF = 272;
constexpr int MB16 = 64 * PB, MF32 = 64 * PF;
constexpr size_t WS_GX = 2 * MiB;
constexpr size_t WS_S0 = 167 * MiB;
static_assert(WS_GX + 512 * 32768 <= WS_WIN && WS_H + (size_t)M * NIN * 2 <= WS_S0 && WS_S0 + 512 * 16384 <= WS_WLOG, "scan scratch map");
constexpr int CA_RHI = 0, CA_RLO = 18432, CA_LB = 36864, CA_KQ = 54272, CA_KD = 63488, CA_BD = 72704, CA_VT = 81920, CA_KET = 91136, CA_BET = 100352, CA_LK = 109568, CA_LOFFT = 118784,
              CA_MD = 128000, CA_TD = 137216, CA_SMALL = 141312;
constexpr int CC_RHI = 0, CC_RLO = 9216, CC_LB = 18432, CC_KQ = 35840, CC_RQ = 45056, CC_KD = 54272, CC_BD = 63488, CC_VT = 72704, CC_KET = 81920, CC_BET = 91136, CC_LK = 100352, CC_MK = 109568, CC_MB = 118784,
              CC_SHI = 128000, CC_SLO = 137216, CC_LOFFT = 146432, CC_TD = 155648, CC_SMALL = 159744, CC_MD = CC_BD;
constexpr int TDP = 64;
constexpr int SM_GL = 0, SM_DOT = 256, SM_BYTES = 512;

__device__ __forceinline__ void mm_nt(f32x4 (&acc)[2], const LAS unsigned char* X, const LAS unsigned char* Y, int wave, int lane) {
    const int tr = wave >> 1, tc0 = (wave & 1) * 2, lr = lane & 15, lq = lane >> 4;
#pragma unroll
    for (int ks = 0; ks < 2; ++ks) {
        const bf16x8 xa = *(const LAS bf16x8*)(X + (16 * tr + lr) * PB + ks * 64 + lq * 16);
#pragma unroll
        for (int j = 0; j < 2; ++j) {
            const bf16x8 yb = *(const LAS bf16x8*)(Y + (16 * (tc0 + j) + lr) * PB + ks * 64 + lq * 16);
            acc[j] = __builtin_amdgcn_mfma_f32_16x16x32_bf16(yb, xa, acc[j], 0, 0, 0);
        }
    }
}
#ifndef REP_PHASE
#define REP_PHASE -1
#endif
#define ACC_ZERO(a) do { a[0] = (f32x4){0.f, 0.f, 0.f, 0.f}; a[1] = (f32x4){0.f, 0.f, 0.f, 0.f}; } while (0)
#define ACC_M(wave, lane) (16 * ((wave) >> 1) + ((lane) & 15))
#define ACC_N(wave, lane, j) (16 * (((wave) & 1) * 2 + (j)) + 4 * ((lane) >> 4))
__device__ __forceinline__ void store_hilo(const f32x4 (&a)[2], LAS unsigned char* HI, LAS unsigned char* LO, int wave, int lane) {
    const int m = ACC_M(wave, lane);
#pragma unroll
    for (int j = 0; j < 2; ++j) { const int n = ACC_N(wave, lane, j);
        const unsigned long long hi = pk4(a[j]); const f32x4 lo = a[j] - bf4_to_f32(hi);
        *(LAS unsigned long long*)(HI + m * PB + n * 2) = hi; *(LAS unsigned long long*)(LO + m * PB + n * 2) = pk4(lo); }
}
__device__ __forceinline__ void solve_td(const LAS unsigned char* LBN, LAS unsigned char* TD, int wave, int lane) {
    if (wave == 0) {
        int lo_ = lane; asm volatile("" : "+v"(lo_));
        const int d = lo_ >> 4, t = lo_ & 15;
        f32x4 x[4];
#pragma unroll
        for (int q = 0; q < 4; ++q)
#pragma unroll
            for (int r = 0; r < 4; ++r) x[q][r] = (4 * q + r == t) ? 1.f : 0.f;
        const LAS unsigned char* lb = LBN + (16 * d) * PF + (16 * d) * 4;
#pragma unroll
        for (int i = 15; i >= 1; --i) {
            const float xi = x[i >> 2][i & 3];
#pragma unroll
            for (int q = 0; q <= (i - 1) >> 2; ++q) x[q] -= *(const LAS f32x4*)(lb + i * PF + q * 16) * xi;
            asm volatile("" ::: "memory");
        }
        v4u w0, w1; w0.x = pk2(x[0][0], x[0][1]); w0.y = pk2(x[0][2], x[0][3]); w0.z = pk2(x[1][0], x[1][1]); w0.w = pk2(x[1][2], x[1][3]);
        w1.x = pk2(x[2][0], x[2][1]); w1.y = pk2(x[2][2], x[2][3]); w1.z = pk2(x[3][0], x[3][1]); w1.w = pk2(x[3][2], x[3][3]);
        LAS v4u* o = (LAS v4u*)(TD + (16 * d + t) * TDP); o[0] = w0; o[1] = w1; o[2] = (v4u){0u, 0u, 0u, 0u}; o[3] = (v4u){0u, 0u, 0u, 0u};
    }
}
__device__ __forceinline__ void solve_md(const LAS unsigned char* LOFFT, const LAS unsigned char* TD, LAS unsigned char* MD, int wave, int lane) {
    const int d = wave >> 1, lr = lane & 15, lq = lane >> 4;
    const bf16x8 zf = (bf16x8){0, 0, 0, 0, 0, 0, 0, 0};
    const bf16x8 tf = *(const LAS bf16x8*)(TD + (16 * d + lr) * TDP + lq * 16);
#pragma unroll
    for (int j = 0; j < 2; ++j) { const int tc = (wave & 1) * 2 + j;
        bf16x8 lf = zf; if (lq < 2) lf = *(const LAS bf16x8*)(LOFFT + (16 * tc + lr) * PB + (16 * d + 8 * lq) * 2);
        f32x4 a = (f32x4){0.f, 0.f, 0.f, 0.f};
        a = __builtin_amdgcn_mfma_f32_16x16x32_bf16(lf, tf, a, 0, 0, 0);
        *(LAS unsigned long long*)(MD + (16 * d + lr) * PB + (16 * tc + 4 * lq) * 2) = pk4(-a); }
}
template <int NT> __device__ __forceinline__ void solve_chain(const LAS unsigned char* TD, const LAS unsigned char* MD, const LAS unsigned char* RHI, const LAS unsigned char* RLO, LAS unsigned char* UT, int wave, int lane) {
    if (wave < NT) {
        const int lr = lane & 15, lq = lane >> 4, col = 16 * wave + lr;
        const bf16x8 zf = (bf16x8){0, 0, 0, 0, 0, 0, 0, 0};
#pragma unroll
        for (int d = 0; d < 4; ++d) {
            const bf16x8 tf = *(const LAS bf16x8*)(TD + (16 * d + lr) * TDP + lq * 16);
            bf16x8 rh = zf, rl = zf;
            if (lq < 2) { rh = *(const LAS bf16x8*)(RHI + col * PB + (16 * d + 8 * lq) * 2); rl = *(const LAS bf16x8*)(RLO + col * PB + (16 * d + 8 * lq) * 2); }
            f32x4 a = (f32x4){0.f, 0.f, 0.f, 0.f};
            a = __builtin_amdgcn_mfma_f32_16x16x32_bf16(tf, rh, a, 0, 0, 0);
            a = __builtin_amdgcn_mfma_f32_16x16x32_bf16(tf, rl, a, 0, 0, 0);
            if (d >= 1) { const bf16x8 mf = *(const LAS bf16x8*)(MD + (16 * d + lr) * PB + lq * 16), uf = *(const LAS bf16x8*)(UT + col * PB + lq * 16);
                a = __builtin_amdgcn_mfma_f32_16x16x32_bf16(mf, uf, a, 0, 0, 0); }
            if (d == 3) { const bf16x8 mf = *(const LAS bf16x8*)(MD + (16 * d + lr) * PB + 64 + lq * 16), uf = *(const LAS bf16x8*)(UT + col * PB + 64 + lq * 16);
                a = __builtin_amdgcn_mfma_f32_16x16x32_bf16(mf, uf, a, 0, 0, 0); }
            *(LAS unsigned long long*)(UT + col * PB + (16 * d + 4 * lq) * 2) = pk4(a);
            asm volatile("s_waitcnt lgkmcnt(0)" ::: "memory");
        }
    }
}
struct ChunkRaw { unsigned rk[9], vv[5], aa[4]; float wl[8]; };
__device__ __forceinline__ void chunk_load(Frame& F, int m0, int h, ChunkRaw& R) {
    const bf16* P = WSP(bf16, WS_H); const float* WLOG = WSP(float, WS_WLOG); const bf16* AA = WSP(bf16, WS_A);
    const int chn = h * 64 + F.lane, mg = m0 + 8 * F.wave;
    unsigned pv[10], av[8];
    if ((mg & (TP - 1)) == 0) { R.rk[0] = 0u; pv[0] = 0u; }
    else { const size_t o = (size_t)(mg - 1) * NIN; R.rk[0] = (unsigned)P[o + chn] | ((unsigned)P[o + RW + chn] << 16); pv[0] = P[o + 2 * RW + chn]; }
#pragma unroll
    for (int j = 0; j < 8; ++j) { const size_t o = (size_t)(mg + j) * NIN; R.rk[j + 1] = (unsigned)P[o + chn] | ((unsigned)P[o + RW + chn] << 16); pv[j + 1] = P[o + 2 * RW + chn];
        R.wl[j] = WLOG[(size_t)(mg + j) * RW + chn]; av[j] = AA[(size_t)(mg + j) * RW + chn]; }
    pv[9] = 0u;
#pragma unroll
    for (int j = 0; j < 5; ++j) R.vv[j] = pv[2 * j] | (pv[2 * j + 1] << 16);
#pragma unroll
    for (int j = 0; j < 4; ++j) R.aa[j] = av[2 * j] | (av[2 * j + 1] << 16);
}
struct ChanConst { float mur, muk, muv, kkc, kac, rkc; };
__device__ __forceinline__ ChanConst chan_const(Frame& F, int h) { const float* mu = GIN(I_MU); const int chn = h * 64 + F.lane;
    ChanConst k; k.mur = mu[chn]; k.muk = mu[RW + chn]; k.muv = mu[2 * RW + chn]; k.kkc = GIN(I_KK)[chn]; k.kac = GIN(I_KA)[chn]; k.rkc = GIN(I_RK)[chn]; return k; }
template <bool PHC> __device__ __forceinline__ void chunk_stage(Frame& F, const ChunkRaw& R, const ChanConst& K, int h, int oKQ, int oRQ, int oKD, int oBD, int oVT, int oKET, int oBET, int oRHI, int oRLO, int oTOT, int oSMALL) {
    LAS unsigned char* lds = F.lds;
    const int e = F.lane, g = F.wave;
    const float mur = K.mur, muk = K.muk, muv = K.muv, kkc = K.kkc, kac = K.kac, rkc = K.rkc;
    float pr[9], pk[9], pv[9], av[8];
#pragma unroll
    for (int j = 0; j < 9; ++j) { pr[j] = bflo(R.rk[j]); pk[j] = bfhi(R.rk[j]); pv[j] = (j & 1) ? bfhi(R.vv[j >> 1]) : bflo(R.vv[j >> 1]); }
#pragma unroll
    for (int j = 0; j < 8; ++j) av[j] = (j & 1) ? bfhi(R.aa[j >> 1]) : bflo(R.aa[j >> 1]);
    const float (&wl)[8] = R.wl;
    float cw[8]; { float s = 0.f;
#pragma unroll
        for (int j = 0; j < 8; ++j) { s += wl[j]; cw[j] = s; } }
    LAS float* TOT = (LAS float*)(lds + oTOT);
    TOT[g * 64 + e] = cw[7];
    __syncthreads();
    float off = 0.f, cwL = 0.f;
#pragma unroll
    for (int gg = 0; gg < 8; ++gg) { const float tv = TOT[gg * 64 + e]; cwL += tv; if (gg < g) off += tv; }
    if (g == 0) ((LAS float*)(lds + oSMALL + SM_GL))[e] = __expf(cwL);
    unsigned vt[8], ket[8], bet[8]; float kq[8];
#pragma unroll
    for (int j = 0; j < 8; ++j) {
        const int t = 8 * g + j;
        const float c = off + cw[j];
        const float xr = pr[j + 1] + (pr[j] - pr[j + 1]) * mur, xk = pk[j + 1] + (pk[j] - pk[j + 1]) * muk, xv = pv[j + 1] + (pv[j] - pv[j + 1]) * muv;
        const float kq0 = xk * kkc, kk = kq0 * (1.0f / fmaxf(sqrtf(wave_sum_dpp(kq0 * kq0)), 1e-12f)), km = xk * (1.0f + (av[j] - 1.0f) * kac), bb = kk * av[j];
        const float e1 = __expf(c), e2 = __builtin_amdgcn_rcpf(e1), e3 = __expf(c - wl[j]), e4 = __expf(cwL - c);
        kq[j] = kk * e3;
        { const unsigned w1 = cvtpk(km * e2, bb * e2), w2 = cvtpk(kq[j], xr * e1);
          *(LAS unsigned short*)(lds + oKD + t * PB + e * 2) = (unsigned short)w1; *(LAS unsigned short*)(lds + oBD + t * PB + e * 2) = (unsigned short)(w1 >> 16);
          *(LAS unsigned short*)(lds + oKQ + t * PB + e * 2) = (unsigned short)w2; if (PHC) *(LAS unsigned short*)(lds + oRQ + t * PB + e * 2) = (unsigned short)(w2 >> 16); }
        if (PHC) {
            const float d = wave_sum_dpp(xr * km * rkc); if (e == 0) ((LAS float*)(lds + oSMALL + SM_DOT))[t] = d; }
        { const unsigned w3 = cvtpk(km * e4, bb * e4); ket[j] = w3 & 0xffffu; bet[j] = w3 >> 16; vt[j] = f2bf(xv); }
        __builtin_amdgcn_sched_barrier(0);
    }
    { v4u w; w.x = vt[0] | (vt[1] << 16); w.y = vt[2] | (vt[3] << 16); w.z = vt[4] | (vt[5] << 16); w.w = vt[6] | (vt[7] << 16); *(LAS v4u*)(lds + oVT + e * PB + g * 16) = w; }
    { v4u w; w.x = ket[0] | (ket[1] << 16); w.y = ket[2] | (ket[3] << 16); w.z = ket[4] | (ket[5] << 16); w.w = ket[6] | (ket[7] << 16); *(LAS v4u*)(lds + oKET + e * PB + g * 16) = w; }
    { v4u w; w.x = bet[0] | (bet[1] << 16); w.y = bet[2] | (bet[3] << 16); w.z = bet[4] | (bet[5] << 16); w.w = bet[6] | (bet[7] << 16); *(LAS v4u*)(lds + oBET + e * PB + g * 16) = w; }
    if (!PHC) { v4u wh, wl2;
        const unsigned h0 = cvtpk(kq[0], kq[1]), h1 = cvtpk(kq[2], kq[3]), h2 = cvtpk(kq[4], kq[5]), h3 = cvtpk(kq[6], kq[7]);
        wh = (v4u){h0, h1, h2, h3};
        wl2.x = cvtpk(kq[0] - bflo(h0), kq[1] - bfhi(h0)); wl2.y = cvtpk(kq[2] - bflo(h1), kq[3] - bfhi(h1)); wl2.z = cvtpk(kq[4] - bflo(h2), kq[5] - bfhi(h2)); wl2.w = cvtpk(kq[6] - bflo(h3), kq[7] - bfhi(h3));
        *(LAS v4u*)(lds + oRHI + e * PB + g * 16) = wh; *(LAS v4u*)(lds + oRLO + e * PB + g * 16) = wl2; }
}
__device__ __forceinline__ void store_hilo_rows(const f32x4 (&a)[2], LAS unsigned char* HI, LAS unsigned char* LO, int r0, int wave, int lane) {
    const int m = r0 + ACC_M(wave, lane);
#pragma unroll
    for (int j = 0; j < 2; ++j) { const int n = ACC_N(wave, lane, j);
        const unsigned long long hi = pk4(a[j]); const f32x4 lo = a[j] - bf4_to_f32(hi);
        *(LAS unsigned long long*)(HI + m * PB + n * 2) = hi; *(LAS unsigned long long*)(LO + m * PB + n * 2) = pk4(lo); }
}
__device__ __forceinline__ void make_L(const LAS unsigned char* KQ, const LAS unsigned char* BD, LAS unsigned char* LBN, LAS unsigned char* LOFFT, int wave, int lane) {
    const int m = ACC_M(wave, lane);
    { f32x4 a[2]; ACC_ZERO(a); mm_nt(a, KQ, BD, wave, lane);
#pragma unroll
      for (int j = 0; j < 2; ++j) { const int n = ACC_N(wave, lane, j); f32x4 o;
#pragma unroll
          for (int r = 0; r < 4; ++r) o[r] = (n + r < m) ? a[j][r] : 0.f;
          *(LAS f32x4*)(LBN + m * PF + n * 4) = o; } }
    __builtin_amdgcn_sched_barrier(0);
    { f32x4 a[2]; ACC_ZERO(a); mm_nt(a, BD, KQ, wave, lane);
#pragma unroll
      for (int j = 0; j < 2; ++j) { const int n = ACC_N(wave, lane, j); f32x4 o;
#pragma unroll
          for (int r = 0; r < 4; ++r) o[r] = (((n + r) >> 4) > (m >> 4)) ? a[j][r] : 0.f;
          *(LAS unsigned long long*)(LOFFT + m * PB + n * 2) = pk4(o); } }
}
__device__ __forceinline__ void scanA_task(Frame& F, int task) {
    LAS unsigned char* lds = F.lds; const int wave = F.wave, lane = F.lane;
    const int sc = task & 31, bh = task >> 5, h = bh & 7, b = bh >> 3;
    const int m = ACC_M(wave, lane);
    f32x4 gacc[2], xacc[2];
#pragma unroll
    for (int j = 0; j < 2; ++j) { const int n = ACC_N(wave, lane, j);
#pragma unroll
        for (int r = 0; r < 4; ++r) { gacc[j][r] = (m == n + r) ? 1.f : 0.f; xacc[j][r] = 0.f; } }
    const ChanConst kc = chan_const(F, h);
    ChunkRaw raw; chunk_load(F, b * TP + sc * 256, h, raw);
    for (int c = 0; c < 4; ++c) {
        __syncthreads();
        chunk_stage<false>(F, raw, kc, h, CA_KQ, 0, CA_KD, CA_BD, CA_VT, CA_KET, CA_BET, CA_RHI, CA_RLO, CA_LB, CA_SMALL);
        __syncthreads();
        make_L(lds + CA_KQ, lds + CA_BD, lds + CA_LB, lds + CA_LOFFT, wave, lane);
        __builtin_amdgcn_sched_barrier(0);
        { f32x4 a[2]; ACC_ZERO(a); mm_nt(a, lds + CA_KQ, lds + CA_KD, wave, lane);
#pragma unroll
          for (int j = 0; j < 2; ++j) { const int n = ACC_N(wave, lane, j); f32x4 o;
#pragma unroll
              for (int r = 0; r < 4; ++r) o[r] = (n + r < m) ? a[j][r] : 0.f;
              *(LAS unsigned long long*)(lds + CA_LK + m * PB + n * 2) = pk4(o); } }
        __syncthreads();
        solve_td(lds + CA_LB, lds + CA_TD, wave, lane);
        __builtin_amdgcn_sched_barrier(0);
        { f32x4 a[2]; ACC_ZERO(a); mm_nt(a, lds + CA_VT, lds + CA_LK, wave, lane);
          store_hilo_rows(a, lds + CA_RHI, lds + CA_RLO, 64, wave, lane); }
        for (int idx = F.tid; idx < 128 * 9; idx += 512) *(LAS v4u*)(lds + CA_KD + idx * 16) = (v4u){0u, 0u, 0u, 0u};
        __builtin_amdgcn_sched_barrier(0);
        if (c < 3) chunk_load(F, b * TP + sc * 256 + (c + 1) * 64, h, raw);
        __syncthreads();
        solve_md(lds + CA_LOFFT, lds + CA_TD, lds + CA_MD, wave, lane);
        __syncthreads();
        solve_chain<8>(lds + CA_TD, lds + CA_MD, lds + CA_RHI, lds + CA_RLO, lds + CA_KD, wave, lane);
        __syncthreads();
        f32x4 pt[2], xc[2];
        { f32x4 a[2]; ACC_ZERO(a); mm_nt(a, lds + CA_BET, lds + CA_KD, wave, lane);
          const LAS float* GL = (const LAS float*)(lds + CA_SMALL + SM_GL);
#pragma unroll
          for (int j = 0; j < 2; ++j) { const int n = ACC_N(wave, lane, j);
#pragma unroll
              for (int r = 0; r < 4; ++r) pt[j][r] = ((m == n + r) ? GL[n + r] : 0.f) - a[j][r]; } }
        __builtin_amdgcn_sched_barrier(0);
        { f32x4 a1[2], a2[2]; ACC_ZERO(a1); ACC_ZERO(a2);
          mm_nt(a1, lds + CA_VT, lds + CA_KET, wave, lane); mm_nt(a2, lds + CA_KD + 64 * PB, lds + CA_BET, wave, lane);
          xc[0] = a1[0] - a2[0]; xc[1] = a1[1] - a2[1]; }
        __builtin_amdgcn_sched_barrier(0);
        store_hilo(pt, lds + CA_KQ, lds + CA_LK, wave, lane);
        store_hilo(gacc, lds + 0, lds + MB16, wave, lane);
        store_hilo(xacc, lds + 2 * MB16, lds + 3 * MB16, wave, lane);
        __syncthreads();
        { f32x4 a[2]; ACC_ZERO(a);
          mm_nt(a, lds + 0, lds + CA_KQ, wave, lane); mm_nt(a, lds + 0, lds + CA_LK, wave, lane); mm_nt(a, lds + MB16, lds + CA_KQ, wave, lane);
          gacc[0] = a[0]; gacc[1] = a[1]; }
        __builtin_amdgcn_sched_barrier(0);
        { f32x4 a[2]; a[0] = xc[0]; a[1] = xc[1];
          mm_nt(a, lds + 2 * MB16, lds + CA_KQ, wave, lane); mm_nt(a, lds + 2 * MB16, lds + CA_LK, wave, lane); mm_nt(a, lds + 3 * MB16, lds + CA_KQ, wave, lane);
          xacc[0] = a[0]; xacc[1] = a[1]; }
    }
    float* GT = (float*)(F.ws + WS_GX + (size_t)task * 32768); float* XO = GT + 4096;
    int lz = lane; asm volatile("" : "+v"(lz));
    const int m2 = ACC_M(wave, lz);
#pragma unroll
    for (int j = 0; j < 2; ++j) { const int n = ACC_N(wave, lz, j);
#pragma unroll
        for (int r = 0; r < 4; ++r) GT[(n + r) * 64 + m2] = gacc[j][r];
        *(f32x4*)(XO + m2 * 64 + n) = xacc[j]; }
}
__device__ __forceinline__ void scanB_unit(Frame& F, int bh) {
    LAS unsigned char* lds = F.lds; const int wave = F.wave, lane = F.lane, tid = F.tid, lr = lane & 15, lq = lane >> 4;
    constexpr int GTB = 2 * MB16;
    LAS unsigned char* myS = lds + 2 * GTB + wave * (2 * 16 * PB);
    const int row = tid >> 3, c8 = (tid & 7) * 8;
    const float* G0 = (const float*)(F.ws + WS_GX + (size_t)(bh * 32) * 32768);
#define SB_PUT(buf, ga, gb) do { const unsigned long long h0_ = pk4(ga), h1_ = pk4(gb); const f32x4 l0_ = ga - bf4_to_f32(h0_), l1_ = gb - bf4_to_f32(h1_); const unsigned long long q0_ = pk4(l0_), q1_ = pk4(l1_); \
        *(LAS v4u*)(lds + (buf) * GTB + row * PB + c8 * 2) = (v4u){(unsigned)h0_, (unsigned)(h0_ >> 32), (unsigned)h1_, (unsigned)(h1_ >> 32)}; \
        *(LAS v4u*)(lds + (buf) * GTB + MB16 + row * PB + c8 * 2) = (v4u){(unsigned)q0_, (unsigned)(q0_ >> 32), (unsigned)q1_, (unsigned)(q1_ >> 32)}; } while (0)
    f32x4 g0 = *(const f32x4*)(G0 + row * 64 + c8), g1 = *(const f32x4*)(G0 + row * 64 + c8 + 4);
    __syncthreads();
    SB_PUT(0, g0, g1);
    g0 = *(const f32x4*)(G0 + 8192 + row * 64 + c8); g1 = *(const f32x4*)(G0 + 8192 + row * 64 + c8 + 4);
    f32x4 s[4], x[4];
#pragma unroll
    for (int tc = 0; tc < 4; ++tc) { s[tc] = (f32x4){0.f, 0.f, 0.f, 0.f}; x[tc] = s[tc]; }
    const int vrow = 16 * (wave & 3) + lr;
    if (wave < 4) {
#pragma unroll
        for (int tc = 0; tc < 4; ++tc) x[tc] = *(const f32x4*)(G0 + 4096 + vrow * 64 + 16 * tc + 4 * lq); }
    __syncthreads();
    for (int sc = 0; sc < 32; ++sc) {
        const int task = bh * 32 + sc;
        if (wave < 4) {
            float* S0 = (float*)(F.ws + WS_S0 + (size_t)task * 16384);
#pragma unroll
            for (int tc = 0; tc < 4; ++tc) { *(f32x4*)(S0 + vrow * 64 + 16 * tc + 4 * lq) = s[tc];
                const unsigned long long hi = pk4(s[tc]); const f32x4 lo = s[tc] - bf4_to_f32(hi);
                *(LAS unsigned long long*)(myS + lr * PB + (16 * tc + 4 * lq) * 2) = hi; *(LAS unsigned long long*)(myS + 16 * PB + lr * PB + (16 * tc + 4 * lq) * 2) = pk4(lo); }
            f32x4 a[4];
#pragma unroll
            for (int tc = 0; tc < 4; ++tc) a[tc] = x[tc];
            if (sc + 1 < 32) { const float* Xn = (const float*)(F.ws + WS_GX + (size_t)(task + 1) * 32768) + 4096;
#pragma unroll
                for (int tc = 0; tc < 4; ++tc) x[tc] = *(const f32x4*)(Xn + vrow * 64 + 16 * tc + 4 * lq); }
            LDS_WAIT(); asm volatile("" ::: "memory");
            const LAS unsigned char* gb = lds + (sc & 1) * GTB;
#pragma unroll
            for (int ks = 0; ks < 2; ++ks) {
                const bf16x8 xh = *(const LAS bf16x8*)(myS + lr * PB + ks * 64 + lq * 16), xl = *(const LAS bf16x8*)(myS + 16 * PB + lr * PB + ks * 64 + lq * 16);
#pragma unroll
                for (int tc = 0; tc < 4; ++tc) {
                    const bf16x8 yh = *(const LAS bf16x8*)(gb + (16 * tc + lr) * PB + ks * 64 + lq * 16), yl = *(const LAS bf16x8*)(gb + MB16 + (16 * tc + lr) * PB + ks * 64 + lq * 16);
                    a[tc] = __builtin_amdgcn_mfma_f32_16x16x32_bf16(yh, xh, a[tc], 0, 0, 0);
                    a[tc] = __builtin_amdgcn_mfma_f32_16x16x32_bf16(yl, xh, a[tc], 0, 0, 0);
                    a[tc] = __builtin_amdgcn_mfma_f32_16x16x32_bf16(yh, xl, a[tc], 0, 0, 0);
                }
            }
#pragma unroll
            for (int tc = 0; tc < 4; ++tc) s[tc] = a[tc];
        }
        if (sc + 1 < 32) SB_PUT((sc + 1) & 1, g0, g1);
        if (sc + 2 < 32) { const float* Gn = (const float*)(F.ws + WS_GX + (size_t)(task + 2) * 32768); g0 = *(const f32x4*)(Gn + row * 64 + c8); g1 = *(const f32x4*)(Gn + row * 64 + c8 + 4); }
        __syncthreads();
    }
#undef SB_PUT
}
__device__ __forceinline__ void scanC_task(Frame& F, int task) {
    LAS unsigned char* lds = F.lds; const int wave = F.wave, lane = F.lane;
    const int sc = task & 31, bh = task >> 5, h = bh & 7, b = bh >> 3;
    const int m = ACC_M(wave, lane);
    const bf16* GG = WSP(bf16, WS_G); bf16* MIX = WSP(bf16, WS_U);
    const int chn = h * 64 + lane; const float gnw = GIN(I_GNW)[chn], gnb = GIN(I_GNB)[chn];
    f32x4 s[2];
    { const float* S0 = (const float*)(F.ws + WS_S0 + (size_t)task * 16384);
#pragma unroll
      for (int j = 0; j < 2; ++j) { const int n = ACC_N(wave, lane, j); s[j] = *(const f32x4*)(S0 + m * 64 + n); } }
    const ChanConst kc = chan_const(F, h);
    ChunkRaw raw; chunk_load(F, b * TP + sc * 256, h, raw);
    for (int c = 0; c < 4; ++c) {
        const int m0 = b * TP + sc * 256 + c * 64;
        __syncthreads();
        chunk_stage<true>(F, raw, kc, h, CC_KQ, CC_RQ, CC_KD, CC_BD, CC_VT, CC_KET, CC_BET, 0, 0, CC_LB, CC_SMALL);
        store_hilo(s, lds + CC_SHI, lds + CC_SLO, wave, lane);
        __syncthreads();
        make_L(lds + CC_KQ, lds + CC_BD, lds + CC_LB, lds + CC_LOFFT, wave, lane);
        __builtin_amdgcn_sched_barrier(0);
        { f32x4 a[2]; ACC_ZERO(a); mm_nt(a, lds + CC_KQ, lds + CC_KD, wave, lane);
#pragma unroll
          for (int j = 0; j < 2; ++j) { const int n = ACC_N(wave, lane, j); f32x4 o;
#pragma unroll
              for (int r = 0; r < 4; ++r) o[r] = (n + r < m) ? a[j][r] : 0.f;
              *(LAS unsigned long long*)(lds + CC_LK + m * PB + n * 2) = pk4(o); } }
        __builtin_amdgcn_sched_barrier(0);
        { f32x4 a[2], a2[2]; ACC_ZERO(a); ACC_ZERO(a2); mm_nt(a, lds + CC_RQ, lds + CC_KD, wave, lane); mm_nt(a2, lds + CC_RQ, lds + CC_BD, wave, lane);
#pragma unroll
          for (int j = 0; j < 2; ++j) { const int n = ACC_N(wave, lane, j); f32x4 o, o2;
#pragma unroll
              for (int r = 0; r < 4; ++r) { o[r] = (n + r <= m) ? a[j][r] : 0.f; o2[r] = (n + r <= m) ? a2[j][r] : 0.f; }
              *(LAS unsigned long long*)(lds + CC_MK + m * PB + n * 2) = pk4(o); *(LAS unsigned long long*)(lds + CC_MB + m * PB + n * 2) = pk4(o2); } }
        __syncthreads();
        solve_td(lds + CC_LB, lds + CC_TD, wave, lane);
        __builtin_amdgcn_sched_barrier(0);
        { f32x4 a[2]; ACC_ZERO(a);
          mm_nt(a, lds + CC_SHI, lds + CC_KQ, wave, lane); mm_nt(a, lds + CC_SLO, lds + CC_KQ, wave, lane); mm_nt(a, lds + CC_VT, lds + CC_LK, wave, lane);
          store_hilo_rows(a, lds + CC_RHI, lds + CC_RLO, 0, wave, lane); }
        for (int idx = F.tid; idx < 64 * 9; idx += 512) *(LAS v4u*)(lds + CC_KD + idx * 16) = (v4u){0u, 0u, 0u, 0u};
        __builtin_amdgcn_sched_barrier(0);
        unsigned gq[8];
#pragma unroll
        for (int i8 = 0; i8 < 8; ++i8) gq[i8] = GG[(size_t)(m0 + wave + 8 * i8) * RW + chn];
        if (c < 3) chunk_load(F, m0 + 64, h, raw);
        __syncthreads();
        solve_md(lds + CC_LOFFT, lds + CC_TD, lds + CC_MD, wave, lane);
        __syncthreads();
        solve_chain<4>(lds + CC_TD, lds + CC_MD, lds + CC_RHI, lds + CC_RLO, lds + CC_KD, wave, lane);
        __syncthreads();
        { f32x4 a[2], a2[2]; ACC_ZERO(a); ACC_ZERO(a2);
          mm_nt(a, lds + CC_RQ, lds + CC_SHI, wave, lane); mm_nt(a, lds + CC_RQ, lds + CC_SLO, wave, lane); mm_nt(a, lds + CC_MK, lds + CC_VT, wave, lane);
          mm_nt(a2, lds + CC_MB, lds + CC_KD, wave, lane);
#pragma unroll
          for (int j = 0; j < 2; ++j) { const int n = ACC_N(wave, lane, j); *(LAS f32x4*)(lds + CC_LB + m * PF + n * 4) = a[j] - a2[j]; } }
        __builtin_amdgcn_sched_barrier(0);
        { f32x4 a1[2], a2[2]; ACC_ZERO(a1); ACC_ZERO(a2);
          mm_nt(a1, lds + CC_VT, lds + CC_KET, wave, lane); mm_nt(a2, lds + CC_KD, lds + CC_BET, wave, lane);
          const LAS float* GL = (const LAS float*)(lds + CC_SMALL + SM_GL);
#pragma unroll
          for (int j = 0; j < 2; ++j) { const int n = ACC_N(wave, lane, j); const f32x4 gl = *(const LAS f32x4*)(GL + n); s[j] = s[j] * gl + a1[j] - a2[j]; } }
        __syncthreads();
#pragma unroll
        for (int i8 = 0; i8 < 8; ++i8) {
            const int t = wave + 8 * i8, mm = m0 + t;
            const float y = *(const LAS float*)(lds + CC_LB + t * PF + lane * 4);
            const float mean = wave_sum_dpp(y) * (1.f / 64.f), d = y - mean, var = wave_sum_dpp(d * d) * (1.f / 64.f);
            const float yn = d * (1.0f / sqrtf(var + GN_EPS));
            const float dot = ((const LAS float*)(lds + CC_SMALL + SM_DOT))[t];
            const float v = bf2f(*(const LAS unsigned short*)(lds + CC_VT + lane * PB + t * 2));
            const float gg = bf2f((unsigned short)gq[i8]);
            MIX[(size_t)mm * D + chn] = (bf16)f2bf((yn * gnw + gnb + dot * v) * gg);
        }
    }
    if (sc == 31) { float* so = GOUT() + O_WKV_P + (size_t)bh * 4096;
        int lz = lane; asm volatile("" : "+v"(lz)); const int m2 = ACC_M(wave, lz);
#pragma unroll
        for (int j = 0; j < 2; ++j) { const int n = ACC_N(wave, lz, j); *(f32x4*)(so + m2 * 64 + n) = s[j]; } }
}
__device__ __forceinline__ int rel_bucket(int n) {
    if (n < 16) return n;
    const int b = 16 + (int)(logf((float)n * (1.0f / 16.0f)) / 2.0794415416798357f * 16.0f);
    return b < 31 ? b : 31;
}
typedef float f32x16 __attribute__((ext_vector_type(16)));
typedef short s16x4 __attribute__((ext_vector_type(4)));
struct AttnLane { const bf16* qrow; int qrel; int rmin; const LAS float* btab; float sink; bf16* orow; };
__device__ __forceinline__ void attn_core32(const LAS unsigned char* Kl, const LAS unsigned char* Vt, int VTP, int kt0, const AttnLane L, int lane) {
    const int r = lane & 31, h = lane >> 5;
    bf16x8 qf[4];
#pragma unroll
    for (int ds = 0; ds < 4; ++ds) qf[ds] = *(const bf16x8*)(L.qrow + 16 * ds + 8 * h);
    f32x16 sc[5];
#pragma unroll
    for (int T = 0; T < 5; ++T) {
#pragma unroll
        for (int e = 0; e < 16; ++e) sc[T][e] = 0.f;
#pragma unroll
        for (int ds = 0; ds < 4; ++ds) { const bf16x8 kf = *(const LAS bf16x8*)(Kl + ((kt0 + T) * 32 + r) * 144 + (16 * ds + 8 * h) * 2);
            sc[T] = __builtin_amdgcn_mfma_f32_32x32x16_bf16(kf, qf[ds], sc[T], 0, 0, 0); }
    }
    float mx = L.sink;
#pragma unroll
    for (int T = 0; T < 5; ++T)
#pragma unroll
        for (int e = 0; e < 16; ++e) { const int rabs = (kt0 + T) * 32 + (e & 3) + 8 * (e >> 2) + 4 * h, dist = L.qrel - rabs;
            const bool valid = dist >= 0 && dist < 128 && rabs >= L.rmin;
            const float s = valid ? sc[T][e] * 0.125f + L.btab[dist & 127] : -1e30f;
            sc[T][e] = s; mx = fmaxf(mx, s); }
    mx = fmaxf(mx, __shfl_xor(mx, 32));
    float l = 0.f;
#pragma unroll
    for (int T = 0; T < 5; ++T)
#pragma unroll
        for (int e = 0; e < 16; ++e) { const float p = sc[T][e] > -1e29f ? __expf(sc[T][e] - mx) : 0.f; sc[T][e] = p; l += p; }
    l += __shfl_xor(l, 32);
    l += __expf(L.sink - mx);
    f32x16 o[2];
#pragma unroll
    for (int e = 0; e < 16; ++e) { o[0][e] = 0.f; o[1][e] = 0.f; }
#pragma unroll
    for (int T = 0; T < 5; ++T)
#pragma unroll
        for (int s2 = 0; s2 < 2; ++s2) {
            v4u pw; pw.x = pk2(sc[T][8 * s2], sc[T][8 * s2 + 1]); pw.y = pk2(sc[T][8 * s2 + 2], sc[T][8 * s2 + 3]); pw.z = pk2(sc[T][8 * s2 + 4], sc[T][8 * s2 + 5]); pw.w = pk2(sc[T][8 * s2 + 6], sc[T][8 * s2 + 7]);
            const bf16x8 pb = __builtin_bit_cast(bf16x8, pw);
#pragma unroll
            for (int dt = 0; dt < 2; ++dt) {
                const LAS unsigned char* vp = Vt + (32 * dt + r) * VTP + ((kt0 + T) * 32 + 16 * s2 + 4 * h) * 2;
                const s16x4 lo = *(const LAS s16x4*)vp, hi = *(const LAS s16x4*)(vp + 16);
                const bf16x8 va = (bf16x8){lo[0], lo[1], lo[2], lo[3], hi[0], hi[1], hi[2], hi[3]};
                o[dt] = __builtin_amdgcn_mfma_f32_32x32x16_bf16(va, pb, o[dt], 0, 0, 0);
            }
        }
    const float il = 1.0f / l;
#pragma unroll
    for (int dt = 0; dt < 2; ++dt)
#pragma unroll
        for (int gq = 0; gq < 4; ++gq) { const int d = 32 * dt + 8 * gq + 4 * h;
            const unsigned long long w = (unsigned long long)pk2(o[dt][4 * gq] * il, o[dt][4 * gq + 1] * il) | ((unsigned long long)pk2(o[dt][4 * gq + 2] * il, o[dt][4 * gq + 3] * il) << 32);
            *(unsigned long long*)(L.orow + d) = w; }
}
constexpr int AP_K = 0, AP_VTP = 528, AP_VT = 256 * 144, AP_BT = AP_VT + 64 * AP_VTP, AP_END = AP_BT + 4 * 128 * 4;
__device__ __forceinline__ void attn_prompt_unit(Frame& F, int b, int kvh, int qb) {
    LAS unsigned char* lds = F.lds;
    const bf16* P = WSP(bf16, WS_H); bf16* MIX = WSP(bf16, WS_U); const float* relb = GIN(I_RELB);
    const int t0 = qb * 128, tid = F.tid;
    __syncthreads();
    for (int idx = tid; idx < 256 * 8; idx += 512) {
        const int row = idx >> 3, part = idx & 7, pos = t0 - 128 + row;
        v4u val = (v4u){0u, 0u, 0u, 0u};
        if (pos >= 0) val = *(const v4u*)(P + (size_t)(b * TP + pos) * NIN + 2304 + kvh * 64 + part * 8);
        *(LAS v4u*)(lds + AP_K + row * 144 + part * 16) = val;
    }
    for (int idx = tid; idx < 256 * 8; idx += 512) {
        const int row = idx & 255, part = idx >> 8, pos = t0 - 128 + row;
        v4u val = (v4u){0u, 0u, 0u, 0u};
        if (pos >= 0) val = *(const v4u*)(P + (size_t)(b * TP + pos) * NIN + 2432 + kvh * 64 + part * 8);
#pragma unroll
        for (int e = 0; e < 4; ++e) { *(LAS unsigned short*)(lds + AP_VT + (part * 8 + 2 * e) * AP_VTP + row * 2) = (unsigned short)(val[e] & 0xffffu);
                                      *(LAS unsigned short*)(lds + AP_VT + (part * 8 + 2 * e + 1) * AP_VTP + row * 2) = (unsigned short)(val[e] >> 16); }
    }
    { const int g = tid >> 7, dist = tid & 127; ((LAS float*)(lds + AP_BT))[g * 128 + dist] = relb[rel_bucket(dist) * 8 + kvh * 4 + g]; }
    __syncthreads();
    const int g = F.wave & 3, qh = F.wave >> 2, hq = kvh * 4 + g;
#pragma unroll 1
    for (int bq = 0; bq < 2; ++bq) {
        const int i = 64 * qh + 32 * bq + (F.lane & 31), m = b * TP + t0 + i;
        AttnLane L; L.qrow = P + (size_t)m * NIN + RWP + hq * 64; L.qrel = i + 128; L.rmin = t0 == 0 ? 128 : 0;
        L.btab = (const LAS float*)(lds + AP_BT) + g * 128; L.sink = GIN(I_SINKS)[hq]; L.orow = MIX + (size_t)m * D + RW + hq * 64;
        attn_core32(lds + AP_K, lds + AP_VT, AP_VTP, 2 * qh + bq, L, F.lane);
    }
}
static_assert(AP_END <= RING_BYTES && AP_VT % 16 == 0 && CC_SMALL + SM_BYTES <= RING_BYTES && CA_SMALL + SM_BYTES <= RING_BYTES, "LDS maps");
constexpr int AS_KB = 160 * 144, AS_VTP = 336, AS_VT = 2 * AS_KB, AS_VB = 64 * AS_VTP, AS_BT = AS_VT + 2 * AS_VB, AS_END = AS_BT + 8 * 128 * 4;
static_assert(AS_END <= RING_BYTES && AS_VT % 16 == 0 && AS_VB % 16 == 0, "LDS maps");
__device__ __forceinline__ void attn_sample_unit(Frame& F, int b) {
    LAS unsigned char* lds = F.lds;
    const bf16* P = WSP(bf16, WS_H); bf16* MIX = WSP(bf16, WS_U); const float* relb = GIN(I_RELB); const float* ck = GIN(I_CK); const float* cv = GIN(I_CV);
    const int tid = F.tid;
    __syncthreads();
    for (int idx = tid; idx < 160 * 32; idx += 512) {
        const int j = idx >> 5, c4 = (idx & 31) * 4, kvh = c4 >> 6, d = c4 & 63;
        f32x4 kx = (f32x4){0.f, 0.f, 0.f, 0.f}, vx = kx;
        if (j < 128) { kx = *(const f32x4*)(ck + (size_t)(b * 128 + j) * 128 + c4); vx = *(const f32x4*)(cv + (size_t)(b * 128 + j) * 128 + c4); }
        else if (j < 136) { const bf16* pr = P + (size_t)(MP + b * TS + (j - 128)) * NIN;
            const unsigned long long kw = *(const unsigned long long*)(pr + 2304 + c4), vw = *(const unsigned long long*)(pr + 2432 + c4); kx = bf4_to_f32(kw); vx = bf4_to_f32(vw); }
        *(LAS unsigned long long*)(lds + kvh * AS_KB + j * 144 + d * 2) = pk4(kx);
#pragma unroll
        for (int e = 0; e < 4; ++e) *(LAS unsigned short*)(lds + AS_VT + kvh * AS_VB + (d + e) * AS_VTP + j * 2) = (unsigned short)f2bf(vx[e]);
    }
    for (int idx = tid; idx < 1024; idx += 512) { const int hq = idx >> 7, dist = idx & 127; ((LAS float*)(lds + AS_BT))[idx] = relb[rel_bucket(dist) * 8 + hq]; }
    __syncthreads();
    if (F.wave < 2) {
        const int kvh = F.wave, rr = F.lane & 31, g = rr >> 3, t = rr & 7, hq = kvh * 4 + g, m = MP + b * TS + t;
        AttnLane L; L.qrow = P + (size_t)m * NIN + RWP + hq * 64; L.qrel = t + 128; L.rmin = 0;
        L.btab = (const LAS float*)(lds + AS_BT) + hq * 128; L.sink = GIN(I_SINKS)[hq]; L.orow = MIX + (size_t)m * D + RW + hq * 64;
        attn_core32(lds + kvh * AS_KB, lds + AS_VT + kvh * AS_VB, AS_VTP, 0, L, F.lane);
    }
}
enum { MT_SCANB = 0, MT_ATTN = 1, MT_SSCAN = 2, MT_SATTN = 3, MT_COPY = 4 };
__device__ __forceinline__ void mixer_task(Frame& F0, int kind, int idx) {
    Frame F = F0;
    { int t_ = threadIdx.x; asm volatile("" : "+v"(t_)); F.tid = t_; F.lane = t_ & 63; F.wave = __builtin_amdgcn_readfirstlane(t_ >> 6); }
#ifndef REP_PHASE
#define REP_PHASE -1
#endif
    if (kind == MT_SCANB) { scanB_unit(F, idx); if (REP_PHASE == 108) scanB_unit(F, idx); }
    else if (kind == MT_ATTN) { attn_prompt_unit(F, idx >> 7, (idx >> 6) & 1, idx & 63); if (REP_PHASE == 208) attn_prompt_unit(F, idx >> 7, (idx >> 6) & 1, idx & 63); }
    else if (kind == MT_SSCAN) { sample_scan_unit(F, idx); if (REP_PHASE == 308) sample_scan_unit(F, idx); }
    else if (kind == MT_SATTN) { attn_sample_unit(F, idx); if (REP_PHASE == 408) attn_sample_unit(F, idx); }
    else { copy_task(F, idx); if (REP_PHASE == 508) copy_task(F, idx); }
}
__device__ __forceinline__ void p_mixer(Frame& F) {
    const bool dealt = F.G == 256;
    const int ntot = 16 + 256 + 128 + 128 + NCOPY;
    for (int i = 0; ; ++i) {
        int kind = -1, idx = 0;
        if (dealt) {
            if (i >= 4) break;
            if (F.vcu < 16) { if (i == 0) { kind = MT_SCANB; idx = F.vcu; } }
            else { const int o = F.vcu - 16;
                if (o < 128) { if (i == 0) { kind = MT_SSCAN; idx = o; } else if (i == 1) { kind = MT_ATTN; idx = o; } }
                else { const int p = o - 128;
                    if (i == 0) { kind = MT_ATTN; idx = 128 + p; }
                    else if (p < 16) { if (i == 1) { kind = MT_ATTN; idx = 240 + p; } }
                    else { const int q = p - 16;
                        if (i == 1) { kind = MT_SATTN; idx = q; }
                        else if (i == 2) { if (q < 32) { kind = MT_SATTN; idx = 96 + q; } else { kind = MT_COPY; idx = q; } }
                        else if (q < 32) { kind = MT_COPY; idx = q; } } } }
        } else {
            const int t = F.vcu + i * F.G; if (t >= ntot) break;
            if (t < 16) { kind = MT_SCANB; idx = t; } else if (t < 272) { kind = MT_ATTN; idx = t - 16; } else if (t < 400) { kind = MT_SSCAN; idx = t - 272; }
            else if (t < 528) { kind = MT_SATTN; idx = t - 400; } else { kind = MT_COPY; idx = t - 528; }
        }
        if (kind >= 0) mixer_task(F, kind, idx);
    }
    __syncthreads();
}
__device__ __forceinline__ void p_scanA(Frame& F) { for (int t = F.vcu; t < 512; t += F.G) scanA_task(F, t); __syncthreads(); }
__device__ __forceinline__ void p_scanC(Frame& F) { for (int t = F.vcu; t < 512; t += F.G) scanC_task(F, t); __syncthreads(); }
#ifndef MK_PER_PHASE
#define MK_PER_PHASE 0
#endif
constexpr int N_PHASES = 15;
__global__ void __launch_bounds__(NWAVES * 64, 2) fwd_kernel(Args args) {
    extern __shared__ __attribute__((aligned(16))) unsigned char lds[];
    Frame F;
    F.lds = (LAS unsigned char*)lds;
    F.MISC = (volatile LAS unsigned*)(F.lds + MISC_OFF);
    F.tid = threadIdx.x; F.lane = F.tid & 63; F.wave = __builtin_amdgcn_readfirstlane(F.tid >> 6);
    F.G = gridDim.x; { const int bx = blockIdx.x; F.vcu = (F.G % 8 == 0) ? (bx % 8) * (F.G / 8) + bx / 8 : bx; }
    F.a = (const __attribute__((address_space(4))) Args*)__builtin_amdgcn_kernarg_segment_ptr(); F.ws = args.ws; F.ctl = (gu32*)(args.ws + WS_CTL);
    for (int u = F.tid; u < (LDS_BYTES - LDSCTL_OFF) / 4; u += NWAVES * 64) ((LAS unsigned*)(F.lds + LDSCTL_OFF))[u] = 0u;
    __syncthreads();
    const int lo = args.ph_lo, hi = args.ph_hi;
    XcdBarrier bar; bar.bar = (unsigned*)(F.ctl + CW_BAR); bar.x = 0; bar.st = nullptr;
    if (hi - lo > 1) bar = xcd_barrier_post((unsigned*)(F.ctl + CW_BAR), F.MISC + 8);
#ifdef ONLY_PHASE
#define IN(k) ((k) == ONLY_PHASE && lo <= (k) && (k) < hi)
#else
#define IN(k) (lo <= (k) && (k) < hi)
#endif
#ifndef REP_PHASE
#define REP_PHASE -1
#endif
#define SEAM(k) do { if ((k) + 1 < hi) xcd_barrier(bar); } while (0)
#define PH(k, BODY) if (IN(k)) { { const __attribute__((address_space(4))) Args* a_ = (const __attribute__((address_space(4))) Args*)__builtin_amdgcn_kernarg_segment_ptr(); asm volatile("" : "+s"(a_)); F.a = a_; F.ws = (unsigned char*)(GAS unsigned char*)(a_->ws); }     BODY; if ((k) == REP_PHASE) { xcd_barrier(bar); BODY; } SEAM(k); }
#define GEMM_SWIGLU(WOFF) { \
        pg8::Gemm g{WSP(bf16, WS_U), WSP(bf16, WOFF), M, NFF, D}; pg8::StaticOrder S; S.init(M, NFF, F.G, (int)blockIdx.x, D); \
        pg8::EpiSwiglu E{WSP(bf16, WS_H), FF}; \
        pg8::gemm_phase<pg8::EpiSwiglu, pg8::StaticOrder, true, true>(F.lds + RING_OFF, g, S, E); }
#define GEMM_RESID(AOFF, WOFF, KK, XP, XS, GTK, GS) { \
        pg8::Gemm g{WSP(bf16, AOFF), WSP(bf16, WOFF), M, D, KK}; pg8::SliceOrder S; S.init(KK, F.G, (int)blockIdx.x); \
        pg8::EpiResid<GS> E{XP, XS, GOUT() + O_Y, WSP(float, WS_MOD) + (GTK) * D, WSP(float, WS_WLOG)}; \
        pg8::gemm_phase<pg8::EpiResid<GS>, pg8::SliceOrder, true, true>(F.lds + RING_OFF, g, S, E); }
#define GEMM_WIN() { \
        pg8::Gemm g{WSP(bf16, WS_U), WSP(bf16, WS_WIN), M, NIN, D}; pg8::StaticOrder S; S.init(M, NIN, F.G, (int)blockIdx.x, D); \
        pg8::EpiBf16<0> E{WSP(bf16, WS_H), NIN, nullptr, 0, 0, 1.f}; \
        pg8::gemm_phase<pg8::EpiBf16<0>, pg8::StaticOrder, true, true>(F.lds + RING_OFF, g, S, E); }
    PH(0, { p0_weights(F); if (REP_PHASE == 100) { __syncthreads(); p0_weights(F); } __syncthreads(); p0_mod(F); if (REP_PHASE == 101) { __syncthreads(); p0_mod(F); } })
    PH(1, p_modulate0(F))
    PH(2, GEMM_SWIGLU(WS_W1IN))
    PH(3, GEMM_RESID(WS_H, WS_W1OUT, FF, GIN(I_XP), GIN(I_XS), 2, 1))
    PH(4, p_layernorm(F, 0, 3 * D, FF / 256, args.in[I_XS], 2, 0.5f))
    PH(5, GEMM_WIN())
    PH(6, p_prep(F))
    PH(7, p_scanA(F))
    PH(8, p_mixer(F))
    PH(9, p_scanC(F))
    PH(10, GEMM_RESID(WS_U, WS_WOUT, D, GOUT() + O_Y, GOUT() + O_Y + (size_t)MP * D, 5, 2))
    PH(11, p_layernorm(F, 1, 6 * D, D / 256, GOUT() + O_Y + (size_t)MP * D, 5, 1.0f))
    PH(12, GEMM_SWIGLU(WS_W2IN))
    PH(13, GEMM_RESID(WS_H, WS_W2OUT, FF, GOUT() + O_Y, GOUT() + O_Y + (size_t)MP * D, 8, 1))
    PH(14, p_layernorm(F, 2, -1, FF / 256, GOUT() + O_Y + (size_t)MP * D, 8, 0.5f))
}

extern "C" void kernel_launch(void* const* d_in, const int* in_sizes, int n_in, void* d_out, int out_size, void* d_ws, size_t ws_size, hipStream_t stream) {
    static int grid = 0;
    if (grid == 0) {
        if (n_in != N_IN || in_sizes[0] != MP * D || out_size != (int)O_END || ws_size < WS_END) { fprintf(stderr, "kernel_launch: unexpected shapes (n_in %d, out %d, ws %zu); nothing launched\n", n_in, out_size, ws_size); grid = -1; return; }
        int dev = 0, cus = 0;
        if (hipGetDevice(&dev) != hipSuccess || hipDeviceGetAttribute(&cus, hipDeviceAttributeMultiprocessorCount, dev) != hipSuccess) { grid = -1; return; }
        if (hipFuncSetAttribute((const void*)fwd_kernel, hipFuncAttributeMaxDynamicSharedMemorySize, LDS_BYTES) != hipSuccess) { fprintf(stderr, "kernel_launch: hipFuncSetAttribute failed\n"); grid = -1; return; }
        int per_cu = 0;
        if (hipOccupancyMaxActiveBlocksPerMultiprocessor(&per_cu, (const void*)fwd_kernel, NWAVES * 64, LDS_BYTES) != hipSuccess || per_cu < 1) fprintf(stderr, "kernel_launch: occupancy query reports %d\n", per_cu);
        (void)hipGetLastError();
        grid = cus;
    }
    if (grid < 0) return;
    if (hipMemsetAsync((char*)d_ws + WS_CTL, 0, CTL_ZERO_BYTES, stream) != hipSuccess) return;
    Args a{};
    for (int i = 0; i < N_IN; ++i) a.in[i] = (const float*)d_in[i];
    a.out = (float*)d_out; a.ws = (unsigned char*)d_ws;
#if MK_PER_PHASE
    for (int ph = 0; ph < N_PHASES; ++ph) { a.ph_lo = ph; a.ph_hi = ph + 1; hipLaunchKernelGGL(fwd_kernel, dim3(grid), dim3(NWAVES * 64), LDS_BYTES, stream, a); }
#else
    a.ph_lo = 0; a.ph_hi = N_PHASES;
    hipLaunchKernelGGL(fwd_kernel, dim3(grid), dim3(NWAVES * 64), LDS_BYTES, stream, a);
#endif
}
```

```cpp
#define MK_PER_PHASE 0


#include <hip/hip_runtime.h>
#include <cstdio>
#include <cstdint>
#include <cmath>
namespace pg8 {
#define PG8_LAS __attribute__((address_space(3)))
typedef unsigned short bf16_t;
typedef short bf16x8 __attribute__((ext_vector_type(8)));
typedef float f32x4 __attribute__((ext_vector_type(4)));
typedef unsigned u32x4 __attribute__((ext_vector_type(4)));
constexpr int BM = 256, BK = 64, HALF = 128, HTB = HALF * BK * 2  , STAGE_BYTES = 8 * HTB, NXCD = 8, WGM = 8;

__host__ __device__ __forceinline__ int lds_byte(int r, int c) { const int st = (r >> 4) * 2 + (c >> 5), rr = r & 15, cc = c & 31, ob = rr * 64 + cc * 2; return st * 1024 + (ob ^ (((ob >> 9) & 1) << 5)); }
__host__ __device__ __forceinline__ void stage_rc(int b, int& R, int& C) { const int st = b / 1024, sb = b % 1024, swz = sb ^ (((sb >> 9) & 1) << 5); R = (st >> 1) * 16 + swz / 64; C = (st & 1) * 32 + (swz % 64) / 2; }
__host__ __device__ __forceinline__ int perm32(int rho) { const int n = rho >> 4, i = rho & 15; return 8 * (i >> 2) + 4 * n + (i & 3); }

struct Unit { int pm, pn, kt0, nt, ks; };
struct Gemm { const bf16_t* A; const bf16_t* Bt; int M, N, K; };

struct StaticOrder {
    int nM, nN, nwg, G, c;
    int ntk;
    __host__ __device__ void init(int M, int N, int G_, int c_, int K = 0) { nM = M / BM; nN = N / BM; nwg = nM * nN; G = G_; c = c_; ntk = K / BK; }
    __host__ __device__ bool next(int i, Unit& u) const {
        const long L = (long)i * G + c; if (L >= nwg) return false;
        int wgid = (int)L; { const int q = nwg / NXCD, r = nwg % NXCD, xcd = wgid % NXCD, off = wgid / NXCD; wgid = (xcd < r ? xcd * (q + 1) : r * (q + 1) + (xcd - r) * q) + off; }
        const int nig = WGM * nN, gid = wgid / nig, fm = gid * WGM, gsz = (nM - fm) < WGM ? (nM - fm) : WGM;
        u.pm = fm + ((wgid % nig) % gsz); u.pn = (wgid % nig) / gsz; u.kt0 = 0; u.nt = ntk; u.ks = -1; return true;
    }
    __device__ __forceinline__ void a_ready(const Unit&) const {}
    __device__ __forceinline__ void done(const Unit&) const {}
};

__device__ __forceinline__ unsigned cvt_pk_bf16(float lo, float hi) { unsigned r; asm volatile("v_cvt_pk_bf16_f32 %0, %1, %2" : "=v"(r) : "v"(lo), "v"(hi)); return r; }
template <int ACT  > struct EpiBf16 {
    static constexpr bool PERM = true, AFTER_DRAIN = false; static_assert(ACT == 0, "EpiBf16: ACT is 0 (none)");
    bf16_t* O; int ldc; const float* bias; int split_cols; size_t split_stride; float scale0;
    __device__ __forceinline__ void operator()(const f32x4 (&acc)[2][2][4][2], const Unit& u, int wr, int wc, int fr, int fq) const {
        const int row0 = u.pm * BM + wr * 64 + fr; int colt = u.pn * BM; bf16_t* base = O;
        float sc = 1.f; if (split_cols) { const int t = colt / split_cols; base += (size_t)t * split_stride; colt -= t * split_cols; if (t == 0) sc = scale0; }
        const int col0 = colt + wc * 32 + 8 * fq, bcol0 = u.pn * BM + wc * 32 + 8 * fq;
        f32x4 bv[2][2];
#pragma unroll
        for (int bj = 0; bj < 2; ++bj)
#pragma unroll
            for (int n = 0; n < 2; ++n) bv[bj][n] = bias ? *(const f32x4*)(bias + bcol0 + bj * HALF + 4 * n) : (f32x4){0.f, 0.f, 0.f, 0.f};
#pragma unroll
        for (int ai = 0; ai < 2; ++ai)
#pragma unroll
            for (int m = 0; m < 4; ++m) { bf16_t* rowp = base + (size_t)(row0 + ai * HALF + m * 16) * ldc + col0;
#pragma unroll
                for (int bj = 0; bj < 2; ++bj) { f32x4 v0 = acc[ai][bj][m][0] + bv[bj][0], v1 = acc[ai][bj][m][1] + bv[bj][1];
                    v0 = v0 * sc; v1 = v1 * sc; u32x4 w; w.x = cvt_pk_bf16(v0[0], v0[1]); w.y = cvt_pk_bf16(v0[2], v0[3]); w.z = cvt_pk_bf16(v1[0], v1[1]); w.w = cvt_pk_bf16(v1[2], v1[3]);
                    *(u32x4*)(rowp + bj * HALF) = w; } }
    }
};

template <class Epi, class Sched, bool ALIGN_EPI = false, bool SP2 = false>
__device__ __forceinline__ void gemm_phase(PG8_LAS unsigned char* lds, const Gemm g, const Sched& S, const Epi& E) {
    const int tid = threadIdx.x, wid = __builtin_amdgcn_readfirstlane(tid >> 6), lane = tid & 63, wr = wid >> 2, wc = wid & 3, fr = lane & 15, fq = lane >> 4;
    const int K = g.K;
    unsigned voffA[2], voffB[2];
#pragma unroll
    for (int i = 0; i < 2; ++i) { int R, C; stage_rc(tid * 16 + i * 8192, R, C); const int Rb = Epi::PERM ? ((R & ~31) + perm32(R & 31)) : R;
        voffA[i] = (unsigned)(R * K + C) * 2u; voffB[i] = (unsigned)(Rb * K + C) * 2u; }
    const size_t kstep = (size_t)(BK * 2);
    const size_t hstep = (size_t)HALF * K * 2;
    const size_t tstep = 2 * hstep;
    const unsigned ldsw = (unsigned)wid * 1024u;
    const int aoff = lds_byte(wr * 64 + fr, fq * 8), boff = lds_byte(wc * 32 + fr, fq * 8);
#define PG8_SA(b, h) (((b) * 2 + (h)) * HTB)
#define PG8_SB(b, h) ((4 + (b) * 2 + (h)) * HTB)
#define PG8_STAGE(bufoff, gbase, voff) do { _Pragma("unroll") for (int _i = 0; _i < 2; ++_i) \
        __builtin_amdgcn_global_load_lds((const unsigned*)((const char*)(gbase) + (voff)[_i]), (PG8_LAS unsigned*)(lds + (bufoff) + ldsw + _i * 8192), 16, 0, 0); } while (0)
#define PG8_LDA(dst, b, h) do { _Pragma("unroll") for (int m = 0; m < 4; ++m) _Pragma("unroll") for (int k = 0; k < 2; ++k) dst[m][k] = *(const PG8_LAS bf16x8*)(lds + PG8_SA(b, h) + aoff + m * 2048 + k * 1024); } while (0)
#define PG8_LDB(dst, b, h) do { _Pragma("unroll") for (int n = 0; n < 2; ++n) _Pragma("unroll") for (int k = 0; k < 2; ++k) dst[n][k] = *(const PG8_LAS bf16x8*)(lds + PG8_SB(b, h) + boff + n * 2048 + k * 1024); } while (0)
#define PG8_MMA(ai, bj, At, Bt) do { __builtin_amdgcn_s_setprio(1); _Pragma("unroll") for (int m = 0; m < 4; ++m) _Pragma("unroll") for (int n = 0; n < 2; ++n) _Pragma("unroll") for (int k = 0; k < 2; ++k) \
        acc[ai][bj][m][n] = __builtin_amdgcn_mfma_f32_16x16x32_bf16(Bt[n][k], At[m][k], acc[ai][bj][m][n], 0, 0, 0); __builtin_amdgcn_s_setprio(0); } while (0)
#define PG8_WAIT_V(n) asm volatile("s_waitcnt vmcnt(" #n ")" ::: "memory")
#define PG8_WAIT_L(n) asm volatile("s_waitcnt lgkmcnt(" #n ")" ::: "memory")
#define PG8_BAR __builtin_amdgcn_s_barrier()
#define PG8_SCHED __builtin_amdgcn_sched_barrier(0)
    Unit cur, nxt; int ui = 0;
    if (!S.next(0, cur)) return;
    f32x4 acc[2][2][4][2];
#pragma unroll
    for (int a = 0; a < 2; ++a)
#pragma unroll
        for (int b = 0; b < 2; ++b)
#pragma unroll
            for (int m = 0; m < 4; ++m)
#pragma unroll
                for (int n = 0; n < 2; ++n) acc[a][b][m][n] = (f32x4){0.f, 0.f, 0.f, 0.f};
    bf16x8 At[4][2], B0[2][2], B1[2][2];
    const char* cA = (const char*)g.A + (size_t)cur.pm * tstep + (size_t)cur.kt0 * kstep; const char* cB = (const char*)g.Bt + (size_t)cur.pn * tstep + (size_t)cur.kt0 * kstep;
    S.a_ready(cur);
    if constexpr (SP2) {
        PG8_STAGE(PG8_SB(0, 0), cB, voffB); PG8_STAGE(PG8_SB(0, 1), cB + hstep, voffB); PG8_STAGE(PG8_SA(0, 0), cA, voffA); PG8_STAGE(PG8_SA(0, 1), cA + hstep, voffA);
        if (wr == 1) PG8_BAR;
        PG8_WAIT_V(2); PG8_BAR;
        PG8_STAGE(PG8_SB(1, 0), cB + kstep, voffB); PG8_STAGE(PG8_SA(1, 0), cA + kstep, voffA); PG8_STAGE(PG8_SB(1, 1), cB + hstep + kstep, voffB);
        PG8_WAIT_V(6); PG8_BAR;
    } else {
        PG8_STAGE(PG8_SB(0, 0), cB, voffB); PG8_STAGE(PG8_SA(0, 0), cA, voffA); PG8_STAGE(PG8_SB(0, 1), cB + hstep, voffB); PG8_STAGE(PG8_SA(0, 1), cA + hstep, voffA);
        if (wr == 1) PG8_BAR;
        PG8_WAIT_V(4); PG8_BAR;
        PG8_STAGE(PG8_SB(1, 0), cB + kstep, voffB); PG8_STAGE(PG8_SA(1, 0), cA + kstep, voffA); PG8_STAGE(PG8_SB(1, 1), cB + hstep + kstep, voffB);
        PG8_WAIT_V(6); PG8_BAR;
    }
    for (;;) {
        const bool has_next = S.next(ui + 1, nxt);
        const char* nA = has_next ? (const char*)g.A + (size_t)nxt.pm * tstep + (size_t)nxt.kt0 * kstep : cA; const char* nB = has_next ? (const char*)g.Bt + (size_t)nxt.pn * tstep + (size_t)nxt.kt0 * kstep : cB;
        const int nt = cur.nt;
        for (int t = 0; t < nt; t += 2) {
            const bool last = (t == nt - 2);
            const char* a1 = cA + (size_t)(t + 1) * kstep;
            const char* a2 = last ? nA : cA + (size_t)(t + 2) * kstep; const char* b2 = last ? nB : cB + (size_t)(t + 2) * kstep;
            const char* a3 = a2 + kstep; const char* b3 = b2 + kstep;
            if (last && has_next) S.a_ready(nxt);
            if constexpr (SP2) {
            PG8_LDB(B0, 0, 0); PG8_LDB(B1, 0, 1); PG8_SCHED; PG8_LDA(At, 0, 0); PG8_STAGE(PG8_SA(1, 1), a1 + hstep, voffA);
            PG8_WAIT_V(8); PG8_WAIT_L(0); PG8_BAR; PG8_MMA(0, 0, At, B0); PG8_MMA(0, 1, At, B1); PG8_BAR; PG8_SCHED;
            PG8_LDA(At, 0, 1); PG8_STAGE(PG8_SB(0, 0), b2, voffB); PG8_STAGE(PG8_SB(0, 1), b2 + hstep, voffB); PG8_STAGE(PG8_SA(0, 0), a2, voffA);
            PG8_WAIT_V(8); PG8_WAIT_L(0); PG8_BAR; PG8_MMA(1, 0, At, B0); PG8_MMA(1, 1, At, B1); PG8_BAR; PG8_SCHED;
            PG8_LDB(B0, 1, 0); PG8_LDB(B1, 1, 1); PG8_SCHED; PG8_LDA(At, 1, 0); PG8_STAGE(PG8_SA(0, 1), a2 + hstep, voffA);
            PG8_WAIT_V(8); PG8_WAIT_L(0); PG8_BAR; PG8_MMA(0, 0, At, B0); PG8_MMA(0, 1, At, B1); PG8_BAR; PG8_SCHED;
            PG8_LDA(At, 1, 1); PG8_STAGE(PG8_SB(1, 0), b3, voffB); PG8_STAGE(PG8_SB(1, 1), b3 + hstep, voffB); PG8_STAGE(PG8_SA(1, 0), a3, voffA);
            PG8_WAIT_V(8); PG8_WAIT_L(0); PG8_BAR; PG8_MMA(1, 0, At, B0); PG8_MMA(1, 1, At, B1); PG8_BAR; PG8_SCHED;
            } else {
            PG8_LDB(B0, 0, 0); PG8_SCHED; PG8_LDA(At, 0, 0); PG8_STAGE(PG8_SA(1, 1), a1 + hstep, voffA);
            PG8_WAIT_L(8); PG8_BAR; PG8_WAIT_L(0); PG8_MMA(0, 0, At, B0); PG8_BAR; PG8_SCHED;
            PG8_LDB(B1, 0, 1); PG8_STAGE(PG8_SB(0, 0), b2, voffB);
            PG8_BAR; PG8_WAIT_L(0); PG8_MMA(0, 1, At, B1); PG8_BAR;
            PG8_LDA(At, 0, 1); PG8_STAGE(PG8_SA(0, 0), a2, voffA);
            PG8_BAR; PG8_WAIT_L(0); PG8_MMA(1, 0, At, B0); PG8_BAR; PG8_SCHED;
            PG8_STAGE(PG8_SB(0, 1), b2 + hstep, voffB);
            PG8_WAIT_V(6); PG8_BAR; PG8_MMA(1, 1, At, B1); PG8_BAR;
            PG8_LDB(B0, 1, 0); PG8_SCHED; PG8_LDA(At, 1, 0); PG8_STAGE(PG8_SA(0, 1), a2 + hstep, voffA);
            PG8_WAIT_L(8); PG8_BAR; PG8_WAIT_L(0); PG8_MMA(0, 0, At, B0); PG8_BAR; PG8_SCHED;
            PG8_LDB(B1, 1, 1); PG8_STAGE(PG8_SB(1, 0), b3, voffB);
            PG8_BAR; PG8_WAIT_L(0); PG8_MMA(0, 1, At, B1); PG8_BAR;
            PG8_LDA(At, 1, 1); PG8_STAGE(PG8_SA(1, 0), a3, voffA);
            PG8_BAR; PG8_WAIT_L(0); PG8_MMA(1, 0, At, B0); PG8_BAR; PG8_SCHED;
            PG8_STAGE(PG8_SB(1, 1), b3 + hstep, voffB);
            PG8_WAIT_V(6); PG8_BAR; PG8_MMA(1, 1, At, B1); PG8_BAR;
            }
        }
        if constexpr (ALIGN_EPI) { if (wr == 0) PG8_BAR; }
        if constexpr (!Epi::AFTER_DRAIN) { E(acc, cur, wr, wc, fr, fq); S.done(cur); }
        if (!has_next) break;
#pragma unroll
        for (int a = 0; a < 2; ++a)
#pragma unroll
            for (int b = 0; b < 2; ++b)
#pragma unroll
                for (int m = 0; m < 4; ++m)
#pragma unroll
                    for (int n = 0; n < 2; ++n) acc[a][b][m][n] = (f32x4){0.f, 0.f, 0.f, 0.f};
        cur = nxt; cA = nA; cB = nB; ++ui;
        if constexpr (ALIGN_EPI) { if (wr == 1) PG8_BAR; }
    }
    PG8_WAIT_V(0);
    if constexpr (!ALIGN_EPI) { if (wr == 0) PG8_BAR; }
    PG8_BAR;
    if constexpr (Epi::AFTER_DRAIN) { E.fused(acc, cur, wr, wc, fr, fq, lds, wid, lane); S.done(cur); }
#undef PG8_SA
#undef PG8_SB
#undef PG8_STAGE
#undef PG8_LDA
#undef PG8_LDB
#undef PG8_MMA
#undef PG8_WAIT_V
#undef PG8_WAIT_L
#undef PG8_BAR
#undef PG8_SCHED
}
struct EpiSwiglu {
    static constexpr bool PERM = true, AFTER_DRAIN = false;
    bf16_t* H; int ldh;
    __device__ __forceinline__ void operator()(const f32x4 (&acc)[2][2][4][2], const Unit& u, int wr, int wc, int fr, int fq) const {
        const int row0 = u.pm * BM + wr * 64 + fr, col0 = u.pn * HALF + wc * 32 + 8 * fq;
#pragma unroll
        for (int ai = 0; ai < 2; ++ai)
#pragma unroll
            for (int m = 0; m < 4; ++m) {
                bf16_t* p = H + (size_t)(row0 + ai * HALF + m * 16) * ldh + col0;
                float h[8];
#pragma unroll
                for (int n = 0; n < 2; ++n)
#pragma unroll
                    for (int i = 0; i < 4; ++i) { const float g = acc[ai][0][m][n][i], up = acc[ai][1][m][n][i];
                        h[n * 4 + i] = g * __builtin_amdgcn_rcpf(1.0f + __expf(-g)) * up; }
                u32x4 w; w.x = cvt_pk_bf16(h[0], h[1]); w.y = cvt_pk_bf16(h[2], h[3]); w.z = cvt_pk_bf16(h[4], h[5]); w.w = cvt_pk_bf16(h[6], h[7]);
                *(u32x4*)p = w;
            }
    }
};
template <int GS2  > struct EpiResid {
    static constexpr bool PERM = false, AFTER_DRAIN = false;
    static constexpr float alpha = 1.189207115002721f, gs = 0.5f * GS2;
    const float* xp; const float* xs; float* X; const float* gt; float* part;
    __device__ __forceinline__ void operator()(const f32x4 (&acc)[2][2][4][2], const Unit& u, int wr, int wc, int fr, int fq) const {
        const int col0 = u.pn * BM + wc * 32 + 4 * fq;
        if (u.ks >= 0) {
#pragma unroll
            for (int ai = 0; ai < 2; ++ai)
#pragma unroll
                for (int m = 0; m < 4; ++m) { float* po = part + ((size_t)u.ks * 1024 + (size_t)(u.pm * BM + ai * HALF + wr * 64 + m * 16 + fr - 16384)) * 1024;
#pragma unroll
                    for (int bj = 0; bj < 2; ++bj)
#pragma unroll
                        for (int n = 0; n < 2; ++n) *(f32x4*)(po + col0 + bj * HALF + n * 16) = acc[ai][bj][m][n]; }
            return;
        }
#pragma unroll
        for (int ai = 0; ai < 2; ++ai)
#pragma unroll
            for (int m = 0; m < 4; ++m) {
                const int row = u.pm * BM + ai * HALF + wr * 64 + m * 16 + fr;
                const bool smp = row >= 16384;
                const float* xr = smp ? xs + (size_t)(row - 16384) * 1024 : xp + (size_t)row * 1024;
                const int b = smp ? 2 + ((row - 16384) >> 3) : (row >> 13);
                const float* gr = gt + (size_t)b * 9216;
                float* xo = X + (size_t)row * 1024;
#pragma unroll
                for (int bj = 0; bj < 2; ++bj)
#pragma unroll
                    for (int n = 0; n < 2; ++n) { const int c = col0 + bj * HALF + n * 16;
                        const f32x4 xv = *(const f32x4*)(xr + c), gv = *(const f32x4*)(gr + c);
                        const f32x4 z = xv * alpha + (gv + 1.0f) * gs * acc[ai][bj][m][n];
                        *(f32x4*)(xo + c) = z; }
            }
    }
};
struct SliceOrder {
    StaticOrder so; int nsl, G, c;
    __host__ __device__ void init(int K, int G_, int c_) { so.init(16384, 1024, G_, c_, K); nsl = K / (4 * BK); G = G_; c = c_; }
    __host__ __device__ bool next(int i, Unit& u) const {
        if (so.next(i, u)) return true;
        const long L = (long)i * G + c - so.nwg; if (L < 0 || L >= 16 * nsl) return false;
        const int t16 = (int)L / nsl, ks = (int)L % nsl;
        u.pm = 64 + (t16 >> 2); u.pn = t16 & 3; u.kt0 = 4 * ks; u.nt = 4; u.ks = ks; return true;
    }
    __device__ __forceinline__ void a_ready(const Unit&) const {}
    __device__ __forceinline__ void done(const Unit&) const {}
};
}
#define GAS __attribute__((address_space(1)))
#define LAS __attribute__((address_space(3)))
typedef unsigned short bf16;
typedef unsigned v4u __attribute__((ext_vector_type(4)));
typedef float f32x4 __attribute__((ext_vector_type(4)));
typedef short bf16x8 __attribute__((ext_vector_type(8)));
typedef GAS unsigned gu32;
typedef GAS unsigned long long gu64;
#define RLX_AGENT __ATOMIC_RELAXED, __HIP_MEMORY_SCOPE_AGENT
#define LDS_WAIT() asm volatile("s_waitcnt lgkmcnt(0)" ::: "memory")
#define VM_WAIT() asm volatile("s_waitcnt vmcnt(0)" ::: "memory")
__device__ __forceinline__ unsigned long long rt() { return __builtin_amdgcn_s_memrealtime(); }
__device__ __forceinline__ unsigned f2bf(float f) { unsigned u = __builtin_bit_cast(unsigned, f); return (u + 0x7fffu + ((u >> 16) & 1u)) >> 16; }
__device__ __forceinline__ unsigned pk2(float lo, float hi) { return f2bf(lo) | (f2bf(hi) << 16); }

#define XB_TMO      128
#define XB_XCNT(j)  (256  + 64 * (j))
#define XB_XSUB(j)  (1280 + 64 * (j))
#define XB_XGEN(j)  (2304 + 64 * (j))
#define XB_TOP      3328
#define XB_TOPGEN   3392
#define XCD_BAR_WORDS 3456
#define XB_SPIN_CAP (1u << 18)

__device__ __forceinline__ unsigned xb_ld(unsigned* p)              { return __hip_atomic_load(p, __ATOMIC_RELAXED, __HIP_MEMORY_SCOPE_AGENT); }
__device__ __forceinline__ unsigned xb_add(unsigned* p, unsigned v) { return __hip_atomic_fetch_add(p, v, __ATOMIC_RELAXED, __HIP_MEMORY_SCOPE_AGENT); }
__device__ __forceinline__ unsigned xb_xcc_id() { return (unsigned)__builtin_amdgcn_s_getreg((3 << 11) | 20) & 0xFu; }
#define XB_SPIN(cond, bar) do { unsigned _sp = 0; while (cond) { __builtin_amdgcn_s_sleep(1); \
    if ((++_sp & 255u) == 0u) { if (xb_ld(&(bar)[XB_TMO])) break; if (_sp > XB_SPIN_CAP) { atomicAdd(&(bar)[XB_TMO], 1u); break; } } } } while (0)

struct XcdBarrier {
    unsigned* bar; unsigned x;
    volatile LAS unsigned* st;
};

__device__ __forceinline__ XcdBarrier xcd_barrier_post(unsigned* bar, volatile LAS unsigned* st) {
    XcdBarrier b; b.bar = bar; b.x = xb_xcc_id(); b.st = st;
    if (threadIdx.x == 0) (void)xb_add(&bar[XB_XCNT(b.x)], 1u);
    return b;
}
__device__ __forceinline__ void xcd_barrier_complete(unsigned* bar, unsigned x, unsigned& nloc, unsigned& nx) {
    const unsigned G = gridDim.x * gridDim.y * gridDim.z;
    unsigned sum, cnt, mine, sp = 0u;
    for (;;) {
        sum = 0u; cnt = 0u; mine = 0u;
#pragma unroll
        for (unsigned j = 0; j < 16; ++j) { const unsigned c = xb_ld(&bar[XB_XCNT(j)]); sum += c; cnt += (c > 0u) ? 1u : 0u; mine = (j == x) ? c : mine; }
        if (sum == G) break;
        __builtin_amdgcn_s_sleep(1);
        if ((++sp & 255u) == 0u) { if (xb_ld(&bar[XB_TMO])) break; if (sp > XB_SPIN_CAP) { atomicAdd(&bar[XB_TMO], 1u); break; } }
    }
    nloc = mine > 0u ? mine : 1u; nx = cnt > 0u ? cnt : 1u;
}

__device__ __forceinline__ void xcd_barrier(const XcdBarrier& b) {
    asm volatile("s_waitcnt vmcnt(0)" ::: "memory");
    __syncthreads();
    if (threadIdx.x == 0) {
        unsigned* bar = b.bar;
        __builtin_amdgcn_s_waitcnt(0);
        unsigned nloc = b.st[0], nx = b.st[1];
        if (nloc == 0u) { xcd_barrier_complete(bar, b.x, nloc, nx); b.st[0] = nloc; b.st[1] = nx; }
        const unsigned old = xb_add(&bar[XB_XSUB(b.x)], 1u);
        const unsigned gen = old / nloc;
        if (old + 1u == (gen + 1u) * nloc) {
            __builtin_amdgcn_fence(__ATOMIC_RELEASE, "agent");
            asm volatile("s_waitcnt vmcnt(0)" ::: "memory");
            const unsigned og = xb_add(&bar[XB_TOP], 1u);
            const unsigned tg = og / nx;
            if (og + 1u == (tg + 1u) * nx) xb_add(&bar[XB_TOPGEN], 1u);
            else XB_SPIN(xb_ld(&bar[XB_TOPGEN]) == tg, bar);
            __builtin_amdgcn_fence(__ATOMIC_ACQUIRE, "agent");
            xb_add(&bar[XB_XGEN(b.x)], 1u);
            asm volatile("s_waitcnt vmcnt(0)" ::: "memory");
        } else {
            XB_SPIN(xb_ld(&bar[XB_XGEN(b.x)]) == gen, bar);
            __builtin_amdgcn_fence(__ATOMIC_ACQUIRE, "agent");
            asm volatile("s_waitcnt vmcnt(0)" ::: "memory");
        }
    }
    __syncthreads();
}

constexpr int D = 1024, FF = 2816, NFF = 2 * FF, NIN = 2560, RW = 512, RWP = 1792;
constexpr int MP = 16384, MS = 1024, M = MP + MS, TP = 8192, TS = 8, NBS = 128;
constexpr int MODW = 9216, NMOD = 130;
constexpr float ALPHA = 1.189207115002721f;
constexpr float LN_EPS = 1e-5f, GN_EPS = 64e-5f;
constexpr int NWAVES = 8;
enum { I_XP = 0, I_XS, I_SWKV, I_SSHIFT, I_CK, I_CV, I_CP, I_CS, I_RELB, I_WADA, I_BADA, I_LNG, I_LNB, I_W1IN, I_W1OUT, I_WIN, I_MU, I_W0, I_WDEC, I_A0, I_WICLR, I_WGATE,
       I_KK, I_KA, I_RK, I_GNW, I_GNB, I_SINKS, I_WOUT, I_W2IN, I_W2OUT, N_IN };
constexpr size_t O_Y = 0, O_WKV_P = (size_t)M * D, O_SHIFT_P = O_WKV_P + 65536, O_WINK_P = O_SHIFT_P + 3584, O_WINV_P = O_WINK_P + 32768,
                 O_WKV_S = O_WINV_P + 32768, O_SHIFT_S = O_WKV_S + 4194304, O_WINK_S = O_SHIFT_S + 229376, O_WINV_S = O_WINK_S + 2097152, O_END = O_WINV_S + 2097152;
static_assert(O_END == 26578432, "d_out size");
constexpr size_t MiB = 1u << 20;
constexpr size_t WS_CTL = 0, CTL_ZERO_BYTES = 1 * MiB;
constexpr size_t WS_W1IN = 2 * MiB, WS_W1OUT = 13 * MiB, WS_WIN = 19 * MiB, WS_WOUT = 24 * MiB, WS_W2IN = 26 * MiB, WS_W2OUT = 37 * MiB;
constexpr size_t WS_MOD = 43 * MiB;
constexpr size_t WS_U = 48 * MiB;
constexpr size_t WS_H = 82 * MiB;
constexpr size_t WS_WLOG = 176 * MiB, WS_A = 210 * MiB, WS_G = 227 * MiB, WS_INV = 244 * MiB, WS_LORA = 245 * MiB, WS_END = 246 * MiB;
constexpr size_t LORA_WI = 512 * 64 * 2, LORA_WG = 2 * 512 * 64 * 2;
static_assert(WS_W1IN + (size_t)NFF * D * 2 <= WS_W1OUT && WS_W1OUT + (size_t)D * FF * 2 <= WS_WIN && WS_WIN + (size_t)NIN * D * 2 <= WS_WOUT && WS_WOUT + (size_t)D * D * 2 <= WS_W2IN &&
              WS_W2IN + (size_t)NFF * D * 2 <= WS_W2OUT && WS_W2OUT + (size_t)D * FF * 2 <= WS_MOD && WS_MOD + (size_t)NMOD * MODW * 4 <= WS_U && WS_U + (size_t)M * D * 2 <= WS_H &&
              WS_H + (size_t)M * FF * 2 <= WS_WLOG && WS_WLOG + (size_t)M * RW * 4 <= WS_A && WS_A + (size_t)M * RW * 2 <= WS_G && WS_G + (size_t)M * RW * 2 <= WS_INV &&
              WS_INV + (size_t)M * 8 * 4 <= WS_LORA && WS_LORA + 4 * 512 * 64 * 2 <= WS_END && WS_END <= 256 * MiB, "d_ws map");
constexpr int CW_BAR = 4096;
constexpr int RING_OFF = 0, RING_BYTES = 160768;
constexpr int LDSCTL_OFF = RING_BYTES, MISC_OFF = LDSCTL_OFF + 320;
constexpr int LDS_BYTES = 161792;
static_assert(MISC_OFF + 128 <= LDS_BYTES, "LDS map");

__device__ __forceinline__ float bf2f(unsigned short h) { return __uint_as_float((unsigned)h << 16); }
__device__ __forceinline__ float bflo(unsigned u) { return __uint_as_float(u << 16); }
__device__ __forceinline__ float bfhi(unsigned u) { return __uint_as_float(u & 0xffff0000u); }
__device__ __forceinline__ unsigned long long pk4(f32x4 v) { return (unsigned long long)pk2(v[0], v[1]) | ((unsigned long long)pk2(v[2], v[3]) << 32); }
__device__ __forceinline__ f32x4 bf4_to_f32(unsigned long long w) { return (f32x4){bflo((unsigned)w), bfhi((unsigned)w), bflo((unsigned)(w >> 32)), bfhi((unsigned)(w >> 32))}; }
__device__ __forceinline__ float wave_sum(float v) {
#pragma unroll
    for (int o = 1; o < 64; o <<= 1) v += __shfl_xor(v, o);
    return v;
}
template <int CTRL> __device__ __forceinline__ float dppf(float x) { return __builtin_bit_cast(float, __builtin_amdgcn_update_dpp(0, __builtin_bit_cast(int, x), CTRL, 0xf, 0xf, true)); }
__device__ __forceinline__ float sum8(float x) {
    x += dppf<0xB1>(x);
    x += dppf<0x4E>(x);
    x += dppf<0x141>(x);
    return x;
}
__device__ __forceinline__ float wave_sum_dpp(float x) {
    x += dppf<0xB1>(x); x += dppf<0x4E>(x); x += dppf<0x141>(x);
    x += dppf<0x140>(x);
    const int xi = __builtin_bit_cast(int, x);
    return __builtin_bit_cast(float, __builtin_amdgcn_readlane(xi, 0)) + __builtin_bit_cast(float, __builtin_amdgcn_readlane(xi, 16)) +
           __builtin_bit_cast(float, __builtin_amdgcn_readlane(xi, 32)) + __builtin_bit_cast(float, __builtin_amdgcn_readlane(xi, 48));
}
__device__ __forceinline__ float sigmoidf_(float x) { return __builtin_amdgcn_rcpf(1.0f + __expf(-x)); }
__device__ __forceinline__ float tanhf_(float x) { return 1.0f - 2.0f * __builtin_amdgcn_rcpf(1.0f + __expf(2.0f * x)); }
__device__ __forceinline__ unsigned cvtpk(float lo, float hi) { unsigned r; asm volatile("v_cvt_pk_bf16_f32 %0, %1, %2" : "=v"(r) : "v"(lo), "v"(hi)); return r; }

#ifdef SW_ID
#define SWX 8
#define TS_FIELDS unsigned sw_acc; unsigned long long sw_t0;
#define TS_BEGIN(id) do { if ((id) == SW_ID) { __builtin_amdgcn_sched_barrier(0); F.sw_t0 = __builtin_amdgcn_s_memrealtime(); __builtin_amdgcn_sched_barrier(0); } } while (0)
#define TS_END(id) do { if ((id) == SW_ID) { __builtin_amdgcn_sched_barrier(0); F.sw_acc += (unsigned)(__builtin_amdgcn_s_memrealtime() - F.sw_t0); __builtin_amdgcn_sched_barrier(0); } } while (0)
#else
#define TS_FIELDS
#define TS_BEGIN(id) do {} while (0)
#define TS_END(id) do {} while (0)
#endif
struct Args { const float* in[N_IN]; float* out; unsigned char* ws; int ph_lo, ph_hi; };
static_assert(sizeof(Args) == N_IN * 8 + 24, "Args has no padding");
struct Frame {
    LAS unsigned char* lds;
    volatile LAS unsigned* MISC;
    gu32* ctl;
    int tid, lane, wave, vcu, G;
    const __attribute__((address_space(4))) Args* a;
    TS_FIELDS
    unsigned char* ws;
};
#define WSP(T, off) ((T*)(F.ws + (off)))
#define GIN(k) ((const float*)(const GAS float*)(F.a->in[k]))
#define GOUT() ((float*)(GAS float*)(F.a->out))

__device__ __forceinline__ void p0_transpose_item(const float* W, int K, int N, bf16* WT, int dst_row0, int k0, int n0, LAS float* scr, int lane) {
#pragma unroll 8
    for (int i = 0; i < 32; ++i) { const int kk = 2 * i + (lane >> 5); scr[kk * 33 + (lane & 31)] = W[(size_t)(k0 + kk) * N + n0 + (lane & 31)]; }
    LDS_WAIT(); asm volatile("" ::: "memory");
    const int c = lane & 7;
#pragma unroll
    for (int j = 0; j < 4; ++j) { const int n = (lane >> 3) + 8 * j; const LAS float* s = scr + (8 * c) * 33 + n;
        v4u o; o.x = pk2(s[0 * 33], s[1 * 33]); o.y = pk2(s[2 * 33], s[3 * 33]); o.z = pk2(s[4 * 33], s[5 * 33]); o.w = pk2(s[6 * 33], s[7 * 33]);
        *(GAS v4u*)(WT + (size_t)(dst_row0 + n) * K + k0 + 8 * c) = o; }
    LDS_WAIT(); asm volatile("" ::: "memory");
}
__device__ __forceinline__ void p0_ffin_item(const float* W, bf16* WT, int r, LAS float* scr, int lane) {
    const int kb = r / 176, nb = r % 176, n0 = 32 * nb; const bool up = n0 >= FF; const int j = up ? n0 - FF : n0;
    p0_transpose_item(W, D, NFF, WT, (j >> 7) * 256 + (up ? 128 : 0) + (j & 127), 64 * kb, n0, scr, lane);
}
__device__ __forceinline__ void p0_plain_item(const float* W, int K, int N, bf16* WT, int r, LAS float* scr, int lane) {
    const int nblk = N / 32, kb = r / nblk, nb = r % nblk;
    p0_transpose_item(W, K, N, WT, 32 * nb, 64 * kb, 32 * nb, scr, lane);
}
__device__ __forceinline__ void p0_weights(Frame& F) {
    LAS float* scr = (LAS float*)(F.lds + RING_OFF + F.wave * 16384);
    const int gw = F.vcu * NWAVES + F.wave, NGW = F.G * NWAVES;
    constexpr int I_FI = 16 * 176, I_FO = 44 * 32, I_IN = 16 * 80, I_O = 16 * 32, I_L = 16, NITEMS = 2 * I_FI + 2 * I_FO + I_IN + I_O + 4 * I_L;
    for (int it = gw; it < NITEMS; it += NGW) {
        int r = it;
        if (r < I_FI) { p0_ffin_item(GIN(I_W1IN), WSP(bf16, WS_W1IN), r, scr, F.lane); continue; } r -= I_FI;
        if (r < I_FI) { p0_ffin_item(GIN(I_W2IN), WSP(bf16, WS_W2IN), r, scr, F.lane); continue; } r -= I_FI;
        if (r < I_FO) { p0_plain_item(GIN(I_W1OUT), FF, D, WSP(bf16, WS_W1OUT), r, scr, F.lane); continue; } r -= I_FO;
        if (r < I_FO) { p0_plain_item(GIN(I_W2OUT), FF, D, WSP(bf16, WS_W2OUT), r, scr, F.lane); continue; } r -= I_FO;
        if (r < I_IN) { p0_plain_item(GIN(I_WIN), D, NIN, WSP(bf16, WS_WIN), r, scr, F.lane); continue; } r -= I_IN;
        if (r < I_O) { p0_plain_item(GIN(I_WOUT), D, D, WSP(bf16, WS_WOUT), r, scr, F.lane); continue; } r -= I_O;
        if (r < I_L) { p0_plain_item(GIN(I_WDEC), 64, RW, WSP(bf16, WS_LORA), r, scr, F.lane); continue; } r -= I_L;
        if (r < I_L) { p0_plain_item(GIN(I_WICLR), 64, RW, WSP(bf16, WS_LORA + LORA_WI), r, scr, F.lane); continue; } r -= I_L;
        p0_plain_item(GIN(I_WGATE), 128, RW, WSP(bf16, WS_LORA + LORA_WG), r, scr, F.lane);
    }
}
typedef float f32x16m __attribute__((ext_vector_type(16)));
__device__ __forceinline__ void p0_mod(Frame& F) {
    const float* wada = GIN(I_WADA); const float* bada = GIN(I_BADA); const float* cp = GIN(I_CP); const float* cs = GIN(I_CS);
    float* mod = WSP(float, WS_MOD);
    LAS float* red = (LAS float*)F.lds;
    const int lane = F.lane, wave = F.wave, r = lane & 31, h = lane >> 5;
    for (int task = blockIdx.x; task < MODW / 32; task += F.G) {
        const int j0 = 32 * task;
        f32x16m acc[5];
#pragma unroll
        for (int bt = 0; bt < 5; ++bt)
#pragma unroll
            for (int e = 0; e < 16; ++e) acc[bt][e] = 0.f;
#pragma unroll 1
        for (int ks = 0; ks < 8; ++ks) {
            const int i0 = 128 * wave + 16 * ks + 8 * h;
            unsigned aw[4];
#pragma unroll
            for (int e = 0; e < 4; ++e) aw[e] = pk2(wada[(size_t)(i0 + 2 * e) * MODW + j0 + r], wada[(size_t)(i0 + 2 * e + 1) * MODW + j0 + r]);
            const bf16x8 af = __builtin_bit_cast(bf16x8, (v4u){aw[0], aw[1], aw[2], aw[3]});
#pragma unroll
            for (int bt = 0; bt < 5; ++bt) {
                const int b = 32 * bt + r;
                f32x4 c0 = (f32x4){0.f, 0.f, 0.f, 0.f}, c1 = c0;
                if (b < NMOD) { const float* cr = (b < 2 ? cp + (size_t)b * D : cs + (size_t)(b - 2) * D) + i0; c0 = *(const f32x4*)cr; c1 = *(const f32x4*)(cr + 4); }
                float sv[8];
#pragma unroll
                for (int e = 0; e < 4; ++e) { sv[e] = c0[e] * __builtin_amdgcn_rcpf(1.0f + __expf(-c0[e])); sv[4 + e] = c1[e] * __builtin_amdgcn_rcpf(1.0f + __expf(-c1[e])); }
                const bf16x8 bfm = __builtin_bit_cast(bf16x8, (v4u){pk2(sv[0], sv[1]), pk2(sv[2], sv[3]), pk2(sv[4], sv[5]), pk2(sv[6], sv[7])});
                acc[bt] = __builtin_amdgcn_mfma_f32_32x32x16_bf16(af, bfm, acc[bt], 0, 0, 0);
            }
        }
#pragma unroll
        for (int rd = 0; rd < 2; ++rd) {
            const int nv = rd == 0 ? 48 : 32, bt0 = rd == 0 ? 0 : 3;
            __syncthreads();
#pragma unroll
            for (int bt = 0; bt < 3; ++bt) if (bt0 + bt < 5)
#pragma unroll
                for (int e = 0; e < 16; ++e) red[(wave * 48 + bt * 16 + e) * 64 + lane] = acc[bt0 + bt][e];
            __syncthreads();
            for (int idx = F.tid; idx < nv * 64; idx += 512) {
                const int v = idx >> 6, ln = idx & 63, bt = bt0 + (v >> 4), e = v & 15;
                float s = 0.f;
#pragma unroll
                for (int w = 0; w < 8; ++w) s += red[(w * 48 + v) * 64 + ln];
                const int b = 32 * bt + (ln & 31), j = j0 + (e & 3) + 8 * (e >> 2) + 4 * (ln >> 5);
                if (b < NMOD) mod[(size_t)b * MODW + j] = s + bada[j];
            }
        }
    }
    __syncthreads();
}

__device__ __forceinline__ int mod_row_of(int m) { return m < MP ? (m >> 13) : 2 + ((m - MP) >> 3); }
constexpr int RB = 4;
__device__ __forceinline__ void p_modulate0(Frame& F) {
    const int gw = F.vcu * NWAVES + F.wave, NGW = F.G * NWAVES;
    const float* mod = WSP(float, WS_MOD); bf16* U = WSP(bf16, WS_U);
    const float* xp = GIN(I_XP); const float* xs = GIN(I_XS);
    for (int m0 = gw; m0 < M; m0 += RB * NGW) {
        f32x4 x[RB][4];
#pragma unroll
        for (int rb = 0; rb < RB; ++rb) { const int m = m0 + rb * NGW; if (m < M) { const float* xr = m < MP ? xp + (size_t)m * D : xs + (size_t)(m - MP) * D;
#pragma unroll
            for (int j = 0; j < 4; ++j) x[rb][j] = *(const f32x4*)(xr + 4 * F.lane + 256 * j); } }
#pragma unroll
        for (int rb = 0; rb < RB; ++rb) { const int m = m0 + rb * NGW; if (m < M) {
            const float* mr = mod + (size_t)mod_row_of(m) * MODW;
            unsigned long long* o8 = (unsigned long long*)(U + (size_t)m * D) + F.lane;
#pragma unroll
            for (int j = 0; j < 4; ++j) { const int c = 4 * F.lane + 256 * j;
                const f32x4 sh = *(const f32x4*)(mr + c), sc = *(const f32x4*)(mr + D + c);
                const f32x4 u = x[rb][j] * (sc + 1.0f) + sh;
                o8[64 * j] = (unsigned long long)cvtpk(u[0], u[1]) | ((unsigned long long)cvtpk(u[2], u[3]) << 32); } } }
    }
}
__device__ __forceinline__ void p_layernorm(Frame& F, int lnidx, int koff, int nsl, const float* xs_old, int gtk, float gs) {
    const int gw = F.vcu * NWAVES + F.wave, NGW = F.G * NWAVES;
    const float* mod = WSP(float, WS_MOD); bf16* U = WSP(bf16, WS_U); float* X = GOUT() + O_Y;
    const float* lg = GIN(I_LNG) + lnidx * D; const float* lb = GIN(I_LNB) + lnidx * D;
    f32x4 gv4[4], bv4[4];
#pragma unroll
    for (int j = 0; j < 4; ++j) { gv4[j] = *(const f32x4*)(lg + 4 * F.lane + 256 * j); bv4[j] = *(const f32x4*)(lb + 4 * F.lane + 256 * j); }
    for (int m0 = gw; m0 < M; m0 += RB * NGW) {
        f32x4 v[RB][4];
#pragma unroll
        for (int rb = 0; rb < RB; ++rb) { const int m = m0 + rb * NGW; if (m < M) {
#pragma unroll
            for (int j = 0; j < 4; ++j) { const int c = 4 * F.lane + 256 * j;
                if (m < MP) v[rb][j] = *(const f32x4*)(X + (size_t)m * D + c);
                else { const float* pp = WSP(float, WS_WLOG) + (size_t)(m - MP) * D + c; f32x4 a = *(const f32x4*)pp;
                    for (int ks = 1; ks < nsl; ++ks) a += *(const f32x4*)(pp + (size_t)ks * MS * D);
                    const f32x4 xo = *(const f32x4*)(xs_old + (size_t)(m - MP) * D + c), gv = *(const f32x4*)(mod + (size_t)mod_row_of(m) * MODW + gtk * D + c);
                    v[rb][j] = xo * ALPHA + (gv + 1.0f) * gs * a; } } } }
#pragma unroll
        for (int rb = 0; rb < RB; ++rb) { const int m = m0 + rb * NGW; if (m < M) {
            float s = 0.f;
#pragma unroll
            for (int j = 0; j < 4; ++j) s += (v[rb][j][0] + v[rb][j][1]) + (v[rb][j][2] + v[rb][j][3]);
            const float mean = wave_sum_dpp(s) * (1.f / D); float s2 = 0.f;
#pragma unroll
            for (int j = 0; j < 4; ++j) { v[rb][j] = v[rb][j] - mean; s2 += (v[rb][j][0] * v[rb][j][0] + v[rb][j][1] * v[rb][j][1]) + (v[rb][j][2] * v[rb][j][2] + v[rb][j][3] * v[rb][j][3]); }
            const float rstd = 1.f / sqrtf(wave_sum_dpp(s2) * (1.f / D) + LN_EPS);
            float* xr = X + (size_t)m * D;
            const float* mr = mod + (size_t)mod_row_of(m) * MODW + (koff >= 0 ? koff : 0);
            unsigned long long* o8 = (unsigned long long*)(U + (size_t)m * D) + F.lane;
#pragma unroll
            for (int j = 0; j < 4; ++j) { const int c = 4 * F.lane + 256 * j;
                const f32x4 x = v[rb][j] * rstd * gv4[j] + bv4[j];
                *(f32x4*)(xr + c) = x;
                if (koff >= 0) { const f32x4 sh = *(const f32x4*)(mr + c), sc = *(const f32x4*)(mr + D + c); const f32x4 u = x * (sc + 1.0f) + sh;
                    o8[64 * j] = (unsigned long long)cvtpk(u[0], u[1]) | ((unsigned long long)cvtpk(u[2], u[3]) << 32); } } } }
    }
}
__device__ __forceinline__ float prev_val(const bf16* P, const float* sshift, int m, int col) {
    if (m < MP) return (m & (TP - 1)) == 0 ? 0.f : bf2f(P[(size_t)(m - 1) * NIN + col]);
    const int ms = m - MP;
    return (ms & (TS - 1)) == 0 ? sshift[(size_t)(ms >> 3) * RWP + col] : bf2f(P[(size_t)(m - 1) * NIN + col]);
}
constexpr int PP_PITCH = 528;
__device__ __forceinline__ void p_prep(Frame& F) {
    LAS unsigned char* lds = F.lds;
    const bf16* P = WSP(bf16, WS_H); const float* sshift = GIN(I_SSHIFT); const float* mu = GIN(I_MU);
    float* WLOG = WSP(float, WS_WLOG); bf16* AA = WSP(bf16, WS_A); bf16* GG = WSP(bf16, WS_G);
    const int tid = F.tid, lane = F.lane, wave = F.wave;
    const int tile_lo0 = (F.vcu * (M / 16)) / F.G, tile_hi0 = ((F.vcu + 1) * (M / 16)) / F.G;
    for (int tile_lo = tile_lo0; tile_lo < tile_hi0; tile_lo += 5) {
    const int ntile = (tile_hi0 - tile_lo) < 5 ? (tile_hi0 - tile_lo) : 5;
    const int m_lo = tile_lo * 16, ntok = ntile * 16;
    __syncthreads();
    {
        const int j = tid & 255, hf = tid >> 8, col = 1536 + j; const float muj = mu[col];
        const int ga = hf == 0 ? 0 : ntile, gb = hf == 0 ? ntile : 2 * ntile;
        float carry = 0.f;
        for (int gi = ga; gi < gb; ++gi) { const int mg = m_lo + 8 * gi;
            float p[8];
#pragma unroll
            for (int t = 0; t < 8; ++t) p[t] = bf2f(P[(size_t)(mg + t) * NIN + col]);
            float prev = (gi == ga || ((mg < MP) ? (mg & (TP - 1)) : ((mg - MP) & (TS - 1))) == 0) ? prev_val(P, sshift, mg, col) : carry;
#pragma unroll
            for (int t = 0; t < 8; ++t) { const float xs = p[t] + (prev - p[t]) * muj; prev = p[t];
                const float f = j < 64 ? tanhf_(xs) : (j < 128 ? xs : sigmoidf_(xs));
                *(LAS unsigned short*)(lds + (8 * gi + t) * PP_PITCH + j * 2) = (unsigned short)f2bf(f); }
            carry = p[7]; }
    }
    __syncthreads();
    const int lr = lane & 15, lq = lane >> 4, c0 = 64 * wave;
#pragma unroll 1
    for (int lo = 0; lo < 3; ++lo) {
        const int kin = lo == 0 ? 0 : (lo == 1 ? 64 : 128), nks = lo == 2 ? 4 : 2, wpitch = lo == 2 ? 128 : 64;
        const bf16* Wt = WSP(bf16, WS_LORA) + (lo == 0 ? 0 : (lo == 1 ? 512 * 64 : 2 * 512 * 64));
        f32x4 acc[5][4];
#pragma unroll
        for (int tt = 0; tt < 5; ++tt)
#pragma unroll
            for (int ct = 0; ct < 4; ++ct) acc[tt][ct] = (f32x4){0.f, 0.f, 0.f, 0.f};
        for (int ks = 0; ks < nks; ++ks) {
            bf16x8 wf[4];
#pragma unroll
            for (int ct = 0; ct < 4; ++ct) wf[ct] = *(const bf16x8*)(Wt + (size_t)(c0 + 16 * ct + lr) * wpitch + ks * 32 + lq * 8);
#pragma unroll
            for (int tt = 0; tt < 5; ++tt) if (tt < ntile) {
                const bf16x8 af = *(const LAS bf16x8*)(lds + (16 * tt + lr) * PP_PITCH + (kin + ks * 32 + lq * 8) * 2);
#pragma unroll
                for (int ct = 0; ct < 4; ++ct) acc[tt][ct] = __builtin_amdgcn_mfma_f32_16x16x32_bf16(wf[ct], af, acc[tt][ct], 0, 0, 0);
            }
        }
#pragma unroll
        for (int tt = 0; tt < 5; ++tt) if (tt < ntile) { const int m = m_lo + 16 * tt + lr;
#pragma unroll
            for (int ct = 0; ct < 4; ++ct) { const int c = c0 + 16 * ct + 4 * lq; const f32x4 a = acc[tt][ct];
                if (lo == 0) { const f32x4 w0v = *(const f32x4*)(GIN(I_W0) + c); f32x4 o;
#pragma unroll
                    for (int e = 0; e < 4; ++e) { const float z = w0v[e] + a[e]; const float sp = fmaxf(-z, 0.f) + __logf(1.0f + __expf(-fabsf(z))); o[e] = -__expf(-sp - 0.5f); }
                    *(f32x4*)(WLOG + (size_t)m * RW + c) = o; }
                else if (lo == 1) { const f32x4 a0v = *(const f32x4*)(GIN(I_A0) + c); f32x4 o;
#pragma unroll
                    for (int e = 0; e < 4; ++e) o[e] = sigmoidf_(a0v[e] + a[e]);
                    *(unsigned long long*)(AA + (size_t)m * RW + c) = pk4(o); }
                else *(unsigned long long*)(GG + (size_t)m * RW + c) = pk4(a); }
        }
    }
    }
}

constexpr int NCOPY = 96;
__device__ __forceinline__ void copy_task(Frame& F, int task) {
    const bf16* P = WSP(bf16, WS_H);
    const int gt = task * 512 + F.tid, NT = NCOPY * 512;
    const float* ck = GIN(I_CK); const float* cv = GIN(I_CV); float* out = GOUT();
#pragma unroll 4
    for (int i = gt; i < NBS * 120 * 32; i += NT) {
        const int b = i / 3840, rem = i - b * 3840, j = rem >> 5, c4 = (rem & 31) * 4; const size_t d = (size_t)(b * 128 + j) * 128 + c4, s = d + 8 * 128;
        *(f32x4*)(out + O_WINK_S + d) = *(const f32x4*)(ck + s); *(f32x4*)(out + O_WINV_S + d) = *(const f32x4*)(cv + s); }
    for (int i = gt; i < NBS * 8 * 128; i += NT) {
        const int b = i >> 10, t = (i >> 7) & 7, c2 = i & 127; const size_t row = (size_t)(MP + b * TS + t) * NIN, d = (size_t)(b * 128 + 120 + t) * 128 + c2;
        out[O_WINK_S + d] = bf2f(P[row + 2304 + c2]); out[O_WINV_S + d] = bf2f(P[row + 2432 + c2]); }
    for (int i = gt; i < 2 * RWP; i += NT) { const int b = i / RWP, col = i % RWP; out[O_SHIFT_P + i] = bf2f(P[(size_t)(b * TP + TP - 1) * NIN + col]); }
#pragma unroll 2
    for (int i = gt; i < NBS * RWP; i += NT) { const int b = i / RWP, col = i % RWP; out[O_SHIFT_S + i] = bf2f(P[(size_t)(MP + b * TS + TS - 1) * NIN + col]); }
    for (int i = gt; i < 2 * 128 * 128; i += NT) { const int b = i >> 14, j = (i >> 7) & 127, c2 = i & 127; const size_t row = (size_t)(b * TP + TP - 128 + j) * NIN;
        out[O_WINK_P + i] = bf2f(P[row + 2304 + c2]); out[O_WINV_P + i] = bf2f(P[row + 2432 + c2]); }
}
constexpr int SS_R = 0, SS_DEC = 1, SS_KM = 2, SS_KK = 3, SS_BB = 4, SS_V = 5;
__device__ __forceinline__ void sample_scan_unit(Frame& F, int b) {
    const int h = F.wave, lane = F.lane, chn = h * 64 + lane;
    LAS float* A = (LAS float*)F.lds + h * (6 * 8 * 64);
    const bf16* P = WSP(bf16, WS_H); const float* sshift = GIN(I_SSHIFT); const float* mu = GIN(I_MU);
    const float* WLOG = WSP(float, WS_WLOG); const bf16* AA = WSP(bf16, WS_A); const bf16* GG = WSP(bf16, WS_G);
    bf16* MIX = WSP(bf16, WS_U);
    const float mur = mu[chn], muk = mu[RW + chn], muv = mu[2 * RW + chn], kkc = GIN(I_KK)[chn], kac = GIN(I_KA)[chn], rkc = GIN(I_RK)[chn], gnw = GIN(I_GNW)[chn], gnb = GIN(I_GNB)[chn];
    __syncthreads();
    float q_r = sshift[(size_t)b * RWP + chn], q_k = sshift[(size_t)b * RWP + RW + chn], q_v = sshift[(size_t)b * RWP + 2 * RW + chn];
#pragma unroll
    for (int t = 0; t < TS; ++t) {
        const int m = MP + b * TS + t; const size_t pr = (size_t)m * NIN;
        const float p_r = bf2f(P[pr + chn]), p_k = bf2f(P[pr + RW + chn]), p_v = bf2f(P[pr + 2 * RW + chn]);
        const float xr = p_r + (q_r - p_r) * mur, xk = p_k + (q_k - p_k) * muk, xv = p_v + (q_v - p_v) * muv;
        q_r = p_r; q_k = p_k; q_v = p_v;
        const float a = bf2f(AA[(size_t)m * RW + chn]), wl = WLOG[(size_t)m * RW + chn];
        const float kq0 = xk * kkc, kk = kq0 * (1.0f / fmaxf(sqrtf(wave_sum_dpp(kq0 * kq0)), 1e-12f));
        A[(SS_R * 8 + t) * 64 + lane] = xr; A[(SS_DEC * 8 + t) * 64 + lane] = __expf(wl); A[(SS_KM * 8 + t) * 64 + lane] = xk * (1.0f + (a - 1.0f) * kac);
        A[(SS_KK * 8 + t) * 64 + lane] = kk; A[(SS_BB * 8 + t) * 64 + lane] = kk * a; A[(SS_V * 8 + t) * 64 + lane] = xv;
    }
    f32x4 S[16];
    { const f32x4* sp = (const f32x4*)(GIN(I_SWKV) + ((size_t)(b * 8 + h) * 64 + lane) * 64);
#pragma unroll
      for (int q = 0; q < 16; ++q) S[q] = sp[q]; }
    float gate[TS];
#pragma unroll
    for (int t = 0; t < TS; ++t) gate[t] = bf2f(GG[(size_t)(MP + b * TS + t) * RW + chn]);
    LDS_WAIT(); asm volatile("" ::: "memory");
#pragma unroll
    for (int t = 0; t < TS; ++t) {
        const LAS f32x4* pk = (const LAS f32x4*)(A + (SS_KK * 8 + t) * 64); const LAS f32x4* pb = (const LAS f32x4*)(A + (SS_BB * 8 + t) * 64);
        const LAS f32x4* pd = (const LAS f32x4*)(A + (SS_DEC * 8 + t) * 64); const LAS f32x4* pm = (const LAS f32x4*)(A + (SS_KM * 8 + t) * 64);
        const LAS f32x4* pq = (const LAS f32x4*)(A + (SS_R * 8 + t) * 64);
        const float v = A[(SS_V * 8 + t) * 64 + lane];
        f32x4 sa4 = (f32x4){0.f, 0.f, 0.f, 0.f};
#pragma unroll
        for (int q = 0; q < 16; ++q) sa4 += S[q] * pk[q];
        const float sa = (sa4[0] + sa4[1]) + (sa4[2] + sa4[3]);
        f32x4 y4 = (f32x4){0.f, 0.f, 0.f, 0.f};
#pragma unroll
        for (int q = 0; q < 16; ++q) { S[q] = S[q] * pd[q] + (pm[q] * v - pb[q] * sa); y4 += S[q] * pq[q]; }
        const float y = (y4[0] + y4[1]) + (y4[2] + y4[3]);
        const float mean = wave_sum_dpp(y) * (1.f / 64.f), d = y - mean, var = wave_sum_dpp(d * d) * (1.f / 64.f);
        const float yn = d * (1.0f / sqrtf(var + GN_EPS));
        const float dot = wave_sum_dpp(A[(SS_R * 8 + t) * 64 + lane] * A[(SS_KM * 8 + t) * 64 + lane] * rkc);
        const int m = MP + b * TS + t;
        MIX[(size_t)m * D + chn] = (bf16)f2bf((yn * gnw + gnb + dot * v) * gate[t]);
        asm volatile("" ::: "memory");
    }
    { f32x4* so = (f32x4*)(GOUT() + O_WKV_S + ((size_t)(b * 8 + h) * 64 + lane) * 64);
#pragma unroll
      for (int q = 0; q < 16; ++q) so[q] = S[q]; }
}
constexpr int PB = 144, PF = 272;
constexpr int MB16 = 64 * PB, MF32 = 64 * PF;
constexpr size_t WS_GX = 2 * MiB;
constexpr size_t WS_S0 = 167 * MiB;
static_assert(WS_GX + 512 * 32768 <= WS_WIN && WS_H + (size_t)M * NIN * 2 <= WS_S0 && WS_S0 + 512 * 16384 <= WS_WLOG, "scan scratch map");
constexpr int CA_RHI = 0, CA_RLO = 18432, CA_LB = 36864, CA_KQ = 54272, CA_KD = 63488, CA_BD = 72704, CA_VT = 81920, CA_KET = 91136, CA_BET = 100352, CA_LK = 109568, CA_LOFFT = 118784,
              CA_MD = 128000, CA_TD = 137216, CA_SMALL = 141312;
constexpr int CC_RHI = 0, CC_RLO = 9216, CC_LB = 18432, CC_KQ = 35840, CC_RQ = 45056, CC_KD = 54272, CC_BD = 63488, CC_VT = 72704, CC_KET = 81920, CC_BET = 91136, CC_LK = 100352, CC_MK = 109568, CC_MB = 118784,
              CC_SHI = 128000, CC_SLO = 137216, CC_LOFFT = 146432, CC_TD = 155648, CC_SMALL = 159744, CC_MD = CC_BD;
constexpr int TDP = 64;
constexpr int SM_GL = 0, SM_DOT = 256, SM_BYTES = 512;

__device__ __forceinline__ void mm_nt(f32x4 (&acc)[2], const LAS unsigned char* X, const LAS unsigned char* Y, int wave, int lane) {
    const int tr = wave >> 1, tc0 = (wave & 1) * 2, lr = lane & 15, lq = lane >> 4;
#pragma unroll
    for (int ks = 0; ks < 2; ++ks) {
        const bf16x8 xa = *(const LAS bf16x8*)(X + (16 * tr + lr) * PB + ks * 64 + lq * 16);
#pragma unroll
        for (int j = 0; j < 2; ++j) {
            const bf16x8 yb = *(const LAS bf16x8*)(Y + (16 * (tc0 + j) + lr) * PB + ks * 64 + lq * 16);
            acc[j] = __builtin_amdgcn_mfma_f32_16x16x32_bf16(yb, xa, acc[j], 0, 0, 0);
        }
    }
}
#ifndef REP_PHASE
#define REP_PHASE -1
#endif
#define LBAR() do { asm volatile("s_waitcnt lgkmcnt(0)" ::: "memory"); __builtin_amdgcn_s_barrier(); asm volatile("" ::: "memory"); } while (0)
#define ACC_ZERO(a) do { a[0] = (f32x4){0.f, 0.f, 0.f, 0.f}; a[1] = (f32x4){0.f, 0.f, 0.f, 0.f}; } while (0)
#define ACC_M(wave, lane) (16 * ((wave) >> 1) + ((lane) & 15))
#define ACC_N(wave, lane, j) (16 * (((wave) & 1) * 2 + (j)) + 4 * ((lane) >> 4))
__device__ __forceinline__ void store_hilo(const f32x4 (&a)[2], LAS unsigned char* HI, LAS unsigned char* LO, int wave, int lane) {
    const int m = ACC_M(wave, lane);
#pragma unroll
    for (int j = 0; j < 2; ++j) { const int n = ACC_N(wave, lane, j);
        const unsigned long long hi = pk4(a[j]); const f32x4 lo = a[j] - bf4_to_f32(hi);
        *(LAS unsigned long long*)(HI + m * PB + n * 2) = hi; *(LAS unsigned long long*)(LO + m * PB + n * 2) = pk4(lo); }
}
__device__ __forceinline__ void solve_td(const LAS unsigned char* LBN, LAS unsigned char* TD, int wave, int lane) {
    if (wave == 0) {
        int lo_ = lane; asm volatile("" : "+v"(lo_));
        const int d = lo_ >> 4, t = lo_ & 15;
        f32x4 x[4];
#pragma unroll
        for (int q = 0; q < 4; ++q)
#pragma unroll
            for (int r = 0; r < 4; ++r) x[q][r] = (4 * q + r == t) ? 1.f : 0.f;
        const LAS unsigned char* lb = LBN + (16 * d) * PF + (16 * d) * 4;
#pragma unroll
        for (int i = 15; i >= 1; --i) {
            const float xi = x[i >> 2][i & 3];
#pragma unroll
            for (int q = 0; q <= (i - 1) >> 2; ++q) x[q] -= *(const LAS f32x4*)(lb + i * PF + q * 16) * xi;
            asm volatile("" ::: "memory");
        }
        v4u w0, w1; w0.x = pk2(x[0][0], x[0][1]); w0.y = pk2(x[0][2], x[0][3]); w0.z = pk2(x[1][0], x[1][1]); w0.w = pk2(x[1][2], x[1][3]);
        w1.x = pk2(x[2][0], x[2][1]); w1.y = pk2(x[2][2], x[2][3]); w1.z = pk2(x[3][0], x[3][1]); w1.w = pk2(x[3][2], x[3][3]);
        LAS v4u* o = (LAS v4u*)(TD + (16 * d + t) * TDP); o[0] = w0; o[1] = w1; o[2] = (v4u){0u, 0u, 0u, 0u}; o[3] = (v4u){0u, 0u, 0u, 0u};
    }
}
__device__ __forceinline__ void solve_md(const LAS unsigned char* LOFFT, const LAS unsigned char* TD, LAS unsigned char* MD, int wave, int lane) {
    const int d = wave >> 1, lr = lane & 15, lq = lane >> 4;
    const bf16x8 zf = (bf16x8){0, 0, 0, 0, 0, 0, 0, 0};
    const bf16x8 tf = *(const LAS bf16x8*)(TD + (16 * d + lr) * TDP + lq * 16);
#pragma unroll
    for (int j = 0; j < 2; ++j) { const int tc = (wave & 1) * 2 + j;
        bf16x8 lf = zf; if (lq < 2) lf = *(const LAS bf16x8*)(LOFFT + (16 * tc + lr) * PB + (16 * d + 8 * lq) * 2);
        f32x4 a = (f32x4){0.f, 0.f, 0.f, 0.f};
        a = __builtin_amdgcn_mfma_f32_16x16x32_bf16(lf, tf, a, 0, 0, 0);
        *(LAS unsigned long long*)(MD + (16 * d + lr) * PB + (16 * tc + 4 * lq) * 2) = pk4(-a); }
}
template <int NT> __device__ __forceinline__ void solve_chain(const LAS unsigned char* TD, const LAS unsigned char* MD, const LAS unsigned char* RHI, const LAS unsigned char* RLO, LAS unsigned char* UT, int wave, int lane) {
    if (wave < NT) {
        const int lr = lane & 15, lq = lane >> 4, col = 16 * wave + lr;
        const bf16x8 zf = (bf16x8){0, 0, 0, 0, 0, 0, 0, 0};
#pragma unroll
        for (int d = 0; d < 4; ++d) {
            const bf16x8 tf = *(const LAS bf16x8*)(TD + (16 * d + lr) * TDP + lq * 16);
            bf16x8 rh = zf, rl = zf;
            if (lq < 2) { rh = *(const LAS bf16x8*)(RHI + col * PB + (16 * d + 8 * lq) * 2); rl = *(const LAS bf16x8*)(RLO + col * PB + (16 * d + 8 * lq) * 2); }
            f32x4 a = (f32x4){0.f, 0.f, 0.f, 0.f};
            a = __builtin_amdgcn_mfma_f32_16x16x32_bf16(tf, rh, a, 0, 0, 0);
            a = __builtin_amdgcn_mfma_f32_16x16x32_bf16(tf, rl, a, 0, 0, 0);
            if (d >= 1) { const bf16x8 mf = *(const LAS bf16x8*)(MD + (16 * d + lr) * PB + lq * 16), uf = *(const LAS bf16x8*)(UT + col * PB + lq * 16);
                a = __builtin_amdgcn_mfma_f32_16x16x32_bf16(mf, uf, a, 0, 0, 0); }
            if (d == 3) { const bf16x8 mf = *(const LAS bf16x8*)(MD + (16 * d + lr) * PB + 64 + lq * 16), uf = *(const LAS bf16x8*)(UT + col * PB + 64 + lq * 16);
                a = __builtin_amdgcn_mfma_f32_16x16x32_bf16(mf, uf, a, 0, 0, 0); }
            *(LAS unsigned long long*)(UT + col * PB + (16 * d + 4 * lq) * 2) = pk4(a);
            asm volatile("s_waitcnt lgkmcnt(0)" ::: "memory");
        }
    }
}
struct ChunkRaw { unsigned rk[9], vv[5], aa[4]; float wl[8]; };
__device__ __forceinline__ void chunk_load(Frame& F, int m0, int h, ChunkRaw& R) {
    const bf16* P = WSP(bf16, WS_H); const float* WLOG = WSP(float, WS_WLOG); const bf16* AA = WSP(bf16, WS_A);
    const int chn = h * 64 + F.lane, mg = m0 + 8 * F.wave;
    unsigned pv[10], av[8];
    if ((mg & (TP - 1)) == 0) { R.rk[0] = 0u; pv[0] = 0u; }
    else { const size_t o = (size_t)(mg - 1) * NIN; R.rk[0] = (unsigned)P[o + chn] | ((unsigned)P[o + RW + chn] << 16); pv[0] = P[o + 2 * RW + chn]; }
#pragma unroll
    for (int j = 0; j < 8; ++j) { const size_t o = (size_t)(mg + j) * NIN; R.rk[j + 1] = (unsigned)P[o + chn] | ((unsigned)P[o + RW + chn] << 16); pv[j + 1] = P[o + 2 * RW + chn];
        R.wl[j] = WLOG[(size_t)(mg + j) * RW + chn]; av[j] = AA[(size_t)(mg + j) * RW + chn]; }
    pv[9] = 0u;
#pragma unroll
    for (int j = 0; j < 5; ++j) R.vv[j] = pv[2 * j] | (pv[2 * j + 1] << 16);
#pragma unroll
    for (int j = 0; j < 4; ++j) R.aa[j] = av[2 * j] | (av[2 * j + 1] << 16);
}
struct ChanConst { float mur, muk, muv, kkc, kac, rkc; };
__device__ __forceinline__ ChanConst chan_const(Frame& F, int h) { const float* mu = GIN(I_MU); const int chn = h * 64 + F.lane;
    ChanConst k; k.mur = mu[chn]; k.muk = mu[RW + chn]; k.muv = mu[2 * RW + chn]; k.kkc = GIN(I_KK)[chn]; k.kac = GIN(I_KA)[chn]; k.rkc = GIN(I_RK)[chn]; return k; }
template <bool PHC> __device__ __forceinline__ void chunk_stage(Frame& F, const ChunkRaw& R, const ChanConst& K, int h, int oKQ, int oRQ, int oKD, int oBD, int oVT, int oKET, int oBET, int oRHI, int oRLO, int oTOT, int oSMALL) {
    LAS unsigned char* lds = F.lds;
    const int e = F.lane, g = F.wave;
    const float mur = K.mur, muk = K.muk, muv = K.muv, kkc = K.kkc, kac = K.kac, rkc = K.rkc;
    float pr[9], pk[9], pv[9], av[8];
#pragma unroll
    for (int j = 0; j < 9; ++j) { pr[j] = bflo(R.rk[j]); pk[j] = bfhi(R.rk[j]); pv[j] = (j & 1) ? bfhi(R.vv[j >> 1]) : bflo(R.vv[j >> 1]); }
#pragma unroll
    for (int j = 0; j < 8; ++j) av[j] = (j & 1) ? bfhi(R.aa[j >> 1]) : bflo(R.aa[j >> 1]);
    const float (&wl)[8] = R.wl;
    float cw[8]; { float s = 0.f;
#pragma unroll
        for (int j = 0; j < 8; ++j) { s += wl[j]; cw[j] = s; } }
    LAS float* TOT = (LAS float*)(lds + oTOT);
    TOT[g * 64 + e] = cw[7];
    LBAR();
    float off = 0.f, cwL = 0.f;
#pragma unroll
    for (int gg = 0; gg < 8; ++gg) { const float tv = TOT[gg * 64 + e]; cwL += tv; if (gg < g) off += tv; }
    if (g == 0) ((LAS float*)(lds + oSMALL + SM_GL))[e] = __expf(cwL);
    unsigned vt[8], ket[8], bet[8]; float kq[8];
#pragma unroll
    for (int j = 0; j < 8; ++j) {
        const int t = 8 * g + j;
        const float c = off + cw[j];
        const float xr = pr[j + 1] + (pr[j] - pr[j + 1]) * mur, xk = pk[j + 1] + (pk[j] - pk[j + 1]) * muk, xv = pv[j + 1] + (pv[j] - pv[j + 1]) * muv;
        const float kq0 = xk * kkc, kk = kq0 * (1.0f / fmaxf(sqrtf(wave_sum_dpp(kq0 * kq0)), 1e-12f)), km = xk * (1.0f + (av[j] - 1.0f) * kac), bb = kk * av[j];
        const float e1 = __expf(c), e2 = __builtin_amdgcn_rcpf(e1), e3 = __expf(c - wl[j]), e4 = __expf(cwL - c);
        kq[j] = kk * e3;
        { const unsigned w1 = cvtpk(km * e2, bb * e2), w2 = cvtpk(kq[j], xr * e1);
          *(LAS unsigned short*)(lds + oKD + t * PB + e * 2) = (unsigned short)w1; *(LAS unsigned short*)(lds + oBD + t * PB + e * 2) = (unsigned short)(w1 >> 16);
          *(LAS unsigned short*)(lds + oKQ + t * PB + e * 2) = (unsigned short)w2; if (PHC) *(LAS unsigned short*)(lds + oRQ + t * PB + e * 2) = (unsigned short)(w2 >> 16); }
        if (PHC) {
            const float d = wave_sum_dpp(xr * km * rkc); if (e == 0) ((LAS float*)(lds + oSMALL + SM_DOT))[t] = d; }
        { const unsigned w3 = cvtpk(km * e4, bb * e4); ket[j] = w3 & 0xffffu; bet[j] = w3 >> 16; vt[j] = f2bf(xv); }
        __builtin_amdgcn_sched_barrier(0);
    }
    { v4u w; w.x = vt[0] | (vt[1] << 16); w.y = vt[2] | (vt[3] << 16); w.z = vt[4] | (vt[5] << 16); w.w = vt[6] | (vt[7] << 16); *(LAS v4u*)(lds + oVT + e * PB + g * 16) = w; }
    { v4u w; w.x = ket[0] | (ket[1] << 16); w.y = ket[2] | (ket[3] << 16); w.z = ket[4] | (ket[5] << 16); w.w = ket[6] | (ket[7] << 16); *(LAS v4u*)(lds + oKET + e * PB + g * 16) = w; }
    { v4u w; w.x = bet[0] | (bet[1] << 16); w.y = bet[2] | (bet[3] << 16); w.z = bet[4] | (bet[5] << 16); w.w = bet[6] | (bet[7] << 16); *(LAS v4u*)(lds + oBET + e * PB + g * 16) = w; }
    if (!PHC) { v4u wh, wl2;
        const unsigned h0 = cvtpk(kq[0], kq[1]), h1 = cvtpk(kq[2], kq[3]), h2 = cvtpk(kq[4], kq[5]), h3 = cvtpk(kq[6], kq[7]);
        wh = (v4u){h0, h1, h2, h3};
        wl2.x = cvtpk(kq[0] - bflo(h0), kq[1] - bfhi(h0)); wl2.y = cvtpk(kq[2] - bflo(h1), kq[3] - bfhi(h1)); wl2.z = cvtpk(kq[4] - bflo(h2), kq[5] - bfhi(h2)); wl2.w = cvtpk(kq[6] - bflo(h3), kq[7] - bfhi(h3));
        *(LAS v4u*)(lds + oRHI + e * PB + g * 16) = wh; *(LAS v4u*)(lds + oRLO + e * PB + g * 16) = wl2; }
}
__device__ __forceinline__ void store_hilo_rows(const f32x4 (&a)[2], LAS unsigned char* HI, LAS unsigned char* LO, int r0, int wave, int lane) {
    const int m = r0 + ACC_M(wave, lane);
#pragma unroll
    for (int j = 0; j < 2; ++j) { const int n = ACC_N(wave, lane, j);
        const unsigned long long hi = pk4(a[j]); const f32x4 lo = a[j] - bf4_to_f32(hi);
        *(LAS unsigned long long*)(HI + m * PB + n * 2) = hi; *(LAS unsigned long long*)(LO + m * PB + n * 2) = pk4(lo); }
}
__device__ __forceinline__ void make_L(const LAS unsigned char* KQ, const LAS unsigned char* BD, LAS unsigned char* LBN, LAS unsigned char* LOFFT, int wave, int lane) {
    const int m = ACC_M(wave, lane);
    { f32x4 a[2]; ACC_ZERO(a); mm_nt(a, KQ, BD, wave, lane);
#pragma unroll
      for (int j = 0; j < 2; ++j) { const int n = ACC_N(wave, lane, j); f32x4 o;
#pragma unroll
          for (int r = 0; r < 4; ++r) o[r] = (n + r < m) ? a[j][r] : 0.f;
          *(LAS f32x4*)(LBN + m * PF + n * 4) = o; } }
    __builtin_amdgcn_sched_barrier(0);
    { f32x4 a[2]; ACC_ZERO(a); mm_nt(a, BD, KQ, wave, lane);
#pragma unroll
      for (int j = 0; j < 2; ++j) { const int n = ACC_N(wave, lane, j); f32x4 o;
#pragma unroll
          for (int r = 0; r < 4; ++r) o[r] = (((n + r) >> 4) > (m >> 4)) ? a[j][r] : 0.f;
          *(LAS unsigned long long*)(LOFFT + m * PB + n * 2) = pk4(o); } }
}
__device__ __forceinline__ void scanA_task(Frame& F, int task) {
    LAS unsigned char* lds = F.lds; const int wave = F.wave, lane = F.lane;
    const int sc = task & 31, bh = task >> 5, h = bh & 7, b = bh >> 3;
    const int m = ACC_M(wave, lane);
    f32x4 gacc[2], xacc[2];
#pragma unroll
    for (int j = 0; j < 2; ++j) { const int n = ACC_N(wave, lane, j);
#pragma unroll
        for (int r = 0; r < 4; ++r) { gacc[j][r] = (m == n + r) ? 1.f : 0.f; xacc[j][r] = 0.f; } }
    TS_BEGIN(70); TS_BEGIN(71);
    const ChanConst kc = chan_const(F, h);
    ChunkRaw raw; chunk_load(F, b * TP + sc * 256, h, raw);
    TS_END(71);
    for (int c = 0; c < 4; ++c) {
        TS_BEGIN(72); LBAR();
        chunk_stage<false>(F, raw, kc, h, CA_KQ, 0, CA_KD, CA_BD, CA_VT, CA_KET, CA_BET, CA_RHI, CA_RLO, CA_LB, CA_SMALL);
        if (REP_PHASE == 702) { LBAR(); chunk_stage<false>(F, raw, kc, h, CA_KQ, 0, CA_KD, CA_BD, CA_VT, CA_KET, CA_BET, CA_RHI, CA_RLO, CA_LB, CA_SMALL); }
        LBAR(); TS_END(72); TS_BEGIN(73);
        make_L(lds + CA_KQ, lds + CA_BD, lds + CA_LB, lds + CA_LOFFT, wave, lane);
        if (REP_PHASE == 711) { LBAR(); make_L(lds + CA_KQ, lds + CA_BD, lds + CA_LB, lds + CA_LOFFT, wave, lane); }
        __builtin_amdgcn_sched_barrier(0);
        { f32x4 a[2]; ACC_ZERO(a); mm_nt(a, lds + CA_KQ, lds + CA_KD, wave, lane);
#pragma unroll
          for (int j = 0; j < 2; ++j) { const int n = ACC_N(wave, lane, j); f32x4 o;
#pragma unroll
              for (int r = 0; r < 4; ++r) o[r] = (n + r < m) ? a[j][r] : 0.f;
              *(LAS unsigned long long*)(lds + CA_LK + m * PB + n * 2) = pk4(o); } }
        LBAR(); TS_END(73); TS_BEGIN(74);
        solve_td(lds + CA_LB, lds + CA_TD, wave, lane);
        if (REP_PHASE == 712) { LBAR(); solve_td(lds + CA_LB, lds + CA_TD, wave, lane); }
        __builtin_amdgcn_sched_barrier(0);
        { f32x4 a[2]; ACC_ZERO(a); mm_nt(a, lds + CA_VT, lds + CA_LK, wave, lane);
          store_hilo_rows(a, lds + CA_RHI, lds + CA_RLO, 64, wave, lane); }
        for (int idx = F.tid; idx < 128 * 9; idx += 512) *(LAS v4u*)(lds + CA_KD + idx * 16) = (v4u){0u, 0u, 0u, 0u};
        __builtin_amdgcn_sched_barrier(0);
        if (c < 3) chunk_load(F, b * TP + sc * 256 + (c + 1) * 64, h, raw);
        LBAR(); TS_END(74); TS_BEGIN(75);
        solve_md(lds + CA_LOFFT, lds + CA_TD, lds + CA_MD, wave, lane);
        LBAR();
        solve_chain<8>(lds + CA_TD, lds + CA_MD, lds + CA_RHI, lds + CA_RLO, lds + CA_KD, wave, lane);
        if (REP_PHASE == 713) { LBAR(); solve_md(lds + CA_LOFFT, lds + CA_TD, lds + CA_MD, wave, lane); LBAR(); solve_chain<8>(lds + CA_TD, lds + CA_MD, lds + CA_RHI, lds + CA_RLO, lds + CA_KD, wave, lane); }
        LBAR(); TS_END(75); TS_BEGIN(76);
        f32x4 pt[2], xc[2];
        { f32x4 a[2]; ACC_ZERO(a); mm_nt(a, lds + CA_BET, lds + CA_KD, wave, lane);
          const LAS float* GL = (const LAS float*)(lds + CA_SMALL + SM_GL);
#pragma unroll
          for (int j = 0; j < 2; ++j) { const int n = ACC_N(wave, lane, j);
#pragma unroll
              for (int r = 0; r < 4; ++r) pt[j][r] = ((m == n + r) ? GL[n + r] : 0.f) - a[j][r]; } }
        __builtin_amdgcn_sched_barrier(0);
        { f32x4 a1[2], a2[2]; ACC_ZERO(a1); ACC_ZERO(a2);
          mm_nt(a1, lds + CA_VT, lds + CA_KET, wave, lane); mm_nt(a2, lds + CA_KD + 64 * PB, lds + CA_BET, wave, lane);
          xc[0] = a1[0] - a2[0]; xc[1] = a1[1] - a2[1]; }
        __builtin_amdgcn_sched_barrier(0);
        store_hilo(pt, lds + CA_KQ, lds + CA_LK, wave, lane);
        store_hilo(gacc, lds + 0, lds + MB16, wave, lane);
        store_hilo(xacc, lds + 2 * MB16, lds + 3 * MB16, wave, lane);
        LBAR();
        { f32x4 a[2]; ACC_ZERO(a);
          mm_nt(a, lds + 0, lds + CA_KQ, wave, lane); mm_nt(a, lds + 0, lds + CA_LK, wave, lane); mm_nt(a, lds + MB16, lds + CA_KQ, wave, lane);
          gacc[0] = a[0]; gacc[1] = a[1]; }
        __builtin_amdgcn_sched_barrier(0);
        { f32x4 a[2]; a[0] = xc[0]; a[1] = xc[1];
          mm_nt(a, lds + 2 * MB16, lds + CA_KQ, wave, lane); mm_nt(a, lds + 2 * MB16, lds + CA_LK, wave, lane); mm_nt(a, lds + 3 * MB16, lds + CA_KQ, wave, lane);
          xacc[0] = a[0]; xacc[1] = a[1]; }
        TS_END(76);
    }
    TS_BEGIN(77);
    float* GT = (float*)(F.ws + WS_GX + (size_t)task * 32768); float* XO = GT + 4096;
    int lz = lane; asm volatile("" : "+v"(lz));
    const int m2 = ACC_M(wave, lz);
#pragma unroll
    for (int j = 0; j < 2; ++j) { const int n = ACC_N(wave, lz, j);
#pragma unroll
        for (int r = 0; r < 4; ++r) GT[(n + r) * 64 + m2] = gacc[j][r];
        *(f32x4*)(XO + m2 * 64 + n) = xacc[j]; }
    TS_END(77); TS_END(70);
}
__device__ __forceinline__ void scanB_unit(Frame& F, int bh) {
    LAS unsigned char* lds = F.lds; const int wave = F.wave, lane = F.lane, tid = F.tid, lr = lane & 15, lq = lane >> 4;
    constexpr int GTB = 2 * MB16;
    LAS unsigned char* myS = lds + 2 * GTB + wave * (2 * 16 * PB);
    const int row = tid >> 3, c8 = (tid & 7) * 8;
    const float* G0 = (const float*)(F.ws + WS_GX + (size_t)(bh * 32) * 32768);
#define SB_PUT(buf, ga, gb) do { const unsigned long long h0_ = pk4(ga), h1_ = pk4(gb); const f32x4 l0_ = ga - bf4_to_f32(h0_), l1_ = gb - bf4_to_f32(h1_); const unsigned long long q0_ = pk4(l0_), q1_ = pk4(l1_); \
        *(LAS v4u*)(lds + (buf) * GTB + row * PB + c8 * 2) = (v4u){(unsigned)h0_, (unsigned)(h0_ >> 32), (unsigned)h1_, (unsigned)(h1_ >> 32)}; \
        *(LAS v4u*)(lds + (buf) * GTB + MB16 + row * PB + c8 * 2) = (v4u){(unsigned)q0_, (unsigned)(q0_ >> 32), (unsigned)q1_, (unsigned)(q1_ >> 32)}; } while (0)
    f32x4 g0 = *(const f32x4*)(G0 + row * 64 + c8), g1 = *(const f32x4*)(G0 + row * 64 + c8 + 4);
    __syncthreads();
    SB_PUT(0, g0, g1);
    g0 = *(const f32x4*)(G0 + 8192 + row * 64 + c8); g1 = *(const f32x4*)(G0 + 8192 + row * 64 + c8 + 4);
    f32x4 s[4], x[4];
#pragma unroll
    for (int tc = 0; tc < 4; ++tc) { s[tc] = (f32x4){0.f, 0.f, 0.f, 0.f}; x[tc] = s[tc]; }
    const int vrow = 16 * (wave & 3) + lr;
    if (wave < 4) {
#pragma unroll
        for (int tc = 0; tc < 4; ++tc) x[tc] = *(const f32x4*)(G0 + 4096 + vrow * 64 + 16 * tc + 4 * lq); }
    __syncthreads();
    for (int sc = 0; sc < 32; ++sc) {
        const int task = bh * 32 + sc;
        if (wave < 4) {
            float* S0 = (float*)(F.ws + WS_S0 + (size_t)task * 16384);
#pragma unroll
            for (int tc = 0; tc < 4; ++tc) { *(f32x4*)(S0 + vrow * 64 + 16 * tc + 4 * lq) = s[tc];
                const unsigned long long hi = pk4(s[tc]); const f32x4 lo = s[tc] - bf4_to_f32(hi);
                *(LAS unsigned long long*)(myS + lr * PB + (16 * tc + 4 * lq) * 2) = hi; *(LAS unsigned long long*)(myS + 16 * PB + lr * PB + (16 * tc + 4 * lq) * 2) = pk4(lo); }
            f32x4 a[4];
#pragma unroll
            for (int tc = 0; tc < 4; ++tc) a[tc] = x[tc];
            if (sc + 1 < 32) { const float* Xn = (const float*)(F.ws + WS_GX + (size_t)(task + 1) * 32768) + 4096;
#pragma unroll
                for (int tc = 0; tc < 4; ++tc) x[tc] = *(const f32x4*)(Xn + vrow * 64 + 16 * tc + 4 * lq); }
            LDS_WAIT(); asm volatile("" ::: "memory");
            const LAS unsigned char* gb = lds + (sc & 1) * GTB;
#pragma unroll
            for (int ks = 0; ks < 2; ++ks) {
                const bf16x8 xh = *(const LAS bf16x8*)(myS + lr * PB + ks * 64 + lq * 16), xl = *(const LAS bf16x8*)(myS + 16 * PB + lr * PB + ks * 64 + lq * 16);
#pragma unroll
                for (int tc = 0; tc < 4; ++tc) {
                    const bf16x8 yh = *(const LAS bf16x8*)(gb + (16 * tc + lr) * PB + ks * 64 + lq * 16), yl = *(const LAS bf16x8*)(gb + MB16 + (16 * tc + lr) * PB + ks * 64 + lq * 16);
                    a[tc] = __builtin_amdgcn_mfma_f32_16x16x32_bf16(yh, xh, a[tc], 0, 0, 0);
                    a[tc] = __builtin_amdgcn_mfma_f32_16x16x32_bf16(yl, xh, a[tc], 0, 0, 0);
                    a[tc] = __builtin_amdgcn_mfma_f32_16x16x32_bf16(yh, xl, a[tc], 0, 0, 0);
                }
            }
#pragma unroll
            for (int tc = 0; tc < 4; ++tc) s[tc] = a[tc];
        }
        if (sc + 1 < 32) SB_PUT((sc + 1) & 1, g0, g1);
        if (sc + 2 < 32) { const float* Gn = (const float*)(F.ws + WS_GX + (size_t)(task + 2) * 32768); g0 = *(const f32x4*)(Gn + row * 64 + c8); g1 = *(const f32x4*)(Gn + row * 64 + c8 + 4); }
        __syncthreads();
    }
#undef SB_PUT
}
__device__ __forceinline__ void scanC_task(Frame& F, int task) {
    LAS unsigned char* lds = F.lds; const int wave = F.wave, lane = F.lane;
    const int sc = task & 31, bh = task >> 5, h = bh & 7, b = bh >> 3;
    const int m = ACC_M(wave, lane);
    const bf16* GG = WSP(bf16, WS_G); bf16* MIX = WSP(bf16, WS_U);
    const int chn = h * 64 + lane; const float gnw = GIN(I_GNW)[chn], gnb = GIN(I_GNB)[chn];
    f32x4 s[2];
    { const float* S0 = (const float*)(F.ws + WS_S0 + (size_t)task * 16384);
#pragma unroll
      for (int j = 0; j < 2; ++j) { const int n = ACC_N(wave, lane, j); s[j] = *(const f32x4*)(S0 + m * 64 + n); } }
    const ChanConst kc = chan_const(F, h);
    ChunkRaw raw; chunk_load(F, b * TP + sc * 256, h, raw);
    for (int c = 0; c < 4; ++c) {
        const int m0 = b * TP + sc * 256 + c * 64;
        LBAR();
        chunk_stage<true>(F, raw, kc, h, CC_KQ, CC_RQ, CC_KD, CC_BD, CC_VT, CC_KET, CC_BET, 0, 0, CC_LB, CC_SMALL);
        store_hilo(s, lds + CC_SHI, lds + CC_SLO, wave, lane);
        LBAR();
        make_L(lds + CC_KQ, lds + CC_BD, lds + CC_LB, lds + CC_LOFFT, wave, lane);
        __builtin_amdgcn_sched_barrier(0);
        { f32x4 a[2]; ACC_ZERO(a); mm_nt(a, lds + CC_KQ, lds + CC_KD, wave, lane);
#pragma unroll
          for (int j = 0; j < 2; ++j) { const int n = ACC_N(wave, lane, j); f32x4 o;
#pragma unroll
              for (int r = 0; r < 4; ++r) o[r] = (n + r < m) ? a[j][r] : 0.f;
              *(LAS unsigned long long*)(lds + CC_LK + m * PB + n * 2) = pk4(o); } }
        __builtin_amdgcn_sched_barrier(0);
        { f32x4 a[2], a2[2]; ACC_ZERO(a); ACC_ZERO(a2); mm_nt(a, lds + CC_RQ, lds + CC_KD, wave, lane); mm_nt(a2, lds + CC_RQ, lds + CC_BD, wave, lane);
#pragma unroll
          for (int j = 0; j < 2; ++j) { const int n = ACC_N(wave, lane, j); f32x4 o, o2;
#pragma unroll
              for (int r = 0; r < 4; ++r) { o[r] = (n + r <= m) ? a[j][r] : 0.f; o2[r] = (n + r <= m) ? a2[j][r] : 0.f; }
              *(LAS unsigned long long*)(lds + CC_MK + m * PB + n * 2) = pk4(o); *(LAS unsigned long long*)(lds + CC_MB + m * PB + n * 2) = pk4(o2); } }
        LBAR();
        solve_td(lds + CC_LB, lds + CC_TD, wave, lane);
        __builtin_amdgcn_sched_barrier(0);
        { f32x4 a[2]; ACC_ZERO(a);
          mm_nt(a, lds + CC_SHI, lds + CC_KQ, wave, lane); mm_nt(a, lds + CC_SLO, lds + CC_KQ, wave, lane); mm_nt(a, lds + CC_VT, lds + CC_LK, wave, lane);
          store_hilo_rows(a, lds + CC_RHI, lds + CC_RLO, 0, wave, lane); }
        for (int idx = F.tid; idx < 64 * 9; idx += 512) *(LAS v4u*)(lds + CC_KD + idx * 16) = (v4u){0u, 0u, 0u, 0u};
        __builtin_amdgcn_sched_barrier(0);
        unsigned gq[8];
#pragma unroll
        for (int i8 = 0; i8 < 8; ++i8) gq[i8] = GG[(size_t)(m0 + wave + 8 * i8) * RW + chn];
        if (c < 3) chunk_load(F, m0 + 64, h, raw);
        LBAR();
        solve_md(lds + CC_LOFFT, lds + CC_TD, lds + CC_MD, wave, lane);
        LBAR();
        solve_chain<4>(lds + CC_TD, lds + CC_MD, lds + CC_RHI, lds + CC_RLO, lds + CC_KD, wave, lane);
        LBAR();
        { f32x4 a[2], a2[2]; ACC_ZERO(a); ACC_ZERO(a2);
          mm_nt(a, lds + CC_RQ, lds + CC_SHI, wave, lane); mm_nt(a, lds + CC_RQ, lds + CC_SLO, wave, lane); mm_nt(a, lds + CC_MK, lds + CC_VT, wave, lane);
          mm_nt(a2, lds + CC_MB, lds + CC_KD, wave, lane);
#pragma unroll
          for (int j = 0; j < 2; ++j) { const int n = ACC_N(wave, lane, j); *(LAS f32x4*)(lds + CC_LB + m * PF + n * 4) = a[j] - a2[j]; } }
        __builtin_amdgcn_sched_barrier(0);
        { f32x4 a1[2], a2[2]; ACC_ZERO(a1); ACC_ZERO(a2);
          mm_nt(a1, lds + CC_VT, lds + CC_KET, wave, lane); mm_nt(a2, lds + CC_KD, lds + CC_BET, wave, lane);
          const LAS float* GL = (const LAS float*)(lds + CC_SMALL + SM_GL);
#pragma unroll
          for (int j = 0; j < 2; ++j) { const int n = ACC_N(wave, lane, j); const f32x4 gl = *(const LAS f32x4*)(GL + n); s[j] = s[j] * gl + a1[j] - a2[j]; } }
        LBAR();
#pragma unroll
        for (int i8 = 0; i8 < 8; ++i8) {
            const int t = wave + 8 * i8, mm = m0 + t;
            const float y = *(const LAS float*)(lds + CC_LB + t * PF + lane * 4);
            const float mean = wave_sum_dpp(y) * (1.f / 64.f), d = y - mean, var = wave_sum_dpp(d * d) * (1.f / 64.f);
            const float yn = d * (1.0f / sqrtf(var + GN_EPS));
            const float dot = ((const LAS float*)(lds + CC_SMALL + SM_DOT))[t];
            const float v = bf2f(*(const LAS unsigned short*)(lds + CC_VT + lane * PB + t * 2));
            const float gg = bf2f((unsigned short)gq[i8]);
            MIX[(size_t)mm * D + chn] = (bf16)f2bf((yn * gnw + gnb + dot * v) * gg);
        }
    }
    if (sc == 31) { float* so = GOUT() + O_WKV_P + (size_t)bh * 4096;
        int lz = lane; asm volatile("" : "+v"(lz)); const int m2 = ACC_M(wave, lz);
#pragma unroll
        for (int j = 0; j < 2; ++j) { const int n = ACC_N(wave, lz, j); *(f32x4*)(so + m2 * 64 + n) = s[j]; } }
}
__device__ __forceinline__ int rel_bucket(int n) {
    if (n < 16) return n;
    const int b = 16 + (int)(logf((float)n * (1.0f / 16.0f)) / 2.0794415416798357f * 16.0f);
    return b < 31 ? b : 31;
}
typedef float f32x16 __attribute__((ext_vector_type(16)));
typedef short s16x4 __attribute__((ext_vector_type(4)));
struct AttnLane { const bf16* qrow; int qrel; int rmin; const LAS float* btab; float sink; bf16* orow; };
__device__ __forceinline__ void attn_core32(const LAS unsigned char* Kl, const LAS unsigned char* Vt, int VTP, int kt0, const AttnLane L, int lane) {
    const int r = lane & 31, h = lane >> 5;
    bf16x8 qf[4];
#pragma unroll
    for (int ds = 0; ds < 4; ++ds) qf[ds] = *(const bf16x8*)(L.qrow + 16 * ds + 8 * h);
    f32x16 sc[5];
#pragma unroll
    for (int T = 0; T < 5; ++T) {
#pragma unroll
        for (int e = 0; e < 16; ++e) sc[T][e] = 0.f;
#pragma unroll
        for (int ds = 0; ds < 4; ++ds) { const bf16x8 kf = *(const LAS bf16x8*)(Kl + ((kt0 + T) * 32 + r) * 144 + (16 * ds + 8 * h) * 2);
            sc[T] = __builtin_amdgcn_mfma_f32_32x32x16_bf16(kf, qf[ds], sc[T], 0, 0, 0); }
    }
    float mx = L.sink;
#pragma unroll
    for (int T = 0; T < 5; ++T)
#pragma unroll
        for (int e = 0; e < 16; ++e) { const int rabs = (kt0 + T) * 32 + (e & 3) + 8 * (e >> 2) + 4 * h, dist = L.qrel - rabs;
            const bool valid = dist >= 0 && dist < 128 && rabs >= L.rmin;
            const float s = valid ? sc[T][e] * 0.125f + L.btab[dist & 127] : -1e30f;
            sc[T][e] = s; mx = fmaxf(mx, s); }
    mx = fmaxf(mx, __shfl_xor(mx, 32));
    float l = 0.f;
#pragma unroll
    for (int T = 0; T < 5; ++T)
#pragma unroll
        for (int e = 0; e < 16; ++e) { const float p = sc[T][e] > -1e29f ? __expf(sc[T][e] - mx) : 0.f; sc[T][e] = p; l += p; }
    l += __shfl_xor(l, 32);
    l += __expf(L.sink - mx);
    f32x16 o[2];
#pragma unroll
    for (int e = 0; e < 16; ++e) { o[0][e] = 0.f; o[1][e] = 0.f; }
#pragma unroll
    for (int T = 0; T < 5; ++T)
#pragma unroll
        for (int s2 = 0; s2 < 2; ++s2) {
            v4u pw; pw.x = pk2(sc[T][8 * s2], sc[T][8 * s2 + 1]); pw.y = pk2(sc[T][8 * s2 + 2], sc[T][8 * s2 + 3]); pw.z = pk2(sc[T][8 * s2 + 4], sc[T][8 * s2 + 5]); pw.w = pk2(sc[T][8 * s2 + 6], sc[T][8 * s2 + 7]);
            const bf16x8 pb = __builtin_bit_cast(bf16x8, pw);
#pragma unroll
            for (int dt = 0; dt < 2; ++dt) {
                const LAS unsigned char* vp = Vt + (32 * dt + r) * VTP + ((kt0 + T) * 32 + 16 * s2 + 4 * h) * 2;
                const s16x4 lo = *(const LAS s16x4*)vp, hi = *(const LAS s16x4*)(vp + 16);
                const bf16x8 va = (bf16x8){lo[0], lo[1], lo[2], lo[3], hi[0], hi[1], hi[2], hi[3]};
                o[dt] = __builtin_amdgcn_mfma_f32_32x32x16_bf16(va, pb, o[dt], 0, 0, 0);
            }
        }
    const float il = 1.0f / l;
#pragma unroll
    for (int dt = 0; dt < 2; ++dt)
#pragma unroll
        for (int gq = 0; gq < 4; ++gq) { const int d = 32 * dt + 8 * gq + 4 * h;
            const unsigned long long w = (unsigned long long)pk2(o[dt][4 * gq] * il, o[dt][4 * gq + 1] * il) | ((unsigned long long)pk2(o[dt][4 * gq + 2] * il, o[dt][4 * gq + 3] * il) << 32);
            *(unsigned long long*)(L.orow + d) = w; }
}
constexpr int AP_K = 0, AP_VTP = 528, AP_VT = 256 * 144, AP_BT = AP_VT + 64 * AP_VTP, AP_END = AP_BT + 4 * 128 * 4;
__device__ __forceinline__ void attn_prompt_unit(Frame& F, int b, int kvh, int qb) {
    LAS unsigned char* lds = F.lds;
    const bf16* P = WSP(bf16, WS_H); bf16* MIX = WSP(bf16, WS_U); const float* relb = GIN(I_RELB);
    const int t0 = qb * 128, tid = F.tid;
    __syncthreads();
    for (int idx = tid; idx < 256 * 8; idx += 512) {
        const int row = idx >> 3, part = idx & 7, pos = t0 - 128 + row;
        v4u val = (v4u){0u, 0u, 0u, 0u};
        if (pos >= 0) val = *(const v4u*)(P + (size_t)(b * TP + pos) * NIN + 2304 + kvh * 64 + part * 8);
        *(LAS v4u*)(lds + AP_K + row * 144 + part * 16) = val;
    }
    for (int idx = tid; idx < 256 * 8; idx += 512) {
        const int row = idx & 255, part = idx >> 8, pos = t0 - 128 + row;
        v4u val = (v4u){0u, 0u, 0u, 0u};
        if (pos >= 0) val = *(const v4u*)(P + (size_t)(b * TP + pos) * NIN + 2432 + kvh * 64 + part * 8);
#pragma unroll
        for (int e = 0; e < 4; ++e) { *(LAS unsigned short*)(lds + AP_VT + (part * 8 + 2 * e) * AP_VTP + row * 2) = (unsigned short)(val[e] & 0xffffu);
                                      *(LAS unsigned short*)(lds + AP_VT + (part * 8 + 2 * e + 1) * AP_VTP + row * 2) = (unsigned short)(val[e] >> 16); }
    }
    { const int g = tid >> 7, dist = tid & 127; ((LAS float*)(lds + AP_BT))[g * 128 + dist] = relb[rel_bucket(dist) * 8 + kvh * 4 + g]; }
    __syncthreads();
    const int g = F.wave & 3, qh = F.wave >> 2, hq = kvh * 4 + g;
#pragma unroll 1
    for (int bq = 0; bq < 2; ++bq) {
        const int i = 64 * qh + 32 * bq + (F.lane & 31), m = b * TP + t0 + i;
        AttnLane L; L.qrow = P + (size_t)m * NIN + RWP + hq * 64; L.qrel = i + 128; L.rmin = t0 == 0 ? 128 : 0;
        L.btab = (const LAS float*)(lds + AP_BT) + g * 128; L.sink = GIN(I_SINKS)[hq]; L.orow = MIX + (size_t)m * D + RW + hq * 64;
        attn_core32(lds + AP_K, lds + AP_VT, AP_VTP, 2 * qh + bq, L, F.lane);
    }
}
static_assert(AP_END <= RING_BYTES && AP_VT % 16 == 0 && CC_SMALL + SM_BYTES <= RING_BYTES && CA_SMALL + SM_BYTES <= RING_BYTES, "LDS maps");
constexpr int AS_KB = 160 * 144, AS_VTP = 336, AS_VT = 2 * AS_KB, AS_VB = 64 * AS_VTP, AS_BT = AS_VT + 2 * AS_VB, AS_END = AS_BT + 8 * 128 * 4;
static_assert(AS_END <= RING_BYTES && AS_VT % 16 == 0 && AS_VB % 16 == 0, "LDS maps");
__device__ __forceinline__ void attn_sample_unit(Frame& F, int b) {
    LAS unsigned char* lds = F.lds;
    const bf16* P = WSP(bf16, WS_H); bf16* MIX = WSP(bf16, WS_U); const float* relb = GIN(I_RELB); const float* ck = GIN(I_CK); const float* cv = GIN(I_CV);
    const int tid = F.tid;
    __syncthreads();
    for (int idx = tid; idx < 160 * 32; idx += 512) {
        const int j = idx >> 5, c4 = (idx & 31) * 4, kvh = c4 >> 6, d = c4 & 63;
        f32x4 kx = (f32x4){0.f, 0.f, 0.f, 0.f}, vx = kx;
        if (j < 128) { kx = *(const f32x4*)(ck + (size_t)(b * 128 + j) * 128 + c4); vx = *(const f32x4*)(cv + (size_t)(b * 128 + j) * 128 + c4); }
        else if (j < 136) { const bf16* pr = P + (size_t)(MP + b * TS + (j - 128)) * NIN;
            const unsigned long long kw = *(const unsigned long long*)(pr + 2304 + c4), vw = *(const unsigned long long*)(pr + 2432 + c4); kx = bf4_to_f32(kw); vx = bf4_to_f32(vw); }
        *(LAS unsigned long long*)(lds + kvh * AS_KB + j * 144 + d * 2) = pk4(kx);
#pragma unroll
        for (int e = 0; e < 4; ++e) *(LAS unsigned short*)(lds + AS_VT + kvh * AS_VB + (d + e) * AS_VTP + j * 2) = (unsigned short)f2bf(vx[e]);
    }
    for (int idx = tid; idx < 1024; idx += 512) { const int hq = idx >> 7, dist = idx & 127; ((LAS float*)(lds + AS_BT))[idx] = relb[rel_bucket(dist) * 8 + hq]; }
    __syncthreads();
    if (F.wave < 2) {
        const int kvh = F.wave, rr = F.lane & 31, g = rr >> 3, t = rr & 7, hq = kvh * 4 + g, m = MP + b * TS + t;
        AttnLane L; L.qrow = P + (size_t)m * NIN + RWP + hq * 64; L.qrel = t + 128; L.rmin = 0;
        L.btab = (const LAS float*)(lds + AS_BT) + hq * 128; L.sink = GIN(I_SINKS)[hq]; L.orow = MIX + (size_t)m * D + RW + hq * 64;
        attn_core32(lds + kvh * AS_KB, lds + AS_VT + kvh * AS_VB, AS_VTP, 0, L, F.lane);
    }
}
enum { MT_SCANB = 0, MT_ATTN = 1, MT_SSCAN = 2, MT_SATTN = 3, MT_COPY = 4 };
__device__ __forceinline__ void mixer_task(Frame& F0, int kind, int idx) {
    Frame F = F0;
    { int t_ = threadIdx.x; asm volatile("" : "+v"(t_)); F.tid = t_; F.lane = t_ & 63; F.wave = __builtin_amdgcn_readfirstlane(t_ >> 6); }
#ifndef REP_PHASE
#define REP_PHASE -1
#endif
    if (kind == MT_SCANB) { scanB_unit(F, idx); if (REP_PHASE == 108) scanB_unit(F, idx); }
    else if (kind == MT_ATTN) { attn_prompt_unit(F, idx >> 7, (idx >> 6) & 1, idx & 63); if (REP_PHASE == 208) attn_prompt_unit(F, idx >> 7, (idx >> 6) & 1, idx & 63); }
    else if (kind == MT_SSCAN) { sample_scan_unit(F, idx); if (REP_PHASE == 308) sample_scan_unit(F, idx); }
    else if (kind == MT_SATTN) { attn_sample_unit(F, idx); if (REP_PHASE == 408) attn_sample_unit(F, idx); }
    else { copy_task(F, idx); if (REP_PHASE == 508) copy_task(F, idx); }
}
__device__ __forceinline__ void p_mixer(Frame& F) {
    const bool dealt = F.G == 256;
    const int ntot = 16 + 256 + 128 + 128 + NCOPY;
    for (int i = 0; ; ++i) {
        int kind = -1, idx = 0;
        if (dealt) {
            if (i >= 4) break;
            if (F.vcu < 16) { if (i == 0) { kind = MT_SCANB; idx = F.vcu; } }
            else { const int o = F.vcu - 16;
                if (o < 128) { if (i == 0) { kind = MT_SSCAN; idx = o; } else if (i == 1) { kind = MT_ATTN; idx = o; } }
                else { const int p = o - 128;
                    if (i == 0) { kind = MT_ATTN; idx = 128 + p; }
                    else if (p < 16) { if (i == 1) { kind = MT_ATTN; idx = 240 + p; } }
                    else { const int q = p - 16;
                        if (i == 1) { kind = MT_SATTN; idx = q; }
                        else if (i == 2) { if (q < 32) { kind = MT_SATTN; idx = 96 + q; } else { kind = MT_COPY; idx = q; } }
                        else if (q < 32) { kind = MT_COPY; idx = q; } } } }
        } else {
            const int t = F.vcu + i * F.G; if (t >= ntot) break;
            if (t < 16) { kind = MT_SCANB; idx = t; } else if (t < 272) { kind = MT_ATTN; idx = t - 16; } else if (t < 400) { kind = MT_SSCAN; idx = t - 272; }
            else if (t < 528) { kind = MT_SATTN; idx = t - 400; } else { kind = MT_COPY; idx = t - 528; }
        }
        if (kind >= 0) mixer_task(F, kind, idx);
    }
    __syncthreads();
}
__device__ __forceinline__ void p_scanA(Frame& F) { for (int t = F.vcu; t < 512; t += F.G) scanA_task(F, t); __syncthreads(); }
__device__ __forceinline__ void p_scanC(Frame& F) { for (int t = F.vcu; t < 512; t += F.G) scanC_task(F, t); __syncthreads(); }
#ifndef MK_PER_PHASE
#define MK_PER_PHASE 0
#endif
constexpr int N_PHASES = 15;
__global__ void __launch_bounds__(NWAVES * 64, 2) fwd_kernel(Args args) {
    extern __shared__ __attribute__((aligned(16))) unsigned char lds[];
    Frame F;
    F.lds = (LAS unsigned char*)lds;
    F.MISC = (volatile LAS unsigned*)(F.lds + MISC_OFF);
    F.tid = threadIdx.x; F.lane = F.tid & 63; F.wave = __builtin_amdgcn_readfirstlane(F.tid >> 6);
    F.G = gridDim.x; { const int bx = blockIdx.x; F.vcu = (F.G % 8 == 0) ? (bx % 8) * (F.G / 8) + bx / 8 : bx; }
    F.a = (const __attribute__((address_space(4))) Args*)__builtin_amdgcn_kernarg_segment_ptr(); F.ws = args.ws; F.ctl = (gu32*)(args.ws + WS_CTL);
    for (int u = F.tid; u < (LDS_BYTES - LDSCTL_OFF) / 4; u += NWAVES * 64) ((LAS unsigned*)(F.lds + LDSCTL_OFF))[u] = 0u;
    __syncthreads();
#ifdef SW_ID
    F.sw_acc = 0u; F.sw_t0 = 0ull;
#endif
    const int lo = args.ph_lo, hi = args.ph_hi;
    XcdBarrier bar; bar.bar = (unsigned*)(F.ctl + CW_BAR); bar.x = 0; bar.st = nullptr;
    if (hi - lo > 1) bar = xcd_barrier_post((unsigned*)(F.ctl + CW_BAR), F.MISC + 8);
#ifdef ONLY_PHASE
#define IN(k) ((k) == ONLY_PHASE && lo <= (k) && (k) < hi)
#else
#define IN(k) (lo <= (k) && (k) < hi)
#endif
#ifndef REP_PHASE
#define REP_PHASE -1
#endif
#define SEAM(k) do { if ((k) + 1 < hi) { TS_BEGIN(3000); TS_BEGIN(2000 + (k)); xcd_barrier(bar); TS_END(2000 + (k)); TS_END(3000); } } while (0)
#define PH(k, BODY) if (IN(k)) { { const __attribute__((address_space(4))) Args* a_ = (const __attribute__((address_space(4))) Args*)__builtin_amdgcn_kernarg_segment_ptr(); asm volatile("" : "+s"(a_)); F.a = a_; F.ws = (unsigned char*)(GAS unsigned char*)(a_->ws); }     TS_BEGIN(1000 + (k)); BODY; TS_END(1000 + (k)); if ((k) == REP_PHASE) { xcd_barrier(bar); BODY; } SEAM(k); }
#define GEMM_SWIGLU(WOFF) { \
        pg8::Gemm g{WSP(bf16, WS_U), WSP(bf16, WOFF), M, NFF, D}; pg8::StaticOrder S; S.init(M, NFF, F.G, (int)blockIdx.x, D); \
        pg8::EpiSwiglu E{WSP(bf16, WS_H), FF}; \
        pg8::gemm_phase<pg8::EpiSwiglu, pg8::StaticOrder, true, true>(F.lds + RING_OFF, g, S, E); }
#define GEMM_RESID(AOFF, WOFF, KK, XP, XS, GTK, GS) { \
        pg8::Gemm g{WSP(bf16, AOFF), WSP(bf16, WOFF), M, D, KK}; pg8::SliceOrder S; S.init(KK, F.G, (int)blockIdx.x); \
        pg8::EpiResid<GS> E{XP, XS, GOUT() + O_Y, WSP(float, WS_MOD) + (GTK) * D, WSP(float, WS_WLOG)}; \
        pg8::gemm_phase<pg8::EpiResid<GS>, pg8::SliceOrder, true, true>(F.lds + RING_OFF, g, S, E); }
#define GEMM_WIN() { \
        pg8::Gemm g{WSP(bf16, WS_U), WSP(bf16, WS_WIN), M, NIN, D}; pg8::StaticOrder S; S.init(M, NIN, F.G, (int)blockIdx.x, D); \
        pg8::EpiBf16<0> E{WSP(bf16, WS_H), NIN, nullptr, 0, 0, 1.f}; \
        pg8::gemm_phase<pg8::EpiBf16<0>, pg8::StaticOrder, true, true>(F.lds + RING_OFF, g, S, E); }
    PH(0, { p0_weights(F); if (REP_PHASE == 100) { __syncthreads(); p0_weights(F); } __syncthreads(); p0_mod(F); if (REP_PHASE == 101) { __syncthreads(); p0_mod(F); } })
    PH(1, p_modulate0(F))
    PH(2, GEMM_SWIGLU(WS_W1IN))
    PH(3, GEMM_RESID(WS_H, WS_W1OUT, FF, GIN(I_XP), GIN(I_XS), 2, 1))
    PH(4, p_layernorm(F, 0, 3 * D, FF / 256, args.in[I_XS], 2, 0.5f))
    PH(5, GEMM_WIN())
    PH(6, p_prep(F))
    PH(7, p_scanA(F))
    PH(8, p_mixer(F))
    PH(9, p_scanC(F))
    PH(10, GEMM_RESID(WS_U, WS_WOUT, D, GOUT() + O_Y, GOUT() + O_Y + (size_t)MP * D, 5, 2))
    PH(11, p_layernorm(F, 1, 6 * D, D / 256, GOUT() + O_Y + (size_t)MP * D, 5, 1.0f))
    PH(12, GEMM_SWIGLU(WS_W2IN))
    PH(13, GEMM_RESID(WS_H, WS_W2OUT, FF, GOUT() + O_Y, GOUT() + O_Y + (size_t)MP * D, 8, 1))
    PH(14, p_layernorm(F, 2, -1, FF / 256, GOUT() + O_Y + (size_t)MP * D, 8, 0.5f))
#ifdef SW_ID
    if (blockIdx.x == 0 && F.tid < 64) { const unsigned long long t0 = __builtin_amdgcn_s_memrealtime(); const unsigned long long want = (unsigned long long)F.sw_acc * SWX;
        while (__builtin_amdgcn_s_memrealtime() - t0 < want) __builtin_amdgcn_s_sleep(8); }
#endif
}

extern "C" void kernel_launch(void* const* d_in, const int* in_sizes, int n_in, void* d_out, int out_size, void* d_ws, size_t ws_size, hipStream_t stream) {
    static int grid = 0;
    if (grid == 0) {
        if (n_in != N_IN || in_sizes[0] != MP * D || out_size != (int)O_END || ws_size < WS_END) { fprintf(stderr, "kernel_launch: unexpected shapes (n_in %d, out %d, ws %zu); nothing launched\n", n_in, out_size, ws_size); grid = -1; return; }
        int dev = 0, cus = 0;
        if (hipGetDevice(&dev) != hipSuccess || hipDeviceGetAttribute(&cus, hipDeviceAttributeMultiprocessorCount, dev) != hipSuccess) { grid = -1; return; }
        if (hipFuncSetAttribute((const void*)fwd_kernel, hipFuncAttributeMaxDynamicSharedMemorySize, LDS_BYTES) != hipSuccess) { fprintf(stderr, "kernel_launch: hipFuncSetAttribute failed\n"); grid = -1; return; }
        int per_cu = 0;
        if (hipOccupancyMaxActiveBlocksPerMultiprocessor(&per_cu, (const void*)fwd_kernel, NWAVES * 64, LDS_BYTES) != hipSuccess || per_cu < 1) fprintf(stderr, "kernel_launch: occupancy query reports %d\n", per_cu);
        (void)hipGetLastError();
        grid = cus;
    }
    if (grid < 0) return;
    if (hipMemsetAsync((char*)d_ws + WS_CTL, 0, CTL_ZERO_BYTES, stream) != hipSuccess) return;
    Args a{};
    for (int i = 0; i < N_IN; ++i) a.in[i] = (const float*)d_in[i];
    a.out = (float*)d_out; a.ws = (unsigned char*)d_ws;
#if MK_PER_PHASE
    for (int ph = 0; ph < N_PHASES; ++ph) { a.ph_lo = ph; a.ph_hi = ph + 1; hipLaunchKernelGGL(fwd_kernel, dim3(grid), dim3(NWAVES * 64), LDS_BYTES, stream, a); }
#else
    a.ph_lo = 0; a.ph_hi = N_PHASES;
    hipLaunchKernelGGL(fwd_kernel, dim3(grid), dim3(NWAVES * 64), LDS_BYTES, stream, a);
#endif
}
```
